# Optimizing an MI355X kernel written in HIP

```python
import jax, jax.numpy as jnp
from jax import lax
import numpy as np

D_MODEL = 2048
BATCH = 2
SEQ = 4096
DEPTH = 2

HEAD_DIM = 128
N_HEADS = D_MODEL // HEAD_DIM
HEADS_DILATED = (3 * N_HEADS) // 8
HEADS_MOBA = (N_HEADS - HEADS_DILATED) // 2
HEADS_STICK = N_HEADS - HEADS_DILATED - HEADS_MOBA
DILATED_PATTERNS = ((128, 1), (512, 4), (2048, 16))
MOBA_BLOCK = 256
MOBA_TOPK = 3
MOBA_Q_CHUNK = 32
SB_BLOCK = 128
D_FF = 5632
N_EXPERTS = 8
TOP_K = 2
EPS = 1e-6

kernel_name = "hybrid_dilated_moba_stickbreaking_moe"


def rms_norm(x, gain):
    xf = x.astype(jnp.float32)
    y = xf * lax.rsqrt(jnp.mean(xf * xf, axis=-1, keepdims=True) + EPS)
    return (y * gain.astype(jnp.float32)).astype(x.dtype)


def alibi_slopes():
    n = HEADS_DILATED + HEADS_MOBA
    s = jnp.asarray(2.0 ** (-8.0 * np.arange(1, n + 1) / n), dtype=jnp.float32)
    return s[:HEADS_DILATED], s[HEADS_DILATED:]


def dilated_branch(q, k, v, slopes, window, dilation):
    B, H, S, Dh = q.shape
    span = window // dilation
    L = S // dilation
    nblk = -(-L // span)
    Lp = nblk * span

    def to_blocks(a):
        a = a.reshape(B, H, L, dilation, Dh).transpose(0, 1, 3, 2, 4)
        a = jnp.pad(a, ((0, 0), (0, 0), (0, 0), (0, Lp - L), (0, 0)))
        return a.reshape(B, H, dilation, nblk, span, Dh)

    def with_prev(a):
        prev = jnp.pad(a, ((0, 0), (0, 0), (0, 0), (1, 0), (0, 0), (0, 0)))[:, :, :, :-1]
        return jnp.concatenate([prev, a], axis=4)

    qb = to_blocks(q)
    kc = with_prev(to_blocks(k))
    vc = with_prev(to_blocks(v))
    s = jnp.einsum('bhrnqd,bhrnkd->bhrnqk', qb, kc) * (Dh ** -0.5)
    qi = jnp.arange(span)[:, None]
    kj = jnp.arange(2 * span)[None, :]
    steps = qi + span - kj
    key_sub = jnp.arange(nblk)[:, None, None] * span + kj[None] - span
    valid = (steps >= 0) & (steps <= span) & (key_sub >= 0)
    dist = (steps * dilation).astype(jnp.float32)
    s = s - slopes[None, :, None, None, None, None] * dist
    s = jnp.where(valid, s, -jnp.inf)
    m = jnp.max(s, axis=-1, keepdims=True)
    p = jnp.exp(s - m)
    l = jnp.sum(p, axis=-1)
    o = jnp.einsum('bhrnqk,bhrnkd->bhrnqd', p, vc) / l[..., None]
    lse = m[..., 0] + jnp.log(l)
    o = o.reshape(B, H, dilation, Lp, Dh)[:, :, :, :L].transpose(0, 1, 3, 2, 4).reshape(B, H, S, Dh)
    lse = lse.reshape(B, H, dilation, Lp)[..., :L].transpose(0, 1, 3, 2).reshape(B, H, S)
    return o, lse


def dilated_attention(q, k, v, slopes):
    results = [dilated_branch(q, k, v, slopes, w, d) for w, d in DILATED_PATTERNS]
    outs = jnp.stack([r[0] for r in results])
    lses = jnp.stack([r[1] for r in results])
    wts = jax.nn.softmax(lses, axis=0)
    return jnp.sum(wts[..., None] * outs, axis=0)


def moba_attention(q, k, v, slopes):
    B, H, S, Dh = q.shape
    nb = -(-S // MOBA_BLOCK)
    Sp = nb * MOBA_BLOCK
    pad = ((0, 0), (0, 0), (0, Sp - S), (0, 0))
    qp, kp, vp = jnp.pad(q, pad), jnp.pad(k, pad), jnp.pad(v, pad)
    kblk = kp.reshape(B, H, nb, MOBA_BLOCK, Dh)
    vblk = vp.reshape(B, H, nb, MOBA_BLOCK, Dh)
    kmean = jnp.mean(kblk, axis=3)
    topk = min(MOBA_TOPK, nb)
    n_chunks = Sp // MOBA_Q_CHUNK
    qc = qp.reshape(B, H, n_chunks, MOBA_Q_CHUNK, Dh).transpose(2, 0, 1, 3, 4)
    scale = Dh ** -0.5
    offs = jnp.arange(MOBA_BLOCK)
    blk_ids = jnp.arange(nb)
    gather = jax.vmap(jax.vmap(lambda blocks, idx: blocks[idx]))

    def step(args):
        qi, c = args
        pos = c * MOBA_Q_CHUNK + jnp.arange(MOBA_Q_CHUNK)
        own = (c * MOBA_Q_CHUNK) // MOBA_BLOCK
        gate = jnp.einsum('bhqd,bhnd->bhqn', qi, kmean)
        past = blk_ids[None, :] < (pos // MOBA_BLOCK)[:, None]
        gate = jnp.where(past, gate, -jnp.inf)
        gval, gidx = lax.top_k(gate, topk)
        ksel = gather(kblk, gidx)
        vsel = gather(vblk, gidx)
        s_sel = jnp.einsum('bhqd,bhqtkd->bhqtk', qi, ksel) * scale
        kpos_sel = gidx[..., None] * MOBA_BLOCK + offs
        dist_sel = (pos[:, None, None] - kpos_sel).astype(jnp.float32)
        s_sel = s_sel - slopes[None, :, None, None, None] * dist_sel
        s_sel = jnp.where((gval > -jnp.inf)[..., None], s_sel, -jnp.inf)
        kown = lax.dynamic_slice_in_dim(kp, own * MOBA_BLOCK, MOBA_BLOCK, axis=2)
        vown = lax.dynamic_slice_in_dim(vp, own * MOBA_BLOCK, MOBA_BLOCK, axis=2)
        s_own = jnp.einsum('bhqd,bhkd->bhqk', qi, kown) * scale
        dist_own = pos[:, None] - (own * MOBA_BLOCK + offs)[None, :]
        s_own = s_own - slopes[None, :, None, None] * dist_own.astype(jnp.float32)
        s_own = jnp.where(dist_own >= 0, s_own, -jnp.inf)
        s = jnp.concatenate([s_sel.reshape(B, H, MOBA_Q_CHUNK, topk * MOBA_BLOCK), s_own], axis=-1)
        p = jax.nn.softmax(s, axis=-1)
        p_sel = p[..., :topk * MOBA_BLOCK].reshape(B, H, MOBA_Q_CHUNK, topk, MOBA_BLOCK)
        p_own = p[..., topk * MOBA_BLOCK:]
        return (jnp.einsum('bhqtk,bhqtkd->bhqd', p_sel, vsel)
                + jnp.einsum('bhqk,bhkd->bhqd', p_own, vown))

    out = lax.map(step, (qc, jnp.arange(n_chunks)))
    return out.transpose(1, 2, 0, 3, 4).reshape(B, H, Sp, Dh)[:, :, :S]


def stick_breaking_attention(q, k, v):
    B, H, S, Dh = q.shape
    nq = S // SB_BLOCK
    qc = q.reshape(B, H, nq, SB_BLOCK, Dh).transpose(2, 0, 1, 3, 4)
    kpos = jnp.arange(S)
    scale = Dh ** -0.5

    def step(args):
        qi, c = args
        pos = c * SB_BLOCK + jnp.arange(SB_BLOCK)
        z = jnp.einsum('bhqd,bhkd->bhqk', qi, k) * scale
        past = kpos[None, :] < pos[:, None]
        log_1m = jnp.where(past, jax.nn.log_sigmoid(-z), 0.0)
        after = lax.cumsum(log_1m, axis=3, reverse=True) - log_1m
        a = jnp.where(past, jnp.exp(jax.nn.log_sigmoid(z) + after), 0.0)
        return jnp.einsum('bhqk,bhkd->bhqd', a, v)

    out = lax.map(step, (qc, jnp.arange(nq)))
    return out.transpose(1, 2, 0, 3, 4).reshape(B, H, S, Dh)


def hybrid_mixer(h, w_in, q_gain, k_gain, out_gain, w_out, slopes_a, slopes_b):
    B, S, D = h.shape
    qkv = (h @ w_in).reshape(B, S, 3, N_HEADS, HEAD_DIM).transpose(2, 0, 3, 1, 4)
    q, k, v = qkv[0], qkv[1], qkv[2]
    a1 = HEADS_DILATED
    a2 = HEADS_DILATED + HEADS_MOBA
    f32 = jnp.float32
    qa = rms_norm(q[:, :a1], q_gain[0]).astype(f32)
    ka = rms_norm(k[:, :a1], k_gain[0]).astype(f32)
    qb = rms_norm(q[:, a1:a2], q_gain[1]).astype(f32)
    kb = rms_norm(k[:, a1:a2], k_gain[1]).astype(f32)
    oa = dilated_attention(qa, ka, v[:, :a1].astype(f32), slopes_a)
    ob = moba_attention(qb, kb, v[:, a1:a2].astype(f32), slopes_b)
    oc = stick_breaking_attention(q[:, a2:].astype(f32), k[:, a2:].astype(f32), v[:, a2:].astype(f32))
    o = jnp.concatenate([oa, ob, oc], axis=1)
    o = rms_norm(o, out_gain.reshape(N_HEADS, 1, HEAD_DIM))
    o = o.transpose(0, 2, 1, 3).reshape(B, S, D).astype(h.dtype)
    return o @ w_out


def swiglu(h, w_gate, w_up, w_down):
    return (jax.nn.silu(h @ w_gate) * (h @ w_up)) @ w_down


def moe_swiglu(h, router, w_gate, w_up, w_down):
    B, S, D = h.shape
    t = h.reshape(B * S, D)
    logits = (t @ router).astype(jnp.float32)
    topv, topi = lax.top_k(logits, TOP_K)
    gates = jax.nn.softmax(topv, axis=-1)
    combine = jnp.sum(jax.nn.one_hot(topi, N_EXPERTS, dtype=jnp.float32) * gates[..., None], axis=1)
    combine = combine.astype(h.dtype)
    out = jnp.zeros_like(t)
    for e in range(N_EXPERTS):
        out = out + combine[:, e:e + 1] * swiglu(t, w_gate[e], w_up[e], w_down[e])
    return out.reshape(B, S, D)


def setup_inputs(seed: int = 0) -> dict:
    key = jax.random.key(seed)
    ks = jax.random.split(key, 16)
    D, F, E = D_MODEL, D_FF, N_EXPERTS
    nd, nm = (DEPTH + 1) // 2, DEPTH // 2

    def normal(k, shape, scale):
        return jax.random.normal(k, shape, jnp.float32) * scale

    def gain(k, shape):
        return 1.0 + 0.02 * jax.random.normal(k, shape, jnp.float32)

    return {
        "x": normal(ks[0], (BATCH, SEQ, D), 1.0),
        "attn_norm": gain(ks[1], (DEPTH, D)),
        "w_in": normal(ks[2], (DEPTH, D, 3 * D), D ** -0.5),
        "q_gain": gain(ks[3], (DEPTH, 2, HEAD_DIM)),
        "k_gain": gain(ks[4], (DEPTH, 2, HEAD_DIM)),
        "out_gain": gain(ks[5], (DEPTH, D)),
        "w_out": normal(ks[6], (DEPTH, D, D), D ** -0.5),
        "ffn_norm": gain(ks[7], (DEPTH, D)),
        "dense_w_gate": normal(ks[8], (nd, D, F), D ** -0.5),
        "dense_w_up": normal(ks[9], (nd, D, F), D ** -0.5),
        "dense_w_down": normal(ks[10], (nd, F, D), F ** -0.5),
        "moe_router": normal(ks[11], (nm, D, E), D ** -0.5),
        "moe_w_gate": normal(ks[12], (nm, E, D, F), D ** -0.5),
        "moe_w_up": normal(ks[13], (nm, E, D, F), D ** -0.5),
        "moe_w_down": normal(ks[14], (nm, E, F, D), F ** -0.5),
    }


def reference(x, attn_norm, w_in, q_gain, k_gain, out_gain, w_out, ffn_norm,
              dense_w_gate, dense_w_up, dense_w_down,
              moe_router, moe_w_gate, moe_w_up, moe_w_down):
    slopes_a, slopes_b = alibi_slopes()
    h = x
    for layer in range(DEPTH):
        a = rms_norm(h, attn_norm[layer])
        h = h + hybrid_mixer(a, w_in[layer], q_gain[layer], k_gain[layer], out_gain[layer],
                             w_out[layer], slopes_a, slopes_b)
        f = rms_norm(h, ffn_norm[layer])
        i = layer // 2
        if layer % 2 == 0:
            h = h + swiglu(f, dense_w_gate[i], dense_w_up[i], dense_w_down[i])
        else:
            h = h + moe_swiglu(f, moe_router[i], moe_w_gate[i], moe_w_up[i], moe_w_down[i])
    return h
```

```cpp
#include <hip/hip_runtime.h>
#include <cstdio>
#include <cstdint>
namespace pg8 {
#define PG8_LAS __attribute__((address_space(3)))
typedef unsigned short bf16_t;
typedef short bf16x8 __attribute__((ext_vector_type(8)));
typedef float f32x4 __attribute__((ext_vector_type(4)));
typedef unsigned u32x4 __attribute__((ext_vector_type(4)));
constexpr int BM = 256, BK = 64, HALF = 128, HTB = HALF * BK * 2  , STAGE_BYTES = 8 * HTB, NXCD = 8, WGM = 8;

__host__ __device__ __forceinline__ int lds_byte(int r, int c) { const int st = (r >> 4) * 2 + (c >> 5), rr = r & 15, cc = c & 31, ob = rr * 64 + cc * 2; return st * 1024 + (ob ^ (((ob >> 9) & 1) << 5)); }
__host__ __device__ __forceinline__ void stage_rc(int b, int& R, int& C) { const int st = b / 1024, sb = b % 1024, swz = sb ^ (((sb >> 9) & 1) << 5); R = (st >> 1) * 16 + swz / 64; C = (st & 1) * 32 + (swz % 64) / 2; }
__host__ __device__ __forceinline__ int perm32(int rho) { const int n = rho >> 4, i = rho & 15; return 8 * (i >> 2) + 4 * n + (i & 3); }

struct Unit { int pm, pn; size_t bofs; };
struct Gemm { const bf16_t* A; const bf16_t* Bt; int M, N, K; };

struct StaticOrder {
    int nM, nN, nwg, G, c;
    __host__ __device__ void init(int M, int N, int G_, int c_) { nM = M / BM; nN = N / BM; nwg = nM * nN; G = G_; c = c_; }
    __host__ __device__ bool next(int i, Unit& u) const {
        const long L = (long)i * G + c; if (L >= nwg) return false;
        int wgid = (int)L; { const int q = nwg / NXCD, r = nwg % NXCD, xcd = wgid % NXCD, off = wgid / NXCD; wgid = (xcd < r ? xcd * (q + 1) : r * (q + 1) + (xcd - r) * q) + off; }
        const int nig = WGM * nN, gid = wgid / nig, fm = gid * WGM, gsz = (nM - fm) < WGM ? (nM - fm) : WGM;
        u.pm = fm + ((wgid % nig) % gsz); u.pn = (wgid % nig) / gsz; u.bofs = 0; return true;
    }
    __device__ __forceinline__ void a_ready(const Unit&) const {}
    __device__ __forceinline__ void done(const Unit&) const {}
};

__device__ __forceinline__ unsigned cvt_pk_bf16(float lo, float hi) { unsigned r; asm volatile("v_cvt_pk_bf16_f32 %0, %1, %2" : "=v"(r) : "v"(lo), "v"(hi)); return r; }

struct GroupSched {
    int nMt, nN, nwg, G, c; int t1, t2, t3, t4, t5, t6, t7; size_t estride;
    __device__ __forceinline__ bool next(int i, Unit& u) const {
        const long L = (long)i * G + c; if (L >= nwg) return false;
        int wgid = (int)L; { const int q = nwg / NXCD, r = nwg % NXCD, xcd = wgid % NXCD, off = wgid / NXCD; wgid = (xcd < r ? xcd * (q + 1) : r * (q + 1) + (xcd - r) * q) + off; }
        const int nig = WGM * nN, gid = wgid / nig, fm = gid * WGM, gsz = (nMt - fm) < WGM ? (nMt - fm) : WGM;
        u.pm = fm + ((wgid % nig) % gsz); u.pn = (wgid % nig) / gsz;
        const int pm = u.pm;
        const int e = (pm >= t1) + (pm >= t2) + (pm >= t3) + (pm >= t4) + (pm >= t5) + (pm >= t6) + (pm >= t7);
        u.bofs = (size_t)e * estride; return true;
    }
    __device__ __forceinline__ void a_ready(const Unit&) const {}
    __device__ __forceinline__ void done(const Unit&) const {}
};

struct EpiStoreBf16 {
    static constexpr bool PERM = true, AFTER_DRAIN = false;
    bf16_t* O; int ldc;
    __device__ __forceinline__ void operator()(const f32x4 (&acc)[2][2][4][2], const Unit& u, int wr, int wc, int fr, int fq) const {
        const int row0 = u.pm * BM + wr * 64 + fr, col0 = u.pn * BM + wc * 32 + 8 * fq;
#pragma unroll
        for (int ai = 0; ai < 2; ++ai)
#pragma unroll
            for (int m = 0; m < 4; ++m) { bf16_t* rowp = O + (size_t)(row0 + ai * HALF + m * 16) * ldc + col0;
#pragma unroll
                for (int bj = 0; bj < 2; ++bj) { const f32x4 v0 = acc[ai][bj][m][0], v1 = acc[ai][bj][m][1];
                    u32x4 w; w.x = cvt_pk_bf16(v0[0], v0[1]); w.y = cvt_pk_bf16(v0[2], v0[3]); w.z = cvt_pk_bf16(v1[0], v1[1]); w.w = cvt_pk_bf16(v1[2], v1[3]);
                    *(u32x4*)(rowp + bj * HALF) = w; } }
    }
};
__device__ __forceinline__ float silu_mul(float g, float u) { const float e = __builtin_amdgcn_exp2f(g * -1.4426950408889634f); return g * __builtin_amdgcn_rcpf(1.0f + e) * u; }
struct EpiSwiGLU {
    static constexpr bool PERM = true, AFTER_DRAIN = false;
    bf16_t* O; int ldc;
    __device__ __forceinline__ void operator()(const f32x4 (&acc)[2][2][4][2], const Unit& u, int wr, int wc, int fr, int fq) const {
        const int row0 = u.pm * BM + wr * 64 + fr, col0 = u.pn * HALF + wc * 32 + 8 * fq;
#pragma unroll
        for (int ai = 0; ai < 2; ++ai)
#pragma unroll
            for (int m = 0; m < 4; ++m) { bf16_t* rowp = O + (size_t)(row0 + ai * HALF + m * 16) * ldc + col0;
                const f32x4 g0 = acc[ai][0][m][0], g1 = acc[ai][0][m][1], u0 = acc[ai][1][m][0], u1 = acc[ai][1][m][1];
                u32x4 w; w.x = cvt_pk_bf16(silu_mul(g0[0], u0[0]), silu_mul(g0[1], u0[1])); w.y = cvt_pk_bf16(silu_mul(g0[2], u0[2]), silu_mul(g0[3], u0[3]));
                w.z = cvt_pk_bf16(silu_mul(g1[0], u1[0]), silu_mul(g1[1], u1[1])); w.w = cvt_pk_bf16(silu_mul(g1[2], u1[2]), silu_mul(g1[3], u1[3]));
                *(u32x4*)rowp = w; }
    }
};
struct EpiResF32 {
    static constexpr bool PERM = true, AFTER_DRAIN = false;
    const float* base; float* out; int ldc;
    __device__ __forceinline__ void operator()(const f32x4 (&acc)[2][2][4][2], const Unit& u, int wr, int wc, int fr, int fq) const {
        const int row0 = u.pm * BM + wr * 64 + fr, col0 = u.pn * BM + wc * 32 + 8 * fq;
#pragma unroll
        for (int ai = 0; ai < 2; ++ai)
#pragma unroll
            for (int m = 0; m < 4; ++m) { const size_t off = (size_t)(row0 + ai * HALF + m * 16) * ldc + col0;
#pragma unroll
                for (int bj = 0; bj < 2; ++bj) { f32x4 v0 = acc[ai][bj][m][0], v1 = acc[ai][bj][m][1];
                    if (base) { v0 += *(const f32x4*)(base + off + bj * HALF); v1 += *(const f32x4*)(base + off + bj * HALF + 4); }
                    *(f32x4*)(out + off + bj * HALF) = v0; *(f32x4*)(out + off + bj * HALF + 4) = v1; } }
    }
};

template <class Epi, class Sched, bool ALIGN_EPI = false, bool SP2 = false>
__device__ __forceinline__ void gemm_phase(PG8_LAS unsigned char* lds, const Gemm g, const Sched& S, const Epi& E) {
    int tid_l = threadIdx.x; asm volatile("" : "+v"(tid_l));
    const int tid = tid_l, wid = __builtin_amdgcn_readfirstlane(tid >> 6), lane = tid & 63, wr = wid >> 2, wc = wid & 3, fr = lane & 15, fq = lane >> 4;
    const int K = g.K, nt = K / BK;
    unsigned voffA[2], voffB[2];
#pragma unroll
    for (int i = 0; i < 2; ++i) { int R, C; stage_rc(tid * 16 + i * 8192, R, C); const int Rb = Epi::PERM ? ((R & ~31) + perm32(R & 31)) : R;
        voffA[i] = (unsigned)(R * K + C) * 2u; voffB[i] = (unsigned)(Rb * K + C) * 2u; }
    const size_t kstep = (size_t)(BK * 2);
    const size_t hstep = (size_t)HALF * K * 2;
    const size_t tstep = 2 * hstep;
    const unsigned ldsw = (unsigned)wid * 1024u;
    const int aoff = lds_byte(wr * 64 + fr, fq * 8), boff = lds_byte(wc * 32 + fr, fq * 8);
#define PG8_SA(b, h) (((b) * 2 + (h)) * HTB)
#define PG8_SB(b, h) ((4 + (b) * 2 + (h)) * HTB)
#define PG8_STAGE(bufoff, gbase, voff) do { _Pragma("unroll") for (int _i = 0; _i < 2; ++_i) \
        __builtin_amdgcn_global_load_lds((const unsigned*)((const char*)(gbase) + (voff)[_i]), (PG8_LAS unsigned*)(lds + (bufoff) + ldsw + _i * 8192), 16, 0, 0); } while (0)
#define PG8_LDA(dst, b, h) do { _Pragma("unroll") for (int m = 0; m < 4; ++m) _Pragma("unroll") for (int k = 0; k < 2; ++k) dst[m][k] = *(const PG8_LAS bf16x8*)(lds + PG8_SA(b, h) + aoff + m * 2048 + k * 1024); } while (0)
#define PG8_LDB(dst, b, h) do { _Pragma("unroll") for (int n = 0; n < 2; ++n) _Pragma("unroll") for (int k = 0; k < 2; ++k) dst[n][k] = *(const PG8_LAS bf16x8*)(lds + PG8_SB(b, h) + boff + n * 2048 + k * 1024); } while (0)
#define PG8_MMA(ai, bj, At, Bt) do { __builtin_amdgcn_s_setprio(1); _Pragma("unroll") for (int m = 0; m < 4; ++m) _Pragma("unroll") for (int n = 0; n < 2; ++n) _Pragma("unroll") for (int k = 0; k < 2; ++k) \
        acc[ai][bj][m][n] = __builtin_amdgcn_mfma_f32_16x16x32_bf16(Bt[n][k], At[m][k], acc[ai][bj][m][n], 0, 0, 0); __builtin_amdgcn_s_setprio(0); } while (0)
#define PG8_WAIT_V(n) asm volatile("s_waitcnt vmcnt(" #n ")" ::: "memory")
#define PG8_WAIT_L(n) asm volatile("s_waitcnt lgkmcnt(" #n ")" ::: "memory")
#define PG8_BAR __builtin_amdgcn_s_barrier()
#define PG8_SCHED __builtin_amdgcn_sched_barrier(0)
    Unit cur, nxt; int ui = 0;
    if (!S.next(0, cur)) return;
    f32x4 acc[2][2][4][2];
#pragma unroll
    for (int a = 0; a < 2; ++a)
#pragma unroll
        for (int b = 0; b < 2; ++b)
#pragma unroll
            for (int m = 0; m < 4; ++m)
#pragma unroll
                for (int n = 0; n < 2; ++n) acc[a][b][m][n] = (f32x4){0.f, 0.f, 0.f, 0.f};
    bf16x8 At[4][2], B0[2][2], B1[2][2];
    const char* cA = (const char*)g.A + (size_t)cur.pm * tstep; const char* cB = (const char*)g.Bt + cur.bofs + (size_t)cur.pn * tstep;
    S.a_ready(cur);
    if constexpr (SP2) {
        PG8_STAGE(PG8_SB(0, 0), cB, voffB); PG8_STAGE(PG8_SB(0, 1), cB + hstep, voffB); PG8_STAGE(PG8_SA(0, 0), cA, voffA); PG8_STAGE(PG8_SA(0, 1), cA + hstep, voffA);
        if (wr == 1) PG8_BAR;
        PG8_WAIT_V(2); PG8_BAR;
        PG8_STAGE(PG8_SB(1, 0), cB + kstep, voffB); PG8_STAGE(PG8_SA(1, 0), cA + kstep, voffA); PG8_STAGE(PG8_SB(1, 1), cB + hstep + kstep, voffB);
        PG8_WAIT_V(6); PG8_BAR;
    } else {
        PG8_STAGE(PG8_SB(0, 0), cB, voffB); PG8_STAGE(PG8_SA(0, 0), cA, voffA); PG8_STAGE(PG8_SB(0, 1), cB + hstep, voffB); PG8_STAGE(PG8_SA(0, 1), cA + hstep, voffA);
        if (wr == 1) PG8_BAR;
        PG8_WAIT_V(4); PG8_BAR;
        PG8_STAGE(PG8_SB(1, 0), cB + kstep, voffB); PG8_STAGE(PG8_SA(1, 0), cA + kstep, voffA); PG8_STAGE(PG8_SB(1, 1), cB + hstep + kstep, voffB);
        PG8_WAIT_V(6); PG8_BAR;
    }
    for (;;) {
        const bool has_next = S.next(ui + 1, nxt);
        const char* nA = has_next ? (const char*)g.A + (size_t)nxt.pm * tstep : cA; const char* nB = has_next ? (const char*)g.Bt + nxt.bofs + (size_t)nxt.pn * tstep : cB;
        for (int t = 0; t < nt; t += 2) {
            const bool last = (t == nt - 2);
            const char* a1 = cA + (size_t)(t + 1) * kstep;
            const char* a2 = last ? nA : cA + (size_t)(t + 2) * kstep; const char* b2 = last ? nB : cB + (size_t)(t + 2) * kstep;
            const char* a3 = a2 + kstep; const char* b3 = b2 + kstep;
            if (last && has_next) S.a_ready(nxt);
            if constexpr (SP2) {
            PG8_LDB(B0, 0, 0); PG8_LDB(B1, 0, 1); PG8_SCHED; PG8_LDA(At, 0, 0); PG8_STAGE(PG8_SA(1, 1), a1 + hstep, voffA);
            PG8_WAIT_V(8); PG8_WAIT_L(0); PG8_BAR; PG8_MMA(0, 0, At, B0); PG8_MMA(0, 1, At, B1); PG8_BAR; PG8_SCHED;
            PG8_LDA(At, 0, 1); PG8_STAGE(PG8_SB(0, 0), b2, voffB); PG8_STAGE(PG8_SB(0, 1), b2 + hstep, voffB); PG8_STAGE(PG8_SA(0, 0), a2, voffA);
            PG8_WAIT_V(8); PG8_WAIT_L(0); PG8_BAR; PG8_MMA(1, 0, At, B0); PG8_MMA(1, 1, At, B1); PG8_BAR; PG8_SCHED;
            PG8_LDB(B0, 1, 0); PG8_LDB(B1, 1, 1); PG8_SCHED; PG8_LDA(At, 1, 0); PG8_STAGE(PG8_SA(0, 1), a2 + hstep, voffA);
            PG8_WAIT_V(8); PG8_WAIT_L(0); PG8_BAR; PG8_MMA(0, 0, At, B0); PG8_MMA(0, 1, At, B1); PG8_BAR; PG8_SCHED;
            PG8_LDA(At, 1, 1); PG8_STAGE(PG8_SB(1, 0), b3, voffB); PG8_STAGE(PG8_SB(1, 1), b3 + hstep, voffB); PG8_STAGE(PG8_SA(1, 0), a3, voffA);
            PG8_WAIT_V(8); PG8_WAIT_L(0); PG8_BAR; PG8_MMA(1, 0, At, B0); PG8_MMA(1, 1, At, B1); PG8_BAR; PG8_SCHED;
            } else {
            PG8_LDB(B0, 0, 0); PG8_SCHED; PG8_LDA(At, 0, 0); PG8_STAGE(PG8_SA(1, 1), a1 + hstep, voffA);
            PG8_WAIT_L(8); PG8_BAR; PG8_WAIT_L(0); PG8_MMA(0, 0, At, B0); PG8_BAR; PG8_SCHED;
            PG8_LDB(B1, 0, 1); PG8_STAGE(PG8_SB(0, 0), b2, voffB);
            PG8_BAR; PG8_WAIT_L(0); PG8_MMA(0, 1, At, B1); PG8_BAR;
            PG8_LDA(At, 0, 1); PG8_STAGE(PG8_SA(0, 0), a2, voffA);
            PG8_BAR; PG8_WAIT_L(0); PG8_MMA(1, 0, At, B0); PG8_BAR; PG8_SCHED;
            PG8_STAGE(PG8_SB(0, 1), b2 + hstep, voffB);
            PG8_WAIT_V(6); PG8_BAR; PG8_MMA(1, 1, At, B1); PG8_BAR;
            PG8_LDB(B0, 1, 0); PG8_SCHED; PG8_LDA(At, 1, 0); PG8_STAGE(PG8_SA(0, 1), a2 + hstep, voffA);
            PG8_WAIT_L(8); PG8_BAR; PG8_WAIT_L(0); PG8_MMA(0, 0, At, B0); PG8_BAR; PG8_SCHED;
            PG8_LDB(B1, 1, 1); PG8_STAGE(PG8_SB(1, 0), b3, voffB);
            PG8_BAR; PG8_WAIT_L(0); PG8_MMA(0, 1, At, B1); PG8_BAR;
            PG8_LDA(At, 1, 1); PG8_STAGE(PG8_SA(1, 0), a3, voffA);
            PG8_BAR; PG8_WAIT_L(0); PG8_MMA(1, 0, At, B0); PG8_BAR; PG8_SCHED;
            PG8_STAGE(PG8_SB(1, 1), b3 + hstep, voffB);
            PG8_WAIT_V(6); PG8_BAR; PG8_MMA(1, 1, At, B1); PG8_BAR;
            }
        }
        if constexpr (ALIGN_EPI) { if (wr == 0) PG8_BAR; }
        if constexpr (!Epi::AFTER_DRAIN) { E(acc, cur, wr, wc, fr, fq); S.done(cur); }
        if (!has_next) break;
#pragma unroll
        for (int a = 0; a < 2; ++a)
#pragma unroll
            for (int b = 0; b < 2; ++b)
#pragma unroll
                for (int m = 0; m < 4; ++m)
#pragma unroll
                    for (int n = 0; n < 2; ++n) acc[a][b][m][n] = (f32x4){0.f, 0.f, 0.f, 0.f};
        cur = nxt; cA = nA; cB = nB; ++ui;
        if constexpr (ALIGN_EPI) { if (wr == 1) PG8_BAR; }
    }
    PG8_WAIT_V(0);
    if constexpr (!ALIGN_EPI) { if (wr == 0) PG8_BAR; }
    PG8_BAR;
    if constexpr (Epi::AFTER_DRAIN) { E.fused(acc, cur, wr, wc, fr, fq, lds, wid, lane); S.done(cur); }
#undef PG8_SA
#undef PG8_SB
#undef PG8_STAGE
#undef PG8_LDA
#undef PG8_LDB
#undef PG8_MMA
#undef PG8_WAIT_V
#undef PG8_WAIT_L
#undef PG8_BAR
#undef PG8_SCHED
}
}

namespace att {
typedef unsigned short bf16;
typedef short bf16x8 __attribute__((ext_vector_type(8)));
typedef short s16x4 __attribute__((ext_vector_type(4)));
typedef float f32x16 __attribute__((ext_vector_type(16)));
typedef float f32x4 __attribute__((ext_vector_type(4)));
typedef unsigned u32x4 __attribute__((ext_vector_type(4)));
typedef int i32x4 __attribute__((ext_vector_type(4)));
constexpr int QS = 6144, SEQ = 4096, DM = 2048;
constexpr int SHM_T = 16384;
constexpr int L_V = 0, L_K = 2 * SHM_T, L_Q = 4 * SHM_T, L_WS = L_Q + 65536, L_TL = L_WS + 2048, L_FLG = L_TL + 256, L_MSK = L_FLG + 64, L_KM = L_V, L_END = L_MSK + 64;
static_assert(L_END <= 140 * 1024, "attention LDS map");
constexpr float C2 = 0.08838834764831845f * 1.4426950408889634f;
#define KSWZ(row, colB) ((row) * 256 + ((colB) ^ (((row) & 7) << 4)))
#define SBAR() __builtin_amdgcn_sched_barrier(0)
__device__ __forceinline__ int v_st(int k, int c) { const int kk = (k & ~0xC) | ((k & 4) << 1) | ((k & 8) >> 1); return ((kk >> 3) * 4 + (c >> 5)) * 512 + ((kk & 7) * 32 + (c & 31)) * 2; }
__device__ __forceinline__ int v_rd_base(int lane) { return ((lane & 3) << 3) | (((lane >> 2) & 3) << 6) | (((lane >> 4) & 1) << 5) | (((lane >> 5) & 1) << 8); }
constexpr int v_rd_off(int d0, int ks, int half) { return d0 * 512 + ks * 4096 + half * 2048; }
__device__ __forceinline__ int crow(int r, int hi) { return (r & 3) + 8 * (r >> 2) + 4 * hi; }
__device__ __forceinline__ unsigned cvtpk(float lo, float hi) { unsigned r; asm volatile("v_cvt_pk_bf16_f32 %0, %1, %2" : "=v"(r) : "v"(lo), "v"(hi)); return r; }
__device__ __forceinline__ float bf2f(short s) { return __uint_as_float(((unsigned)(unsigned short)s) << 16); }

__device__ __forceinline__ void qkt(f32x16& p0, f32x16& p1, const char* Kt, int r32, int hi, const char* qf  ) {
    p0 = f32x16{}; p1 = f32x16{};
    const char* kb[4];
#pragma unroll
    for (int dd = 0; dd < 4; ++dd) kb[dd] = Kt + KSWZ(r32, (dd * 16 + hi * 8) * 2);
#pragma unroll
    for (int d0 = 0; d0 < 8; ++d0) { const char* a = kb[d0 & 3] + (d0 >> 2) * 128;
        bf16x8 b0 = *reinterpret_cast<const bf16x8*>(a);
        bf16x8 b1 = *reinterpret_cast<const bf16x8*>(a + 32 * 256);
        const bf16x8 q = *reinterpret_cast<const bf16x8*>(qf + d0 * 1024);
        p0 = __builtin_amdgcn_mfma_f32_32x32x16_bf16(b0, q, p0, 0, 0, 0);
        p1 = __builtin_amdgcn_mfma_f32_32x32x16_bf16(b1, q, p1, 0, 0, 0); }
}
__device__ __forceinline__ void pv_tile(f32x16* o, int vb, bf16x8 pa0, bf16x8 pa1, bf16x8 pa2, bf16x8 pa3) {
#define TRRD(dst, off) asm volatile("ds_read_b64_tr_b16 %0, %1 offset:%2" : "=&v"(dst) : "v"(vb), "i"(off) : "memory")
#define PV_D0(d0) do { s16x4 l0, l1, l2, l3, h0, h1, h2, h3; constexpr int b_ = v_rd_off(d0, 0, 0); \
        TRRD(l0, b_); TRRD(h0, b_ + 2048); TRRD(l1, b_ + 4096); TRRD(h1, b_ + 6144); TRRD(l2, b_ + 8192); TRRD(h2, b_ + 10240); TRRD(l3, b_ + 12288); TRRD(h3, b_ + 14336); \
        asm volatile("s_waitcnt lgkmcnt(0)" ::: "memory"); SBAR(); \
        o[d0] = __builtin_amdgcn_mfma_f32_32x32x16_bf16(pa0, (bf16x8){l0[0], l0[1], l0[2], l0[3], h0[0], h0[1], h0[2], h0[3]}, o[d0], 0, 0, 0);   \
        o[d0] = __builtin_amdgcn_mfma_f32_32x32x16_bf16(pa1, (bf16x8){l1[0], l1[1], l1[2], l1[3], h1[0], h1[1], h1[2], h1[3]}, o[d0], 0, 0, 0);   \
        o[d0] = __builtin_amdgcn_mfma_f32_32x32x16_bf16(pa2, (bf16x8){l2[0], l2[1], l2[2], l2[3], h2[0], h2[1], h2[2], h2[3]}, o[d0], 0, 0, 0);   \
        o[d0] = __builtin_amdgcn_mfma_f32_32x32x16_bf16(pa3, (bf16x8){l3[0], l3[1], l3[2], l3[3], h3[0], h3[1], h3[2], h3[3]}, o[d0], 0, 0, 0); } while (0)
    PV_D0(0); PV_D0(1); PV_D0(2); PV_D0(3);
#undef PV_D0
#undef TRRD
}
__device__ __forceinline__ void pack_p(const f32x16& p0, const f32x16& p1, bf16x8& pa0, bf16x8& pa1, bf16x8& pa2, bf16x8& pa3) {
#define PK4(P, B_, OUT) do { unsigned a0 = cvtpk(P[B_+0], P[B_+1]), a1 = cvtpk(P[B_+2], P[B_+3]);                          \
        unsigned b0 = cvtpk(P[B_+4], P[B_+5]), b1 = cvtpk(P[B_+6], P[B_+7]);                                             \
        auto r0 = __builtin_amdgcn_permlane32_swap(a0, b0, false, false); auto r1 = __builtin_amdgcn_permlane32_swap(a1, b1, false, false); \
        u32x4 w = {r0[0], r1[0], r0[1], r1[1]}; OUT = *reinterpret_cast<bf16x8*>(&w); } while (0)
    PK4(p0, 0, pa0); PK4(p0, 8, pa1); PK4(p1, 0, pa2); PK4(p1, 8, pa3);
#undef PK4
}
__device__ __forceinline__ float dil_score(float S, int d, float slope2) {
    const unsigned ud = (unsigned)d;
    const int m = (int)(ud <= 128u) + (int)((ud <= 512u) & ((d & 3) == 0)) + (int)((ud <= 2048u) & ((d & 15) == 0));
    const float lg = (m == 3) ? 1.5849625007211562f : ((m == 2) ? 1.0f : 0.0f);
    const float s = fmaf(S, C2, fmaf(-slope2, (float)d, lg));
    return m ? s : -__builtin_inff();
}
__device__ __forceinline__ float softplus2(float y) { return fmaxf(y, 0.f) + __builtin_amdgcn_logf(1.0f + __builtin_amdgcn_exp2f(-fabsf(y))); }

struct AttnArgs { const bf16* qkv; bf16* obuf; const float* kmean; const float* out_gain; };

__device__ __forceinline__ void attn_unit(const AttnArgs& A, const int mode, const int b, const int h, const int qb, char* shm) {
    int tid_l = threadIdx.x; asm volatile("" : "+v"(tid_l));
    const int tid = tid_l, wid = __builtin_amdgcn_readfirstlane(tid >> 6), lane = tid & 63, r32 = lane & 31, hi = lane >> 5;
    const size_t rowbase = (size_t)b * SEQ; const int q0 = qb * 256;
    const bf16* Qp = A.qkv + (rowbase + q0 + wid * 32 + r32) * QS + h * 128;
    const bf16* Kh = A.qkv + rowbase * QS + 2048 + h * 128;
    const bf16* Vh = A.qkv + rowbase * QS + 4096 + h * 128;
    char* V_lds = shm + L_V; char* K_lds = shm + L_K;
    float* wsf = (float*)(shm + L_WS) + wid * 64; float* li_l = wsf; float* al_l = wsf + 32;
    int* TL = (int*)(shm + L_TL); int* FLG = (int*)(shm + L_FLG); unsigned* MSK = (unsigned*)(shm + L_MSK); float* KM = (float*)(shm + L_KM);
    char* qf = shm + L_Q + wid * 8192 + lane * 16;
    bf16x8 qr[8];
#pragma unroll
    for (int d0 = 0; d0 < 8; ++d0) { qr[d0] = *reinterpret_cast<const bf16x8*>(Qp + d0 * 16 + hi * 8); *reinterpret_cast<bf16x8*>(qf + d0 * 1024) = qr[d0]; }
    const int pos = q0 + wid * 32 + r32;
    const int sr = tid >> 4, sc = (tid & 15) * 8;
    const int vst0 = v_st(sr, sc), vst1 = v_st(32 + sr, sc), kws = KSWZ(sr, sc * 2);
    const int vb0 = (int)(uintptr_t)V_lds + v_rd_base(lane);
    const float slope2 = __builtin_amdgcn_exp2f(-8.0f * (float)(h + 1) / 11.0f) * 1.4426950408889634f;

    unsigned sel = 0u; int NT = 0;
    if (mode == 1) {
        if (tid == 0) MSK[0] = 0u;
        { const float* src = A.kmean + (size_t)((b * 5 + (h - 6)) * 16) * 128; *(f32x4*)(KM + tid * 4) = *(const f32x4*)(src + tid * 4); }
        __syncthreads();
        float gate[16];
#pragma unroll
        for (int j = 0; j < 16; ++j) gate[j] = 0.f;
#pragma unroll
        for (int d0 = 0; d0 < 8; ++d0) {
            float qf[8];
#pragma unroll
            for (int e = 0; e < 8; ++e) qf[e] = bf2f(qr[d0][e]);
#pragma unroll
            for (int j = 0; j < 16; ++j) { const f32x4 k0 = *(const f32x4*)(KM + j * 128 + d0 * 16 + hi * 8), k1 = *(const f32x4*)(KM + j * 128 + d0 * 16 + hi * 8 + 4);
                float a = gate[j];
                a = fmaf(qf[0], k0[0], a); a = fmaf(qf[1], k0[1], a); a = fmaf(qf[2], k0[2], a); a = fmaf(qf[3], k0[3], a);
                a = fmaf(qf[4], k1[0], a); a = fmaf(qf[5], k1[1], a); a = fmaf(qf[6], k1[2], a); a = fmaf(qf[7], k1[3], a);
                gate[j] = a; }
        }
#pragma unroll
        for (int j = 0; j < 16; ++j) gate[j] += __shfl_xor(gate[j], 32);
#pragma unroll
        for (int it = 0; it < 3; ++it) { float best = -__builtin_inff(); int bi = -1;
#pragma unroll
            for (int j = 0; j < 16; ++j) { const bool ok = (j < qb) && (((sel >> j) & 1u) == 0u) && (gate[j] > best); if (ok) { best = gate[j]; bi = j; } }
            if (bi >= 0) sel |= 1u << bi; }
        __hip_atomic_fetch_or(MSK, sel, __ATOMIC_RELAXED, __HIP_MEMORY_SCOPE_WORKGROUP);
        __syncthreads();
        const unsigned bm = MSK[0] & ((1u << qb) - 1u);
        NT = 4 * (__builtin_popcount(bm) + 1);
        if (tid < 64) { const int j = tid >> 2, sub = tid & 3;
            if (j < qb && ((bm >> j) & 1u)) TL[4 * __builtin_popcount(bm & ((1u << j) - 1u)) + sub] = 256 * j + 64 * sub;
            if (j == qb) TL[4 * __builtin_popcount(bm) + sub] = 256 * j + 64 * sub; }
    } else if (mode == 0) {
        const int lo = q0 > 2048 ? q0 - 2048 : 0; NT = (q0 + 256 - lo) / 64;
        if (tid < NT) TL[tid] = lo + 64 * tid;
    } else {
        NT = (q0 + 256) / 64;
        if (tid < NT) TL[tid] = q0 + 192 - 64 * tid;
    }
    __syncthreads();

    float m_reg = -1e30f, l_reg = 0.f, carry = 0.f; f32x16 o[4];
#pragma unroll
    for (int d0 = 0; d0 < 4; ++d0) o[d0] = f32x16{};
    bf16x8 st_v0, st_v1, st_k0, st_k1;
#define SLOAD(k0_) do { st_v0 = *reinterpret_cast<const bf16x8*>(Vh + (size_t)((k0_) + sr) * QS + sc); st_v1 = *reinterpret_cast<const bf16x8*>(Vh + (size_t)((k0_) + 32 + sr) * QS + sc); \
                        st_k0 = *reinterpret_cast<const bf16x8*>(Kh + (size_t)((k0_) + sr) * QS + sc); st_k1 = *reinterpret_cast<const bf16x8*>(Kh + (size_t)((k0_) + 32 + sr) * QS + sc); } while (0)
#define SWRITE(bf_) do { *(bf16x8*)(K_lds + (bf_) * SHM_T + kws) = st_k0; *(bf16x8*)(K_lds + (bf_) * SHM_T + kws + 32 * 256) = st_k1; \
                         *(bf16x8*)(V_lds + (bf_) * SHM_T + vst0) = st_v0; *(bf16x8*)(V_lds + (bf_) * SHM_T + vst1) = st_v1; } while (0)
    { const int k0 = TL[0]; SLOAD(k0); SWRITE(0); }
    __syncthreads();
    for (int t = 0; t < NT; ++t) {
        const int buf = t & 1; const int kb = TL[t];
        const bool more = (t + 1 < NT);
        if (more && mode != 2) { const int k1 = TL[t + 1]; SLOAD(k1); }
        f32x16 p0, p1;
        qkt(p0, p1, K_lds + buf * SHM_T, r32, hi, qf);
        bf16x8 pa0, pa1, pa2, pa3;
        const int dq = pos - kb - 4 * hi;
        if (mode == 2) {
            float Og[8], Pg[8];
#pragma unroll
            for (int i = 0; i < 8; ++i) { float ye[4], le[4];
#pragma unroll
                for (int e = 0; e < 4; ++e) { const int c = (i < 4) ? (8 * i + e) : (8 * (i - 4) + 32 + e); const float y = ((i < 4) ? p0[4 * i + e] : p1[4 * (i - 4) + e]) * C2;
                    ye[e] = y; le[e] = (dq - c >= 1) ? -softplus2(y) : 0.f; }
                const float w2 = le[3], w1 = w2 + le[2], w0 = w1 + le[1];
                Og[i] = w0 + le[0];
                const float x0 = ye[0] + le[0] + w0, x1 = ye[1] + le[1] + w1, x2 = ye[2] + le[2] + w2, x3 = ye[3] + le[3];
                if (i < 4) { p0[4 * i] = x0; p0[4 * i + 1] = x1; p0[4 * i + 2] = x2; p0[4 * i + 3] = x3; } else { p1[4 * (i - 4)] = x0; p1[4 * (i - 4) + 1] = x1; p1[4 * (i - 4) + 2] = x2; p1[4 * (i - 4) + 3] = x3; } }
#pragma unroll
            for (int i = 0; i < 8; ++i) Pg[i] = __shfl_xor(Og[i], 32);
            float run = carry;
#pragma unroll
            for (int i = 7; i >= 0; --i) { const float ab = run + (hi == 0 ? Pg[i] : 0.f);
#pragma unroll
                for (int e = 0; e < 4; ++e) { const int c = (i < 4) ? (8 * i + e) : (8 * (i - 4) + 32 + e);
                    if (i < 4) p0[4 * i + e] = (dq - c >= 1) ? __builtin_amdgcn_exp2f(p0[4 * i + e] + ab) : 0.f;
                    else p1[4 * (i - 4) + e] = (dq - c >= 1) ? __builtin_amdgcn_exp2f(p1[4 * (i - 4) + e] + ab) : 0.f; }
                run += Og[i] + Pg[i]; }
            carry = run;
            pack_p(p0, p1, pa0, pa1, pa2, pa3);
            if (more) { const int k1 = TL[t + 1]; SLOAD(k1); }
        } else {
            if (mode == 0) {
#pragma unroll
                for (int r = 0; r < 16; ++r) { const int c = (r & 3) + 8 * (r >> 2); p0[r] = dil_score(p0[r], dq - c, slope2); p1[r] = dil_score(p1[r], dq - c - 32, slope2); }
            } else {
                const int jb = kb >> 8; const bool own = (jb == qb); const bool rowsel = ((sel >> jb) & 1u) != 0u;
                const float NEG = -__builtin_inff();
#pragma unroll
                for (int r = 0; r < 16; ++r) { const int c = (r & 3) + 8 * (r >> 2); const int d0_ = dq - c, d1_ = dq - c - 32;
                    const bool v0 = own ? (d0_ >= 0) : rowsel, v1 = own ? (d1_ >= 0) : rowsel;
                    p0[r] = v0 ? fmaf(p0[r], C2, -slope2 * (float)d0_) : NEG; p1[r] = v1 ? fmaf(p1[r], C2, -slope2 * (float)d1_) : NEG; }
            }
            float pmax = p0[0];
#pragma unroll
            for (int r = 1; r < 16; ++r) pmax = fmaxf(pmax, p0[r]);
#pragma unroll
            for (int r = 0; r < 16; ++r) pmax = fmaxf(pmax, p1[r]);
            { auto rr = __builtin_amdgcn_permlane32_swap(__float_as_uint(pmax), __float_as_uint(pmax), false, false); pmax = fmaxf(__uint_as_float(rr[0]), __uint_as_float(rr[1])); }
            const float mn = fmaxf(m_reg, pmax); const float alpha = __builtin_amdgcn_exp2f(m_reg - mn); m_reg = mn;
            float ps = 0.f;
#pragma unroll
            for (int r = 0; r < 16; ++r) { p0[r] = __builtin_amdgcn_exp2f(p0[r] - mn); p1[r] = __builtin_amdgcn_exp2f(p1[r] - mn); ps += p0[r] + p1[r]; }
            { auto rr = __builtin_amdgcn_permlane32_swap(__float_as_uint(ps), __float_as_uint(ps), false, false); ps = __uint_as_float(rr[0]) + __uint_as_float(rr[1]); }
            l_reg = l_reg * alpha + ps;
            pack_p(p0, p1, pa0, pa1, pa2, pa3);
            if (__any(alpha < 1.f)) { if (hi == 0) al_l[r32] = alpha; asm volatile("s_waitcnt lgkmcnt(0)" ::: "memory");
#pragma unroll
                for (int d_ = 0; d_ < 4; ++d_)
#pragma unroll
                    for (int r = 0; r < 16; ++r) o[d_][r] *= al_l[crow(r, hi)]; }
        }
        SBAR();
        pv_tile(o, vb0 + buf * SHM_T, pa0, pa1, pa2, pa3);
        if (more) SWRITE(buf ^ 1);
        if (mode == 2) { const int dn = __all(carry < -160.f) ? 1 : 0; if (lane == 0) FLG[buf * 8 + wid] = dn; }
        __syncthreads();
        if (mode == 2) { const i32x4 fa = *(const i32x4*)(FLG + buf * 8), fb = *(const i32x4*)(FLG + buf * 8 + 4);
            if ((fa[0] & fa[1] & fa[2] & fa[3] & fb[0] & fb[1] & fb[2] & fb[3]) != 0) break; }
    }
#undef SLOAD
#undef SWRITE
    float rli[16];
    if (mode != 2) { if (hi == 0) li_l[r32] = l_reg; asm volatile("s_waitcnt lgkmcnt(0)" ::: "memory");
#pragma unroll
        for (int r = 0; r < 16; ++r) rli[r] = __builtin_amdgcn_rcpf(li_l[crow(r, hi)]); }
    else {
#pragma unroll
        for (int r = 0; r < 16; ++r) rli[r] = 1.f; }
    float ssq[16];
#pragma unroll
    for (int r = 0; r < 16; ++r) { float a = 0.f;
#pragma unroll
        for (int d0 = 0; d0 < 4; ++d0) { const float v = o[d0][r] * rli[r]; o[d0][r] = v; a = fmaf(v, v, a); }
        ssq[r] = a; }
#pragma unroll
    for (int off = 1; off < 32; off <<= 1)
#pragma unroll
        for (int r = 0; r < 16; ++r) ssq[r] += __shfl_xor(ssq[r], off);
    float gn[4];
#pragma unroll
    for (int d0 = 0; d0 < 4; ++d0) gn[d0] = A.out_gain[h * 128 + d0 * 32 + r32];
    bf16* Ow = A.obuf + (rowbase + q0 + wid * 32) * DM + h * 128;
#pragma unroll
    for (int r = 0; r < 16; ++r) { const int orow = crow(r, hi); const float rn = 1.0f / sqrtf(ssq[r] * (1.0f / 128.0f) + 1e-6f);
#pragma unroll
        for (int d0 = 0; d0 < 4; ++d0) { const float v = o[d0][r] * rn * gn[d0]; const float vn = __shfl_xor(v, 1);
            if ((r32 & 1) == 0) *(unsigned*)(Ow + (size_t)orow * DM + d0 * 32 + r32) = cvtpk(v, vn); } }
}

struct OrderTab { unsigned short v[512]; };
constexpr int unit_cost(int mode, int qb) { return mode == 0 ? 4 * ((qb < 8 ? qb : 8) + 1) : (mode == 1 ? 4 * (qb + 1) : (4 * (qb + 1) < 8 ? 4 * (qb + 1) : 8)); }
constexpr OrderTab make_order() {
    OrderTab T{}; int n = 0;
    for (int cost = 64; cost >= 1; --cost)
        for (int mode = 0; mode < 3; ++mode) { const int nh = (mode == 0) ? 6 : 5;
            for (int qb = 15; qb >= 0; --qb) { if (unit_cost(mode, qb) != cost) continue;
                for (int b = 0; b < 2; ++b) for (int hr = 0; hr < nh; ++hr) T.v[n++] = (unsigned short)((mode << 8) | (b << 7) | (hr << 4) | qb); } }
    return T;
}
__device__ const OrderTab ATT_ORDER = make_order();
constexpr int N_UNITS = 512;

__device__ __forceinline__ void attn_phase(const AttnArgs& A, unsigned* qctr, char* shm) {
    int* TK = (int*)(shm + L_MSK) + 4;
    for (;;) {
        __syncthreads();
        if (threadIdx.x == 0) TK[0] = (int)__hip_atomic_fetch_add(qctr, 1u, __ATOMIC_RELAXED, __HIP_MEMORY_SCOPE_AGENT);
        __syncthreads();
        const int tk = __builtin_amdgcn_readfirstlane(TK[0]);
        if (tk >= N_UNITS) break;
        const int code = ATT_ORDER.v[tk];
        const int mode = code >> 8, b = (code >> 7) & 1, hr = (code >> 4) & 7, qb = code & 15;
        const int h = (mode == 0) ? hr : ((mode == 1) ? 6 + hr : 11 + hr);
        attn_unit(A, mode, b, h, qb, shm);
    }
}
#undef KSWZ
#undef SBAR
}


constexpr int NWAVES = 8;
#ifndef MK_SPLIT
#define MK_SPLIT 0
#endif
constexpr int BATCH = 2, SEQ = 4096, D = 2048, FF = 5632, NE = 8;
constexpr int M = BATCH * SEQ;
constexpr int NQKV = 3 * D, NGU = 2 * FF;
constexpr int MPAD = 18432;
constexpr float EPS = 1e-6f;
constexpr size_t MiB = 1u << 20;
constexpr size_t WS_CTL = 0, CTL_ZERO_BYTES = 1 * MiB;
constexpr size_t WS_WQKV = 1 * MiB;
constexpr size_t WS_WO = 49 * MiB;
constexpr size_t WS_WGU_D = 65 * MiB;
constexpr size_t WS_WD_D = 109 * MiB;
constexpr size_t WS_WGU_M = 131 * MiB;
constexpr size_t WS_WD_M = 483 * MiB;
constexpr size_t WS_H = 659 * MiB;
constexpr size_t WS_QKV = 723 * MiB;
constexpr size_t WS_O = 819 * MiB;
constexpr size_t WS_A = 851 * MiB;
constexpr size_t WS_YS = WS_QKV;
constexpr size_t WS_ACT = 883 * MiB;
constexpr size_t WS_XS = 1081 * MiB;
constexpr size_t WS_MISC = 1153 * MiB;
constexpr size_t WS_END = 1154 * MiB;
constexpr size_t MISC_KMEAN = 0, MISC_SELE = 131072, MISC_SELREL = MISC_SELE + 32768, MISC_SELG = MISC_SELREL + 65536, MISC_SELPOS = MISC_SELG + 65536;
static_assert(MISC_SELPOS + 65536 <= MiB && (size_t)MPAD * D * 4 <= 160 * MiB && (size_t)MPAD * FF * 2 <= 198 * MiB, "ws map");
constexpr int CW_TMO = 0, CW_CODE = 1;
constexpr int CW_BAR = 4096;
constexpr int CW_ATTQ = 8192;
constexpr int CW_CNT = 8448;
constexpr int RING_OFF = 0, RING_BYTES = 131072;
constexpr int LDSCTL_OFF = 143360, MISC_OFF = LDSCTL_OFF + 320;
constexpr int LDS_BYTES = 147456;
constexpr int N_PHASES = 20;

#define GAS __attribute__((address_space(1)))
#define LAS __attribute__((address_space(3)))
typedef unsigned short bf16;
typedef unsigned v4u __attribute__((ext_vector_type(4)));
typedef float f32x4 __attribute__((ext_vector_type(4)));
typedef short bf16x8 __attribute__((ext_vector_type(8)));
typedef GAS unsigned gu32;
typedef GAS unsigned long long gu64;
#define RLX_AGENT __ATOMIC_RELAXED, __HIP_MEMORY_SCOPE_AGENT
#define LDS_WAIT() asm volatile("s_waitcnt lgkmcnt(0)" ::: "memory")
#define VM_WAIT() asm volatile("s_waitcnt vmcnt(0)" ::: "memory")
__device__ __forceinline__ unsigned long long rt() { return __builtin_amdgcn_s_memrealtime(); }
__device__ __forceinline__ unsigned f2bf(float f) { unsigned u = __builtin_bit_cast(unsigned, f); return (u + 0x7fffu + ((u >> 16) & 1u)) >> 16; }
__device__ __forceinline__ unsigned pk2(float lo, float hi) { return f2bf(lo) | (f2bf(hi) << 16); }

#define XB_TMO      128
#define XB_XCNT(j)  (256  + 64 * (j))
#define XB_XSUB(j)  (1280 + 64 * (j))
#define XB_XGEN(j)  (2304 + 64 * (j))
#define XB_TOP      3328
#define XB_TOPGEN   3392
#define XCD_BAR_WORDS 3456
#define XB_SPIN_CAP (1u << 18)

__device__ __forceinline__ unsigned xb_ld(unsigned* p)              { return __hip_atomic_load(p, __ATOMIC_RELAXED, __HIP_MEMORY_SCOPE_AGENT); }
__device__ __forceinline__ unsigned xb_add(unsigned* p, unsigned v) { return __hip_atomic_fetch_add(p, v, __ATOMIC_RELAXED, __HIP_MEMORY_SCOPE_AGENT); }
__device__ __forceinline__ unsigned xb_xcc_id() { return (unsigned)__builtin_amdgcn_s_getreg((3 << 11) | 20) & 0xFu; }
#define XB_SPIN(cond, bar) do { unsigned _sp = 0; while (cond) { __builtin_amdgcn_s_sleep(1); \
    if ((++_sp & 255u) == 0u) { if (xb_ld(&(bar)[XB_TMO])) break; if (_sp > XB_SPIN_CAP) { atomicAdd(&(bar)[XB_TMO], 1u); break; } } } } while (0)

struct XcdBarrier {
    unsigned* bar; unsigned x;
    volatile LAS unsigned* st;
};

__device__ __forceinline__ XcdBarrier xcd_barrier_post(unsigned* bar, volatile LAS unsigned* st) {
    XcdBarrier b; b.bar = bar; b.x = xb_xcc_id(); b.st = st;
    if (threadIdx.x == 0) (void)xb_add(&bar[XB_XCNT(b.x)], 1u);
    return b;
}
__device__ __forceinline__ void xcd_barrier_complete(unsigned* bar, unsigned x, unsigned& nloc, unsigned& nx) {
    const unsigned G = gridDim.x * gridDim.y * gridDim.z;
    unsigned sum, cnt, mine, sp = 0u;
    for (;;) {
        sum = 0u; cnt = 0u; mine = 0u;
#pragma unroll
        for (unsigned j = 0; j < 16; ++j) { const unsigned c = xb_ld(&bar[XB_XCNT(j)]); sum += c; cnt += (c > 0u) ? 1u : 0u; mine = (j == x) ? c : mine; }
        if (sum == G) break;
        __builtin_amdgcn_s_sleep(1);
        if ((++sp & 255u) == 0u) { if (xb_ld(&bar[XB_TMO])) break; if (sp > XB_SPIN_CAP) { atomicAdd(&bar[XB_TMO], 1u); break; } }
    }
    nloc = mine > 0u ? mine : 1u; nx = cnt > 0u ? cnt : 1u;
}

__device__ __forceinline__ void xcd_barrier(const XcdBarrier& b) {
    asm volatile("s_waitcnt vmcnt(0)" ::: "memory");
    __syncthreads();
    if (threadIdx.x == 0) {
        unsigned* bar = b.bar;
        __builtin_amdgcn_s_waitcnt(0);
        unsigned nloc = b.st[0], nx = b.st[1];
        if (nloc == 0u) { xcd_barrier_complete(bar, b.x, nloc, nx); b.st[0] = nloc; b.st[1] = nx; }
        const unsigned old = xb_add(&bar[XB_XSUB(b.x)], 1u);
        const unsigned gen = old / nloc;
        if (old + 1u == (gen + 1u) * nloc) {
            __builtin_amdgcn_fence(__ATOMIC_RELEASE, "agent");
            asm volatile("s_waitcnt vmcnt(0)" ::: "memory");
            const unsigned og = xb_add(&bar[XB_TOP], 1u);
            const unsigned tg = og / nx;
            if (og + 1u == (tg + 1u) * nx) xb_add(&bar[XB_TOPGEN], 1u);
            else XB_SPIN(xb_ld(&bar[XB_TOPGEN]) == tg, bar);
            __builtin_amdgcn_fence(__ATOMIC_ACQUIRE, "agent");
            xb_add(&bar[XB_XGEN(b.x)], 1u);
            asm volatile("s_waitcnt vmcnt(0)" ::: "memory");
        } else {
            XB_SPIN(xb_ld(&bar[XB_XGEN(b.x)]) == gen, bar);
            __builtin_amdgcn_fence(__ATOMIC_ACQUIRE, "agent");
            asm volatile("s_waitcnt vmcnt(0)" ::: "memory");
        }
    }
    __syncthreads();
}


__device__ __forceinline__ float wave_sum(float v) {
#pragma unroll
    for (int o = 1; o < 64; o <<= 1) v += __shfl_xor(v, o);
    return v;
}
__device__ __forceinline__ float bf2f_u(unsigned short s) { return __uint_as_float(((unsigned)s) << 16); }

__device__ __forceinline__ void p0_transpose_item(const float* W, int K, int N, bf16* WT, int mode, LAS float* scr, int item, int lane) {
    const int nblk = N / 32, kb = item / nblk, nb = item % nblk, k0 = 64 * kb, n0 = 32 * nb;
#pragma unroll 8
    for (int i = 0; i < 32; ++i) { const int kk = 2 * i + (lane >> 5); scr[kk * 33 + (lane & 31)] = W[(size_t)(k0 + kk) * N + n0 + (lane & 31)]; }
    LDS_WAIT(); asm volatile("" ::: "memory");
    const int drow0 = (mode == 0) ? n0 : (256 * (n0 >> 7) + (n0 & 127) + (mode == 2 ? 128 : 0));
    const int c = lane & 7;
#pragma unroll
    for (int j = 0; j < 4; ++j) { const int n = (lane >> 3) + 8 * j; const LAS float* s = scr + (8 * c) * 33 + n;
        v4u o; o.x = pk2(s[0 * 33], s[1 * 33]); o.y = pk2(s[2 * 33], s[3 * 33]); o.z = pk2(s[4 * 33], s[5 * 33]); o.w = pk2(s[6 * 33], s[7 * 33]);
        *(GAS v4u*)(WT + (size_t)(drow0 + n) * K + k0 + 8 * c) = o; }
    LDS_WAIT(); asm volatile("" ::: "memory");
}

struct Ptrs {
    const float *x, *attn_norm, *w_in, *q_gain, *k_gain, *out_gain, *w_out, *ffn_norm, *dwg, *dwu, *dwd, *router, *mwg, *mwu, *mwd;
    float* out;
    bf16 *Wqkv_t, *Wo_t, *Wgu_d, *Wd_d, *Wgu_m, *Wd_m, *QKV, *OB, *AB, *ACT, *XS;
    float *H, *YS, *kmean; unsigned* sel_e; int* sel_rel; float* sel_g; int* sel_pos;
    gu32* ctl;
};

__device__ __forceinline__ void convert_weights(const Ptrs& P, LAS unsigned char* lds, int vcu, int G, int wave, int lane) {
    asm volatile("" : "+v"(lane));
    LAS float* scr = (LAS float*)(lds + RING_OFF + wave * 16384);
    const int gw = vcu * NWAVES + wave, NGW = G * NWAVES;
    constexpr int I_IN = (D / 64) * (NQKV / 32), I_O = (D / 64) * (D / 32), I_G = (D / 64) * (FF / 32), I_D = (FF / 64) * (D / 32);
    constexpr int NITEMS = 2 * I_IN + 2 * I_O + 2 * I_G + I_D + NE * (2 * I_G + I_D);
    for (int it = gw; it < NITEMS; it += NGW) {
        int r = it;
        if (r < 2 * I_IN) { const int l = r / I_IN; r -= l * I_IN; p0_transpose_item(P.w_in + (size_t)l * D * NQKV, D, NQKV, P.Wqkv_t + (size_t)l * NQKV * D, 0, scr, r, lane); continue; } r -= 2 * I_IN;
        if (r < 2 * I_O) { const int l = r / I_O; r -= l * I_O; p0_transpose_item(P.w_out + (size_t)l * D * D, D, D, P.Wo_t + (size_t)l * D * D, 0, scr, r, lane); continue; } r -= 2 * I_O;
        if (r < I_G) { p0_transpose_item(P.dwg, D, FF, P.Wgu_d, 1, scr, r, lane); continue; } r -= I_G;
        if (r < I_G) { p0_transpose_item(P.dwu, D, FF, P.Wgu_d, 2, scr, r, lane); continue; } r -= I_G;
        if (r < I_D) { p0_transpose_item(P.dwd, FF, D, P.Wd_d, 0, scr, r, lane); continue; } r -= I_D;
        constexpr int I_E = 2 * I_G + I_D; const int e = r / I_E; r -= e * I_E;
        if (r < I_G) { p0_transpose_item(P.mwg + (size_t)e * D * FF, D, FF, P.Wgu_m + (size_t)e * NGU * D, 1, scr, r, lane); continue; } r -= I_G;
        if (r < I_G) { p0_transpose_item(P.mwu + (size_t)e * D * FF, D, FF, P.Wgu_m + (size_t)e * NGU * D, 2, scr, r, lane); continue; } r -= I_G;
        p0_transpose_item(P.mwd + (size_t)e * FF * D, FF, D, P.Wd_m + (size_t)e * D * FF, 0, scr, r, lane);
    }
}
__device__ __forceinline__ void norm_rows(const float* src, const float* gain, bf16* dst, int vcu, int G, int wave, int lane) {
    asm volatile("" : "+v"(lane));
    const int gw = vcu * NWAVES + wave, NGW = G * NWAVES;
    for (int m = gw; m < M; m += NGW) {
        const GAS f32x4* xr = (const GAS f32x4*)(src + (size_t)m * D) + lane;
        f32x4 v[8]; float s = 0.f;
#pragma unroll
        for (int j = 0; j < 8; ++j) { v[j] = xr[64 * j]; s += (v[j].x * v[j].x + v[j].y * v[j].y) + (v[j].z * v[j].z + v[j].w * v[j].w); }
        const float r = 1.0f / sqrtf(wave_sum(s) * (1.0f / D) + EPS);
        GAS unsigned long long* o8 = (GAS unsigned long long*)(dst + (size_t)m * D) + lane;
#pragma unroll
        for (int j = 0; j < 8; ++j) { const f32x4 g = ((const GAS f32x4*)gain)[lane + 64 * j];
            o8[64 * j] = (unsigned long long)pk2(v[j].x * r * g.x, v[j].y * r * g.y) | ((unsigned long long)pk2(v[j].z * r * g.z, v[j].w * r * g.w) << 32); }
    }
}
__device__ __forceinline__ void prep_phase(const Ptrs& P, int layer, LAS unsigned char* lds, int vcu, int G, int tid, int wave, int lane) {
    asm volatile("" : "+v"(lane), "+v"(tid));
    LAS float* red = (LAS float*)(lds + RING_OFF);
    const int tsub = lane >> 4, c = lane & 15;
    for (int it = vcu; it < 32 * 22; it += G) {
        const int v = it % 22, blk = it / 22, b = blk >> 4, n = blk & 15;
        const bool isk = v >= 11; const int hh = isk ? v - 11 : v;
        const int col0 = (isk ? 2048 : 0) + hh * 128;
        const float* gp = (isk ? P.k_gain : P.q_gain) + layer * 256 + (hh >= 6 ? 128 : 0) + 8 * c;
        const f32x4 g0 = *(const f32x4*)gp, g1 = *(const f32x4*)(gp + 4);
        const bool km = isk && hh >= 6;
        float cs[8];
#pragma unroll
        for (int e = 0; e < 8; ++e) cs[e] = 0.f;
#pragma unroll 2
        for (int i8 = 0; i8 < 8; ++i8) {
            const size_t row = (size_t)b * SEQ + n * 256 + wave * 32 + i8 * 4 + tsub;
            bf16* p = P.QKV + row * NQKV + col0 + 8 * c;
            const v4u raw = *(const GAS v4u*)p;
            float x[8]; x[0] = bf2f_u((unsigned short)(raw.x & 0xffff)); x[1] = bf2f_u((unsigned short)(raw.x >> 16)); x[2] = bf2f_u((unsigned short)(raw.y & 0xffff)); x[3] = bf2f_u((unsigned short)(raw.y >> 16));
            x[4] = bf2f_u((unsigned short)(raw.z & 0xffff)); x[5] = bf2f_u((unsigned short)(raw.z >> 16)); x[6] = bf2f_u((unsigned short)(raw.w & 0xffff)); x[7] = bf2f_u((unsigned short)(raw.w >> 16));
            float ss = 0.f;
#pragma unroll
            for (int e = 0; e < 8; ++e) ss = fmaf(x[e], x[e], ss);
            ss += __shfl_xor(ss, 1); ss += __shfl_xor(ss, 2); ss += __shfl_xor(ss, 4); ss += __shfl_xor(ss, 8);
            const float r = 1.0f / sqrtf(ss * (1.0f / 128.0f) + EPS);
            float y[8];
            y[0] = x[0] * r * g0.x; y[1] = x[1] * r * g0.y; y[2] = x[2] * r * g0.z; y[3] = x[3] * r * g0.w;
            y[4] = x[4] * r * g1.x; y[5] = x[5] * r * g1.y; y[6] = x[6] * r * g1.z; y[7] = x[7] * r * g1.w;
            v4u o; o.x = pk2(y[0], y[1]); o.y = pk2(y[2], y[3]); o.z = pk2(y[4], y[5]); o.w = pk2(y[6], y[7]);
            *(GAS v4u*)p = o;
#pragma unroll
            for (int e = 0; e < 8; ++e) cs[e] += y[e];
        }
        if (km) {
#pragma unroll
            for (int e = 0; e < 8; ++e) { cs[e] += __shfl_xor(cs[e], 16); cs[e] += __shfl_xor(cs[e], 32); }
            if (lane < 16) {
#pragma unroll
                for (int e = 0; e < 8; ++e) red[wave * 128 + 8 * c + e] = cs[e]; }
            LDS_WAIT(); __syncthreads();
            if (tid < 128) { float s = 0.f;
#pragma unroll
                for (int w = 0; w < 8; ++w) s += red[w * 128 + tid];
                P.kmean[(size_t)((b * 5 + (hh - 6)) * 16 + n) * 128 + tid] = s * (1.0f / 256.0f); }
            LDS_WAIT(); __syncthreads();
        }
    }
}
__device__ __forceinline__ void router_phase(const Ptrs& P, const float* gain, LAS unsigned char* lds, int vcu, int G, int tid, int wave, int lane) {
    asm volatile("" : "+v"(lane), "+v"(tid));
    LAS unsigned* lcnt = (LAS unsigned*)(lds + RING_OFF);
    LAS unsigned* rinfo = (LAS unsigned*)(lds + RING_OFF + 256);
    if (tid < 16) lcnt[tid] = 0u;
    LDS_WAIT(); __syncthreads();
    const int gw = vcu * NWAVES + wave, NGW = G * NWAVES;
    int li = wave;
    for (int m = gw; m < M; m += NGW, li += NWAVES) {
        const GAS f32x4* xr = (const GAS f32x4*)(P.H + (size_t)m * D) + lane;
        f32x4 v[8]; float s = 0.f;
#pragma unroll
        for (int j = 0; j < 8; ++j) { v[j] = xr[64 * j]; s += (v[j].x * v[j].x + v[j].y * v[j].y) + (v[j].z * v[j].z + v[j].w * v[j].w); }
        const float r = 1.0f / sqrtf(wave_sum(s) * (1.0f / D) + EPS);
        float lg[8];
#pragma unroll
        for (int e = 0; e < 8; ++e) lg[e] = 0.f;
        GAS unsigned long long* o8 = (GAS unsigned long long*)(P.AB + (size_t)m * D) + lane;
#pragma unroll
        for (int j = 0; j < 8; ++j) { const f32x4 g = ((const GAS f32x4*)gain)[lane + 64 * j];
            const float f0 = v[j].x * r * g.x, f1 = v[j].y * r * g.y, f2 = v[j].z * r * g.z, f3 = v[j].w * r * g.w;
            o8[64 * j] = (unsigned long long)pk2(f0, f1) | ((unsigned long long)pk2(f2, f3) << 32);
            const GAS f32x4* rw = (const GAS f32x4*)(P.router + (size_t)(256 * j + 4 * lane) * NE);
            const f32x4 a0 = rw[0], a1 = rw[1], b0 = rw[2], b1 = rw[3], c0 = rw[4], c1 = rw[5], d0 = rw[6], d1 = rw[7];
            lg[0] += f0 * a0.x + f1 * b0.x + f2 * c0.x + f3 * d0.x; lg[1] += f0 * a0.y + f1 * b0.y + f2 * c0.y + f3 * d0.y;
            lg[2] += f0 * a0.z + f1 * b0.z + f2 * c0.z + f3 * d0.z; lg[3] += f0 * a0.w + f1 * b0.w + f2 * c0.w + f3 * d0.w;
            lg[4] += f0 * a1.x + f1 * b1.x + f2 * c1.x + f3 * d1.x; lg[5] += f0 * a1.y + f1 * b1.y + f2 * c1.y + f3 * d1.y;
            lg[6] += f0 * a1.z + f1 * b1.z + f2 * c1.z + f3 * d1.z; lg[7] += f0 * a1.w + f1 * b1.w + f2 * c1.w + f3 * d1.w; }
#pragma unroll
        for (int e = 0; e < 8; ++e) lg[e] = wave_sum(lg[e]);
        int e0 = 0; float b0v = lg[0];
#pragma unroll
        for (int e = 1; e < 8; ++e) if (lg[e] > b0v) { b0v = lg[e]; e0 = e; }
        int e1 = -1; float b1v = -__builtin_inff();
#pragma unroll
        for (int e = 0; e < 8; ++e) if (e != e0 && lg[e] > b1v) { b1v = lg[e]; e1 = e; }
        const float g1 = 1.0f / (1.0f + __expf(b0v - b1v)), g0 = 1.0f - g1;
        if (lane == 0) {
            const unsigned k0 = __hip_atomic_fetch_add(lcnt + e0, 1u, __ATOMIC_RELAXED, __HIP_MEMORY_SCOPE_WORKGROUP);
            const unsigned k1 = __hip_atomic_fetch_add(lcnt + e1, 1u, __ATOMIC_RELAXED, __HIP_MEMORY_SCOPE_WORKGROUP);
            rinfo[li * 4 + 0] = (unsigned)e0 | ((unsigned)e1 << 8); rinfo[li * 4 + 1] = k0; rinfo[li * 4 + 2] = k1;
            P.sel_g[2 * m] = g0; P.sel_g[2 * m + 1] = g1;
        }
    }
    LDS_WAIT(); __syncthreads();
    if (tid < 8) lcnt[8 + tid] = __hip_atomic_fetch_add(P.ctl + CW_CNT + 64 * tid, lcnt[tid], RLX_AGENT);
    LDS_WAIT(); __syncthreads();
    li = wave;
    for (int m = gw; m < M; m += NGW, li += NWAVES) {
        if (lane == 0) { const unsigned ee = rinfo[li * 4 + 0]; const unsigned e0 = ee & 0xffu, e1 = ee >> 8;
            P.sel_e[m] = ee; P.sel_rel[2 * m] = (int)(lcnt[8 + e0] + rinfo[li * 4 + 1]); P.sel_rel[2 * m + 1] = (int)(lcnt[8 + e1] + rinfo[li * 4 + 2]); }
    }
}
__device__ __forceinline__ void build_tile_table(const Ptrs& P, bool moe, volatile LAS unsigned* MISC, int tid) {
    if (tid == 0) { unsigned t = 0u; MISC[16] = 0u;
        for (int e = 0; e < 8; ++e) { const unsigned cnt = moe ? __hip_atomic_load(P.ctl + CW_CNT + 64 * e, RLX_AGENT) : (e == 0 ? (unsigned)M : 0u); t += (cnt + 255u) >> 8; if (t > (unsigned)(MPAD / 256)) t = MPAD / 256; MISC[17 + e] = t; } }
    LDS_WAIT(); __syncthreads();
}
__device__ __forceinline__ void scatter_phase(const Ptrs& P, volatile LAS unsigned* MISC, int vcu, int G, int wave, int lane) {
    asm volatile("" : "+v"(lane));
    const int gw = vcu * NWAVES + wave, NGW = G * NWAVES;
    for (int m = gw; m < M; m += NGW) {
        const unsigned ee = P.sel_e[m]; const unsigned e0 = ee & 0xffu, e1 = (ee >> 8) & 0xffu;
        const int p0 = (int)(256u * MISC[16 + e0]) + P.sel_rel[2 * m], p1 = (int)(256u * MISC[16 + e1]) + P.sel_rel[2 * m + 1];
        if (lane == 0) { P.sel_pos[2 * m] = p0; P.sel_pos[2 * m + 1] = p1; }
        const GAS v4u* src = (const GAS v4u*)(P.AB + (size_t)m * D) + lane;
        GAS v4u* d0 = (GAS v4u*)(P.XS + (size_t)p0 * D) + lane; GAS v4u* d1 = (GAS v4u*)(P.XS + (size_t)p1 * D) + lane;
#pragma unroll
        for (int j = 0; j < 4; ++j) { const v4u t = src[64 * j]; d0[64 * j] = t; d1[64 * j] = t; }
    }
}
__device__ __forceinline__ void combine_phase(const Ptrs& P, int vcu, int G, int wave, int lane) {
    asm volatile("" : "+v"(lane));
    const int gw = vcu * NWAVES + wave, NGW = G * NWAVES;
    for (int m = gw; m < M; m += NGW) {
        const int p0 = P.sel_pos[2 * m], p1 = P.sel_pos[2 * m + 1]; const float g0 = P.sel_g[2 * m], g1 = P.sel_g[2 * m + 1];
        const GAS f32x4* hr = (const GAS f32x4*)(P.H + (size_t)m * D) + lane;
        const GAS f32x4* y0 = (const GAS f32x4*)(P.YS + (size_t)p0 * D) + lane; const GAS f32x4* y1 = (const GAS f32x4*)(P.YS + (size_t)p1 * D) + lane;
        GAS f32x4* orow = (GAS f32x4*)(P.out + (size_t)m * D) + lane;
#pragma unroll
        for (int j = 0; j < 8; ++j) orow[64 * j] = hr[64 * j] + y0[64 * j] * g0 + y1[64 * j] * g1;
    }
}

struct Args { const float* in[15]; float* out; unsigned char* ws; int ph_lo, ph_hi; };
__device__ __forceinline__ Ptrs make_ptrs(const Args& args, unsigned char* ws0) {
    int z = 0; asm volatile("" : "+s"(z));
    const float* const* in = args.in + z;
    unsigned char* ws = ws0 + z;
    Ptrs P;
    P.x = in[0]; P.attn_norm = in[1]; P.w_in = in[2]; P.q_gain = in[3]; P.k_gain = in[4]; P.out_gain = in[5]; P.w_out = in[6]; P.ffn_norm = in[7];
    P.dwg = in[8]; P.dwu = in[9]; P.dwd = in[10]; P.router = in[11]; P.mwg = in[12]; P.mwu = in[13]; P.mwd = in[14];
    P.out = args.out; P.ctl = (gu32*)(ws + WS_CTL);
    P.Wqkv_t = (bf16*)(ws + WS_WQKV); P.Wo_t = (bf16*)(ws + WS_WO); P.Wgu_d = (bf16*)(ws + WS_WGU_D); P.Wd_d = (bf16*)(ws + WS_WD_D); P.Wgu_m = (bf16*)(ws + WS_WGU_M); P.Wd_m = (bf16*)(ws + WS_WD_M);
    P.QKV = (bf16*)(ws + WS_QKV); P.OB = (bf16*)(ws + WS_O); P.AB = (bf16*)(ws + WS_A); P.ACT = (bf16*)(ws + WS_ACT); P.XS = (bf16*)(ws + WS_XS);
    P.H = (float*)(ws + WS_H); P.YS = (float*)(ws + WS_YS); P.kmean = (float*)(ws + WS_MISC + MISC_KMEAN);
    P.sel_e = (unsigned*)(ws + WS_MISC + MISC_SELE); P.sel_rel = (int*)(ws + WS_MISC + MISC_SELREL); P.sel_g = (float*)(ws + WS_MISC + MISC_SELG); P.sel_pos = (int*)(ws + WS_MISC + MISC_SELPOS);
    return P;
}
__global__ void __launch_bounds__(NWAVES * 64, 2) hybrid_fwd(Args args) {
    extern __shared__ __attribute__((aligned(16))) unsigned char lds[];
    LAS unsigned char* ldsL = (LAS unsigned char*)lds;
    volatile LAS unsigned* MISC = (volatile LAS unsigned*)(ldsL + MISC_OFF);
    const int tid = threadIdx.x, lane = tid & 63, wave = __builtin_amdgcn_readfirstlane(tid >> 6);
    const int G = gridDim.x; int vcu; { const int bx = blockIdx.x; vcu = (G % 8 == 0) ? (bx % 8) * (G / 8) + bx / 8 : bx; }
    for (int u = tid; u < (LDS_BYTES - LDSCTL_OFF) / 4; u += NWAVES * 64) ((LAS unsigned*)(ldsL + LDSCTL_OFF))[u] = 0u;
    __syncthreads();
    int z0 = 0; asm volatile("" : "+s"(z0)); unsigned char* ws0 = args.ws + z0;
    unsigned* const barw = (unsigned*)(ws0 + WS_CTL) + CW_BAR;
    XcdBarrier bar; bar.bar = barw; bar.x = 0; bar.st = nullptr;
    if (!MK_SPLIT) bar = xcd_barrier_post(barw, MISC + 8);
    const int lo = args.ph_lo, hi = args.ph_hi;
#define PH(k) (lo <= (k) && (k) < hi)
#define SEAM(a, b) do { if (PH(a) && PH(b)) { int zb_ = 0; asm volatile("" : "+s"(zb_)); XcdBarrier b2_ = bar; b2_.bar = bar.bar + zb_; xcd_barrier(b2_); } } while (0)

    for (int layer = 0; layer < 2; ++layer) {
        const int PB = layer * 10;
        if (PH(PB + 0)) {
            const Ptrs P = make_ptrs(args, ws0);
            #ifndef NO_P0
            if (layer == 0) convert_weights(P, ldsL, vcu, G, wave, lane);
            norm_rows(layer == 0 ? P.x : P.H, P.attn_norm + layer * D, P.AB, vcu, G, wave, lane);
#endif
        }
        SEAM(PB + 0, PB + 1);
        if (PH(PB + 1)) {
            const Ptrs P = make_ptrs(args, ws0);
            pg8::Gemm g{P.AB, P.Wqkv_t + (size_t)layer * NQKV * D, M, NQKV, D}; pg8::StaticOrder S; S.init(M, NQKV, G, (int)blockIdx.x);
            pg8::EpiStoreBf16 E{P.QKV, NQKV};
#ifndef NO_P1
            pg8::gemm_phase<pg8::EpiStoreBf16, pg8::StaticOrder, true, true>(ldsL + RING_OFF, g, S, E);
#endif
        }
        SEAM(PB + 1, PB + 2);
#ifndef NO_P2
        if (PH(PB + 2)) { const Ptrs P = make_ptrs(args, ws0); prep_phase(P, layer, ldsL, vcu, G, tid, wave, lane); }
#endif
        SEAM(PB + 2, PB + 3);
        if (PH(PB + 3)) {
            const Ptrs P = make_ptrs(args, ws0);
            const att::AttnArgs AA{P.QKV, P.OB, P.kmean, P.out_gain + layer * D};
#ifndef NO_P3
            att::attn_phase(AA, (unsigned*)(P.ctl + CW_ATTQ + 64 * layer), (char*)lds + RING_OFF);
#endif
        }
        SEAM(PB + 3, PB + 4);
        if (PH(PB + 4)) {
            const Ptrs P = make_ptrs(args, ws0);
            pg8::Gemm g{P.OB, P.Wo_t + (size_t)layer * D * D, M, D, D}; pg8::StaticOrder S; S.init(M, D, G, (int)blockIdx.x);
            pg8::EpiResF32 E{layer == 0 ? P.x : P.H, P.H, D};
#ifndef NO_P4
            pg8::gemm_phase<pg8::EpiResF32, pg8::StaticOrder, true, true>(ldsL + RING_OFF, g, S, E);
#endif
        }
        SEAM(PB + 4, PB + 5);
        if (PH(PB + 5)) {
            const Ptrs P = make_ptrs(args, ws0);
#ifndef NO_P5
            if (layer == 0) norm_rows(P.H, P.ffn_norm, P.AB, vcu, G, wave, lane);
            else router_phase(P, P.ffn_norm + D, ldsL, vcu, G, tid, wave, lane);
#endif
        }
        if (layer == 1) {
            SEAM(PB + 5, PB + 6);
#ifndef NO_P6
            if (PH(PB + 6)) { const Ptrs P = make_ptrs(args, ws0); build_tile_table(P, true, MISC, tid); scatter_phase(P, MISC, vcu, G, wave, lane); }
#endif
            SEAM(PB + 6, PB + 7);
        } else SEAM(PB + 5, PB + 7);
        if (PH(PB + 7)) {
            const Ptrs P = make_ptrs(args, ws0);
            build_tile_table(P, layer == 1, MISC, tid);
            pg8::GroupSched S; S.nMt = __builtin_amdgcn_readfirstlane((int)MISC[24]); S.nN = NGU / 256; S.nwg = S.nMt * S.nN; S.G = G; S.c = (int)blockIdx.x;
            S.t1 = __builtin_amdgcn_readfirstlane((int)MISC[17]); S.t2 = __builtin_amdgcn_readfirstlane((int)MISC[18]); S.t3 = __builtin_amdgcn_readfirstlane((int)MISC[19]); S.t4 = __builtin_amdgcn_readfirstlane((int)MISC[20]);
            S.t5 = __builtin_amdgcn_readfirstlane((int)MISC[21]); S.t6 = __builtin_amdgcn_readfirstlane((int)MISC[22]); S.t7 = __builtin_amdgcn_readfirstlane((int)MISC[23]); S.estride = (size_t)NGU * D * 2;
            pg8::Gemm g{layer == 0 ? P.AB : P.XS, layer == 0 ? P.Wgu_d : P.Wgu_m, MPAD, NGU, D};
            pg8::EpiSwiGLU E{P.ACT, FF};
#ifndef NO_P7
            pg8::gemm_phase<pg8::EpiSwiGLU, pg8::GroupSched, true, true>(ldsL + RING_OFF, g, S, E);
#endif
        }
        SEAM(PB + 7, PB + 8);
        if (PH(PB + 8)) {
            const Ptrs P = make_ptrs(args, ws0);
            build_tile_table(P, layer == 1, MISC, tid);
            pg8::GroupSched S; S.nMt = __builtin_amdgcn_readfirstlane((int)MISC[24]); S.nN = D / 256; S.nwg = S.nMt * S.nN; S.G = G; S.c = (int)blockIdx.x;
            S.t1 = __builtin_amdgcn_readfirstlane((int)MISC[17]); S.t2 = __builtin_amdgcn_readfirstlane((int)MISC[18]); S.t3 = __builtin_amdgcn_readfirstlane((int)MISC[19]); S.t4 = __builtin_amdgcn_readfirstlane((int)MISC[20]);
            S.t5 = __builtin_amdgcn_readfirstlane((int)MISC[21]); S.t6 = __builtin_amdgcn_readfirstlane((int)MISC[22]); S.t7 = __builtin_amdgcn_readfirstlane((int)MISC[23]); S.estride = (size_t)D * FF * 2;
            pg8::Gemm g{P.ACT, layer == 0 ? P.Wd_d : P.Wd_m, MPAD, D, FF};
            pg8::EpiResF32 E{layer == 0 ? P.H : nullptr, layer == 0 ? P.H : P.YS, D};
#ifndef NO_P8
            pg8::gemm_phase<pg8::EpiResF32, pg8::GroupSched, true, true>(ldsL + RING_OFF, g, S, E);
#endif
        }
        if (layer == 0) SEAM(PB + 8, PB + 10);
        else { SEAM(PB + 8, PB + 9);
#ifndef NO_P9
            if (PH(PB + 9)) { const Ptrs P = make_ptrs(args, ws0); combine_phase(P, vcu, G, wave, lane); }
#endif
        }
    }
#undef PH
#undef SEAM
}

extern "C" void kernel_launch(void* const* d_in, const int* in_sizes, int n_in, void* d_out, int out_size, void* d_ws, size_t ws_size, hipStream_t stream) {
    static int grid = 0;
    if (grid == 0) {
        if (n_in != 15 || in_sizes[0] != M * D || out_size != M * D || ws_size < WS_END) { fprintf(stderr, "kernel_launch: unexpected shapes / workspace (n_in %d, in0 %d, out %d, ws %zu < %zu); nothing launched\n", n_in, n_in > 0 ? in_sizes[0] : -1, out_size, ws_size, (size_t)WS_END); grid = -1; return; }
        int dev = 0, cus = 0, per_cu = 0;
        if (hipGetDevice(&dev) != hipSuccess || hipDeviceGetAttribute(&cus, hipDeviceAttributeMultiprocessorCount, dev) != hipSuccess) { fprintf(stderr, "kernel_launch: device query failed\n"); grid = -1; return; }
        if (hipFuncSetAttribute((const void*)hybrid_fwd, hipFuncAttributeMaxDynamicSharedMemorySize, LDS_BYTES) != hipSuccess) { fprintf(stderr, "kernel_launch: hipFuncSetAttribute failed\n"); grid = -1; return; }
        if (hipOccupancyMaxActiveBlocksPerMultiprocessor(&per_cu, (const void*)hybrid_fwd, NWAVES * 64, LDS_BYTES) != hipSuccess || per_cu < 1) fprintf(stderr, "kernel_launch: note: occupancy query reports %d workgroups per CU\n", per_cu);
        (void)hipGetLastError();
        grid = cus;
    }
    if (grid < 0) return;
    if (hipMemsetAsync((char*)d_ws + WS_CTL, 0, CTL_ZERO_BYTES, stream) != hipSuccess) { fprintf(stderr, "kernel_launch: memset failed\n"); return; }
    Args a{};
    for (int i = 0; i < 15; ++i) a.in[i] = (const float*)d_in[i];
    a.out = (float*)d_out; a.ws = (unsigned char*)d_ws;
#if MK_SPLIT
    for (int ph = 0; ph < N_PHASES; ++ph) {
        if (ph == 6 || ph == 9) continue;
        a.ph_lo = ph; a.ph_hi = ph + 1;
        hipLaunchKernelGGL(hybrid_fwd, dim3(grid), dim3(NWAVES * 64), LDS_BYTES, stream, a);
    }
#else
    a.ph_lo = 0; a.ph_hi = N_PHASES;
    hipLaunchKernelGGL(hybrid_fwd, dim3(grid), dim3(NWAVES * 64), LDS_BYTES, stream, a);
#endif
    const hipError_t le = hipPeekAtLastError();
    if (le != hipSuccess) fprintf(stderr, "kernel_launch: launch failed: %s\n", hipGetErrorName(le));
}
```

```cpp
#include <hip/hip_runtime.h>
#include <cstdio>
#include <cstdint>
__device__ __forceinline__ int lane_id() { int l; asm volatile("v_mbcnt_lo_u32_b32 %0, -1, 0\n\tv_mbcnt_hi_u32_b32 %0, -1, %0" : "=v"(l)); return l; }
template <int MSK> __device__ __forceinline__ float xor_get(float v) {
    static_assert(MSK == 1 || MSK == 2 || MSK == 4 || MSK == 8 || MSK == 16, "xor_get: 1..16");
    if constexpr (MSK == 1) return __int_as_float(__builtin_amdgcn_update_dpp(0, __float_as_int(v), 0xB1, 0xF, 0xF, true));
    else if constexpr (MSK == 2) return __int_as_float(__builtin_amdgcn_update_dpp(0, __float_as_int(v), 0x4E, 0xF, 0xF, true));
    else return __int_as_float(__builtin_amdgcn_ds_swizzle(__float_as_int(v), 0x1F | (MSK << 10)));
}
__device__ __forceinline__ float xor32_sum(float v) { auto rr = __builtin_amdgcn_permlane32_swap(__float_as_uint(v), __float_as_uint(v), false, false); return __uint_as_float(rr[0]) + __uint_as_float(rr[1]); }
__device__ __forceinline__ float xor32_get(float v, int hi) { auto rr = __builtin_amdgcn_permlane32_swap(__float_as_uint(v), __float_as_uint(v), false, false); return __uint_as_float(hi ? rr[0] : rr[1]); }
__device__ __forceinline__ int tid_of(int wave) { int t = wave * 64 + lane_id(); asm volatile("" : "+v"(t)); return t; }
namespace pg8 {
#define PG8_LAS __attribute__((address_space(3)))
typedef unsigned short bf16_t;
typedef short bf16x8 __attribute__((ext_vector_type(8)));
typedef float f32x4 __attribute__((ext_vector_type(4)));
typedef unsigned u32x4 __attribute__((ext_vector_type(4)));
constexpr int BM = 256, BK = 64, HALF = 128, HTB = HALF * BK * 2  , STAGE_BYTES = 8 * HTB, NXCD = 8, WGM = 8;

__host__ __device__ __forceinline__ int lds_byte(int r, int c) { const int st = (r >> 4) * 2 + (c >> 5), rr = r & 15, cc = c & 31, ob = rr * 64 + cc * 2; return st * 1024 + (ob ^ (((ob >> 9) & 1) << 5)); }
__host__ __device__ __forceinline__ void stage_rc(int b, int& R, int& C) { const int st = b / 1024, sb = b % 1024, swz = sb ^ (((sb >> 9) & 1) << 5); R = (st >> 1) * 16 + swz / 64; C = (st & 1) * 32 + (swz % 64) / 2; }
__host__ __device__ __forceinline__ int perm32(int rho) { const int n = rho >> 4, i = rho & 15; return 8 * (i >> 2) + 4 * n + (i & 3); }

struct Unit { int pm, pn; size_t bofs; int kofs, ntu, kh; };
struct Gemm { const bf16_t* A; const bf16_t* Bt; int M, N, K; };

struct StaticOrder {
    int nM, nN, nwg, G, c;
    __host__ __device__ void init(int M, int N, int G_, int c_) { nM = M / BM; nN = N / BM; nwg = nM * nN; G = G_; c = c_; }
    __host__ __device__ bool next(int i, Unit& u) const {
        const long L = (long)i * G + c; if (L >= nwg) return false;
        int wgid = (int)L; { const int q = nwg / NXCD, r = nwg % NXCD, xcd = wgid % NXCD, off = wgid / NXCD; wgid = (xcd < r ? xcd * (q + 1) : r * (q + 1) + (xcd - r) * q) + off; }
        const int nig = WGM * nN, gid = wgid / nig, fm = gid * WGM, gsz = (nM - fm) < WGM ? (nM - fm) : WGM;
        u.pm = fm + ((wgid % nig) % gsz); u.pn = (wgid % nig) / gsz; u.bofs = 0; u.kofs = 0; u.ntu = 0; u.kh = 0; return true;
    }
    __device__ __forceinline__ void a_ready(const Unit&) const {}
    __device__ __forceinline__ void done(const Unit&) const {}
};

__device__ __forceinline__ unsigned cvt_pk_bf16(float lo, float hi) { unsigned r; asm volatile("v_cvt_pk_bf16_f32 %0, %1, %2" : "=v"(r) : "v"(lo), "v"(hi)); return r; }

typedef int i32x8 __attribute__((ext_vector_type(8)));
typedef int i32x4v __attribute__((ext_vector_type(4)));
__device__ __forceinline__ i32x8 cat8(bf16x8 a, bf16x8 b) { const i32x4v x = __builtin_bit_cast(i32x4v, a), y = __builtin_bit_cast(i32x4v, b); return (i32x8){x[0], x[1], x[2], x[3], y[0], y[1], y[2], y[3]}; }
__device__ __forceinline__ unsigned pk4_fp8(float a, float b, float c, float d) { int w = 0; w = __builtin_amdgcn_cvt_pk_fp8_f32(a, b, w, false); w = __builtin_amdgcn_cvt_pk_fp8_f32(c, d, w, true); return (unsigned)w; }
typedef unsigned u32x2w __attribute__((ext_vector_type(2)));
struct GroupSched {
    int nMt, nN, nwg, G, c; int t1, t2, t3, t4, t5, t6, t7; size_t estride;
    int nfullM, ntail, khalf;
    __device__ __forceinline__ bool next(int i, Unit& u) const {
        const long L = (long)i * G + c; if (L >= nwg) return false;
        const int nMf = nMt < nfullM ? nMt : nfullM, nwf = nMf * nN;
        if (L < nwf) {
            int wgid = (int)L; { const int q = nwf / NXCD, r = nwf % NXCD, xcd = wgid % NXCD, off = wgid / NXCD; wgid = (xcd < r ? xcd * (q + 1) : r * (q + 1) + (xcd - r) * q) + off; }
            const int nig = WGM * nN, gid = wgid / nig, fm = gid * WGM, gsz = (nMf - fm) < WGM ? (nMf - fm) : WGM;
            u.pm = fm + ((wgid % nig) % gsz); u.pn = (wgid % nig) / gsz; u.kofs = 0; u.ntu = 0; u.kh = 0;
        } else { const int r = (int)L - nwf, t = r >> 1; u.kh = r & 1; u.pm = nMf + t / nN; u.pn = t % nN; u.kofs = u.kh * khalf; u.ntu = ntail; }
        const int pm = u.pm;
        const int e = (pm >= t1) + (pm >= t2) + (pm >= t3) + (pm >= t4) + (pm >= t5) + (pm >= t6) + (pm >= t7);
        u.bofs = (size_t)__builtin_amdgcn_readfirstlane(e) * estride; return true;
    }
    __device__ __forceinline__ void a_ready(const Unit&) const {}
    __device__ __forceinline__ void done(const Unit&) const {}
};

struct EpiStoreBf16 {
    static constexpr bool PERM = true, AFTER_DRAIN = false;
    bf16_t* O; int ldc;
    __device__ __forceinline__ void operator()(const f32x4 (&acc)[2][2][4][2], const Unit& u, int wr, int wc, int fr, int fq) const {
        const int row0 = u.pm * BM + wr * 64 + fr, col0 = u.pn * BM + wc * 32 + 8 * fq;
#pragma unroll
        for (int ai = 0; ai < 2; ++ai)
#pragma unroll
            for (int m = 0; m < 4; ++m) { bf16_t* rowp = O + (size_t)(row0 + ai * HALF + m * 16) * ldc + col0;
#pragma unroll
                for (int bj = 0; bj < 2; ++bj) { const f32x4 v0 = acc[ai][bj][m][0], v1 = acc[ai][bj][m][1];
                    u32x4 w; w.x = cvt_pk_bf16(v0[0], v0[1]); w.y = cvt_pk_bf16(v0[2], v0[3]); w.z = cvt_pk_bf16(v1[0], v1[1]); w.w = cvt_pk_bf16(v1[2], v1[3]);
                    *(u32x4*)(rowp + bj * HALF) = w; } }
    }
};
struct EpiQKV {
    static constexpr bool PERM = true, AFTER_DRAIN = false;
    bf16_t* O; int ldc; const float* qg; const float* kg; float* kmean; PG8_LAS float* scr; const float* rsq;
    __device__ __forceinline__ void operator()(const f32x4 (&acc)[2][2][4][2], const Unit& u, int wr, int wc, int fr, int fq) const {
        const int row0 = u.pm * BM + wr * 64 + fr, col0 = u.pn * BM + wc * 32 + 8 * fq;
        const int part = u.pn >> 3, hp = u.pn & 7, h0 = 2 * hp;
        float rr[2][4];
#pragma unroll
        for (int ai = 0; ai < 2; ++ai)
#pragma unroll
            for (int m = 0; m < 4; ++m) { rr[ai][m] = 1.0f;
                if (rsq) { const f32x4 t_ = *(const f32x4*)(rsq + (size_t)(row0 + ai * HALF + m * 16) * 8 + 4 * (fq & 1)); float s_ = (t_[0] + t_[1]) + (t_[2] + t_[3]); s_ += xor_get<16>(s_);
                    rr[ai][m] = 1.0f / sqrtf(s_ * (1.0f / 2048.0f) + 1e-6f); } }
        if (!(part < 2 && hp <= 5)) {
#pragma unroll
            for (int ai = 0; ai < 2; ++ai)
#pragma unroll
                for (int m = 0; m < 4; ++m) { bf16_t* rowp = O + (size_t)(row0 + ai * HALF + m * 16) * ldc + col0;
#pragma unroll
                    for (int bj = 0; bj < 2; ++bj) { const f32x4 v0 = acc[ai][bj][m][0] * rr[ai][m], v1 = acc[ai][bj][m][1] * rr[ai][m];
                        u32x4 w; w.x = cvt_pk_bf16(v0[0], v0[1]); w.y = cvt_pk_bf16(v0[2], v0[3]); w.z = cvt_pk_bf16(v1[0], v1[1]); w.w = cvt_pk_bf16(v1[2], v1[3]);
                        *(u32x4*)(rowp + bj * HALF) = w; } }
            return;
        }
#pragma unroll
        for (int ai = 0; ai < 2; ++ai)
#pragma unroll
            for (int m = 0; m < 4; ++m)
#pragma unroll
                for (int bj = 0; bj < 2; ++bj) { const f32x4 v0 = acc[ai][bj][m][0] * rr[ai][m], v1 = acc[ai][bj][m][1] * rr[ai][m];
                    float s_ = v0[0] * v0[0]; s_ = fmaf(v0[1], v0[1], s_); s_ = fmaf(v0[2], v0[2], s_); s_ = fmaf(v0[3], v0[3], s_);
                    s_ = fmaf(v1[0], v1[0], s_); s_ = fmaf(v1[1], v1[1], s_); s_ = fmaf(v1[2], v1[2], s_); s_ = fmaf(v1[3], v1[3], s_);
                    s_ += xor_get<16>(s_); s_ = xor32_sum(s_);
                    if (fq == 0) scr[((wr * 16 + (ai * 4 + m) * 2 + bj) * 16 + fr) * 4 + wc] = s_; }
        asm volatile("s_waitcnt lgkmcnt(0)" ::: "memory"); __builtin_amdgcn_s_barrier();
        const float* gp = (part == 0) ? qg : kg; const float qs = (part == 0) ? 0.08838834764831845f * 1.4426950408889634f : 1.0f;
        f32x4 g[2][2];
#pragma unroll
        for (int bj = 0; bj < 2; ++bj) { const float* p_ = gp + ((h0 + bj) >= 6 ? 128 : 0) + wc * 32 + 8 * fq; g[bj][0] = *(const f32x4*)p_; g[bj][1] = *(const f32x4*)(p_ + 4); }
        const bool pass1 = (h0 + 1 > 10);
        f32x4 cs[2][2];
#pragma unroll
        for (int bj = 0; bj < 2; ++bj) { cs[bj][0] = (f32x4){0.f, 0.f, 0.f, 0.f}; cs[bj][1] = (f32x4){0.f, 0.f, 0.f, 0.f}; }
#pragma unroll
        for (int ai = 0; ai < 2; ++ai)
#pragma unroll
            for (int m = 0; m < 4; ++m) { bf16_t* rowp = O + (size_t)(row0 + ai * HALF + m * 16) * ldc + col0;
#pragma unroll
                for (int bj = 0; bj < 2; ++bj) { const f32x4 t_ = *(const PG8_LAS f32x4*)(scr + ((wr * 16 + (ai * 4 + m) * 2 + bj) * 16 + fr) * 4);
                    float rn = qs / sqrtf(((t_[0] + t_[1]) + (t_[2] + t_[3])) * (1.0f / 128.0f) + 1e-6f);
                    f32x4 y0 = acc[ai][bj][m][0] * rr[ai][m], y1 = acc[ai][bj][m][1] * rr[ai][m];
                    if (!(bj == 1 && pass1)) { y0 = y0 * rn * g[bj][0]; y1 = y1 * rn * g[bj][1]; }
                    cs[bj][0] += y0; cs[bj][1] += y1;
                    u32x4 w; w.x = cvt_pk_bf16(y0[0], y0[1]); w.y = cvt_pk_bf16(y0[2], y0[3]); w.z = cvt_pk_bf16(y1[0], y1[1]); w.w = cvt_pk_bf16(y1[2], y1[3]);
                    *(u32x4*)(rowp + bj * HALF) = w; } }
        if (part == 1 && hp >= 3) {
            PG8_LAS float* scr2 = scr + 2048;
#pragma unroll
            for (int bj = 0; bj < 2; ++bj)
#pragma unroll
                for (int n = 0; n < 2; ++n)
#pragma unroll
                    for (int j = 0; j < 4; ++j) { float c_ = cs[bj][n][j]; c_ += xor_get<1>(c_); c_ += xor_get<2>(c_); c_ += xor_get<4>(c_); c_ += xor_get<8>(c_);
                        if (fr == 0) scr2[wr * 256 + bj * HALF + wc * 32 + 8 * fq + 4 * n + j] = c_; }
            asm volatile("s_waitcnt lgkmcnt(0)" ::: "memory"); __builtin_amdgcn_s_barrier();
            const int t_ = (wr * 4 + wc) * 64 + fq * 16 + fr;
            if (t_ < 256) { const int hh = h0 + (t_ >> 7);
                if (hh >= 6 && hh <= 10) kmean[(size_t)(((u.pm >> 4) * 5 + (hh - 6)) * 16 + (u.pm & 15)) * 128 + (t_ & 127)] = (scr2[t_] + scr2[256 + t_]) * (1.0f / 256.0f); }
        }
    }
};
__device__ __forceinline__ float silu_mul(float g, float u) { const float e = __builtin_amdgcn_exp2f(g * -1.4426950408889634f); return g * __builtin_amdgcn_rcpf(1.0f + e) * u; }
struct EpiSwiGLU {
    static constexpr bool PERM = true, AFTER_DRAIN = false;
    bf16_t* O; int ldc;
    __device__ __forceinline__ void operator()(const f32x4 (&acc)[2][2][4][2], const Unit& u, int wr, int wc, int fr, int fq) const {
        const int row0 = u.pm * BM + wr * 64 + fr, col0 = u.pn * HALF + wc * 32 + 8 * fq;
#pragma unroll
        for (int ai = 0; ai < 2; ++ai)
#pragma unroll
            for (int m = 0; m < 4; ++m) { bf16_t* rowp = O + (size_t)(row0 + ai * HALF + m * 16) * ldc + col0;
                const f32x4 g0 = acc[ai][0][m][0], g1 = acc[ai][0][m][1], u0 = acc[ai][1][m][0], u1 = acc[ai][1][m][1];
                u32x4 w; w.x = cvt_pk_bf16(silu_mul(g0[0], u0[0]), silu_mul(g0[1], u0[1])); w.y = cvt_pk_bf16(silu_mul(g0[2], u0[2]), silu_mul(g0[3], u0[3]));
                w.z = cvt_pk_bf16(silu_mul(g1[0], u1[0]), silu_mul(g1[1], u1[1])); w.w = cvt_pk_bf16(silu_mul(g1[2], u1[2]), silu_mul(g1[3], u1[3]));
                *(u32x4*)rowp = w; }
    }
};
struct EpiSwiGLU8 {
    static constexpr bool PERM = true, AFTER_DRAIN = false;
    unsigned char* O; int ldc; const float* rsq;
    __device__ __forceinline__ void operator()(const f32x4 (&acc)[2][2][4][2], const Unit& u, int wr, int wc, int fr, int fq) const {
        typedef unsigned u32x2 __attribute__((ext_vector_type(2)));
        const int row0 = u.pm * BM + wr * 64 + fr, col0 = u.pn * HALF + wc * 32 + 8 * fq;
#pragma unroll
        for (int ai = 0; ai < 2; ++ai)
#pragma unroll
            for (int m = 0; m < 4; ++m) { unsigned char* rowp = O + (size_t)(row0 + ai * HALF + m * 16) * ldc + col0;
                float rr = 1.0f;
                if (rsq) { const f32x4 t_ = *(const f32x4*)(rsq + (size_t)(row0 + ai * HALF + m * 16) * 8 + 4 * (fq & 1)); float s_ = (t_[0] + t_[1]) + (t_[2] + t_[3]); s_ += xor_get<16>(s_);
                    rr = 1.0f / sqrtf(s_ * (1.0f / 2048.0f) + 1e-6f); }
                const f32x4 g0 = acc[ai][0][m][0] * rr, g1 = acc[ai][0][m][1] * rr, u0 = acc[ai][1][m][0] * rr, u1 = acc[ai][1][m][1] * rr;
                u32x2 w; w.x = pk4_fp8(silu_mul(g0[0], u0[0]), silu_mul(g0[1], u0[1]), silu_mul(g0[2], u0[2]), silu_mul(g0[3], u0[3]));
                w.y = pk4_fp8(silu_mul(g1[0], u1[0]), silu_mul(g1[1], u1[1]), silu_mul(g1[2], u1[2]), silu_mul(g1[3], u1[3]));
                *(u32x2*)rowp = w; }
    }
};
struct EpiResF32 {
    static constexpr bool PERM = true, AFTER_DRAIN = false;
    const float* base32; const bf16_t* base16; bf16_t* out16; int ldc; bf16_t* out16b; float* ssq; PG8_LAS float* scr; unsigned char* out8;
    __device__ __forceinline__ void operator()(const f32x4 (&acc)[2][2][4][2], const Unit& u, int wr, int wc, int fr, int fq) const {
        const int row0 = u.pm * BM + wr * 64 + fr, col0 = u.pn * BM + wc * 32 + 8 * fq;
#pragma unroll
        for (int ai = 0; ai < 2; ++ai)
#pragma unroll
            for (int m = 0; m < 4; ++m) { const size_t off = (size_t)(row0 + ai * HALF + m * 16) * ldc + col0; float sq_ = 0.f;
#pragma unroll
                for (int bj = 0; bj < 2; ++bj) { f32x4 v0 = acc[ai][bj][m][0], v1 = acc[ai][bj][m][1];
                    if (base32) { v0 += *(const f32x4*)(base32 + off + bj * HALF); v1 += *(const f32x4*)(base32 + off + bj * HALF + 4); }
                    else if (base16) { const u32x4 b = *(const u32x4*)(base16 + off + bj * HALF);
                        v0 += (f32x4){__uint_as_float(b.x << 16), __uint_as_float(b.x & 0xffff0000u), __uint_as_float(b.y << 16), __uint_as_float(b.y & 0xffff0000u)};
                        v1 += (f32x4){__uint_as_float(b.z << 16), __uint_as_float(b.z & 0xffff0000u), __uint_as_float(b.w << 16), __uint_as_float(b.w & 0xffff0000u)}; }
                    if (ssq) { float s_ = sq_; s_ = fmaf(v0[0], v0[0], s_); s_ = fmaf(v0[1], v0[1], s_); s_ = fmaf(v0[2], v0[2], s_); s_ = fmaf(v0[3], v0[3], s_);
                      s_ = fmaf(v1[0], v1[0], s_); s_ = fmaf(v1[1], v1[1], s_); s_ = fmaf(v1[2], v1[2], s_); s_ = fmaf(v1[3], v1[3], s_); sq_ = s_; }
                    u32x4 w; w.x = cvt_pk_bf16(v0[0], v0[1]); w.y = cvt_pk_bf16(v0[2], v0[3]); w.z = cvt_pk_bf16(v1[0], v1[1]); w.w = cvt_pk_bf16(v1[2], v1[3]);
                    *(u32x4*)((u.kh ? out16b : out16) + off + bj * HALF) = w;
                    if (out8) { u32x2w w8; w8.x = pk4_fp8(v0[0], v0[1], v0[2], v0[3]); w8.y = pk4_fp8(v1[0], v1[1], v1[2], v1[3]); *(u32x2w*)(out8 + off + bj * HALF) = w8; } }
                if (ssq) { float s_ = sq_; s_ += xor_get<16>(s_); s_ = xor32_sum(s_);
                    if (fq == 0) scr[((wr * 8 + ai * 4 + m) * 16 + fr) * 4 + wc] = s_; } }
        if (ssq) {
            asm volatile("s_waitcnt lgkmcnt(0)" ::: "memory"); __builtin_amdgcn_s_barrier();
            if (wc == 0 && fq == 0) {
#pragma unroll
                for (int ai = 0; ai < 2; ++ai)
#pragma unroll
                    for (int m = 0; m < 4; ++m) { const f32x4 t_ = *(const PG8_LAS f32x4*)(scr + ((wr * 8 + ai * 4 + m) * 16 + fr) * 4);
                        ssq[(size_t)(row0 + ai * HALF + m * 16) * 8 + u.pn] = (t_[0] + t_[1]) + (t_[2] + t_[3]); } }
        }
    }
};

template <class Epi, class Sched, bool ALIGN_EPI = false, bool SP2 = false, bool FP8 = false>
__device__ __forceinline__ void gemm_phase(PG8_LAS unsigned char* lds, const Gemm g, const Sched& S, const Epi& E, const int wave_) {
    const int tid = tid_of(wave_), wid = wave_, lane = tid & 63, wr = wid >> 2, wc = wid & 3, fr = lane & 15, fq = lane >> 4;
    const int K = g.K, nt = K / BK;
    unsigned voffA[2], voffB[2];
#pragma unroll
    for (int i = 0; i < 2; ++i) { int R, C; stage_rc(tid * 16 + i * 8192, R, C); const int Rb = Epi::PERM ? ((R & ~31) + perm32(R & 31)) : R;
        voffA[i] = (unsigned)(R * K + C) * 2u; voffB[i] = (unsigned)(Rb * K + C) * 2u; }
    const size_t kstep = (size_t)(BK * 2);
    const size_t hstep = (size_t)HALF * K * 2;
    const size_t tstep = 2 * hstep;
    const unsigned ldsw = (unsigned)wid * 1024u;
    const int aoff = lds_byte(wr * 64 + fr, fq * 8), boff = lds_byte(wc * 32 + fr, fq * 8);
#define PG8_SA(b, h) (((b) * 2 + (h)) * HTB)
#define PG8_SB(b, h) ((4 + (b) * 2 + (h)) * HTB)
#define PG8_STAGE(bufoff, gbase, voff) do { _Pragma("unroll") for (int _i = 0; _i < 2; ++_i) { unsigned _vo = (voff)[_i]; asm volatile("" : "+v"(_vo));     \
        __builtin_amdgcn_global_load_lds((const unsigned*)((const char*)(gbase) + _vo), (PG8_LAS unsigned*)(lds + (bufoff) + ldsw + _i * 8192), 16, 0, 0); } } while (0)
#define PG8_LDA(dst, b, h) do { _Pragma("unroll") for (int m = 0; m < 4; ++m) _Pragma("unroll") for (int k = 0; k < 2; ++k) dst[m][k] = *(const PG8_LAS bf16x8*)(lds + PG8_SA(b, h) + aoff + m * 2048 + k * 1024); } while (0)
#define PG8_LDB(dst, b, h) do { _Pragma("unroll") for (int n = 0; n < 2; ++n) _Pragma("unroll") for (int k = 0; k < 2; ++k) dst[n][k] = *(const PG8_LAS bf16x8*)(lds + PG8_SB(b, h) + boff + n * 2048 + k * 1024); } while (0)
#define PG8_MMA(ai, bj, At, Bt) do { __builtin_amdgcn_s_setprio(1); _Pragma("unroll") for (int m = 0; m < 4; ++m) _Pragma("unroll") for (int n = 0; n < 2; ++n) { \
        if constexpr (FP8) { acc[ai][bj][m][n] = __builtin_amdgcn_mfma_scale_f32_16x16x128_f8f6f4(cat8(Bt[n][0], Bt[n][1]), cat8(At[m][0], At[m][1]), acc[ai][bj][m][n], 0, 0, 0, 0x77777777, 0, 0x7f7f7f7f); } \
        else { _Pragma("unroll") for (int k = 0; k < 2; ++k) acc[ai][bj][m][n] = __builtin_amdgcn_mfma_f32_16x16x32_bf16(Bt[n][k], At[m][k], acc[ai][bj][m][n], 0, 0, 0); } } __builtin_amdgcn_s_setprio(0); } while (0)
#define PG8_WAIT_V(n) asm volatile("s_waitcnt vmcnt(" #n ")" ::: "memory")
#define PG8_WAIT_L(n) asm volatile("s_waitcnt lgkmcnt(" #n ")" ::: "memory")
#define PG8_BAR __builtin_amdgcn_s_barrier()
#define PG8_SCHED __builtin_amdgcn_sched_barrier(0)
    Unit cur, nxt; int ui = 0;
    if (!S.next(0, cur)) return;
    f32x4 acc[2][2][4][2];
#pragma unroll
    for (int a = 0; a < 2; ++a)
#pragma unroll
        for (int b = 0; b < 2; ++b)
#pragma unroll
            for (int m = 0; m < 4; ++m)
#pragma unroll
                for (int n = 0; n < 2; ++n) acc[a][b][m][n] = (f32x4){0.f, 0.f, 0.f, 0.f};
    bf16x8 At[4][2], B0[2][2], B1[2][2];
    const char* cA = (const char*)g.A + (size_t)cur.pm * tstep + cur.kofs; const char* cB = (const char*)g.Bt + cur.bofs + (size_t)cur.pn * tstep + cur.kofs;
    S.a_ready(cur);
    if constexpr (SP2) {
        PG8_STAGE(PG8_SB(0, 0), cB, voffB); PG8_STAGE(PG8_SB(0, 1), cB + hstep, voffB); PG8_STAGE(PG8_SA(0, 0), cA, voffA); PG8_STAGE(PG8_SA(0, 1), cA + hstep, voffA);
        if (wr == 1) PG8_BAR;
        PG8_WAIT_V(2); PG8_BAR;
        PG8_STAGE(PG8_SB(1, 0), cB + kstep, voffB); PG8_STAGE(PG8_SA(1, 0), cA + kstep, voffA); PG8_STAGE(PG8_SB(1, 1), cB + hstep + kstep, voffB);
        PG8_WAIT_V(6); PG8_BAR;
    } else {
        PG8_STAGE(PG8_SB(0, 0), cB, voffB); PG8_STAGE(PG8_SA(0, 0), cA, voffA); PG8_STAGE(PG8_SB(0, 1), cB + hstep, voffB); PG8_STAGE(PG8_SA(0, 1), cA + hstep, voffA);
        if (wr == 1) PG8_BAR;
        PG8_WAIT_V(4); PG8_BAR;
        PG8_STAGE(PG8_SB(1, 0), cB + kstep, voffB); PG8_STAGE(PG8_SA(1, 0), cA + kstep, voffA); PG8_STAGE(PG8_SB(1, 1), cB + hstep + kstep, voffB);
        PG8_WAIT_V(6); PG8_BAR;
    }
    for (;;) {
        const bool has_next = S.next(ui + 1, nxt);
        const char* nA = has_next ? (const char*)g.A + (size_t)nxt.pm * tstep + nxt.kofs : cA; const char* nB = has_next ? (const char*)g.Bt + nxt.bofs + (size_t)nxt.pn * tstep + nxt.kofs : cB;
        const int ntc = cur.ntu ? cur.ntu : nt;
        for (int t = 0; t < ntc; t += 2) {
            const bool last = (t == ntc - 2);
            const char* a1 = cA + (size_t)(t + 1) * kstep;
            const char* a2 = last ? nA : cA + (size_t)(t + 2) * kstep; const char* b2 = last ? nB : cB + (size_t)(t + 2) * kstep;
            const char* a3 = a2 + kstep; const char* b3 = b2 + kstep;
            if (last && has_next) S.a_ready(nxt);
            if constexpr (SP2) {
            PG8_LDB(B0, 0, 0); PG8_LDB(B1, 0, 1); PG8_SCHED; PG8_LDA(At, 0, 0); PG8_STAGE(PG8_SA(1, 1), a1 + hstep, voffA);
            PG8_WAIT_V(8); PG8_WAIT_L(0); PG8_BAR; PG8_MMA(0, 0, At, B0); PG8_MMA(0, 1, At, B1); PG8_BAR; PG8_SCHED;
            PG8_LDA(At, 0, 1); PG8_STAGE(PG8_SB(0, 0), b2, voffB); PG8_STAGE(PG8_SB(0, 1), b2 + hstep, voffB); PG8_STAGE(PG8_SA(0, 0), a2, voffA);
            PG8_WAIT_V(8); PG8_WAIT_L(0); PG8_BAR; PG8_MMA(1, 0, At, B0); PG8_MMA(1, 1, At, B1); PG8_BAR; PG8_SCHED;
            PG8_LDB(B0, 1, 0); PG8_LDB(B1, 1, 1); PG8_SCHED; PG8_LDA(At, 1, 0); PG8_STAGE(PG8_SA(0, 1), a2 + hstep, voffA);
            PG8_WAIT_V(8); PG8_WAIT_L(0); PG8_BAR; PG8_MMA(0, 0, At, B0); PG8_MMA(0, 1, At, B1); PG8_BAR; PG8_SCHED;
            PG8_LDA(At, 1, 1); PG8_STAGE(PG8_SB(1, 0), b3, voffB); PG8_STAGE(PG8_SB(1, 1), b3 + hstep, voffB); PG8_STAGE(PG8_SA(1, 0), a3, voffA);
            PG8_WAIT_V(8); PG8_WAIT_L(0); PG8_BAR; PG8_MMA(1, 0, At, B0); PG8_MMA(1, 1, At, B1); PG8_BAR; PG8_SCHED;
            } else {
            PG8_LDB(B0, 0, 0); PG8_SCHED; PG8_LDA(At, 0, 0); PG8_STAGE(PG8_SA(1, 1), a1 + hstep, voffA);
            PG8_WAIT_L(8); PG8_BAR; PG8_WAIT_L(0); PG8_MMA(0, 0, At, B0); PG8_BAR; PG8_SCHED;
            PG8_LDB(B1, 0, 1); PG8_STAGE(PG8_SB(0, 0), b2, voffB);
            PG8_BAR; PG8_WAIT_L(0); PG8_MMA(0, 1, At, B1); PG8_BAR;
            PG8_LDA(At, 0, 1); PG8_STAGE(PG8_SA(0, 0), a2, voffA);
            PG8_BAR; PG8_WAIT_L(0); PG8_MMA(1, 0, At, B0); PG8_BAR; PG8_SCHED;
            PG8_STAGE(PG8_SB(0, 1), b2 + hstep, voffB);
            PG8_WAIT_V(6); PG8_BAR; PG8_MMA(1, 1, At, B1); PG8_BAR;
            PG8_LDB(B0, 1, 0); PG8_SCHED; PG8_LDA(At, 1, 0); PG8_STAGE(PG8_SA(0, 1), a2 + hstep, voffA);
            PG8_WAIT_L(8); PG8_BAR; PG8_WAIT_L(0); PG8_MMA(0, 0, At, B0); PG8_BAR; PG8_SCHED;
            PG8_LDB(B1, 1, 1); PG8_STAGE(PG8_SB(1, 0), b3, voffB);
            PG8_BAR; PG8_WAIT_L(0); PG8_MMA(0, 1, At, B1); PG8_BAR;
            PG8_LDA(At, 1, 1); PG8_STAGE(PG8_SA(1, 0), a3, voffA);
            PG8_BAR; PG8_WAIT_L(0); PG8_MMA(1, 0, At, B0); PG8_BAR; PG8_SCHED;
            PG8_STAGE(PG8_SB(1, 1), b3 + hstep, voffB);
            PG8_WAIT_V(6); PG8_BAR; PG8_MMA(1, 1, At, B1); PG8_BAR;
            }
        }
        if constexpr (ALIGN_EPI) { if (wr == 0) PG8_BAR; }
        if constexpr (!Epi::AFTER_DRAIN) { const int l2_ = lane_id(); E(acc, cur, wr, wc, l2_ & 15, l2_ >> 4); S.done(cur); }
        if (!has_next) break;
#pragma unroll
        for (int a = 0; a < 2; ++a)
#pragma unroll
            for (int b = 0; b < 2; ++b)
#pragma unroll
                for (int m = 0; m < 4; ++m)
#pragma unroll
                    for (int n = 0; n < 2; ++n) acc[a][b][m][n] = (f32x4){0.f, 0.f, 0.f, 0.f};
        cur = nxt; cA = nA; cB = nB; ++ui;
        if constexpr (ALIGN_EPI) { if (wr == 1) PG8_BAR; }
    }
    PG8_WAIT_V(0);
    if constexpr (!ALIGN_EPI) { if (wr == 0) PG8_BAR; }
    PG8_BAR;
    if constexpr (Epi::AFTER_DRAIN) { E.fused(acc, cur, wr, wc, fr, fq, lds, wid, lane); S.done(cur); }
#undef PG8_SA
#undef PG8_SB
#undef PG8_STAGE
#undef PG8_LDA
#undef PG8_LDB
#undef PG8_MMA
#undef PG8_WAIT_V
#undef PG8_WAIT_L
#undef PG8_BAR
#undef PG8_SCHED
}
}

namespace att {
typedef unsigned short bf16;
typedef short bf16x8 __attribute__((ext_vector_type(8)));
typedef short s16x4 __attribute__((ext_vector_type(4)));
typedef float f32x16 __attribute__((ext_vector_type(16)));
typedef float f32x4 __attribute__((ext_vector_type(4)));
typedef unsigned u32x4 __attribute__((ext_vector_type(4)));
typedef int i32x4 __attribute__((ext_vector_type(4)));
constexpr int QS = 6144, SEQ = 4096, DM = 2048;
constexpr int DPW = 1408, DPLW = 16, NTOK = 8192;
constexpr int SHM_T = 16384;
constexpr int L_V = 0, L_K = 2 * SHM_T, L_Q = 4 * SHM_T, L_WS = L_Q + 65536, L_TL = L_WS + 2048, L_FLG = L_TL + 256, L_MSK = L_FLG + 64, L_KM = L_V, L_END = L_MSK + 64;
static_assert(L_END <= 140 * 1024, "attention LDS map");
constexpr float C2 = 0.08838834764831845f * 1.4426950408889634f;
#define KSWZ(row, colB) ((row) * 256 + ((colB) ^ (((row) & 7) << 4)))
#define SBAR() __builtin_amdgcn_sched_barrier(0)
__device__ __forceinline__ int v_st(int k, int c) { const int kk = (k & ~0xC) | ((k & 4) << 1) | ((k & 8) >> 1); return ((kk >> 3) * 4 + (c >> 5)) * 512 + ((kk & 7) * 32 + (c & 31)) * 2; }
__device__ __forceinline__ int v_rd_base(int lane) { return ((lane & 3) << 3) | (((lane >> 2) & 3) << 6) | (((lane >> 4) & 1) << 5) | (((lane >> 5) & 1) << 8); }
constexpr int v_rd_off(int d0, int ks, int half) { return d0 * 512 + ks * 4096 + half * 2048; }
__device__ __forceinline__ int crow(int r, int hi) { return (r & 3) + 8 * (r >> 2) + 4 * hi; }
__device__ __forceinline__ unsigned cvtpk(float lo, float hi) { unsigned r; asm volatile("v_cvt_pk_bf16_f32 %0, %1, %2" : "=v"(r) : "v"(lo), "v"(hi)); return r; }
__device__ __forceinline__ float bf2f(short s) { return __uint_as_float(((unsigned)(unsigned short)s) << 16); }

__device__ __forceinline__ void qkt(f32x16& p0, f32x16& p1, const f32x16& init, const char* Kt, int r32, int hi, const char* qf  ) {
    p0 = init; p1 = init;
    const char* kb[4];
#pragma unroll
    for (int dd = 0; dd < 4; ++dd) kb[dd] = Kt + KSWZ(r32, (dd * 16 + hi * 8) * 2);
#pragma unroll
    for (int d0 = 0; d0 < 8; ++d0) { const char* a = kb[d0 & 3] + (d0 >> 2) * 128;
        bf16x8 b0 = *reinterpret_cast<const bf16x8*>(a);
        bf16x8 b1 = *reinterpret_cast<const bf16x8*>(a + 32 * 256);
        const bf16x8 q = *reinterpret_cast<const bf16x8*>(qf + d0 * 1024);
        p0 = __builtin_amdgcn_mfma_f32_32x32x16_bf16(b0, q, p0, 0, 0, 0);
        p1 = __builtin_amdgcn_mfma_f32_32x32x16_bf16(b1, q, p1, 0, 0, 0); }
}
__device__ __forceinline__ void pv_tile(f32x16* o, int vb, bf16x8 pa0, bf16x8 pa1, bf16x8 pa2, bf16x8 pa3) {
#define TRRD(dst, off) asm volatile("ds_read_b64_tr_b16 %0, %1 offset:%2" : "=&v"(dst) : "v"(vb), "i"(off) : "memory")
#define PV_D0(d0) do { s16x4 l0, l1, l2, l3, h0, h1, h2, h3; constexpr int b_ = v_rd_off(d0, 0, 0); \
        TRRD(l0, b_); TRRD(h0, b_ + 2048); TRRD(l1, b_ + 4096); TRRD(h1, b_ + 6144); TRRD(l2, b_ + 8192); TRRD(h2, b_ + 10240); TRRD(l3, b_ + 12288); TRRD(h3, b_ + 14336); \
        asm volatile("s_waitcnt lgkmcnt(0)" ::: "memory"); SBAR(); \
        o[d0] = __builtin_amdgcn_mfma_f32_32x32x16_bf16(pa0, (bf16x8){l0[0], l0[1], l0[2], l0[3], h0[0], h0[1], h0[2], h0[3]}, o[d0], 0, 0, 0);   \
        o[d0] = __builtin_amdgcn_mfma_f32_32x32x16_bf16(pa1, (bf16x8){l1[0], l1[1], l1[2], l1[3], h1[0], h1[1], h1[2], h1[3]}, o[d0], 0, 0, 0);   \
        o[d0] = __builtin_amdgcn_mfma_f32_32x32x16_bf16(pa2, (bf16x8){l2[0], l2[1], l2[2], l2[3], h2[0], h2[1], h2[2], h2[3]}, o[d0], 0, 0, 0);   \
        o[d0] = __builtin_amdgcn_mfma_f32_32x32x16_bf16(pa3, (bf16x8){l3[0], l3[1], l3[2], l3[3], h3[0], h3[1], h3[2], h3[3]}, o[d0], 0, 0, 0); } while (0)
    PV_D0(0); PV_D0(1); PV_D0(2); PV_D0(3);
#undef PV_D0
#undef TRRD
}
__device__ __forceinline__ void pack_p(const f32x16& p0, const f32x16& p1, bf16x8& pa0, bf16x8& pa1, bf16x8& pa2, bf16x8& pa3) {
#define PK4(P, B_, OUT) do { unsigned a0 = cvtpk(P[B_+0], P[B_+1]), a1 = cvtpk(P[B_+2], P[B_+3]);                          \
        unsigned b0 = cvtpk(P[B_+4], P[B_+5]), b1 = cvtpk(P[B_+6], P[B_+7]);                                             \
        auto r0 = __builtin_amdgcn_permlane32_swap(a0, b0, false, false); auto r1 = __builtin_amdgcn_permlane32_swap(a1, b1, false, false); \
        u32x4 w = {r0[0], r1[0], r0[1], r1[1]}; OUT = *reinterpret_cast<bf16x8*>(&w); } while (0)
    PK4(p0, 0, pa0); PK4(p0, 8, pa1); PK4(p1, 0, pa2); PK4(p1, 8, pa3);
#undef PK4
}
__device__ __forceinline__ float softplus2(float y) { return fmaxf(y, 0.f) + __builtin_amdgcn_logf(1.0f + __builtin_amdgcn_exp2f(-fabsf(y))); }

struct AttnArgs { const bf16* qkv; bf16* obuf; const float* kmean; const float* out_gain; bf16* dpo; float* dpl; unsigned* mlist; unsigned* mcnt; unsigned* mdone; };
constexpr int MLCAP = 3840, N_SEL = 2 * 5 * 15;
__device__ __forceinline__ unsigned ld_sc1(const unsigned* p) { return __hip_atomic_load(p, __ATOMIC_RELAXED, __HIP_MEMORY_SCOPE_AGENT); }
__device__ __forceinline__ void st_sc1(unsigned* p, unsigned v) { __hip_atomic_store(p, v, __ATOMIC_RELAXED, __HIP_MEMORY_SCOPE_AGENT); }

template <int mode> __device__ __forceinline__ void attn_unit(const AttnArgs& A, const int b, const int h, const int sub, char* shm, const int wave_) {
    const int tid = tid_of(wave_), wid = wave_, lane = tid & 63, r32 = lane & 31, hi = lane >> 5;
    int dil = 1, res = 0, qb = sub, br = 0;
    int gk = 0, gcnt = 0; unsigned gent = 0u; bool gvalid = true, wvalid = true;
    if (mode == 0) { br = sub >> 4; const int x = sub & 15; if (br == 0) { qb = x; } else if (br == 1) { dil = 4; res = x >> 2; qb = x & 3; } else { dil = 16; res = x; qb = 0; } }
    if (mode == 3) { gk = sub >> 4; const int c = sub & 15; const int li = (b * 5 + (h - 6)) * 15 + gk;
        gcnt = __builtin_amdgcn_readfirstlane((int)ld_sc1(A.mcnt + li));
        if (c * 256 >= gcnt) return;
        const int gi = c * 256 + wid * 32 + r32; gvalid = gi < gcnt; wvalid = (c * 256 + wid * 32) < gcnt;
        gent = ld_sc1(A.mlist + (size_t)li * MLCAP + (gvalid ? gi : 0)); qb = 0; }
    const size_t rowbase = (size_t)b * SEQ + res; const int q0 = qb * 256;
    const bf16* Qp = A.qkv + (rowbase + (size_t)dil * ((mode == 3) ? (int)(gent & 4095u) : (q0 + wid * 32 + r32))) * QS + h * 128;
    const bf16* Kh = A.qkv + rowbase * QS + 2048 + h * 128;
    const bf16* Vh = A.qkv + rowbase * QS + 4096 + h * 128;
    const size_t rstep = (size_t)dil * QS;
    char* V_lds = shm + L_V; char* K_lds = shm + L_K;
    float* wsf = (float*)(shm + L_WS) + wid * 64; float* li_l = wsf; float* al_l = wsf + 32;
    int* TL = (int*)(shm + L_TL); int* FLG = (int*)(shm + L_FLG); unsigned* MSK = (unsigned*)(shm + L_MSK); float* KM = (float*)(shm + L_KM);
    char* qf = shm + L_Q + wid * 8192 + lane * 16;
    bf16x8 qr[8];
#pragma unroll
    for (int d0 = 0; d0 < 8; ++d0) { qr[d0] = *reinterpret_cast<const bf16x8*>(Qp + d0 * 16 + hi * 8); *reinterpret_cast<bf16x8*>(qf + d0 * 1024) = qr[d0]; }
    const int qw0 = q0 + wid * 32;
    const int pos = qw0 + r32;
    const int vb0 = (int)(uintptr_t)V_lds + v_rd_base(lane);
    unsigned koffb[2], voffb[2];
#pragma unroll
    for (int i = 0; i < 2; ++i) { const int Lb = (2 * wid + i) * 1024 + lane * 16;
        const int rowk = Lb >> 8, ck = ((Lb >> 4) & 15) ^ (rowk & 7);
        koffb[i] = (unsigned)(((size_t)rowk * rstep + ck * 8) * 2);
        const int sub_ = Lb >> 9, win_ = Lb & 511, kk = (sub_ >> 2) * 8 + (win_ >> 6), kv = (kk & ~0xC) | ((kk & 4) << 1) | ((kk & 8) >> 1), cc = (sub_ & 3) * 4 + ((win_ & 63) >> 4);
        voffb[i] = (unsigned)(((size_t)kv * rstep + cc * 8) * 2); }
    typedef __attribute__((address_space(3))) unsigned lds_u32;
    lds_u32* const Kdst = (lds_u32*)(K_lds + wid * 2048); lds_u32* const Vdst = (lds_u32*)(V_lds + wid * 2048);
    const float sl = (mode == 2) ? 0.f : __builtin_amdgcn_exp2f(-8.0f * (float)(h + 1) / 11.0f) * 1.4426950408889634f * (float)dil;
    f32x16 binit;
#pragma unroll
    for (int r = 0; r < 16; ++r) binit[r] = sl * (float)((r & 3) + 8 * (r >> 2) + 4 * hi);
    const float sl32 = 32.f * sl;

    int NT = 0;
    if (mode == 1) { NT = 4; if (tid < 4) TL[tid] = q0 + 192 - 64 * tid; }
    else if (mode == 3) { NT = 4; if (tid < 4) TL[tid] = gk * 256 + 192 - 64 * tid; }
    else if (mode == 0) {
        const int lo = q0 >= 128 ? q0 - 128 : 0; NT = (q0 + 256 - lo) / 64;
        if (tid < NT) TL[NT - 1 - tid] = lo + 64 * tid;
    } else {
        NT = (q0 + 256) / 64;
        if (tid < NT) TL[tid] = q0 + 192 - 64 * tid;
    }
    __syncthreads();

    float m_reg = -1e30f, l_reg = 0.f, carry = 0.f; asm volatile("" : "+v"(m_reg), "+v"(l_reg), "+v"(carry));
    f32x16 o[4];
#pragma unroll
    for (int d0 = 0; d0 < 4; ++d0) o[d0] = f32x16{};
    bool wdone = false;
#define TDMA(k0_, bf_) do { const char* kt_ = (const char*)(Kh + (size_t)(k0_) * rstep); const char* vt_ = (const char*)(Vh + (size_t)(k0_) * rstep); \
        _Pragma("unroll") for (int i_ = 0; i_ < 2; ++i_) { unsigned ko_ = koffb[i_], vo_ = voffb[i_]; asm volatile("" : "+v"(ko_), "+v"(vo_)); \
            __builtin_amdgcn_global_load_lds((const unsigned*)(kt_ + ko_), (lds_u32*)((__attribute__((address_space(3))) char*)Kdst + (bf_) * SHM_T + i_ * 1024), 16, 0, 0); \
            __builtin_amdgcn_global_load_lds((const unsigned*)(vt_ + vo_), (lds_u32*)((__attribute__((address_space(3))) char*)Vdst + (bf_) * SHM_T + i_ * 1024), 16, 0, 0); } } while (0)
    if (NT > 0) { const int k0 = __builtin_amdgcn_readfirstlane(TL[0]); TDMA(k0, 0); }
    __syncthreads();
    for (int t = 0; t < NT; ++t) {
        const int buf = t & 1; const int kb = __builtin_amdgcn_readfirstlane(TL[t]);
        const bool more = (t + 1 < NT);
        if (more) { const int k1 = __builtin_amdgcn_readfirstlane(TL[t + 1]); TDMA(k1, buf ^ 1); }
        bool act;
        if (mode == 0) act = (kb <= qw0 + 31) && (kb + 63 >= qw0 - 128);
        else if (mode == 1) act = (kb <= qw0 + 31);
        else if (mode == 3) act = wvalid;
        else act = (kb < qw0 + 32) && !wdone;
        if (act) {
            f32x16 p0, p1;
            qkt(p0, p1, binit, K_lds + buf * SHM_T, r32, hi, qf);
            bf16x8 pa0, pa1, pa2, pa3;
            const int dq = pos - kb - 4 * hi;
            if (mode == 2) {
                float Og[8], Pg[8];
#pragma unroll
                for (int i = 0; i < 8; ++i) { float ye[4], le[4];
#pragma unroll
                    for (int e = 0; e < 4; ++e) { const int c = (i < 4) ? (8 * i + e) : (8 * (i - 4) + 32 + e); const float y = ((i < 4) ? p0[4 * i + e] : p1[4 * (i - 4) + e]) * C2;
                        ye[e] = y; le[e] = (dq - c >= 1) ? -softplus2(y) : 0.f; }
                    const float w2 = le[3], w1 = w2 + le[2], w0 = w1 + le[1];
                    Og[i] = w0 + le[0];
                    const float x0 = ye[0] + le[0] + w0, x1 = ye[1] + le[1] + w1, x2 = ye[2] + le[2] + w2, x3 = ye[3] + le[3];
                    if (i < 4) { p0[4 * i] = x0; p0[4 * i + 1] = x1; p0[4 * i + 2] = x2; p0[4 * i + 3] = x3; } else { p1[4 * (i - 4)] = x0; p1[4 * (i - 4) + 1] = x1; p1[4 * (i - 4) + 2] = x2; p1[4 * (i - 4) + 3] = x3; } }
#pragma unroll
                for (int i = 0; i < 8; ++i) Pg[i] = xor32_get(Og[i], hi);
                float run = carry;
#pragma unroll
                for (int i = 7; i >= 0; --i) { const float ab = run + (hi == 0 ? Pg[i] : 0.f);
#pragma unroll
                    for (int e = 0; e < 4; ++e) { const int c = (i < 4) ? (8 * i + e) : (8 * (i - 4) + 32 + e);
                        if (i < 4) p0[4 * i + e] = (dq - c >= 1) ? __builtin_amdgcn_exp2f(p0[4 * i + e] + ab) : 0.f;
                        else p1[4 * (i - 4) + e] = (dq - c >= 1) ? __builtin_amdgcn_exp2f(p1[4 * (i - 4) + e] + ab) : 0.f; }
                    run += Og[i] + Pg[i]; }
                carry = run;
                wdone = __all(carry < -160.f) != 0;
                pack_p(p0, p1, pa0, pa1, pa2, pa3);
            } else {
                const float NEG = -__builtin_inff();
                bool rowok = true;
                if (mode == 0) {
                    if (!((kb + 63 <= qw0) && (qw0 + 31 - kb <= 128))) {
#pragma unroll
                        for (int r = 0; r < 16; ++r) { const int c = (r & 3) + 8 * (r >> 2);
                            p0[r] = ((unsigned)(dq - c) <= 128u) ? p0[r] : NEG; p1[r] = ((unsigned)(dq - c - 32) <= 128u) ? p1[r] : NEG; } }
                } else if (mode == 1) {
                    if (kb + 63 > qw0) {
#pragma unroll
                        for (int r = 0; r < 16; ++r) { const int c = (r & 3) + 8 * (r >> 2);
                            p0[r] = (dq - c >= 0) ? p0[r] : NEG; p1[r] = (dq - c - 32 >= 0) ? p1[r] : NEG; } }
                } else rowok = gvalid;
                const float tb = sl * (float)kb;
                float pm0 = p0[0], pm1 = p1[0];
#pragma unroll
                for (int r = 1; r < 16; ++r) { pm0 = fmaxf(pm0, p0[r]); pm1 = fmaxf(pm1, p1[r]); }
                float pmax = fmaxf(pm0, pm1 + sl32);
                { auto rr = __builtin_amdgcn_permlane32_swap(__float_as_uint(pmax), __float_as_uint(pmax), false, false); pmax = fmaxf(__uint_as_float(rr[0]), __uint_as_float(rr[1])); }
                pmax = rowok ? pmax : NEG;
                const float m_loc = m_reg - tb;
                const float mn = fmaxf(m_loc, pmax); const float alpha = __builtin_amdgcn_exp2f(m_loc - mn); m_reg = mn + tb;
                const float ref0 = rowok ? mn : __builtin_inff(), ref1 = ref0 - sl32;
                float ps = 0.f;
#pragma unroll
                for (int r = 0; r < 16; ++r) { p0[r] = __builtin_amdgcn_exp2f(p0[r] - ref0); p1[r] = __builtin_amdgcn_exp2f(p1[r] - ref1); ps += p0[r] + p1[r]; }
                { auto rr = __builtin_amdgcn_permlane32_swap(__float_as_uint(ps), __float_as_uint(ps), false, false); ps = __uint_as_float(rr[0]) + __uint_as_float(rr[1]); }
                l_reg = l_reg * alpha + ps;
                pack_p(p0, p1, pa0, pa1, pa2, pa3);
                if (__any(alpha < 1.f)) { if (hi == 0) al_l[r32] = alpha; asm volatile("s_waitcnt lgkmcnt(0)" ::: "memory");
#pragma unroll
                    for (int d_ = 0; d_ < 4; ++d_)
#pragma unroll
                        for (int r = 0; r < 16; ++r) o[d_][r] *= al_l[crow(r, hi)]; }
            }
            SBAR();
            pv_tile(o, vb0 + buf * SHM_T, pa0, pa1, pa2, pa3);
        }
        if (mode == 2) { if (lane == 0) FLG[buf * 8 + wid] = wdone ? 1 : 0; }
        __syncthreads();
        if (mode == 2) { const i32x4 fa = *(const i32x4*)(FLG + buf * 8), fb = *(const i32x4*)(FLG + buf * 8 + 4);
            if ((fa[0] & fa[1] & fa[2] & fa[3] & fb[0] & fb[1] & fb[2] & fb[3]) != 0) break; }
    }
#undef TDMA
    if (mode != 2) {
        const int slot = (mode == 0) ? br : 0;
        const size_t tok0 = rowbase + (size_t)dil * qw0;
        int* ts_l = (int*)al_l;
        if (hi == 0) { const float lse = (l_reg > 0.f) ? (m_reg + __builtin_amdgcn_logf(l_reg) - ((mode == 0) ? sl * (float)pos : 0.f)) : -__builtin_inff();
            if (mode == 3) { const int ts = gvalid ? (int)((1u + (gent >> 12)) * (unsigned)NTOK + (unsigned)rowbase + (gent & 4095u)) : -1; ts_l[r32] = ts; if (gvalid) A.dpl[(size_t)ts * DPLW + h] = lse; }
            else A.dpl[((size_t)slot * NTOK + tok0 + (size_t)dil * r32) * DPLW + h] = lse;
            if (mode == 1) { for (int s_ = 1 + (qb < 3 ? qb : 3); s_ < 4; ++s_) A.dpl[((size_t)s_ * NTOK + tok0 + r32) * DPLW + h] = -__builtin_inff(); }
            li_l[r32] = (l_reg > 0.f) ? __builtin_amdgcn_rcpf(l_reg) : 0.f; }
        asm volatile("s_waitcnt lgkmcnt(0)" ::: "memory");
        float rli[16];
#pragma unroll
        for (int r = 0; r < 16; ++r) rli[r] = li_l[crow(r, hi)];
        if (mode == 3) {
#pragma unroll
            for (int r = 0; r < 16; ++r) { const int ts = ts_l[crow(r, hi)]; bf16* Ow = A.dpo + (size_t)(ts < 0 ? 0 : ts) * DPW + h * 128;
#pragma unroll
                for (int d0 = 0; d0 < 4; ++d0) { const float v = o[d0][r] * rli[r]; const float vn = xor_get<1>(v);
                    if ((r32 & 1) == 0 && ts >= 0) *(unsigned*)(Ow + d0 * 32 + r32) = cvtpk(v, vn); } }
        } else {
        bf16* Ow = A.dpo + ((size_t)slot * NTOK + tok0) * DPW + h * 128;
#pragma unroll
        for (int r = 0; r < 16; ++r) { const int orow = crow(r, hi);
#pragma unroll
            for (int d0 = 0; d0 < 4; ++d0) { const float v = o[d0][r] * rli[r]; const float vn = xor_get<1>(v);
                if ((r32 & 1) == 0) *(unsigned*)(Ow + (size_t)orow * dil * DPW + d0 * 32 + r32) = cvtpk(v, vn); } }
        }
    } else {
        float ssq[16];
#pragma unroll
        for (int r = 0; r < 16; ++r) { float a = 0.f;
#pragma unroll
            for (int d0 = 0; d0 < 4; ++d0) { const float v = o[d0][r]; a = fmaf(v, v, a); }
            ssq[r] = a; }
#pragma unroll
        for (int r = 0; r < 16; ++r) { float a = ssq[r]; a += xor_get<1>(a); a += xor_get<2>(a); a += xor_get<4>(a); a += xor_get<8>(a); a += xor_get<16>(a); ssq[r] = a; }
        float gn[4];
#pragma unroll
        for (int d0 = 0; d0 < 4; ++d0) gn[d0] = A.out_gain[h * 128 + d0 * 32 + r32];
        bf16* Ow = A.obuf + (rowbase + qw0) * DM + h * 128;
#pragma unroll
        for (int r = 0; r < 16; ++r) { const int orow = crow(r, hi); const float rn = 1.0f / sqrtf(ssq[r] * (1.0f / 128.0f) + 1e-6f);
#pragma unroll
            for (int d0 = 0; d0 < 4; ++d0) { const float v = o[d0][r] * rn * gn[d0]; const float vn = xor_get<1>(v);
                if ((r32 & 1) == 0) *(unsigned*)(Ow + (size_t)orow * DM + d0 * 32 + r32) = cvtpk(v, vn); } }
    }
}

__device__ __forceinline__ void moba_select(const AttnArgs& A, const int b, const int h, const int qb, char* shm, const int wave_) {
    const int tid = tid_of(wave_), wid = wave_, lane = tid & 63, r32 = lane & 31, hi = lane >> 5;
    float* KM = (float*)(shm + L_KM); int* LC = (int*)(shm + L_TL); int* LB = LC + 16;
    const int pos = qb * 256 + wid * 32 + r32;
    const bf16* Qp = A.qkv + ((size_t)b * SEQ + pos) * QS + h * 128;
    bf16x8 qr[8];
#pragma unroll
    for (int d0 = 0; d0 < 8; ++d0) qr[d0] = *reinterpret_cast<const bf16x8*>(Qp + d0 * 16 + hi * 8);
    if (tid < 16) LC[tid] = 0;
    { const float* src = A.kmean + (size_t)((b * 5 + (h - 6)) * 16) * 128; *(f32x4*)(KM + tid * 4) = *(const f32x4*)(src + tid * 4); }
    __syncthreads();
    float gate[16];
#pragma unroll
    for (int j = 0; j < 16; ++j) gate[j] = 0.f;
#pragma unroll
    for (int d0 = 0; d0 < 8; ++d0) {
        float qv[8];
#pragma unroll
        for (int e = 0; e < 8; ++e) qv[e] = bf2f(qr[d0][e]);
#pragma unroll
        for (int j = 0; j < 16; ++j) { const f32x4 k0 = *(const f32x4*)(KM + j * 128 + d0 * 16 + hi * 8), k1 = *(const f32x4*)(KM + j * 128 + d0 * 16 + hi * 8 + 4);
            float a = gate[j];
            a = fmaf(qv[0], k0[0], a); a = fmaf(qv[1], k0[1], a); a = fmaf(qv[2], k0[2], a); a = fmaf(qv[3], k0[3], a);
            a = fmaf(qv[4], k1[0], a); a = fmaf(qv[5], k1[1], a); a = fmaf(qv[6], k1[2], a); a = fmaf(qv[7], k1[3], a);
            gate[j] = a; }
    }
#pragma unroll
    for (int j = 0; j < 16; ++j) gate[j] = xor32_sum(gate[j]);
    unsigned sel = 0u;
#pragma unroll
    for (int it = 0; it < 3; ++it) { float best = -__builtin_inff(); int bi = -1;
#pragma unroll
        for (int j = 0; j < 16; ++j) { const bool ok = (j < qb) && (((sel >> j) & 1u) == 0u) && (gate[j] > best); if (ok) { best = gate[j]; bi = j; } }
        if (bi >= 0) sel |= 1u << bi; }
    int jj0 = -1, jj1 = -1, jj2 = -1, ll0 = 0, ll1 = 0, ll2 = 0;
    if (hi == 0) { unsigned s_ = sel;
        if (s_) { jj0 = __builtin_ctz(s_); s_ &= s_ - 1u; ll0 = __hip_atomic_fetch_add(LC + jj0, 1, __ATOMIC_RELAXED, __HIP_MEMORY_SCOPE_WORKGROUP); }
        if (s_) { jj1 = __builtin_ctz(s_); s_ &= s_ - 1u; ll1 = __hip_atomic_fetch_add(LC + jj1, 1, __ATOMIC_RELAXED, __HIP_MEMORY_SCOPE_WORKGROUP); }
        if (s_) { jj2 = __builtin_ctz(s_); ll2 = __hip_atomic_fetch_add(LC + jj2, 1, __ATOMIC_RELAXED, __HIP_MEMORY_SCOPE_WORKGROUP); } }
    __syncthreads();
    const int lbase = (b * 5 + (h - 6)) * 15;
    if (tid < 15) { const int n = LC[tid]; LB[tid] = n ? (int)__hip_atomic_fetch_add(A.mcnt + lbase + tid, (unsigned)n, __ATOMIC_RELAXED, __HIP_MEMORY_SCOPE_AGENT) : 0; }
    __syncthreads();
    if (hi == 0) {
        if (jj0 >= 0) st_sc1(A.mlist + (size_t)(lbase + jj0) * MLCAP + LB[jj0] + ll0, (unsigned)pos);
        if (jj1 >= 0) st_sc1(A.mlist + (size_t)(lbase + jj1) * MLCAP + LB[jj1] + ll1, (unsigned)pos | (1u << 12));
        if (jj2 >= 0) st_sc1(A.mlist + (size_t)(lbase + jj2) * MLCAP + LB[jj2] + ll2, (unsigned)pos | (2u << 12)); }
    asm volatile("s_waitcnt vmcnt(0)" ::: "memory");
    __syncthreads();
    if (tid == 0) __hip_atomic_fetch_add(A.mdone, 1u, __ATOMIC_RELAXED, __HIP_MEMORY_SCOPE_AGENT);
}

constexpr bool unit_valid(int mode, int sub) { return mode == 0 ? sub < 48 : sub < 16; }
constexpr int unit_cost(int mode, int sub) {
    if (mode == 0) return 4;
    if (mode == 2) return 4 * (sub + 1) < 6 ? 4 * (sub + 1) : 6;
    return 4;
}
constexpr int gath_expected(int kb) { int len = 0; for (int qb = kb + 1; qb < 16; ++qb) len += (qb <= 3) ? 256 : 768 / qb; return (len + 255) / 256; }
constexpr int N_GATH = 2 * 5 * 120;
constexpr int N_UNITS = 2 * 6 * 48 + 2 * 5 * 16 + 2 * 5 * 16;
constexpr int CHUNK_TILES = 2, N_CHUNKS = 2240;
constexpr int N_TICKETS = N_SEL + N_UNITS + N_GATH + N_CHUNKS;
struct OrderTab { unsigned short v[N_TICKETS]; };
constexpr OrderTab make_order() {
    OrderTab T{}; int n = 0, nc = 0; long tot = 0, acc = 0;
    for (int b = 0; b < 2; ++b) for (int hr = 0; hr < 5; ++hr) for (int qb = 15; qb >= 1; --qb) T.v[n++] = (unsigned short)(0x2000 | (b << 9) | (hr << 6) | qb);
    for (int mode = 0; mode < 3; ++mode) { const int nh = (mode == 0) ? 6 : 5; for (int sub = 0; sub < 64; ++sub) if (unit_valid(mode, sub)) tot += 2L * nh * unit_cost(mode, sub); }
    for (int kb = 0; kb < 15; ++kb) tot += 2L * 5 * 4 * (gath_expected(kb) < 15 - kb ? gath_expected(kb) : 15 - kb);
    for (int cost = 64; cost >= 1; --cost)
        for (int mode = 2; mode >= 0; --mode) { const int nh = (mode == 0) ? 6 : 5;
            for (int sub = 63; sub >= 0; --sub) { if (!unit_valid(mode, sub) || unit_cost(mode, sub) != cost) continue;
                for (int b = 0; b < 2; ++b) for (int hr = 0; hr < nh; ++hr) { T.v[n++] = (unsigned short)((mode << 10) | (b << 9) | (hr << 6) | sub);
                    acc += (long)cost * N_CHUNKS; while (acc >= tot && nc < N_CHUNKS) { T.v[n++] = (unsigned short)(0x8000 | nc); ++nc; acc -= tot; } } } }
    for (int c = 0; c < 15; ++c) for (int kb = 0; kb + c < 15; ++kb) { if (c >= gath_expected(kb)) continue;
        for (int b = 0; b < 2; ++b) for (int hr = 0; hr < 5; ++hr) { T.v[n++] = (unsigned short)(0x4000 | (b << 11) | (hr << 8) | (kb << 4) | c);
            acc += 4L * N_CHUNKS; while (acc >= tot && nc < N_CHUNKS) { T.v[n++] = (unsigned short)(0x8000 | nc); ++nc; acc -= tot; } } }
    while (nc < N_CHUNKS) { T.v[n++] = (unsigned short)(0x8000 | nc); ++nc; }
    for (int c = 0; c < 15; ++c) for (int kb = 0; kb + c < 15; ++kb) { if (c < gath_expected(kb)) continue;
        for (int b = 0; b < 2; ++b) for (int hr = 0; hr < 5; ++hr) T.v[n++] = (unsigned short)(0x4000 | (b << 11) | (hr << 8) | (kb << 4) | c); }
    return T;
}
__device__ const OrderTab ATT_ORDER = make_order();
#undef KSWZ
#undef SBAR
}


constexpr int NWAVES = 8;
#ifndef MK_SPLIT
#define MK_SPLIT 0
#endif
constexpr int BATCH = 2, SEQ = 4096, D = 2048, FF = 5632, NE = 8;
constexpr int M = BATCH * SEQ;
constexpr int NQKV = 3 * D, NGU = 2 * FF;
constexpr int MPAD = 18432;
constexpr float EPS = 1e-6f;
constexpr size_t MiB = 1u << 20;
constexpr size_t WS_CTL = 0, CTL_ZERO_BYTES = 1 * MiB;
constexpr size_t WS_WQKV = 1 * MiB;
constexpr size_t WS_WO = 49 * MiB;
constexpr size_t WS_WGU_D = 65 * MiB;
constexpr size_t WS_WD_D = 109 * MiB;
constexpr size_t WS_WGU_M = 131 * MiB;
constexpr size_t WS_WD_M = 483 * MiB;
constexpr size_t WS_H = 659 * MiB;
constexpr size_t WS_QKV = 723 * MiB;
constexpr size_t WS_O = 819 * MiB;
constexpr size_t WS_A = 851 * MiB;
constexpr size_t WS_YS = WS_QKV;
constexpr size_t WS_ACT = 883 * MiB;
constexpr size_t WS_XS = 1081 * MiB;
constexpr size_t WS_MISC = 1153 * MiB;
constexpr size_t WS_DPO = 1154 * MiB;
constexpr size_t WS_DPL = 1242 * MiB;
constexpr size_t WS_MLIST = 1244 * MiB;
constexpr size_t WS_END = 1249 * MiB;
constexpr size_t MISC_KMEAN = 0, MISC_SELE = 131072, MISC_SELREL = MISC_SELE + 32768, MISC_SELG = MISC_SELREL + 65536, MISC_SELPOS = MISC_SELG + 65536, MISC_RSQ = 393216  , MISC_RSQ2 = MISC_RSQ + 262144;
static_assert(MISC_SELPOS + 65536 <= MISC_RSQ && MISC_RSQ2 + 262144 <= MiB && (size_t)MPAD * D * 4 <= 160 * MiB && (size_t)MPAD * FF * 2 <= 198 * MiB, "ws map");
constexpr int CW_TMO = 0, CW_CODE = 1;
constexpr int CW_BAR = 4096;
constexpr int CW_ATTQ = 8192;
constexpr int CW_CNT = 8448;
constexpr int CW_MCNT = 9216;
constexpr int CW_MDONE = 10240;
constexpr int RING_OFF = 0, RING_BYTES = 131072;
constexpr int LDSCTL_OFF = 143360, MISC_OFF = LDSCTL_OFF + 320;
constexpr int LDS_BYTES = 147456;
constexpr int PPL = 11, N_PHASES = 2 * PPL;

#define GAS __attribute__((address_space(1)))
#define LAS __attribute__((address_space(3)))
typedef unsigned short bf16;
typedef unsigned v4u __attribute__((ext_vector_type(4)));
typedef float f32x4 __attribute__((ext_vector_type(4)));
typedef short bf16x8 __attribute__((ext_vector_type(8)));
typedef GAS unsigned gu32;
typedef GAS unsigned long long gu64;
#define RLX_AGENT __ATOMIC_RELAXED, __HIP_MEMORY_SCOPE_AGENT
#define LDS_WAIT() asm volatile("s_waitcnt lgkmcnt(0)" ::: "memory")
#define VM_WAIT() asm volatile("s_waitcnt vmcnt(0)" ::: "memory")
__device__ __forceinline__ unsigned long long rt() { return __builtin_amdgcn_s_memrealtime(); }
__device__ __forceinline__ unsigned f2bf(float f) { unsigned u = __builtin_bit_cast(unsigned, f); return (u + 0x7fffu + ((u >> 16) & 1u)) >> 16; }
__device__ __forceinline__ unsigned pk2(float lo, float hi) { return f2bf(lo) | (f2bf(hi) << 16); }

#define XB_TMO      128
#define XB_XCNT(j)  (256  + 64 * (j))
#define XB_XSUB(j)  (1280 + 64 * (j))
#define XB_XGEN(j)  (2304 + 64 * (j))
#define XB_TOP      3328
#define XB_TOPGEN   3392
#define XCD_BAR_WORDS 3456
#define XB_SPIN_CAP (1u << 18)

__device__ __forceinline__ unsigned xb_ld(unsigned* p)              { return __hip_atomic_load(p, __ATOMIC_RELAXED, __HIP_MEMORY_SCOPE_AGENT); }
__device__ __forceinline__ unsigned xb_add(unsigned* p, unsigned v) { return __hip_atomic_fetch_add(p, v, __ATOMIC_RELAXED, __HIP_MEMORY_SCOPE_AGENT); }
__device__ __forceinline__ unsigned xb_xcc_id() { return (unsigned)__builtin_amdgcn_s_getreg((3 << 11) | 20) & 0xFu; }
#define XB_SPIN(cond, bar) do { unsigned _sp = 0; while (cond) { __builtin_amdgcn_s_sleep(1); \
    if ((++_sp & 255u) == 0u) { if (xb_ld(&(bar)[XB_TMO])) break; if (_sp > XB_SPIN_CAP) { atomicAdd(&(bar)[XB_TMO], 1u); break; } } } } while (0)

#define XB_IS_T0 (b.wv == 0 && lane_id() == 0)
struct XcdBarrier {
    int wv;
    unsigned* bar; unsigned x;
    volatile LAS unsigned* st;
};

__device__ __forceinline__ XcdBarrier xcd_barrier_post(unsigned* bar, volatile LAS unsigned* st, int wv) {
    XcdBarrier b; b.bar = bar; b.x = xb_xcc_id(); b.st = st; b.wv = wv;
    if (XB_IS_T0) (void)xb_add(&bar[XB_XCNT(b.x)], 1u);
    return b;
}
__device__ __forceinline__ void xcd_barrier_complete(unsigned* bar, unsigned x, unsigned& nloc, unsigned& nx) {
    const unsigned G = gridDim.x * gridDim.y * gridDim.z;
    unsigned sum, cnt, mine, sp = 0u;
    for (;;) {
        sum = 0u; cnt = 0u; mine = 0u;
#pragma unroll
        for (unsigned j = 0; j < 16; ++j) { const unsigned c = xb_ld(&bar[XB_XCNT(j)]); sum += c; cnt += (c > 0u) ? 1u : 0u; mine = (j == x) ? c : mine; }
        if (sum == G) break;
        __builtin_amdgcn_s_sleep(1);
        if ((++sp & 255u) == 0u) { if (xb_ld(&bar[XB_TMO])) break; if (sp > XB_SPIN_CAP) { atomicAdd(&bar[XB_TMO], 1u); break; } }
    }
    nloc = mine > 0u ? mine : 1u; nx = cnt > 0u ? cnt : 1u;
}

__device__ __forceinline__ void xcd_barrier(const XcdBarrier& b) {
    asm volatile("s_waitcnt vmcnt(0)" ::: "memory");
    __syncthreads();
    if (XB_IS_T0) {
        unsigned* bar = b.bar;
        __builtin_amdgcn_s_waitcnt(0);
        unsigned nloc = b.st[0], nx = b.st[1];
        if (nloc == 0u) { xcd_barrier_complete(bar, b.x, nloc, nx); b.st[0] = nloc; b.st[1] = nx; }
        const unsigned old = xb_add(&bar[XB_XSUB(b.x)], 1u);
        const unsigned gen = old / nloc;
        if (old + 1u == (gen + 1u) * nloc) {
            __builtin_amdgcn_fence(__ATOMIC_RELEASE, "agent");
            asm volatile("s_waitcnt vmcnt(0)" ::: "memory");
            const unsigned og = xb_add(&bar[XB_TOP], 1u);
            const unsigned tg = og / nx;
            if (og + 1u == (tg + 1u) * nx) xb_add(&bar[XB_TOPGEN], 1u);
            else XB_SPIN(xb_ld(&bar[XB_TOPGEN]) == tg, bar);
            __builtin_amdgcn_fence(__ATOMIC_ACQUIRE, "agent");
            xb_add(&bar[XB_XGEN(b.x)], 1u);
            asm volatile("s_waitcnt vmcnt(0)" ::: "memory");
        } else {
            XB_SPIN(xb_ld(&bar[XB_XGEN(b.x)]) == gen, bar);
            __builtin_amdgcn_fence(__ATOMIC_ACQUIRE, "agent");
            asm volatile("s_waitcnt vmcnt(0)" ::: "memory");
        }
    }
    __syncthreads();
}


__device__ __forceinline__ float wave_sum(float v) {
    v += xor_get<1>(v); v += xor_get<2>(v); v += xor_get<4>(v); v += xor_get<8>(v); v += xor_get<16>(v);
    return xor32_sum(v);
}
__device__ __forceinline__ float bf2f_u(unsigned short s) { return __uint_as_float(((unsigned)s) << 16); }
typedef unsigned u32x2_g __attribute__((ext_vector_type(2)));
__device__ __forceinline__ f32x4 bf4_to_f32(u32x2_g a) { return (f32x4){__uint_as_float(a.x << 16), __uint_as_float(a.x & 0xffff0000u), __uint_as_float(a.y << 16), __uint_as_float(a.y & 0xffff0000u)}; }

__device__ __forceinline__ void p0_transpose_item(const float* W, int K, int N, bf16* WT, int mode, LAS float* scr, int item, int lane) {
    const int nblk = N / 32, kb = item / nblk, nb = item % nblk, k0 = 64 * kb, n0 = 32 * nb;
#pragma unroll 8
    for (int i = 0; i < 32; ++i) { const int kk = 2 * i + (lane >> 5); scr[kk * 33 + (lane & 31)] = W[(size_t)(k0 + kk) * N + n0 + (lane & 31)]; }
    LDS_WAIT(); asm volatile("" ::: "memory");
    const int drow0 = (mode == 0) ? n0 : (256 * (n0 >> 7) + (n0 & 127) + (mode == 2 ? 128 : 0));
    const int c = lane & 7;
#pragma unroll
    for (int j = 0; j < 4; ++j) { const int n = (lane >> 3) + 8 * j; const LAS float* s = scr + (8 * c) * 33 + n;
        v4u o; o.x = pk2(s[0 * 33], s[1 * 33]); o.y = pk2(s[2 * 33], s[3 * 33]); o.z = pk2(s[4 * 33], s[5 * 33]); o.w = pk2(s[6 * 33], s[7 * 33]);
        *(GAS v4u*)(WT + (size_t)(drow0 + n) * K + k0 + 8 * c) = o; }
    LDS_WAIT(); asm volatile("" ::: "memory");
}

__device__ __forceinline__ void p0_transpose_item_fp8(const float* W, int K, int N, unsigned char* WT, int mode, LAS float* scr, int item, int lane) {
    const int nblk = N / 32, kb = item / nblk, nb = item % nblk, k0 = 64 * kb, n0 = 32 * nb;
#pragma unroll 8
    for (int i = 0; i < 32; ++i) { const int kk = 2 * i + (lane >> 5); scr[kk * 33 + (lane & 31)] = W[(size_t)(k0 + kk) * N + n0 + (lane & 31)]; }
    LDS_WAIT(); asm volatile("" ::: "memory");
    const int drow0 = (mode == 0) ? n0 : (256 * (n0 >> 7) + (n0 & 127) + (mode == 2 ? 128 : 0));
    const int n = lane & 31, kq = lane >> 5; const LAS float* sp = scr + (32 * kq) * 33 + n;
    v4u o0, o1;
#define P4(j) pg8::pk4_fp8(sp[(4 * (j)) * 33] * 256.f, sp[(4 * (j) + 1) * 33] * 256.f, sp[(4 * (j) + 2) * 33] * 256.f, sp[(4 * (j) + 3) * 33] * 256.f)
    o0.x = P4(0); o0.y = P4(1); o0.z = P4(2); o0.w = P4(3); o1.x = P4(4); o1.y = P4(5); o1.z = P4(6); o1.w = P4(7);
#undef P4
    GAS v4u* dst = (GAS v4u*)(WT + (size_t)(drow0 + n) * K + k0 + 32 * kq);
    dst[0] = o0; dst[1] = o1;
    LDS_WAIT(); asm volatile("" ::: "memory");
}

struct Ptrs {
    const float *x, *attn_norm, *w_in, *q_gain, *k_gain, *out_gain, *w_out, *ffn_norm, *dwg, *dwu, *dwd, *router, *mwg, *mwu, *mwd;
    float* out;
    bf16 *Wqkv_t, *Wo_t, *QKV, *OB, *AB;
    unsigned char *Wgu_d, *Wd_d, *Wgu_m, *Wd_m, *AB8, *ACT, *XS;
    float *kmean, *DPL; bf16 *DPO, *YS, *H; unsigned* sel_e; int* sel_rel; float* sel_g; int* sel_pos;
    gu32* ctl; float* rsq;
};

struct CvTile { const float* W; unsigned char* WT; int K, N, mode, f8, r; const float* gain; };
__device__ __forceinline__ CvTile cv_decode(const Ptrs& P, int it) {
    constexpr int T_IN = (D / 128) * (NQKV / 256), T_O = (D / 128) * (D / 256), T_G = (D / 128) * (FF / 256), T_D = (FF / 128) * (D / 256), T_E = 2 * T_G + T_D;
    CvTile c; int r = it; c.gain = nullptr;
    if (r < T_IN) { c.W = P.w_in; c.WT = (unsigned char*)P.Wqkv_t; c.K = D; c.N = NQKV; c.mode = 0; c.f8 = 0; c.r = r; return c; } r -= T_IN;
    if (r < T_O) { c.W = P.w_out; c.WT = (unsigned char*)P.Wo_t; c.K = D; c.N = D; c.mode = 0; c.f8 = 0; c.r = r; return c; } r -= T_O;
    if (r < T_G) { c.W = P.dwg; c.WT = P.Wgu_d; c.K = D; c.N = FF; c.mode = 1; c.f8 = 1; c.r = r; c.gain = P.ffn_norm; return c; } r -= T_G;
    if (r < T_G) { c.W = P.dwu; c.WT = P.Wgu_d; c.K = D; c.N = FF; c.mode = 2; c.f8 = 1; c.r = r; c.gain = P.ffn_norm; return c; } r -= T_G;
    if (r < T_D) { c.W = P.dwd; c.WT = P.Wd_d; c.K = FF; c.N = D; c.mode = 0; c.f8 = 1; c.r = r; return c; } r -= T_D;
    if (r < T_IN) { c.W = P.w_in + (size_t)D * NQKV; c.WT = (unsigned char*)(P.Wqkv_t + (size_t)NQKV * D); c.K = D; c.N = NQKV; c.mode = 0; c.f8 = 0; c.r = r; c.gain = P.attn_norm + D; return c; } r -= T_IN;
    if (r < T_O) { c.W = P.w_out + (size_t)D * D; c.WT = (unsigned char*)(P.Wo_t + (size_t)D * D); c.K = D; c.N = D; c.mode = 0; c.f8 = 0; c.r = r; return c; } r -= T_O;
    const int e = r / T_E; r -= e * T_E; c.f8 = 1;
    if (r < T_G) { c.W = P.mwg + (size_t)e * D * FF; c.WT = P.Wgu_m + (size_t)e * NGU * D; c.K = D; c.N = FF; c.mode = 1; c.r = r; return c; } r -= T_G;
    if (r < T_G) { c.W = P.mwu + (size_t)e * D * FF; c.WT = P.Wgu_m + (size_t)e * NGU * D; c.K = D; c.N = FF; c.mode = 2; c.r = r; return c; } r -= T_G;
    c.W = P.mwd + (size_t)e * FF * D; c.WT = P.Wd_m + (size_t)e * D * FF; c.K = FF; c.N = D; c.mode = 0; c.r = r; return c;
}
constexpr int CV_T_IN = (D / 128) * (NQKV / 256), CV_T_O = (D / 128) * (D / 256), CV_T_G = (D / 128) * (FF / 256), CV_T_D = (FF / 128) * (D / 256);
constexpr int CV_L0 = CV_T_IN + CV_T_O + 2 * CV_T_G + CV_T_D, CV_DEF = CV_T_IN + CV_T_O + NE * (2 * CV_T_G + CV_T_D);
static_assert(CV_DEF == 2 * att::N_CHUNKS * att::CHUNK_TILES, "deferred conversion tiles = 2 phases x N_CHUNKS x CHUNK_TILES");
__device__ __forceinline__ void cv_tile_out(const CvTile& cur, LAS float* S, int tid_) {
    constexpr int LS = 260;
    const int nbl = cur.N / 256, kb = cur.r / nbl, nb = cur.r - kb * nbl;
    if (cur.f8) {
#pragma unroll
        for (int i = 0; i < 4; ++i) { const int p = tid_ + 512 * i, kq = p & 7, n = p >> 3, nn = 256 * nb + n;
            const int drow = (cur.mode == 0) ? nn : (256 * (nn >> 7) + (nn & 127) + (cur.mode == 2 ? 128 : 0));
            const LAS float* sp = S + (16 * kq) * LS + (n ^ (4 * kq)); v4u o;
#define P4(j) pg8::pk4_fp8(sp[(4 * (j)) * LS] * 256.f, sp[(4 * (j) + 1) * LS] * 256.f, sp[(4 * (j) + 2) * LS] * 256.f, sp[(4 * (j) + 3) * LS] * 256.f)
            o.x = P4(0); o.y = P4(1); o.z = P4(2); o.w = P4(3);
#undef P4
            __builtin_nontemporal_store(o, (GAS v4u*)(cur.WT + (size_t)drow * cur.K + 128 * kb + 16 * kq)); } }
    else {
#pragma unroll
        for (int i = 0; i < 8; ++i) { const int p = tid_ + 512 * i, kc = p & 15, n = p >> 4, nn = 256 * nb + n;
            const int drow = (cur.mode == 0) ? nn : (256 * (nn >> 7) + (nn & 127) + (cur.mode == 2 ? 128 : 0));
            const LAS float* sp = S + (8 * kc) * LS + (n ^ (4 * (kc >> 1))); v4u o;
            o.x = pk2(sp[0], sp[LS]); o.y = pk2(sp[2 * LS], sp[3 * LS]); o.z = pk2(sp[4 * LS], sp[5 * LS]); o.w = pk2(sp[6 * LS], sp[7 * LS]);
            *(GAS v4u*)((bf16*)cur.WT + (size_t)drow * cur.K + 128 * kb + 8 * kc) = o; } }
}
__device__ __forceinline__ void cv8_to_lds(const f32x4 (&v)[16], LAS unsigned char* T, int wave, int lane) {
    unsigned d[16];
#pragma unroll
    for (int i = 0; i < 16; ++i) d[i] = pg8::pk4_fp8(v[i].x * 256.f, v[i].y * 256.f, v[i].z * 256.f, v[i].w * 256.f);
    unsigned o[4][4];
#pragma unroll
    for (int q = 0; q < 4; ++q) { const unsigned a = d[4 * q], b = d[4 * q + 1], c = d[4 * q + 2], e = d[4 * q + 3];
        const unsigned t0 = __builtin_amdgcn_perm(b, a, 0x05010400u), t1 = __builtin_amdgcn_perm(b, a, 0x07030602u), t2 = __builtin_amdgcn_perm(e, c, 0x05010400u), t3 = __builtin_amdgcn_perm(e, c, 0x07030602u);
        o[0][q] = __builtin_amdgcn_perm(t2, t0, 0x05040100u); o[1][q] = __builtin_amdgcn_perm(t2, t0, 0x07060302u); o[2][q] = __builtin_amdgcn_perm(t3, t1, 0x05040100u); o[3][q] = __builtin_amdgcn_perm(t3, t1, 0x07060302u); }
#pragma unroll
    for (int j = 0; j < 4; ++j) { v4u w; w.x = o[j][0]; w.y = o[j][1]; w.z = o[j][2]; w.w = o[j][3];
        *(LAS v4u*)(T + (4 * lane + j) * 128 + 16 * (wave ^ (lane & 7))) = w; }
}
__device__ __forceinline__ void cv8_out(const CvTile& cur, const LAS unsigned char* T, int tid_) {
    const int nbl = cur.N / 256, kb = cur.r / nbl, nb = cur.r - kb * nbl;
#pragma unroll
    for (int i = 0; i < 4; ++i) { const int p = tid_ + 512 * i, c = p & 7, n = p >> 3, nn = 256 * nb + n;
        const int drow = (cur.mode == 0) ? nn : (256 * (nn >> 7) + (nn & 127) + (cur.mode == 2 ? 128 : 0));
        const v4u w = *(const LAS v4u*)(T + n * 128 + 16 * (c ^ ((n >> 2) & 7)));
        __builtin_nontemporal_store(w, (GAS v4u*)(cur.WT + (size_t)drow * cur.K + 128 * kb + 16 * c)); }
}
__device__ __forceinline__ void convert_weights(const Ptrs& P, LAS unsigned char* lds, int t0, int step, int t1, int wave, int lane) {
    asm volatile("" : "+v"(lane));
    constexpr int LS = 260;
    LAS float* S = (LAS float*)(lds + RING_OFF);
    LAS unsigned char* T8 = lds + RING_OFF;
    const int tid_ = wave * 64 + lane;
    if (t0 >= t1) return;
    f32x4 va[16], vb[16];
#define CV_LOAD(v, c) do { const int nbl_ = (c).N / 256, kb_ = (c).r / nbl_, nb_ = (c).r - kb_ * nbl_; const float* p_ = (c).W + (size_t)(128 * kb_ + wave * 16) * (c).N + 256 * nb_ + 4 * lane; \
        _Pragma("unroll") for (int i_ = 0; i_ < 16; ++i_) (v)[i_] = __builtin_nontemporal_load((const f32x4*)(p_ + (size_t)i_ * (c).N)); } while (0)
#define CV_TOLDS(v) do { _Pragma("unroll") for (int i_ = 0; i_ < 16; ++i_) *(LAS f32x4*)(S + (wave * 16 + i_) * LS + ((4 * lane) ^ (4 * wave))) = (v)[i_]; LDS_WAIT(); __syncthreads(); } while (0)
#define CV_STEP(v, c, tcur, tnext_is_f8) do { const CvTile done_ = (c); \
        if (done_.gain) { const int nbl_ = done_.N / 256; typedef __attribute__((address_space(4))) const float cfloat_; const cfloat_* gp_ = (const cfloat_*)(done_.gain + 128 * (done_.r / nbl_) + wave * 16);     \
            _Pragma("unroll") for (int i_ = 0; i_ < 16; ++i_) (v)[i_] = (v)[i_] * gp_[i_]; } \
        if (done_.f8) { cv8_to_lds(v, T8 + par * 32768, wave, lane); LDS_WAIT(); __syncthreads(); } else { CV_TOLDS(v); } \
        tcur += 2 * step; if (tcur < t1) { (c) = cv_decode(P, tcur); CV_LOAD(v, c); } \
        if (done_.f8) { cv8_out(done_, T8 + par * 32768, tid_); par ^= 1; if (!(tnext_is_f8)) { LDS_WAIT(); __syncthreads(); } } \
        else { cv_tile_out(done_, S, tid_); LDS_WAIT(); __syncthreads(); } } while (0)
    int ta = t0, tb = t0 + step, par = 0;
    CvTile ca = cv_decode(P, ta), cb = ca; CV_LOAD(va, ca);
    if (tb < t1) { cb = cv_decode(P, tb); CV_LOAD(vb, cb); }
    for (;;) {
        { const bool nf8 = (tb < t1) && cb.f8; CV_STEP(va, ca, ta, nf8); }
        if (tb >= t1) break;
        { const bool nf8 = (ta < t1) && ca.f8; CV_STEP(vb, cb, tb, nf8); }
        if (ta >= t1) break;
    }
#undef CV_LOAD
#undef CV_TOLDS
#undef CV_STEP
}
__device__ __forceinline__ void attn_conv_phase(const Ptrs& P, const att::AttnArgs& A, int layer, unsigned* qctr, unsigned char* lds, const int wave_) {
    char* shm = (char*)lds + RING_OFF;
    int* TK = (int*)(shm + att::L_MSK) + 4;
    const bool t0_ = (wave_ == 0 && lane_id() == 0);
    int nxt_ = 0; if (t0_) nxt_ = (int)__hip_atomic_fetch_add(qctr, 1u, __ATOMIC_RELAXED, __HIP_MEMORY_SCOPE_AGENT);
    bool selrdy = false;
    for (;;) {
        __syncthreads();
        if (t0_) TK[0] = nxt_;
        __syncthreads();
        const int tk = __builtin_amdgcn_readfirstlane(TK[0]);
        if (tk >= att::N_TICKETS) break;
        if (t0_) nxt_ = (int)__hip_atomic_fetch_add(qctr, 1u, __ATOMIC_RELAXED, __HIP_MEMORY_SCOPE_AGENT);
        const int code = att::ATT_ORDER.v[tk];
        if (code & 0x8000) {
            const int t0 = CV_L0 + (layer * att::N_CHUNKS + (code & 0x7fff)) * att::CHUNK_TILES;
            convert_weights(P, (LAS unsigned char*)lds, t0, 1, t0 + att::CHUNK_TILES, wave_, lane_id());
        } else if (code & 0x4000) {
            if (!selrdy) { if (t0_) { unsigned spins = 0; while (att::ld_sc1(A.mdone) < (unsigned)att::N_SEL && ++spins < (1u << 24)) __builtin_amdgcn_s_sleep(8); } selrdy = true; __syncthreads(); }
            att::attn_unit<3>(A, (code >> 11) & 1, 6 + ((code >> 8) & 7), code & 0xff, shm, wave_);
        } else if (code & 0x2000) {
            att::moba_select(A, (code >> 9) & 1, 6 + ((code >> 6) & 7), code & 63, shm, wave_);
        } else {
            const int mode = code >> 10, b = (code >> 9) & 1, hr = (code >> 6) & 7, sub = code & 63;
            const int h = (mode == 0) ? hr : ((mode == 1) ? 6 + hr : 11 + hr);
            if (mode == 0) att::attn_unit<0>(A, b, h, sub, shm, wave_); else if (mode == 1) att::attn_unit<1>(A, b, h, sub, shm, wave_); else att::attn_unit<2>(A, b, h, sub, shm, wave_);
        }
    }
}
template <bool F8, bool SRC16, int NR> __device__ __forceinline__ void norm_rows(const void* srcv, const float* gain, void* dstv, int vcu, int G, int wave, int lane) {
    asm volatile("" : "+v"(lane));
    const int gw = vcu * NWAVES + wave, NGW = G * NWAVES;
    f32x4 g[8];
#pragma unroll
    for (int j = 0; j < 8; ++j) g[j] = ((const GAS f32x4*)gain)[lane + 64 * j];
    for (int m0 = gw; m0 < M; m0 += NR * NGW) {
        f32x4 v[NR][8];
#pragma unroll
        for (int q = 0; q < NR; ++q) { const int mq = m0 + q * NGW; const int m = mq < M ? mq : m0;
            if constexpr (SRC16) { const GAS u32x2_g* xr = (const GAS u32x2_g*)((const bf16*)srcv + (size_t)m * D) + lane;
#pragma unroll
                for (int j = 0; j < 8; ++j) v[q][j] = bf4_to_f32(xr[64 * j]); }
            else { const GAS f32x4* xr = (const GAS f32x4*)((const float*)srcv + (size_t)m * D) + lane;
#pragma unroll
                for (int j = 0; j < 8; ++j) v[q][j] = xr[64 * j]; } }
#pragma unroll
        for (int q = 0; q < NR; ++q) { const int m = m0 + q * NGW; if (m >= M) break;
            float s = 0.f;
#pragma unroll
            for (int j = 0; j < 8; ++j) s += (v[q][j].x * v[q][j].x + v[q][j].y * v[q][j].y) + (v[q][j].z * v[q][j].z + v[q][j].w * v[q][j].w);
            const float r = 1.0f / sqrtf(wave_sum(s) * (1.0f / D) + EPS);
            if constexpr (F8) { GAS unsigned* o4 = (GAS unsigned*)((unsigned char*)dstv + (size_t)m * D) + lane;
#pragma unroll
                for (int j = 0; j < 8; ++j) o4[64 * j] = pg8::pk4_fp8(v[q][j].x * r * g[j].x, v[q][j].y * r * g[j].y, v[q][j].z * r * g[j].z, v[q][j].w * r * g[j].w); }
            else { GAS unsigned long long* o8 = (GAS unsigned long long*)((bf16*)dstv + (size_t)m * D) + lane;
#pragma unroll
                for (int j = 0; j < 8; ++j) o8[64 * j] = (unsigned long long)pk2(v[q][j].x * r * g[j].x, v[q][j].y * r * g[j].y) | ((unsigned long long)pk2(v[q][j].z * r * g[j].z, v[q][j].w * r * g[j].w) << 32); }
        }
    }
}
__device__ __forceinline__ void prep_phase(const Ptrs& P, int layer, LAS unsigned char* lds, int vcu, int G, int tid, int wave, int lane) {
    asm volatile("" : "+v"(lane), "+v"(tid));
    LAS float* red = (LAS float*)(lds + RING_OFF);
    const int tsub = lane >> 4, c = lane & 15;
#define PREP_ADDR(it_) (P.QKV + ((size_t)(((it_) / 22) >> 4) * SEQ + (((it_) / 22) & 15) * 256 + wave * 32 + tsub) * NQKV + ((((it_) % 22) >= 11) ? 2048 + (((it_) % 22) - 11) * 128 : ((it_) % 22) * 128) + 8 * c)
    v4u raws[8], rawn[8];
    if (vcu < 32 * 22) { bf16* const q0_ = PREP_ADDR(vcu);
#pragma unroll
        for (int i8 = 0; i8 < 8; ++i8) raws[i8] = *(const GAS v4u*)(q0_ + (size_t)(i8 * 4) * NQKV); }
    for (int it = vcu; it < 32 * 22; it += G) {
        const int v = it % 22, blk = it / 22, b = blk >> 4, n = blk & 15;
        if (it + G < 32 * 22) { bf16* const q1_ = PREP_ADDR(it + G);
#pragma unroll
            for (int i8 = 0; i8 < 8; ++i8) rawn[i8] = *(const GAS v4u*)(q1_ + (size_t)(i8 * 4) * NQKV); }
        const bool isk = v >= 11; const int hh = isk ? v - 11 : v;
        const int col0 = (isk ? 2048 : 0) + hh * 128;
        const float* gp = (isk ? P.k_gain : P.q_gain) + layer * 256 + (hh >= 6 ? 128 : 0) + 8 * c;
        const f32x4 g0 = *(const f32x4*)gp, g1 = *(const f32x4*)(gp + 4);
        const bool km = isk && hh >= 6;
        float cs[8];
#pragma unroll
        for (int e = 0; e < 8; ++e) cs[e] = 0.f;
        bf16* const p0_ = P.QKV + ((size_t)b * SEQ + n * 256 + wave * 32 + tsub) * NQKV + col0 + 8 * c;
#pragma unroll
        for (int i8 = 0; i8 < 8; ++i8) {
            bf16* p = p0_ + (size_t)(i8 * 4) * NQKV;
            const v4u raw = raws[i8];
            float x[8]; x[0] = bf2f_u((unsigned short)(raw.x & 0xffff)); x[1] = bf2f_u((unsigned short)(raw.x >> 16)); x[2] = bf2f_u((unsigned short)(raw.y & 0xffff)); x[3] = bf2f_u((unsigned short)(raw.y >> 16));
            x[4] = bf2f_u((unsigned short)(raw.z & 0xffff)); x[5] = bf2f_u((unsigned short)(raw.z >> 16)); x[6] = bf2f_u((unsigned short)(raw.w & 0xffff)); x[7] = bf2f_u((unsigned short)(raw.w >> 16));
            float ss = 0.f;
#pragma unroll
            for (int e = 0; e < 8; ++e) ss = fmaf(x[e], x[e], ss);
            ss += xor_get<1>(ss); ss += xor_get<2>(ss); ss += xor_get<4>(ss); ss += xor_get<8>(ss);
            const float r = (isk ? 1.0f : att::C2) / sqrtf(ss * (1.0f / 128.0f) + EPS);
            float y[8];
            y[0] = x[0] * r * g0.x; y[1] = x[1] * r * g0.y; y[2] = x[2] * r * g0.z; y[3] = x[3] * r * g0.w;
            y[4] = x[4] * r * g1.x; y[5] = x[5] * r * g1.y; y[6] = x[6] * r * g1.z; y[7] = x[7] * r * g1.w;
            v4u o; o.x = pk2(y[0], y[1]); o.y = pk2(y[2], y[3]); o.z = pk2(y[4], y[5]); o.w = pk2(y[6], y[7]);
            *(GAS v4u*)p = o;
#pragma unroll
            for (int e = 0; e < 8; ++e) cs[e] += y[e];
        }
        if (km) {
#pragma unroll
            for (int e = 0; e < 8; ++e) { cs[e] += xor_get<16>(cs[e]); cs[e] = xor32_sum(cs[e]); }
            if (lane < 16) {
#pragma unroll
                for (int e = 0; e < 8; ++e) red[wave * 128 + 8 * c + e] = cs[e]; }
            LDS_WAIT(); __syncthreads();
            if (tid < 128) { float s = 0.f;
#pragma unroll
                for (int w = 0; w < 8; ++w) s += red[w * 128 + tid];
                P.kmean[(size_t)((b * 5 + (hh - 6)) * 16 + n) * 128 + tid] = s * (1.0f / 256.0f); }
            LDS_WAIT(); __syncthreads();
        }
#pragma unroll
        for (int i8 = 0; i8 < 8; ++i8) raws[i8] = rawn[i8];
    }
#undef PREP_ADDR
}
__device__ __forceinline__ void dcombine_phase(const Ptrs& P, const float* gain, int vcu, int G, int wave, int lane) {
    asm volatile("" : "+v"(lane));
    const int gw = vcu * NWAVES + wave, NGW = G * NWAVES; const int c = lane & 15; constexpr int NIT = M * 11 / 4;
    constexpr int NQ = 4;
    for (int it0 = gw; it0 < NIT; it0 += NQ * NGW) {
        int tok[NQ], hh[NQ]; float ls[NQ][4]; v4u raw[NQ][4];
#pragma unroll
        for (int q = 0; q < NQ; ++q) { const int itq = it0 + q * NGW; const int it = itq < NIT ? itq : it0; const int pair = it * 4 + (lane >> 4); tok[q] = pair / 11; hh[q] = pair - tok[q] * 11;
#pragma unroll
            for (int p = 0; p < 3; ++p) { ls[q][p] = P.DPL[((size_t)p * M + tok[q]) * 16 + hh[q]]; raw[q][p] = *(const GAS v4u*)(P.DPO + ((size_t)p * M + tok[q]) * 1408 + hh[q] * 128 + 8 * c); }
            ls[q][3] = -__builtin_inff(); raw[q][3] = (v4u){0u, 0u, 0u, 0u};
            if (hh[q] >= 6) { ls[q][3] = P.DPL[((size_t)3 * M + tok[q]) * 16 + hh[q]]; raw[q][3] = *(const GAS v4u*)(P.DPO + ((size_t)3 * M + tok[q]) * 1408 + hh[q] * 128 + 8 * c); } }
#pragma unroll
        for (int q = 0; q < NQ; ++q) { if (it0 + q * NGW >= NIT) break;
            const float mx = fmaxf(fmaxf(ls[q][0], ls[q][1]), fmaxf(ls[q][2], ls[q][3]));
            float w0 = __builtin_amdgcn_exp2f(ls[q][0] - mx), w1 = __builtin_amdgcn_exp2f(ls[q][1] - mx), w2 = __builtin_amdgcn_exp2f(ls[q][2] - mx), w3 = __builtin_amdgcn_exp2f(ls[q][3] - mx);
            const float inv = 1.0f / (w0 + w1 + w2 + w3); w0 *= inv; w1 *= inv; w2 *= inv; w3 *= inv;
            float acc[8];
#pragma unroll
            for (int e = 0; e < 8; ++e) acc[e] = 0.f;
#pragma unroll
            for (int p = 0; p < 4; ++p) { const v4u r_ = raw[q][p]; const float w = (p == 0) ? w0 : ((p == 1) ? w1 : ((p == 2) ? w2 : w3));
                acc[0] += w * bf2f_u((unsigned short)(r_.x & 0xffff)); acc[1] += w * bf2f_u((unsigned short)(r_.x >> 16)); acc[2] += w * bf2f_u((unsigned short)(r_.y & 0xffff)); acc[3] += w * bf2f_u((unsigned short)(r_.y >> 16));
                acc[4] += w * bf2f_u((unsigned short)(r_.z & 0xffff)); acc[5] += w * bf2f_u((unsigned short)(r_.z >> 16)); acc[6] += w * bf2f_u((unsigned short)(r_.w & 0xffff)); acc[7] += w * bf2f_u((unsigned short)(r_.w >> 16)); }
            float ss = 0.f;
#pragma unroll
            for (int e = 0; e < 8; ++e) ss = fmaf(acc[e], acc[e], ss);
            ss += xor_get<1>(ss); ss += xor_get<2>(ss); ss += xor_get<4>(ss); ss += xor_get<8>(ss);
            const float rn = 1.0f / sqrtf(ss * (1.0f / 128.0f) + EPS);
            const f32x4 g0 = *(const f32x4*)(gain + hh[q] * 128 + 8 * c), g1 = *(const f32x4*)(gain + hh[q] * 128 + 8 * c + 4);
            v4u o; o.x = pk2(acc[0] * rn * g0.x, acc[1] * rn * g0.y); o.y = pk2(acc[2] * rn * g0.z, acc[3] * rn * g0.w); o.z = pk2(acc[4] * rn * g1.x, acc[5] * rn * g1.y); o.w = pk2(acc[6] * rn * g1.z, acc[7] * rn * g1.w);
            *(GAS v4u*)(P.OB + (size_t)tok[q] * D + hh[q] * 128 + 8 * c) = o; }
    }
}
__device__ __forceinline__ void router_phase(const Ptrs& P, const float* gain, LAS unsigned char* lds, int vcu, int G, int tid, int wave, int lane) {
    asm volatile("" : "+v"(lane), "+v"(tid));
    LAS unsigned* lcnt = (LAS unsigned*)(lds + RING_OFF);
    LAS unsigned* rinfo = (LAS unsigned*)(lds + RING_OFF + 256);
    if (tid < 16) lcnt[tid] = 0u;
    LAS f32x4* LT = (LAS f32x4*)(lds + RING_OFF + 4096);
    for (int i = tid; i < 2 * D; i += NWAVES * 64) { const int d = i >> 1, eq = i & 1; LT[eq * D + d] = ((const GAS f32x4*)P.router)[i]; }
    LDS_WAIT(); __syncthreads();
    int gw = vcu * NWAVES + wave; asm volatile("" : "+s"(gw));
    const int NGW = G * NWAVES;
    int li = wave;
    for (int m = gw; m < M; m += NGW, li += NWAVES) {
        const GAS u32x2_g* xr = (const GAS u32x2_g*)(P.H + (size_t)m * D) + lane;
        f32x4 v[8]; float s = 0.f;
#pragma unroll
        for (int j = 0; j < 8; ++j) { v[j] = bf4_to_f32(xr[64 * j]); s += (v[j].x * v[j].x + v[j].y * v[j].y) + (v[j].z * v[j].z + v[j].w * v[j].w); }
        const float r = 1.0f / sqrtf(wave_sum(s) * (1.0f / D) + EPS);
        float lg[8];
#pragma unroll
        for (int e = 0; e < 8; ++e) lg[e] = 0.f;
        GAS unsigned* o4 = (GAS unsigned*)(P.AB8 + (size_t)m * D) + lane;
#pragma unroll
        for (int j = 0; j < 8; ++j) { const f32x4 g = ((const GAS f32x4*)gain)[lane + 64 * j];
            const float f0 = v[j].x * r * g.x, f1 = v[j].y * r * g.y, f2 = v[j].z * r * g.z, f3 = v[j].w * r * g.w;
            o4[64 * j] = pg8::pk4_fp8(f0, f1, f2, f3);
            const LAS f32x4* rw = LT + 256 * j + 4 * lane;
            const f32x4 a0 = rw[0], a1 = rw[D], b0 = rw[1], b1 = rw[D + 1], c0 = rw[2], c1 = rw[D + 2], d0 = rw[3], d1 = rw[D + 3];
            lg[0] += f0 * a0.x + f1 * b0.x + f2 * c0.x + f3 * d0.x; lg[1] += f0 * a0.y + f1 * b0.y + f2 * c0.y + f3 * d0.y;
            lg[2] += f0 * a0.z + f1 * b0.z + f2 * c0.z + f3 * d0.z; lg[3] += f0 * a0.w + f1 * b0.w + f2 * c0.w + f3 * d0.w;
            lg[4] += f0 * a1.x + f1 * b1.x + f2 * c1.x + f3 * d1.x; lg[5] += f0 * a1.y + f1 * b1.y + f2 * c1.y + f3 * d1.y;
            lg[6] += f0 * a1.z + f1 * b1.z + f2 * c1.z + f3 * d1.z; lg[7] += f0 * a1.w + f1 * b1.w + f2 * c1.w + f3 * d1.w; }
#pragma unroll
        for (int e = 0; e < 8; ++e) lg[e] = wave_sum(lg[e]);
        int e0 = 0; float b0v = lg[0];
#pragma unroll
        for (int e = 1; e < 8; ++e) if (lg[e] > b0v) { b0v = lg[e]; e0 = e; }
        int e1 = -1; float b1v = -__builtin_inff();
#pragma unroll
        for (int e = 0; e < 8; ++e) if (e != e0 && lg[e] > b1v) { b1v = lg[e]; e1 = e; }
        const float g1 = 1.0f / (1.0f + __expf(b0v - b1v)), g0 = 1.0f - g1;
        if (lane == 0) {
            const unsigned k0 = __hip_atomic_fetch_add(lcnt + e0, 1u, __ATOMIC_RELAXED, __HIP_MEMORY_SCOPE_WORKGROUP);
            const unsigned k1 = __hip_atomic_fetch_add(lcnt + e1, 1u, __ATOMIC_RELAXED, __HIP_MEMORY_SCOPE_WORKGROUP);
            rinfo[li * 4 + 0] = (unsigned)e0 | ((unsigned)e1 << 8); rinfo[li * 4 + 1] = k0; rinfo[li * 4 + 2] = k1;
            P.sel_g[2 * m] = g0; P.sel_g[2 * m + 1] = g1;
        }
    }
    LDS_WAIT(); __syncthreads();
    if (tid < 8) lcnt[8 + tid] = __hip_atomic_fetch_add(P.ctl + CW_CNT + 64 * tid, lcnt[tid], RLX_AGENT);
    LDS_WAIT(); __syncthreads();
    li = wave;
    for (int m = gw; m < M; m += NGW, li += NWAVES) {
        if (lane == 0) { const unsigned ee = rinfo[li * 4 + 0]; const unsigned e0 = ee & 0xffu, e1 = ee >> 8;
            P.sel_e[m] = ee; P.sel_rel[2 * m] = (int)(lcnt[8 + e0] + rinfo[li * 4 + 1]); P.sel_rel[2 * m + 1] = (int)(lcnt[8 + e1] + rinfo[li * 4 + 2]); }
    }
}
__device__ __forceinline__ void build_tile_table(const Ptrs& P, bool moe, volatile LAS unsigned* MISC, int tid) {
    if (tid == 0) { unsigned t = 0u; MISC[16] = 0u;
        for (int e = 0; e < 8; ++e) { const unsigned cnt = moe ? __hip_atomic_load(P.ctl + CW_CNT + 64 * e, RLX_AGENT) : (e == 0 ? (unsigned)M : 0u); t += (cnt + 255u) >> 8; if (t > (unsigned)(MPAD / 256)) t = MPAD / 256; MISC[17 + e] = t; } }
    LDS_WAIT(); __syncthreads();
}
__device__ __forceinline__ void scatter_phase(const Ptrs& P, volatile LAS unsigned* MISC, int vcu, int G, int wave, int lane) {
    asm volatile("" : "+v"(lane));
    const int gw = vcu * NWAVES + wave, NGW = G * NWAVES;
    constexpr int NR = 4;
    for (int m0 = gw; m0 < M; m0 += NR * NGW) {
        unsigned ee[NR]; int r0[NR], r1[NR]; v4u a0[NR], a1[NR];
#pragma unroll
        for (int q = 0; q < NR; ++q) { const int mq = m0 + q * NGW; const int m = mq < M ? mq : m0;
            ee[q] = P.sel_e[m]; r0[q] = P.sel_rel[2 * m]; r1[q] = P.sel_rel[2 * m + 1];
            const GAS v4u* sp = (const GAS v4u*)(P.AB8 + (size_t)m * D) + lane; a0[q] = sp[0]; a1[q] = sp[64]; }
#pragma unroll
        for (int q = 0; q < NR; ++q) { const int m = m0 + q * NGW; if (m >= M) break;
            const int p0 = (int)(256u * MISC[16 + (ee[q] & 0xffu)]) + r0[q], p1 = (int)(256u * MISC[16 + ((ee[q] >> 8) & 0xffu)]) + r1[q];
            if (lane == 0) { P.sel_pos[2 * m] = p0; P.sel_pos[2 * m + 1] = p1; }
            GAS v4u* d0 = (GAS v4u*)(P.XS + (size_t)p0 * D) + lane; GAS v4u* d1 = (GAS v4u*)(P.XS + (size_t)p1 * D) + lane;
            d0[0] = a0[q]; d0[64] = a1[q]; d1[0] = a0[q]; d1[64] = a1[q]; }
    }
}
__device__ __forceinline__ void combine_phase(const Ptrs& P, int vcu, int G, int wave, int lane) {
    asm volatile("" : "+v"(lane));
    const int gw = vcu * NWAVES + wave, NGW = G * NWAVES;
    typedef unsigned u32x2_t __attribute__((ext_vector_type(2)));
    for (int m0 = gw; m0 < M; m0 += 2 * NGW) {
        const int m1 = m0 + NGW; const bool has1 = m1 < M; const int mm[2] = {m0, has1 ? m1 : m0};
        int pa[2], pb[2]; float ga[2], gb[2];
#pragma unroll
        for (int q = 0; q < 2; ++q) { pa[q] = P.sel_pos[2 * mm[q]]; pb[q] = P.sel_pos[2 * mm[q] + 1]; ga[q] = P.sel_g[2 * mm[q]]; gb[q] = P.sel_g[2 * mm[q] + 1]; }
        f32x4 ya[2][8], yb[2][8], hv[2][8];
#pragma unroll
        for (int q = 0; q < 2; ++q) { const GAS u32x2_t* y0 = (const GAS u32x2_t*)(P.YS + (size_t)pa[q] * D) + lane; const GAS u32x2_t* y1 = (const GAS u32x2_t*)(P.YS + (size_t)pb[q] * D) + lane;
            const GAS u32x2_g* hr = (const GAS u32x2_g*)(P.H + (size_t)mm[q] * D) + lane;
#pragma unroll
            for (int j = 0; j < 8; ++j) { ya[q][j] = bf4_to_f32(y0[64 * j]); yb[q][j] = bf4_to_f32(y1[64 * j]); hv[q][j] = bf4_to_f32(hr[64 * j]); } }
#pragma unroll
        for (int q = 0; q < 2; ++q) { if (q == 1 && !has1) break;
            if (pa[q] >= 16384) { const GAS u32x2_t* z0 = (const GAS u32x2_t*)(P.YS + (size_t)MPAD * D + (size_t)pa[q] * D) + lane;
#pragma unroll
                for (int j = 0; j < 8; ++j) ya[q][j] += bf4_to_f32(z0[64 * j]); }
            if (pb[q] >= 16384) { const GAS u32x2_t* z1 = (const GAS u32x2_t*)(P.YS + (size_t)MPAD * D + (size_t)pb[q] * D) + lane;
#pragma unroll
                for (int j = 0; j < 8; ++j) yb[q][j] += bf4_to_f32(z1[64 * j]); }
            GAS f32x4* orow = (GAS f32x4*)(P.out + (size_t)mm[q] * D) + lane;
#pragma unroll
            for (int j = 0; j < 8; ++j) orow[64 * j] = hv[q][j] + ya[q][j] * ga[q] + yb[q][j] * gb[q]; }
    }
}

struct Args { const float* in[15]; float* out; unsigned char* ws; int ph_lo, ph_hi, qoff, pad; };
__device__ __forceinline__ Ptrs make_ptrs(const Args& args, unsigned char* ws0) {
    int z = 0; asm volatile("" : "+s"(z));
    const float* const* in = args.in + z;
    unsigned char* ws = ws0 + z;
    Ptrs P;
    P.x = in[0]; P.attn_norm = in[1]; P.w_in = in[2]; P.q_gain = in[3]; P.k_gain = in[4]; P.out_gain = in[5]; P.w_out = in[6]; P.ffn_norm = in[7];
    P.dwg = in[8]; P.dwu = in[9]; P.dwd = in[10]; P.router = in[11]; P.mwg = in[12]; P.mwu = in[13]; P.mwd = in[14];
    P.out = args.out; P.ctl = (gu32*)(ws + WS_CTL);
    P.Wqkv_t = (bf16*)(ws + WS_WQKV); P.Wo_t = (bf16*)(ws + WS_WO); P.Wgu_d = ws + WS_WGU_D; P.Wd_d = ws + WS_WD_D; P.Wgu_m = ws + WS_WGU_M; P.Wd_m = ws + WS_WD_M;
    P.QKV = (bf16*)(ws + WS_QKV); P.OB = (bf16*)(ws + WS_O); P.AB = (bf16*)(ws + WS_A); P.AB8 = ws + WS_A; P.ACT = ws + WS_ACT; P.XS = ws + WS_XS;
    P.H = (bf16*)(ws + WS_H); P.YS = (bf16*)(ws + WS_YS); P.kmean = (float*)(ws + WS_MISC + MISC_KMEAN); P.DPO = (bf16*)(ws + WS_DPO); P.DPL = (float*)(ws + WS_DPL);
    P.rsq = (float*)(ws + WS_MISC + MISC_RSQ);
    P.sel_e = (unsigned*)(ws + WS_MISC + MISC_SELE); P.sel_rel = (int*)(ws + WS_MISC + MISC_SELREL); P.sel_g = (float*)(ws + WS_MISC + MISC_SELG); P.sel_pos = (int*)(ws + WS_MISC + MISC_SELPOS);
    return P;
}
__global__ void __launch_bounds__(NWAVES * 64, 2) hybrid_fwd(Args args) {
    extern __shared__ __attribute__((aligned(16))) unsigned char lds[];
    LAS unsigned char* ldsL = (LAS unsigned char*)lds;
    volatile LAS unsigned* MISC = (volatile LAS unsigned*)(ldsL + MISC_OFF);
    const int wave = __builtin_amdgcn_readfirstlane((int)threadIdx.x >> 6);
#define tid (tid_of(wave))
#define lane (lane_id())
    const int G = gridDim.x; int vcu; { const int bx = blockIdx.x; vcu = (G % 8 == 0) ? (bx % 8) * (G / 8) + bx / 8 : bx; }
    for (int u = tid; u < (LDS_BYTES - LDSCTL_OFF) / 4; u += NWAVES * 64) ((LAS unsigned*)(ldsL + LDSCTL_OFF))[u] = 0u;
    __syncthreads();
    int z0 = 0; asm volatile("" : "+s"(z0)); unsigned char* ws0 = args.ws + z0;
    unsigned* const barw = (unsigned*)(ws0 + WS_CTL) + CW_BAR;
    XcdBarrier bar; bar.bar = barw; bar.x = 0; bar.st = nullptr; bar.wv = wave;
    if (!MK_SPLIT) { bar = xcd_barrier_post(barw, MISC + 8, wave); }
    const int lo = args.ph_lo, hi = args.ph_hi;
#define PH(k) (lo <= (k) && (k) < hi)
#define SEAM(a, b) do { if (PH(a) && PH(b)) { int zb_ = 0; asm volatile("" : "+s"(zb_)); XcdBarrier b2_ = bar; b2_.bar = bar.bar + zb_; xcd_barrier(b2_); } } while (0)

    for (int layer = 0; layer < 2; ++layer) {
        const int PB = layer * PPL;
        if (layer == 0 && PH(PB + 0)) {
            const Ptrs P = make_ptrs(args, ws0);
            #ifndef NO_P0
            if (layer == 0) convert_weights(P, ldsL, vcu, G, CV_L0, wave, lane);
            if (layer == 0) norm_rows<false, false, 4>(P.x, P.attn_norm, P.AB, vcu, G, wave, lane);
#endif
        }
        if (layer == 0) SEAM(PB + 0, PB + 1);
        if (PH(PB + 1)) {
            const Ptrs P = make_ptrs(args, ws0);
            pg8::Gemm g{layer == 0 ? P.AB : P.H, P.Wqkv_t + (size_t)layer * NQKV * D, M, NQKV, D}; pg8::StaticOrder S; S.init(M, NQKV, G, (int)blockIdx.x);
            pg8::EpiQKV E{P.QKV, NQKV, P.q_gain + layer * 256, P.k_gain + layer * 256, P.kmean, (LAS float*)(ldsL + RING_OFF + RING_BYTES), layer == 0 ? nullptr : P.rsq};
#ifndef NO_P1
            pg8::gemm_phase<pg8::EpiQKV, pg8::StaticOrder, true, true>(ldsL + RING_OFF, g, S, E, wave);
#endif
        }
        SEAM(PB + 1, PB + 3);
        if (PH(PB + 3)) {
            const Ptrs P = make_ptrs(args, ws0);
            const att::AttnArgs AA{P.QKV, P.OB, P.kmean, P.out_gain + layer * D, P.DPO, P.DPL, (unsigned*)((unsigned char*)P.DPL + (WS_MLIST - WS_DPL)) + (size_t)layer * att::N_SEL * att::MLCAP, (unsigned*)(P.ctl + CW_MCNT + 256 * (layer + args.qoff)), (unsigned*)(P.ctl + CW_MDONE + 64 * (layer + args.qoff))};
#ifndef NO_P3
            attn_conv_phase(P, AA, layer, (unsigned*)(P.ctl + CW_ATTQ + 64 * (layer + args.qoff)), lds, wave);
#endif
        }
        SEAM(PB + 3, PB + 4);
#ifndef NO_P4B
        if (PH(PB + 4)) { const Ptrs P = make_ptrs(args, ws0); dcombine_phase(P, P.out_gain + layer * D, vcu, G, wave, lane); }
#endif
        SEAM(PB + 4, PB + 5);
        if (PH(PB + 5)) {
            const Ptrs P = make_ptrs(args, ws0);
            pg8::Gemm g{P.OB, P.Wo_t + (size_t)layer * D * D, M, D, D}; pg8::StaticOrder S; S.init(M, D, G, (int)blockIdx.x);
            pg8::EpiResF32 E{layer == 0 ? P.x : nullptr, layer == 0 ? nullptr : P.H, P.H, D, nullptr, layer == 0 ? P.rsq + 65536 : nullptr, (LAS float*)(ldsL + RING_OFF + RING_BYTES), layer == 0 ? P.AB8 : nullptr};
#ifndef NO_P4
            pg8::gemm_phase<pg8::EpiResF32, pg8::StaticOrder, true, true>(ldsL + RING_OFF, g, S, E, wave);
#endif
        }
        if (layer == 1) SEAM(PB + 5, PB + 6);
        if (layer == 1 && PH(PB + 6)) {
            const Ptrs P = make_ptrs(args, ws0);
#ifndef NO_P5
            router_phase(P, P.ffn_norm + D, ldsL, vcu, G, tid, wave, lane);
#endif
        }
        if (layer == 1) {
            SEAM(PB + 6, PB + 7);
#ifndef NO_P6
            if (PH(PB + 7)) { const Ptrs P = make_ptrs(args, ws0); build_tile_table(P, true, MISC, tid); scatter_phase(P, MISC, vcu, G, wave, lane); }
#endif
            SEAM(PB + 7, PB + 8);
        } else SEAM(PB + 5, PB + 8);
        if (PH(PB + 8)) {
            const Ptrs P = make_ptrs(args, ws0);
            build_tile_table(P, layer == 1, MISC, tid);
            pg8::GroupSched S; S.nMt = __builtin_amdgcn_readfirstlane((int)MISC[24]); S.nN = NGU / 256; S.nwg = S.nMt * S.nN; S.G = G; S.c = (int)blockIdx.x;
            S.t1 = __builtin_amdgcn_readfirstlane((int)MISC[17]); S.t2 = __builtin_amdgcn_readfirstlane((int)MISC[18]); S.t3 = __builtin_amdgcn_readfirstlane((int)MISC[19]); S.t4 = __builtin_amdgcn_readfirstlane((int)MISC[20]);
            S.t5 = __builtin_amdgcn_readfirstlane((int)MISC[21]); S.t6 = __builtin_amdgcn_readfirstlane((int)MISC[22]); S.t7 = __builtin_amdgcn_readfirstlane((int)MISC[23]); S.estride = (size_t)NGU * D; S.nfullM = 1 << 20; S.ntail = 0; S.khalf = 0;
            pg8::Gemm g{(const bf16*)(layer == 0 ? P.AB8 : P.XS), (const bf16*)(layer == 0 ? P.Wgu_d : P.Wgu_m), MPAD, NGU, D / 2};
            pg8::EpiSwiGLU8 E{P.ACT, FF, layer == 0 ? P.rsq + 65536 : nullptr};
#ifndef NO_P7
            pg8::gemm_phase<pg8::EpiSwiGLU8, pg8::GroupSched, true, true, true>(ldsL + RING_OFF, g, S, E, wave);
#endif
        }
        SEAM(PB + 8, PB + 9);
        if (PH(PB + 9)) {
            const Ptrs P = make_ptrs(args, ws0);
            build_tile_table(P, layer == 1, MISC, tid);
            pg8::GroupSched S; S.nMt = __builtin_amdgcn_readfirstlane((int)MISC[24]); S.nN = D / 256; S.nwg = S.nMt * S.nN; S.G = G; S.c = (int)blockIdx.x;
            S.t1 = __builtin_amdgcn_readfirstlane((int)MISC[17]); S.t2 = __builtin_amdgcn_readfirstlane((int)MISC[18]); S.t3 = __builtin_amdgcn_readfirstlane((int)MISC[19]); S.t4 = __builtin_amdgcn_readfirstlane((int)MISC[20]);
            S.t5 = __builtin_amdgcn_readfirstlane((int)MISC[21]); S.t6 = __builtin_amdgcn_readfirstlane((int)MISC[22]); S.t7 = __builtin_amdgcn_readfirstlane((int)MISC[23]); S.estride = (size_t)D * FF;
            if (layer == 1 && S.nMt > 64) { S.nfullM = 64; S.ntail = FF / 128 / 2; S.khalf = FF / 2; S.nwg = 64 * S.nN + 2 * S.nN * (S.nMt - 64); } else { S.nfullM = 1 << 20; S.ntail = 0; S.khalf = 0; }
            pg8::Gemm g{(const bf16*)P.ACT, (const bf16*)(layer == 0 ? P.Wd_d : P.Wd_m), MPAD, D, FF / 2};
            pg8::EpiResF32 E{nullptr, layer == 0 ? P.H : nullptr, layer == 0 ? P.H : P.YS, D, P.YS + (size_t)MPAD * D, layer == 0 ? P.rsq : nullptr, (LAS float*)(ldsL + RING_OFF + RING_BYTES), nullptr};
#ifndef NO_P8
            pg8::gemm_phase<pg8::EpiResF32, pg8::GroupSched, true, true, true>(ldsL + RING_OFF, g, S, E, wave);
#endif
        }
        if (layer == 0) SEAM(PB + 9, PB + 12);
        else { SEAM(PB + 9, PB + 10);
#ifndef NO_P9
            if (PH(PB + 10)) { const Ptrs P = make_ptrs(args, ws0); combine_phase(P, vcu, G, wave, lane); }
#endif
        }
    }
#undef PH
#undef SEAM
#undef tid
#undef lane
}

extern "C" void kernel_launch(void* const* d_in, const int* in_sizes, int n_in, void* d_out, int out_size, void* d_ws, size_t ws_size, hipStream_t stream) {
    static int grid = 0;
    if (grid == 0) {
        if (n_in != 15 || in_sizes[0] != M * D || out_size != M * D || ws_size < WS_END) { fprintf(stderr, "kernel_launch: unexpected shapes / workspace (n_in %d, in0 %d, out %d, ws %zu < %zu); nothing launched\n", n_in, n_in > 0 ? in_sizes[0] : -1, out_size, ws_size, (size_t)WS_END); grid = -1; return; }
        int dev = 0, cus = 0, per_cu = 0;
        if (hipGetDevice(&dev) != hipSuccess || hipDeviceGetAttribute(&cus, hipDeviceAttributeMultiprocessorCount, dev) != hipSuccess) { fprintf(stderr, "kernel_launch: device query failed\n"); grid = -1; return; }
        if (hipFuncSetAttribute((const void*)hybrid_fwd, hipFuncAttributeMaxDynamicSharedMemorySize, LDS_BYTES) != hipSuccess) { fprintf(stderr, "kernel_launch: hipFuncSetAttribute failed\n"); grid = -1; return; }
        if (hipOccupancyMaxActiveBlocksPerMultiprocessor(&per_cu, (const void*)hybrid_fwd, NWAVES * 64, LDS_BYTES) != hipSuccess || per_cu < 1) fprintf(stderr, "kernel_launch: note: occupancy query reports %d workgroups per CU\n", per_cu);
        (void)hipGetLastError();
        grid = cus;
    }
    if (grid < 0) return;
    if (hipMemsetAsync((char*)d_ws + WS_CTL, 0, CTL_ZERO_BYTES, stream) != hipSuccess) { fprintf(stderr, "kernel_launch: memset failed\n"); return; }
    Args a{};
    for (int i = 0; i < 15; ++i) a.in[i] = (const float*)d_in[i];
    a.out = (float*)d_out; a.ws = (unsigned char*)d_ws;
#if MK_SPLIT
    for (int ph = 0; ph < N_PHASES; ++ph) {
        if (ph == 7 || ph == 10 || ph == 2 || ph == PPL + 2 || ph == PPL || ph == 6) continue;
        a.ph_lo = ph; a.ph_hi = ph + 1; a.qoff = 0;
        hipLaunchKernelGGL(hybrid_fwd, dim3(grid), dim3(NWAVES * 64), LDS_BYTES, stream, a);
#ifdef MK_PROBE_REPEAT
        if (((MK_PROBE_REPEAT) >> ph) & 1) { a.qoff = 2; hipLaunchKernelGGL(hybrid_fwd, dim3(grid), dim3(NWAVES * 64), LDS_BYTES, stream, a); }
#endif
    }
#else
    a.ph_lo = 0; a.ph_hi = N_PHASES;
    hipLaunchKernelGGL(hybrid_fwd, dim3(grid), dim3(NWAVES * 64), LDS_BYTES, stream, a);
#endif
    const hipError_t le = hipPeekAtLastError();
    if (le != hipSuccess) fprintf(stderr, "kernel_launch: launch failed: %s\n", hipGetErrorName(le));
}
```

```cpp
#include <hip/hip_runtime.h>
#include <cstdio>
#include <cstdint>
__device__ __forceinline__ int lane_id() { int l; asm volatile("v_mbcnt_lo_u32_b32 %0, -1, 0\n\tv_mbcnt_hi_u32_b32 %0, -1, %0" : "=v"(l)); return l; }
template <int MSK> __device__ __forceinline__ float xor_get(float v) {
    static_assert(MSK == 1 || MSK == 2 || MSK == 4 || MSK == 8 || MSK == 16, "xor_get: 1..16");
    if constexpr (MSK == 1) return __int_as_float(__builtin_amdgcn_update_dpp(0, __float_as_int(v), 0xB1, 0xF, 0xF, true));
    else if constexpr (MSK == 2) return __int_as_float(__builtin_amdgcn_update_dpp(0, __float_as_int(v), 0x4E, 0xF, 0xF, true));
    else return __int_as_float(__builtin_amdgcn_ds_swizzle(__float_as_int(v), 0x1F | (MSK << 10)));
}
__device__ __forceinline__ float xor32_sum(float v) { auto rr = __builtin_amdgcn_permlane32_swap(__float_as_uint(v), __float_as_uint(v), false, false); return __uint_as_float(rr[0]) + __uint_as_float(rr[1]); }
__device__ __forceinline__ float xor32_get(float v, int hi) { auto rr = __builtin_amdgcn_permlane32_swap(__float_as_uint(v), __float_as_uint(v), false, false); return __uint_as_float(hi ? rr[0] : rr[1]); }
__device__ __forceinline__ int tid_of(int wave) { int t = wave * 64 + lane_id(); asm volatile("" : "+v"(t)); return t; }
namespace pg8 {
#define PG8_LAS __attribute__((address_space(3)))
typedef unsigned short bf16_t;
typedef short bf16x8 __attribute__((ext_vector_type(8)));
typedef float f32x4 __attribute__((ext_vector_type(4)));
typedef unsigned u32x4 __attribute__((ext_vector_type(4)));
constexpr int BM = 256, BK = 64, HALF = 128, HTB = HALF * BK * 2  , STAGE_BYTES = 8 * HTB, NXCD = 8, WGM = 8;

__host__ __device__ __forceinline__ int lds_byte(int r, int c) { const int st = (r >> 4) * 2 + (c >> 5), rr = r & 15, cc = c & 31, ob = rr * 64 + cc * 2; return st * 1024 + (ob ^ (((ob >> 9) & 1) << 5)); }
__host__ __device__ __forceinline__ void stage_rc(int b, int& R, int& C) { const int st = b / 1024, sb = b % 1024, swz = sb ^ (((sb >> 9) & 1) << 5); R = (st >> 1) * 16 + swz / 64; C = (st & 1) * 32 + (swz % 64) / 2; }
__host__ __device__ __forceinline__ int perm32(int rho) { const int n = rho >> 4, i = rho & 15; return 8 * (i >> 2) + 4 * n + (i & 3); }

struct Unit { int pm, pn; size_t bofs; int kofs, ntu, kh; };
struct Gemm { const bf16_t* A; const bf16_t* Bt; int M, N, K; };

struct StaticOrder {
    int nM, nN, nwg, G, c;
    __host__ __device__ void init(int M, int N, int G_, int c_) { nM = M / BM; nN = N / BM; nwg = nM * nN; G = G_; c = c_; }
    __host__ __device__ bool next(int i, Unit& u) const {
        const long L = (long)i * G + c; if (L >= nwg) return false;
        int wgid = (int)L; { const int q = nwg / NXCD, r = nwg % NXCD, xcd = wgid % NXCD, off = wgid / NXCD; wgid = (xcd < r ? xcd * (q + 1) : r * (q + 1) + (xcd - r) * q) + off; }
        const int nig = WGM * nN, gid = wgid / nig, fm = gid * WGM, gsz = (nM - fm) < WGM ? (nM - fm) : WGM;
        u.pm = fm + ((wgid % nig) % gsz); u.pn = (wgid % nig) / gsz; u.bofs = 0; u.kofs = 0; u.ntu = 0; u.kh = 0; return true;
    }
    __device__ __forceinline__ void a_ready(const Unit&) const {}
    __device__ __forceinline__ void done(const Unit&) const {}
};

__device__ __forceinline__ unsigned cvt_pk_bf16(float lo, float hi) { unsigned r; asm volatile("v_cvt_pk_bf16_f32 %0, %1, %2" : "=v"(r) : "v"(lo), "v"(hi)); return r; }

typedef int i32x8 __attribute__((ext_vector_type(8)));
typedef int i32x4v __attribute__((ext_vector_type(4)));
__device__ __forceinline__ i32x8 cat8(bf16x8 a, bf16x8 b) { const i32x4v x = __builtin_bit_cast(i32x4v, a), y = __builtin_bit_cast(i32x4v, b); return (i32x8){x[0], x[1], x[2], x[3], y[0], y[1], y[2], y[3]}; }
__device__ __forceinline__ unsigned pk4_fp8(float a, float b, float c, float d) { int w = 0; w = __builtin_amdgcn_cvt_pk_fp8_f32(a, b, w, false); w = __builtin_amdgcn_cvt_pk_fp8_f32(c, d, w, true); return (unsigned)w; }
struct GroupSched {
    int nMt, nN, nwg, G, c; int t1, t2, t3, t4, t5, t6, t7; size_t estride;
    int nfullM, ntail, khalf;
    __device__ __forceinline__ bool next(int i, Unit& u) const {
        const long L = (long)i * G + c; if (L >= nwg) return false;
        const int nMf = nMt < nfullM ? nMt : nfullM, nwf = nMf * nN;
        if (L < nwf) {
            int wgid = (int)L; { const int q = nwf / NXCD, r = nwf % NXCD, xcd = wgid % NXCD, off = wgid / NXCD; wgid = (xcd < r ? xcd * (q + 1) : r * (q + 1) + (xcd - r) * q) + off; }
            const int nig = WGM * nN, gid = wgid / nig, fm = gid * WGM, gsz = (nMf - fm) < WGM ? (nMf - fm) : WGM;
            u.pm = fm + ((wgid % nig) % gsz); u.pn = (wgid % nig) / gsz; u.kofs = 0; u.ntu = 0; u.kh = 0;
        } else { const int r = (int)L - nwf, t = r >> 1; u.kh = r & 1; u.pm = nMf + t / nN; u.pn = t % nN; u.kofs = u.kh * khalf; u.ntu = ntail; }
        const int pm = u.pm;
        const int e = (pm >= t1) + (pm >= t2) + (pm >= t3) + (pm >= t4) + (pm >= t5) + (pm >= t6) + (pm >= t7);
        u.bofs = (size_t)__builtin_amdgcn_readfirstlane(e) * estride; return true;
    }
    __device__ __forceinline__ void a_ready(const Unit&) const {}
    __device__ __forceinline__ void done(const Unit&) const {}
};

struct EpiStoreBf16 {
    static constexpr bool PERM = true, AFTER_DRAIN = false;
    bf16_t* O; int ldc;
    __device__ __forceinline__ void operator()(const f32x4 (&acc)[2][2][4][2], const Unit& u, int wr, int wc, int fr, int fq) const {
        const int row0 = u.pm * BM + wr * 64 + fr, col0 = u.pn * BM + wc * 32 + 8 * fq;
#pragma unroll
        for (int ai = 0; ai < 2; ++ai)
#pragma unroll
            for (int m = 0; m < 4; ++m) { bf16_t* rowp = O + (size_t)(row0 + ai * HALF + m * 16) * ldc + col0;
#pragma unroll
                for (int bj = 0; bj < 2; ++bj) { const f32x4 v0 = acc[ai][bj][m][0], v1 = acc[ai][bj][m][1];
                    u32x4 w; w.x = cvt_pk_bf16(v0[0], v0[1]); w.y = cvt_pk_bf16(v0[2], v0[3]); w.z = cvt_pk_bf16(v1[0], v1[1]); w.w = cvt_pk_bf16(v1[2], v1[3]);
                    *(u32x4*)(rowp + bj * HALF) = w; } }
    }
};
struct EpiQKV {
    static constexpr bool PERM = true, AFTER_DRAIN = false;
    bf16_t* O; int ldc; const float* qg; const float* kg; float* kmean; PG8_LAS float* scr; const float* rsq;
    __device__ __forceinline__ void operator()(const f32x4 (&acc)[2][2][4][2], const Unit& u, int wr, int wc, int fr, int fq) const {
        const int row0 = u.pm * BM + wr * 64 + fr, col0 = u.pn * BM + wc * 32 + 8 * fq;
        const int part = u.pn >> 3, hp = u.pn & 7, h0 = 2 * hp;
        float rr[2][4];
#pragma unroll
        for (int ai = 0; ai < 2; ++ai)
#pragma unroll
            for (int m = 0; m < 4; ++m) { rr[ai][m] = 1.0f;
                if (rsq) { const f32x4 t_ = *(const f32x4*)(rsq + (size_t)(row0 + ai * HALF + m * 16) * 8 + 4 * (fq & 1)); float s_ = (t_[0] + t_[1]) + (t_[2] + t_[3]); s_ += xor_get<16>(s_);
                    rr[ai][m] = 1.0f / sqrtf(s_ * (1.0f / 2048.0f) + 1e-6f); } }
        if (!(part < 2 && hp <= 5)) {
#pragma unroll
            for (int ai = 0; ai < 2; ++ai)
#pragma unroll
                for (int m = 0; m < 4; ++m) { bf16_t* rowp = O + (size_t)(row0 + ai * HALF + m * 16) * ldc + col0;
#pragma unroll
                    for (int bj = 0; bj < 2; ++bj) { const f32x4 v0 = acc[ai][bj][m][0] * rr[ai][m], v1 = acc[ai][bj][m][1] * rr[ai][m];
                        u32x4 w; w.x = cvt_pk_bf16(v0[0], v0[1]); w.y = cvt_pk_bf16(v0[2], v0[3]); w.z = cvt_pk_bf16(v1[0], v1[1]); w.w = cvt_pk_bf16(v1[2], v1[3]);
                        *(u32x4*)(rowp + bj * HALF) = w; } }
            return;
        }
#pragma unroll
        for (int ai = 0; ai < 2; ++ai)
#pragma unroll
            for (int m = 0; m < 4; ++m)
#pragma unroll
                for (int bj = 0; bj < 2; ++bj) { const f32x4 v0 = acc[ai][bj][m][0] * rr[ai][m], v1 = acc[ai][bj][m][1] * rr[ai][m];
                    float s_ = v0[0] * v0[0]; s_ = fmaf(v0[1], v0[1], s_); s_ = fmaf(v0[2], v0[2], s_); s_ = fmaf(v0[3], v0[3], s_);
                    s_ = fmaf(v1[0], v1[0], s_); s_ = fmaf(v1[1], v1[1], s_); s_ = fmaf(v1[2], v1[2], s_); s_ = fmaf(v1[3], v1[3], s_);
                    s_ += xor_get<16>(s_); s_ = xor32_sum(s_);
                    if (fq == 0) scr[((wr * 16 + (ai * 4 + m) * 2 + bj) * 16 + fr) * 4 + wc] = s_; }
        asm volatile("s_waitcnt lgkmcnt(0)" ::: "memory"); __builtin_amdgcn_s_barrier();
        const float* gp = (part == 0) ? qg : kg; const float qs = (part == 0) ? 0.08838834764831845f * 1.4426950408889634f : 1.0f;
        f32x4 g[2][2];
#pragma unroll
        for (int bj = 0; bj < 2; ++bj) { const float* p_ = gp + ((h0 + bj) >= 6 ? 128 : 0) + wc * 32 + 8 * fq; g[bj][0] = *(const f32x4*)p_; g[bj][1] = *(const f32x4*)(p_ + 4); }
        const bool pass1 = (h0 + 1 > 10);
        f32x4 cs[2][2];
#pragma unroll
        for (int bj = 0; bj < 2; ++bj) { cs[bj][0] = (f32x4){0.f, 0.f, 0.f, 0.f}; cs[bj][1] = (f32x4){0.f, 0.f, 0.f, 0.f}; }
#pragma unroll
        for (int ai = 0; ai < 2; ++ai)
#pragma unroll
            for (int m = 0; m < 4; ++m) { bf16_t* rowp = O + (size_t)(row0 + ai * HALF + m * 16) * ldc + col0;
#pragma unroll
                for (int bj = 0; bj < 2; ++bj) { const f32x4 t_ = *(const PG8_LAS f32x4*)(scr + ((wr * 16 + (ai * 4 + m) * 2 + bj) * 16 + fr) * 4);
                    float rn = qs / sqrtf(((t_[0] + t_[1]) + (t_[2] + t_[3])) * (1.0f / 128.0f) + 1e-6f);
                    f32x4 y0 = acc[ai][bj][m][0] * rr[ai][m], y1 = acc[ai][bj][m][1] * rr[ai][m];
                    if (!(bj == 1 && pass1)) { y0 = y0 * rn * g[bj][0]; y1 = y1 * rn * g[bj][1]; }
                    cs[bj][0] += y0; cs[bj][1] += y1;
                    u32x4 w; w.x = cvt_pk_bf16(y0[0], y0[1]); w.y = cvt_pk_bf16(y0[2], y0[3]); w.z = cvt_pk_bf16(y1[0], y1[1]); w.w = cvt_pk_bf16(y1[2], y1[3]);
                    *(u32x4*)(rowp + bj * HALF) = w; } }
        if (part == 1 && hp >= 3) {
            PG8_LAS float* scr2 = scr + 2048;
#pragma unroll
            for (int bj = 0; bj < 2; ++bj)
#pragma unroll
                for (int n = 0; n < 2; ++n)
#pragma unroll
                    for (int j = 0; j < 4; ++j) { float c_ = cs[bj][n][j]; c_ += xor_get<1>(c_); c_ += xor_get<2>(c_); c_ += xor_get<4>(c_); c_ += xor_get<8>(c_);
                        if (fr == 0) scr2[wr * 256 + bj * HALF + wc * 32 + 8 * fq + 4 * n + j] = c_; }
            asm volatile("s_waitcnt lgkmcnt(0)" ::: "memory"); __builtin_amdgcn_s_barrier();
            const int t_ = (wr * 4 + wc) * 64 + fq * 16 + fr;
            if (t_ < 256) { const int hh = h0 + (t_ >> 7);
                if (hh >= 6 && hh <= 10) kmean[(size_t)(((u.pm >> 4) * 5 + (hh - 6)) * 16 + (u.pm & 15)) * 128 + (t_ & 127)] = (scr2[t_] + scr2[256 + t_]) * (1.0f / 256.0f); }
        }
    }
};
__device__ __forceinline__ float silu_mul(float g, float u) { const float e = __builtin_amdgcn_exp2f(g * -1.4426950408889634f); return g * __builtin_amdgcn_rcpf(1.0f + e) * u; }
struct EpiSwiGLU {
    static constexpr bool PERM = true, AFTER_DRAIN = false;
    bf16_t* O; int ldc;
    __device__ __forceinline__ void operator()(const f32x4 (&acc)[2][2][4][2], const Unit& u, int wr, int wc, int fr, int fq) const {
        const int row0 = u.pm * BM + wr * 64 + fr, col0 = u.pn * HALF + wc * 32 + 8 * fq;
#pragma unroll
        for (int ai = 0; ai < 2; ++ai)
#pragma unroll
            for (int m = 0; m < 4; ++m) { bf16_t* rowp = O + (size_t)(row0 + ai * HALF + m * 16) * ldc + col0;
                const f32x4 g0 = acc[ai][0][m][0], g1 = acc[ai][0][m][1], u0 = acc[ai][1][m][0], u1 = acc[ai][1][m][1];
                u32x4 w; w.x = cvt_pk_bf16(silu_mul(g0[0], u0[0]), silu_mul(g0[1], u0[1])); w.y = cvt_pk_bf16(silu_mul(g0[2], u0[2]), silu_mul(g0[3], u0[3]));
                w.z = cvt_pk_bf16(silu_mul(g1[0], u1[0]), silu_mul(g1[1], u1[1])); w.w = cvt_pk_bf16(silu_mul(g1[2], u1[2]), silu_mul(g1[3], u1[3]));
                *(u32x4*)rowp = w; }
    }
};
struct EpiSwiGLU8 {
    static constexpr bool PERM = true, AFTER_DRAIN = false;
    unsigned char* O; int ldc;
    __device__ __forceinline__ void operator()(const f32x4 (&acc)[2][2][4][2], const Unit& u, int wr, int wc, int fr, int fq) const {
        typedef unsigned u32x2 __attribute__((ext_vector_type(2)));
        const int row0 = u.pm * BM + wr * 64 + fr, col0 = u.pn * HALF + wc * 32 + 8 * fq;
#pragma unroll
        for (int ai = 0; ai < 2; ++ai)
#pragma unroll
            for (int m = 0; m < 4; ++m) { unsigned char* rowp = O + (size_t)(row0 + ai * HALF + m * 16) * ldc + col0;
                const f32x4 g0 = acc[ai][0][m][0], g1 = acc[ai][0][m][1], u0 = acc[ai][1][m][0], u1 = acc[ai][1][m][1];
                u32x2 w; w.x = pk4_fp8(silu_mul(g0[0], u0[0]), silu_mul(g0[1], u0[1]), silu_mul(g0[2], u0[2]), silu_mul(g0[3], u0[3]));
                w.y = pk4_fp8(silu_mul(g1[0], u1[0]), silu_mul(g1[1], u1[1]), silu_mul(g1[2], u1[2]), silu_mul(g1[3], u1[3]));
                *(u32x2*)rowp = w; }
    }
};
struct EpiResF32 {
    static constexpr bool PERM = true, AFTER_DRAIN = false;
    const float* base32; const bf16_t* base16; bf16_t* out16; int ldc; bf16_t* out16b; float* ssq; PG8_LAS float* scr;
    __device__ __forceinline__ void operator()(const f32x4 (&acc)[2][2][4][2], const Unit& u, int wr, int wc, int fr, int fq) const {
        const int row0 = u.pm * BM + wr * 64 + fr, col0 = u.pn * BM + wc * 32 + 8 * fq;
#pragma unroll
        for (int ai = 0; ai < 2; ++ai)
#pragma unroll
            for (int m = 0; m < 4; ++m) { const size_t off = (size_t)(row0 + ai * HALF + m * 16) * ldc + col0; float sq_ = 0.f;
#pragma unroll
                for (int bj = 0; bj < 2; ++bj) { f32x4 v0 = acc[ai][bj][m][0], v1 = acc[ai][bj][m][1];
                    if (base32) { v0 += *(const f32x4*)(base32 + off + bj * HALF); v1 += *(const f32x4*)(base32 + off + bj * HALF + 4); }
                    else if (base16) { const u32x4 b = *(const u32x4*)(base16 + off + bj * HALF);
                        v0 += (f32x4){__uint_as_float(b.x << 16), __uint_as_float(b.x & 0xffff0000u), __uint_as_float(b.y << 16), __uint_as_float(b.y & 0xffff0000u)};
                        v1 += (f32x4){__uint_as_float(b.z << 16), __uint_as_float(b.z & 0xffff0000u), __uint_as_float(b.w << 16), __uint_as_float(b.w & 0xffff0000u)}; }
                    if (ssq) { float s_ = sq_; s_ = fmaf(v0[0], v0[0], s_); s_ = fmaf(v0[1], v0[1], s_); s_ = fmaf(v0[2], v0[2], s_); s_ = fmaf(v0[3], v0[3], s_);
                      s_ = fmaf(v1[0], v1[0], s_); s_ = fmaf(v1[1], v1[1], s_); s_ = fmaf(v1[2], v1[2], s_); s_ = fmaf(v1[3], v1[3], s_); sq_ = s_; }
                    u32x4 w; w.x = cvt_pk_bf16(v0[0], v0[1]); w.y = cvt_pk_bf16(v0[2], v0[3]); w.z = cvt_pk_bf16(v1[0], v1[1]); w.w = cvt_pk_bf16(v1[2], v1[3]);
                    *(u32x4*)((u.kh ? out16b : out16) + off + bj * HALF) = w; }
                if (ssq) { float s_ = sq_; s_ += xor_get<16>(s_); s_ = xor32_sum(s_);
                    if (fq == 0) scr[((wr * 8 + ai * 4 + m) * 16 + fr) * 4 + wc] = s_; } }
        if (ssq) {
            asm volatile("s_waitcnt lgkmcnt(0)" ::: "memory"); __builtin_amdgcn_s_barrier();
            if (wc == 0 && fq == 0) {
#pragma unroll
                for (int ai = 0; ai < 2; ++ai)
#pragma unroll
                    for (int m = 0; m < 4; ++m) { const f32x4 t_ = *(const PG8_LAS f32x4*)(scr + ((wr * 8 + ai * 4 + m) * 16 + fr) * 4);
                        ssq[(size_t)(row0 + ai * HALF + m * 16) * 8 + u.pn] = (t_[0] + t_[1]) + (t_[2] + t_[3]); } }
        }
    }
};

template <class Epi, class Sched, bool ALIGN_EPI = false, bool SP2 = false, bool FP8 = false>
__device__ __forceinline__ void gemm_phase(PG8_LAS unsigned char* lds, const Gemm g, const Sched& S, const Epi& E, const int wave_) {
    const int tid = tid_of(wave_), wid = wave_, lane = tid & 63, wr = wid >> 2, wc = wid & 3, fr = lane & 15, fq = lane >> 4;
    const int K = g.K, nt = K / BK;
    unsigned voffA[2], voffB[2];
#pragma unroll
    for (int i = 0; i < 2; ++i) { int R, C; stage_rc(tid * 16 + i * 8192, R, C); const int Rb = Epi::PERM ? ((R & ~31) + perm32(R & 31)) : R;
        voffA[i] = (unsigned)(R * K + C) * 2u; voffB[i] = (unsigned)(Rb * K + C) * 2u; }
    const size_t kstep = (size_t)(BK * 2);
    const size_t hstep = (size_t)HALF * K * 2;
    const size_t tstep = 2 * hstep;
    const unsigned ldsw = (unsigned)wid * 1024u;
    const int aoff = lds_byte(wr * 64 + fr, fq * 8), boff = lds_byte(wc * 32 + fr, fq * 8);
#define PG8_SA(b, h) (((b) * 2 + (h)) * HTB)
#define PG8_SB(b, h) ((4 + (b) * 2 + (h)) * HTB)
#define PG8_STAGE(bufoff, gbase, voff) do { _Pragma("unroll") for (int _i = 0; _i < 2; ++_i) { unsigned _vo = (voff)[_i]; asm volatile("" : "+v"(_vo));     \
        __builtin_amdgcn_global_load_lds((const unsigned*)((const char*)(gbase) + _vo), (PG8_LAS unsigned*)(lds + (bufoff) + ldsw + _i * 8192), 16, 0, 0); } } while (0)
#define PG8_LDA(dst, b, h) do { _Pragma("unroll") for (int m = 0; m < 4; ++m) _Pragma("unroll") for (int k = 0; k < 2; ++k) dst[m][k] = *(const PG8_LAS bf16x8*)(lds + PG8_SA(b, h) + aoff + m * 2048 + k * 1024); } while (0)
#define PG8_LDB(dst, b, h) do { _Pragma("unroll") for (int n = 0; n < 2; ++n) _Pragma("unroll") for (int k = 0; k < 2; ++k) dst[n][k] = *(const PG8_LAS bf16x8*)(lds + PG8_SB(b, h) + boff + n * 2048 + k * 1024); } while (0)
#define PG8_MMA(ai, bj, At, Bt) do { __builtin_amdgcn_s_setprio(1); _Pragma("unroll") for (int m = 0; m < 4; ++m) _Pragma("unroll") for (int n = 0; n < 2; ++n) { \
        if constexpr (FP8) { acc[ai][bj][m][n] = __builtin_amdgcn_mfma_scale_f32_16x16x128_f8f6f4(cat8(Bt[n][0], Bt[n][1]), cat8(At[m][0], At[m][1]), acc[ai][bj][m][n], 0, 0, 0, 0x77777777, 0, 0x7f7f7f7f); } \
        else { _Pragma("unroll") for (int k = 0; k < 2; ++k) acc[ai][bj][m][n] = __builtin_amdgcn_mfma_f32_16x16x32_bf16(Bt[n][k], At[m][k], acc[ai][bj][m][n], 0, 0, 0); } } __builtin_amdgcn_s_setprio(0); } while (0)
#define PG8_WAIT_V(n) asm volatile("s_waitcnt vmcnt(" #n ")" ::: "memory")
#define PG8_WAIT_L(n) asm volatile("s_waitcnt lgkmcnt(" #n ")" ::: "memory")
#define PG8_BAR __builtin_amdgcn_s_barrier()
#define PG8_SCHED __builtin_amdgcn_sched_barrier(0)
    Unit cur, nxt; int ui = 0;
    if (!S.next(0, cur)) return;
    f32x4 acc[2][2][4][2];
#pragma unroll
    for (int a = 0; a < 2; ++a)
#pragma unroll
        for (int b = 0; b < 2; ++b)
#pragma unroll
            for (int m = 0; m < 4; ++m)
#pragma unroll
                for (int n = 0; n < 2; ++n) acc[a][b][m][n] = (f32x4){0.f, 0.f, 0.f, 0.f};
    bf16x8 At[4][2], B0[2][2], B1[2][2];
    const char* cA = (const char*)g.A + (size_t)cur.pm * tstep + cur.kofs; const char* cB = (const char*)g.Bt + cur.bofs + (size_t)cur.pn * tstep + cur.kofs;
    S.a_ready(cur);
    if constexpr (SP2) {
        PG8_STAGE(PG8_SB(0, 0), cB, voffB); PG8_STAGE(PG8_SB(0, 1), cB + hstep, voffB); PG8_STAGE(PG8_SA(0, 0), cA, voffA); PG8_STAGE(PG8_SA(0, 1), cA + hstep, voffA);
        if (wr == 1) PG8_BAR;
        PG8_WAIT_V(2); PG8_BAR;
        PG8_STAGE(PG8_SB(1, 0), cB + kstep, voffB); PG8_STAGE(PG8_SA(1, 0), cA + kstep, voffA); PG8_STAGE(PG8_SB(1, 1), cB + hstep + kstep, voffB);
        PG8_WAIT_V(6); PG8_BAR;
    } else {
        PG8_STAGE(PG8_SB(0, 0), cB, voffB); PG8_STAGE(PG8_SA(0, 0), cA, voffA); PG8_STAGE(PG8_SB(0, 1), cB + hstep, voffB); PG8_STAGE(PG8_SA(0, 1), cA + hstep, voffA);
        if (wr == 1) PG8_BAR;
        PG8_WAIT_V(4); PG8_BAR;
        PG8_STAGE(PG8_SB(1, 0), cB + kstep, voffB); PG8_STAGE(PG8_SA(1, 0), cA + kstep, voffA); PG8_STAGE(PG8_SB(1, 1), cB + hstep + kstep, voffB);
        PG8_WAIT_V(6); PG8_BAR;
    }
    for (;;) {
        const bool has_next = S.next(ui + 1, nxt);
        const char* nA = has_next ? (const char*)g.A + (size_t)nxt.pm * tstep + nxt.kofs : cA; const char* nB = has_next ? (const char*)g.Bt + nxt.bofs + (size_t)nxt.pn * tstep + nxt.kofs : cB;
        const int ntc = cur.ntu ? cur.ntu : nt;
        for (int t = 0; t < ntc; t += 2) {
            const bool last = (t == ntc - 2);
            const char* a1 = cA + (size_t)(t + 1) * kstep;
            const char* a2 = last ? nA : cA + (size_t)(t + 2) * kstep; const char* b2 = last ? nB : cB + (size_t)(t + 2) * kstep;
            const char* a3 = a2 + kstep; const char* b3 = b2 + kstep;
            if (last && has_next) S.a_ready(nxt);
            if constexpr (SP2) {
            PG8_LDB(B0, 0, 0); PG8_LDB(B1, 0, 1); PG8_SCHED; PG8_LDA(At, 0, 0); PG8_STAGE(PG8_SA(1, 1), a1 + hstep, voffA);
            PG8_WAIT_V(8); PG8_WAIT_L(0); PG8_BAR; PG8_MMA(0, 0, At, B0); PG8_MMA(0, 1, At, B1); PG8_BAR; PG8_SCHED;
            PG8_LDA(At, 0, 1); PG8_STAGE(PG8_SB(0, 0), b2, voffB); PG8_STAGE(PG8_SB(0, 1), b2 + hstep, voffB); PG8_STAGE(PG8_SA(0, 0), a2, voffA);
            PG8_WAIT_V(8); PG8_WAIT_L(0); PG8_BAR; PG8_MMA(1, 0, At, B0); PG8_MMA(1, 1, At, B1); PG8_BAR; PG8_SCHED;
            PG8_LDB(B0, 1, 0); PG8_LDB(B1, 1, 1); PG8_SCHED; PG8_LDA(At, 1, 0); PG8_STAGE(PG8_SA(0, 1), a2 + hstep, voffA);
            PG8_WAIT_V(8); PG8_WAIT_L(0); PG8_BAR; PG8_MMA(0, 0, At, B0); PG8_MMA(0, 1, At, B1); PG8_BAR; PG8_SCHED;
            PG8_LDA(At, 1, 1); PG8_STAGE(PG8_SB(1, 0), b3, voffB); PG8_STAGE(PG8_SB(1, 1), b3 + hstep, voffB); PG8_STAGE(PG8_SA(1, 0), a3, voffA);
            PG8_WAIT_V(8); PG8_WAIT_L(0); PG8_BAR; PG8_MMA(1, 0, At, B0); PG8_MMA(1, 1, At, B1); PG8_BAR; PG8_SCHED;
            } else {
            PG8_LDB(B0, 0, 0); PG8_SCHED; PG8_LDA(At, 0, 0); PG8_STAGE(PG8_SA(1, 1), a1 + hstep, voffA);
            PG8_WAIT_L(8); PG8_BAR; PG8_WAIT_L(0); PG8_MMA(0, 0, At, B0); PG8_BAR; PG8_SCHED;
            PG8_LDB(B1, 0, 1); PG8_STAGE(PG8_SB(0, 0), b2, voffB);
            PG8_BAR; PG8_WAIT_L(0); PG8_MMA(0, 1, At, B1); PG8_BAR;
            PG8_LDA(At, 0, 1); PG8_STAGE(PG8_SA(0, 0), a2, voffA);
            PG8_BAR; PG8_WAIT_L(0); PG8_MMA(1, 0, At, B0); PG8_BAR; PG8_SCHED;
            PG8_STAGE(PG8_SB(0, 1), b2 + hstep, voffB);
            PG8_WAIT_V(6); PG8_BAR; PG8_MMA(1, 1, At, B1); PG8_BAR;
            PG8_LDB(B0, 1, 0); PG8_SCHED; PG8_LDA(At, 1, 0); PG8_STAGE(PG8_SA(0, 1), a2 + hstep, voffA);
            PG8_WAIT_L(8); PG8_BAR; PG8_WAIT_L(0); PG8_MMA(0, 0, At, B0); PG8_BAR; PG8_SCHED;
            PG8_LDB(B1, 1, 1); PG8_STAGE(PG8_SB(1, 0), b3, voffB);
            PG8_BAR; PG8_WAIT_L(0); PG8_MMA(0, 1, At, B1); PG8_BAR;
            PG8_LDA(At, 1, 1); PG8_STAGE(PG8_SA(1, 0), a3, voffA);
            PG8_BAR; PG8_WAIT_L(0); PG8_MMA(1, 0, At, B0); PG8_BAR; PG8_SCHED;
            PG8_STAGE(PG8_SB(1, 1), b3 + hstep, voffB);
            PG8_WAIT_V(6); PG8_BAR; PG8_MMA(1, 1, At, B1); PG8_BAR;
            }
        }
        if constexpr (ALIGN_EPI) { if (wr == 0) PG8_BAR; }
        if constexpr (!Epi::AFTER_DRAIN) { const int l2_ = lane_id(); E(acc, cur, wr, wc, l2_ & 15, l2_ >> 4); S.done(cur); }
        if (!has_next) break;
#pragma unroll
        for (int a = 0; a < 2; ++a)
#pragma unroll
            for (int b = 0; b < 2; ++b)
#pragma unroll
                for (int m = 0; m < 4; ++m)
#pragma unroll
                    for (int n = 0; n < 2; ++n) acc[a][b][m][n] = (f32x4){0.f, 0.f, 0.f, 0.f};
        cur = nxt; cA = nA; cB = nB; ++ui;
        if constexpr (ALIGN_EPI) { if (wr == 1) PG8_BAR; }
    }
    PG8_WAIT_V(0);
    if constexpr (!ALIGN_EPI) { if (wr == 0) PG8_BAR; }
    PG8_BAR;
    if constexpr (Epi::AFTER_DRAIN) { E.fused(acc, cur, wr, wc, fr, fq, lds, wid, lane); S.done(cur); }
#undef PG8_SA
#undef PG8_SB
#undef PG8_STAGE
#undef PG8_LDA
#undef PG8_LDB
#undef PG8_MMA
#undef PG8_WAIT_V
#undef PG8_WAIT_L
#undef PG8_BAR
#undef PG8_SCHED
}
}

namespace att {
typedef unsigned short bf16;
typedef short bf16x8 __attribute__((ext_vector_type(8)));
typedef short s16x4 __attribute__((ext_vector_type(4)));
typedef float f32x16 __attribute__((ext_vector_type(16)));
typedef float f32x4 __attribute__((ext_vector_type(4)));
typedef unsigned u32x4 __attribute__((ext_vector_type(4)));
typedef int i32x4 __attribute__((ext_vector_type(4)));
constexpr int QS = 6144, SEQ = 4096, DM = 2048;
constexpr int DPW = 1408, DPLW = 16, NTOK = 8192;
constexpr int SHM_T = 16384;
constexpr int L_V = 0, L_K = 2 * SHM_T, L_Q = 4 * SHM_T, L_WS = L_Q + 65536, L_TL = L_WS + 2048, L_FLG = L_TL + 256, L_MSK = L_FLG + 64, L_KM = L_V, L_END = L_MSK + 64;
static_assert(L_END <= 140 * 1024, "attention LDS map");
constexpr float C2 = 0.08838834764831845f * 1.4426950408889634f;
#define KSWZ(row, colB) ((row) * 256 + ((colB) ^ (((row) & 7) << 4)))
#define SBAR() __builtin_amdgcn_sched_barrier(0)
__device__ __forceinline__ int v_st(int k, int c) { const int kk = (k & ~0xC) | ((k & 4) << 1) | ((k & 8) >> 1); return ((kk >> 3) * 4 + (c >> 5)) * 512 + ((kk & 7) * 32 + (c & 31)) * 2; }
__device__ __forceinline__ int v_rd_base(int lane) { return ((lane & 3) << 3) | (((lane >> 2) & 3) << 6) | (((lane >> 4) & 1) << 5) | (((lane >> 5) & 1) << 8); }
constexpr int v_rd_off(int d0, int ks, int half) { return d0 * 512 + ks * 4096 + half * 2048; }
__device__ __forceinline__ int crow(int r, int hi) { return (r & 3) + 8 * (r >> 2) + 4 * hi; }
__device__ __forceinline__ unsigned cvtpk(float lo, float hi) { unsigned r; asm volatile("v_cvt_pk_bf16_f32 %0, %1, %2" : "=v"(r) : "v"(lo), "v"(hi)); return r; }
__device__ __forceinline__ float bf2f(short s) { return __uint_as_float(((unsigned)(unsigned short)s) << 16); }

__device__ __forceinline__ void qkt(f32x16& p0, f32x16& p1, const f32x16& init, const char* Kt, int r32, int hi, const char* qf  ) {
    p0 = init; p1 = init;
    const char* kb[4];
#pragma unroll
    for (int dd = 0; dd < 4; ++dd) kb[dd] = Kt + KSWZ(r32, (dd * 16 + hi * 8) * 2);
#pragma unroll
    for (int d0 = 0; d0 < 8; ++d0) { const char* a = kb[d0 & 3] + (d0 >> 2) * 128;
        bf16x8 b0 = *reinterpret_cast<const bf16x8*>(a);
        bf16x8 b1 = *reinterpret_cast<const bf16x8*>(a + 32 * 256);
        const bf16x8 q = *reinterpret_cast<const bf16x8*>(qf + d0 * 1024);
        p0 = __builtin_amdgcn_mfma_f32_32x32x16_bf16(b0, q, p0, 0, 0, 0);
        p1 = __builtin_amdgcn_mfma_f32_32x32x16_bf16(b1, q, p1, 0, 0, 0); }
}
__device__ __forceinline__ void qkt_r(f32x16& p0, f32x16& p1, const f32x16& init, const char* Kt, int r32, int hi, const bf16x8 (&q)[8]) {
    p0 = init; p1 = init;
    const char* kb[4];
#pragma unroll
    for (int dd = 0; dd < 4; ++dd) kb[dd] = Kt + KSWZ(r32, (dd * 16 + hi * 8) * 2);
#pragma unroll
    for (int d0 = 0; d0 < 8; ++d0) { const char* a = kb[d0 & 3] + (d0 >> 2) * 128;
        bf16x8 b0 = *reinterpret_cast<const bf16x8*>(a);
        bf16x8 b1 = *reinterpret_cast<const bf16x8*>(a + 32 * 256);
        p0 = __builtin_amdgcn_mfma_f32_32x32x16_bf16(b0, q[d0], p0, 0, 0, 0);
        p1 = __builtin_amdgcn_mfma_f32_32x32x16_bf16(b1, q[d0], p1, 0, 0, 0); }
}
__device__ __forceinline__ void pv_tile(f32x16* o, int vb, bf16x8 pa0, bf16x8 pa1, bf16x8 pa2, bf16x8 pa3) {
#define TRRD(dst, off) asm volatile("ds_read_b64_tr_b16 %0, %1 offset:%2" : "=&v"(dst) : "v"(vb), "i"(off) : "memory")
#define PV_D0(d0) do { s16x4 l0, l1, l2, l3, h0, h1, h2, h3; constexpr int b_ = v_rd_off(d0, 0, 0); \
        TRRD(l0, b_); TRRD(h0, b_ + 2048); TRRD(l1, b_ + 4096); TRRD(h1, b_ + 6144); TRRD(l2, b_ + 8192); TRRD(h2, b_ + 10240); TRRD(l3, b_ + 12288); TRRD(h3, b_ + 14336); \
        asm volatile("s_waitcnt lgkmcnt(0)" ::: "memory"); SBAR(); \
        o[d0] = __builtin_amdgcn_mfma_f32_32x32x16_bf16(pa0, (bf16x8){l0[0], l0[1], l0[2], l0[3], h0[0], h0[1], h0[2], h0[3]}, o[d0], 0, 0, 0);   \
        o[d0] = __builtin_amdgcn_mfma_f32_32x32x16_bf16(pa1, (bf16x8){l1[0], l1[1], l1[2], l1[3], h1[0], h1[1], h1[2], h1[3]}, o[d0], 0, 0, 0);   \
        o[d0] = __builtin_amdgcn_mfma_f32_32x32x16_bf16(pa2, (bf16x8){l2[0], l2[1], l2[2], l2[3], h2[0], h2[1], h2[2], h2[3]}, o[d0], 0, 0, 0);   \
        o[d0] = __builtin_amdgcn_mfma_f32_32x32x16_bf16(pa3, (bf16x8){l3[0], l3[1], l3[2], l3[3], h3[0], h3[1], h3[2], h3[3]}, o[d0], 0, 0, 0); } while (0)
    PV_D0(0); PV_D0(1); PV_D0(2); PV_D0(3);
#undef PV_D0
#undef TRRD
}
__device__ __forceinline__ void pack_p(const f32x16& p0, const f32x16& p1, bf16x8& pa0, bf16x8& pa1, bf16x8& pa2, bf16x8& pa3) {
#define PK4(P, B_, OUT) do { unsigned a0 = cvtpk(P[B_+0], P[B_+1]), a1 = cvtpk(P[B_+2], P[B_+3]);                          \
        unsigned b0 = cvtpk(P[B_+4], P[B_+5]), b1 = cvtpk(P[B_+6], P[B_+7]);                                             \
        auto r0 = __builtin_amdgcn_permlane32_swap(a0, b0, false, false); auto r1 = __builtin_amdgcn_permlane32_swap(a1, b1, false, false); \
        u32x4 w = {r0[0], r1[0], r0[1], r1[1]}; OUT = *reinterpret_cast<bf16x8*>(&w); } while (0)
    PK4(p0, 0, pa0); PK4(p0, 8, pa1); PK4(p1, 0, pa2); PK4(p1, 8, pa3);
#undef PK4
}
__device__ __forceinline__ float softplus2(float y) { return fmaxf(y, 0.f) + __builtin_amdgcn_logf(1.0f + __builtin_amdgcn_exp2f(-fabsf(y))); }

struct AttnArgs { const bf16* qkv; bf16* obuf; const float* kmean; const float* out_gain; bf16* dpo; float* dpl; unsigned* mlist; unsigned* mcnt; unsigned* mdone; };
constexpr int MLCAP = 3840, N_SEL = 2 * 5 * 15;
__device__ __forceinline__ unsigned ld_sc1(const unsigned* p) { return __hip_atomic_load(p, __ATOMIC_RELAXED, __HIP_MEMORY_SCOPE_AGENT); }
__device__ __forceinline__ void st_sc1(unsigned* p, unsigned v) { __hip_atomic_store(p, v, __ATOMIC_RELAXED, __HIP_MEMORY_SCOPE_AGENT); }

template <int mode> __device__ __forceinline__ void attn_unit(const AttnArgs& A, const int b, const int h, const int sub, char* shm, const int wave_) {
    const int tid = tid_of(wave_), wid = wave_, lane = tid & 63, r32 = lane & 31, hi = lane >> 5;
    int dil = 1, res = 0, qb = sub, br = 0;
    int gk = 0, gcnt = 0; unsigned gent = 0u; bool gvalid = true, wvalid = true;
    if (mode == 0) { br = sub >> 4; const int x = sub & 15; if (br == 0) { qb = x; } else if (br == 1) { dil = 4; res = x >> 2; qb = x & 3; } else { dil = 16; res = x; qb = 0; } }
    if (mode == 3) { gk = sub >> 4; const int c = sub & 15; const int li = (b * 5 + (h - 6)) * 15 + gk;
        gcnt = __builtin_amdgcn_readfirstlane((int)ld_sc1(A.mcnt + li));
        if (c * 256 >= gcnt) return;
        const int gi = c * 256 + wid * 32 + r32; gvalid = gi < gcnt; wvalid = (c * 256 + wid * 32) < gcnt;
        gent = ld_sc1(A.mlist + (size_t)li * MLCAP + (gvalid ? gi : 0)); qb = 0; }
    const size_t rowbase = (size_t)b * SEQ + res; const int q0 = qb * 256;
    const bf16* Qp = A.qkv + (rowbase + (size_t)dil * ((mode == 3) ? (int)(gent & 4095u) : (q0 + wid * 32 + r32))) * QS + h * 128;
    const bf16* Kh = A.qkv + rowbase * QS + 2048 + h * 128;
    const bf16* Vh = A.qkv + rowbase * QS + 4096 + h * 128;
    const size_t rstep = (size_t)dil * QS;
    char* V_lds = shm + L_V; char* K_lds = shm + L_K;
    float* wsf = (float*)(shm + L_WS) + wid * 64; float* li_l = wsf; float* al_l = wsf + 32;
    int* TL = (int*)(shm + L_TL); int* FLG = (int*)(shm + L_FLG); unsigned* MSK = (unsigned*)(shm + L_MSK); float* KM = (float*)(shm + L_KM);
    char* qf = shm + L_Q + wid * 8192 + lane * 16;
    bf16x8 qr[8];
#pragma unroll
    for (int d0 = 0; d0 < 8; ++d0) { qr[d0] = *reinterpret_cast<const bf16x8*>(Qp + d0 * 16 + hi * 8); if (mode == 2) *reinterpret_cast<bf16x8*>(qf + d0 * 1024) = qr[d0]; }
    const int qw0 = q0 + wid * 32;
    const int pos = qw0 + r32;
    const int vb0 = (int)(uintptr_t)V_lds + v_rd_base(lane);
    unsigned koffb[2], voffb[2];
#pragma unroll
    for (int i = 0; i < 2; ++i) { const int Lb = (2 * wid + i) * 1024 + lane * 16;
        const int rowk = Lb >> 8, ck = ((Lb >> 4) & 15) ^ (rowk & 7);
        koffb[i] = (unsigned)(((size_t)rowk * rstep + ck * 8) * 2);
        const int sub_ = Lb >> 9, win_ = Lb & 511, kk = (sub_ >> 2) * 8 + (win_ >> 6), kv = (kk & ~0xC) | ((kk & 4) << 1) | ((kk & 8) >> 1), cc = (sub_ & 3) * 4 + ((win_ & 63) >> 4);
        voffb[i] = (unsigned)(((size_t)kv * rstep + cc * 8) * 2); }
    typedef __attribute__((address_space(3))) unsigned lds_u32;
    lds_u32* const Kdst = (lds_u32*)(K_lds + wid * 2048); lds_u32* const Vdst = (lds_u32*)(V_lds + wid * 2048);
    const float sl = (mode == 2) ? 0.f : __builtin_amdgcn_exp2f(-8.0f * (float)(h + 1) / 11.0f) * 1.4426950408889634f * (float)dil;
    f32x16 binit;
#pragma unroll
    for (int r = 0; r < 16; ++r) binit[r] = sl * (float)((r & 3) + 8 * (r >> 2) + 4 * hi);
    const float sl32 = 32.f * sl;

    int NT = 0;
    if (mode == 1) { NT = 4; if (tid < 4) TL[tid] = q0 + 192 - 64 * tid; }
    else if (mode == 3) { NT = 4; if (tid < 4) TL[tid] = gk * 256 + 192 - 64 * tid; }
    else if (mode == 0) {
        const int lo = q0 >= 128 ? q0 - 128 : 0; NT = (q0 + 256 - lo) / 64;
        if (tid < NT) TL[NT - 1 - tid] = lo + 64 * tid;
    } else {
        NT = (q0 + 256) / 64;
        if (tid < NT) TL[tid] = q0 + 192 - 64 * tid;
    }
    __syncthreads();

    float m_reg = -1e30f, l_reg = 0.f, carry = 0.f; asm volatile("" : "+v"(m_reg), "+v"(l_reg), "+v"(carry));
    f32x16 o[4];
#pragma unroll
    for (int d0 = 0; d0 < 4; ++d0) o[d0] = f32x16{};
    bool wdone = false;
#define KOFF(b_) ((b_) < 2 ? (b_) * SHM_T : (L_Q + SHM_T - L_K))
#define VOFF(b_) ((b_) < 2 ? (b_) * SHM_T : (L_Q - L_V))
#define TDMA(k0_, bf_) do { const char* kt_ = (const char*)(Kh + (size_t)(k0_) * rstep); const char* vt_ = (const char*)(Vh + (size_t)(k0_) * rstep); \
        _Pragma("unroll") for (int i_ = 0; i_ < 2; ++i_) { unsigned ko_ = koffb[i_], vo_ = voffb[i_]; asm volatile("" : "+v"(ko_), "+v"(vo_)); \
            __builtin_amdgcn_global_load_lds((const unsigned*)(kt_ + ko_), (lds_u32*)((__attribute__((address_space(3))) char*)Kdst + KOFF(bf_) + i_ * 1024), 16, 0, 0); \
            __builtin_amdgcn_global_load_lds((const unsigned*)(vt_ + vo_), (lds_u32*)((__attribute__((address_space(3))) char*)Vdst + VOFF(bf_) + i_ * 1024), 16, 0, 0); } } while (0)
    if (NT > 0) { const int k0 = __builtin_amdgcn_readfirstlane(TL[0]); TDMA(k0, 0); }
    if (mode != 2) {
        if (NT > 1) { const int k1 = __builtin_amdgcn_readfirstlane(TL[1]); TDMA(k1, 1); asm volatile("s_waitcnt vmcnt(4)" ::: "memory"); } else asm volatile("s_waitcnt vmcnt(0)" ::: "memory");
        asm volatile("s_waitcnt lgkmcnt(0)" ::: "memory"); __builtin_amdgcn_s_barrier(); asm volatile("" ::: "memory");
    } else __syncthreads();
    int buf3 = 0;
    for (int t = 0; t < NT; ++t) {
        const int buf = (mode == 2) ? (t & 1) : buf3; const int kb = __builtin_amdgcn_readfirstlane(TL[t]);
        const bool more = (mode == 2) ? (t + 1 < NT) : (t + 2 < NT);
        if (mode == 2) { if (more) { const int k1 = __builtin_amdgcn_readfirstlane(TL[t + 1]); TDMA(k1, buf ^ 1); } }
        else { const int nb = (buf3 == 0) ? 2 : buf3 - 1;
            if (more) { const int k2 = __builtin_amdgcn_readfirstlane(TL[t + 2]); TDMA(k2, nb); } buf3 = (buf3 == 2) ? 0 : buf3 + 1; }
        bool act;
        if (mode == 0) act = (kb <= qw0 + 31) && (kb + 63 >= qw0 - 128);
        else if (mode == 1) act = (kb <= qw0 + 31);
        else if (mode == 3) act = wvalid;
        else act = (kb < qw0 + 32) && !wdone;
        if (act) {
            f32x16 p0, p1;
            if (mode == 2) qkt(p0, p1, binit, K_lds + buf * SHM_T, r32, hi, qf); else qkt_r(p0, p1, binit, K_lds + KOFF(buf), r32, hi, qr);
            bf16x8 pa0, pa1, pa2, pa3;
            const int dq = pos - kb - 4 * hi;
            if (mode == 2) {
                float Og[8], Pg[8];
#pragma unroll
                for (int i = 0; i < 8; ++i) { float ye[4], le[4];
#pragma unroll
                    for (int e = 0; e < 4; ++e) { const int c = (i < 4) ? (8 * i + e) : (8 * (i - 4) + 32 + e); const float y = ((i < 4) ? p0[4 * i + e] : p1[4 * (i - 4) + e]) * C2;
                        ye[e] = y; le[e] = (dq - c >= 1) ? -softplus2(y) : 0.f; }
                    const float w2 = le[3], w1 = w2 + le[2], w0 = w1 + le[1];
                    Og[i] = w0 + le[0];
                    const float x0 = ye[0] + le[0] + w0, x1 = ye[1] + le[1] + w1, x2 = ye[2] + le[2] + w2, x3 = ye[3] + le[3];
                    if (i < 4) { p0[4 * i] = x0; p0[4 * i + 1] = x1; p0[4 * i + 2] = x2; p0[4 * i + 3] = x3; } else { p1[4 * (i - 4)] = x0; p1[4 * (i - 4) + 1] = x1; p1[4 * (i - 4) + 2] = x2; p1[4 * (i - 4) + 3] = x3; } }
#pragma unroll
                for (int i = 0; i < 8; ++i) Pg[i] = xor32_get(Og[i], hi);
                float run = carry;
#pragma unroll
                for (int i = 7; i >= 0; --i) { const float ab = run + (hi == 0 ? Pg[i] : 0.f);
#pragma unroll
                    for (int e = 0; e < 4; ++e) { const int c = (i < 4) ? (8 * i + e) : (8 * (i - 4) + 32 + e);
                        if (i < 4) p0[4 * i + e] = (dq - c >= 1) ? __builtin_amdgcn_exp2f(p0[4 * i + e] + ab) : 0.f;
                        else p1[4 * (i - 4) + e] = (dq - c >= 1) ? __builtin_amdgcn_exp2f(p1[4 * (i - 4) + e] + ab) : 0.f; }
                    run += Og[i] + Pg[i]; }
                carry = run;
                wdone = __all(carry < -160.f) != 0;
                pack_p(p0, p1, pa0, pa1, pa2, pa3);
            } else {
                const float NEG = -__builtin_inff();
                bool rowok = true;
                if (mode == 0) {
                    if (!((kb + 63 <= qw0) && (qw0 + 31 - kb <= 128))) {
#pragma unroll
                        for (int r = 0; r < 16; ++r) { const int c = (r & 3) + 8 * (r >> 2);
                            p0[r] = ((unsigned)(dq - c) <= 128u) ? p0[r] : NEG; p1[r] = ((unsigned)(dq - c - 32) <= 128u) ? p1[r] : NEG; } }
                } else if (mode == 1) {
                    if (kb + 63 > qw0) {
#pragma unroll
                        for (int r = 0; r < 16; ++r) { const int c = (r & 3) + 8 * (r >> 2);
                            p0[r] = (dq - c >= 0) ? p0[r] : NEG; p1[r] = (dq - c - 32 >= 0) ? p1[r] : NEG; } }
                } else rowok = gvalid;
                const float tb = sl * (float)kb;
                float pm0 = p0[0], pm1 = p1[0];
#pragma unroll
                for (int r = 1; r < 16; ++r) { pm0 = fmaxf(pm0, p0[r]); pm1 = fmaxf(pm1, p1[r]); }
                float pmax = fmaxf(pm0, pm1 + sl32);
                { auto rr = __builtin_amdgcn_permlane32_swap(__float_as_uint(pmax), __float_as_uint(pmax), false, false); pmax = fmaxf(__uint_as_float(rr[0]), __uint_as_float(rr[1])); }
                pmax = rowok ? pmax : NEG;
                const float m_loc = m_reg - tb;
                const float mn = fmaxf(m_loc, pmax); const float alpha = __builtin_amdgcn_exp2f(m_loc - mn); m_reg = mn + tb;
                const float ref0 = rowok ? mn : __builtin_inff(), ref1 = ref0 - sl32;
                float ps = 0.f;
#pragma unroll
                for (int r = 0; r < 16; ++r) { p0[r] = __builtin_amdgcn_exp2f(p0[r] - ref0); p1[r] = __builtin_amdgcn_exp2f(p1[r] - ref1); ps += p0[r] + p1[r]; }
                { auto rr = __builtin_amdgcn_permlane32_swap(__float_as_uint(ps), __float_as_uint(ps), false, false); ps = __uint_as_float(rr[0]) + __uint_as_float(rr[1]); }
                l_reg = l_reg * alpha + ps;
                pack_p(p0, p1, pa0, pa1, pa2, pa3);
                if (__any(alpha < 1.f)) { if (hi == 0) al_l[r32] = alpha; asm volatile("s_waitcnt lgkmcnt(0)" ::: "memory");
#pragma unroll
                    for (int d_ = 0; d_ < 4; ++d_)
#pragma unroll
                        for (int r = 0; r < 16; ++r) o[d_][r] *= al_l[crow(r, hi)]; }
            }
            SBAR();
            pv_tile(o, vb0 + VOFF(buf), pa0, pa1, pa2, pa3);
        }
        if (mode == 2) { if (lane == 0) FLG[buf * 8 + wid] = wdone ? 1 : 0; }
        if (mode == 2) __syncthreads();
        else { if (more) asm volatile("s_waitcnt vmcnt(4)" ::: "memory"); else asm volatile("s_waitcnt vmcnt(0)" ::: "memory");
            asm volatile("s_waitcnt lgkmcnt(0)" ::: "memory"); __builtin_amdgcn_s_barrier(); asm volatile("" ::: "memory"); }
        if (mode == 2) { const i32x4 fa = *(const i32x4*)(FLG + buf * 8), fb = *(const i32x4*)(FLG + buf * 8 + 4);
            if ((fa[0] & fa[1] & fa[2] & fa[3] & fb[0] & fb[1] & fb[2] & fb[3]) != 0) break; }
    }
#undef TDMA
#undef KOFF
#undef VOFF
    if (mode != 2) {
        const int slot = (mode == 0) ? br : 0;
        const size_t tok0 = rowbase + (size_t)dil * qw0;
        int* ts_l = (int*)al_l;
        if (hi == 0) { const float lse = (l_reg > 0.f) ? (m_reg + __builtin_amdgcn_logf(l_reg) - ((mode == 0) ? sl * (float)pos : 0.f)) : -__builtin_inff();
            if (mode == 3) { const int ts = gvalid ? (int)((1u + (gent >> 12)) * (unsigned)NTOK + (unsigned)rowbase + (gent & 4095u)) : -1; ts_l[r32] = ts; if (gvalid) A.dpl[(size_t)ts * DPLW + h] = lse; }
            else A.dpl[((size_t)slot * NTOK + tok0 + (size_t)dil * r32) * DPLW + h] = lse;
            if (mode == 1) { for (int s_ = 1 + (qb < 3 ? qb : 3); s_ < 4; ++s_) A.dpl[((size_t)s_ * NTOK + tok0 + r32) * DPLW + h] = -__builtin_inff(); }
            li_l[r32] = (l_reg > 0.f) ? __builtin_amdgcn_rcpf(l_reg) : 0.f; }
        asm volatile("s_waitcnt lgkmcnt(0)" ::: "memory");
        float rli[16];
#pragma unroll
        for (int r = 0; r < 16; ++r) rli[r] = li_l[crow(r, hi)];
        if (mode == 3) {
#pragma unroll
            for (int r = 0; r < 16; ++r) { const int ts = ts_l[crow(r, hi)]; bf16* Ow = A.dpo + (size_t)(ts < 0 ? 0 : ts) * DPW + h * 128;
#pragma unroll
                for (int d0 = 0; d0 < 4; ++d0) { const float v = o[d0][r] * rli[r]; const float vn = xor_get<1>(v);
                    if ((r32 & 1) == 0 && ts >= 0) *(unsigned*)(Ow + d0 * 32 + r32) = cvtpk(v, vn); } }
        } else {
        bf16* Ow = A.dpo + ((size_t)slot * NTOK + tok0) * DPW + h * 128;
#pragma unroll
        for (int r = 0; r < 16; ++r) { const int orow = crow(r, hi);
#pragma unroll
            for (int d0 = 0; d0 < 4; ++d0) { const float v = o[d0][r] * rli[r]; const float vn = xor_get<1>(v);
                if ((r32 & 1) == 0) *(unsigned*)(Ow + (size_t)orow * dil * DPW + d0 * 32 + r32) = cvtpk(v, vn); } }
        }
    } else {
        float ssq[16];
#pragma unroll
        for (int r = 0; r < 16; ++r) { float a = 0.f;
#pragma unroll
            for (int d0 = 0; d0 < 4; ++d0) { const float v = o[d0][r]; a = fmaf(v, v, a); }
            ssq[r] = a; }
#pragma unroll
        for (int r = 0; r < 16; ++r) { float a = ssq[r]; a += xor_get<1>(a); a += xor_get<2>(a); a += xor_get<4>(a); a += xor_get<8>(a); a += xor_get<16>(a); ssq[r] = a; }
        float gn[4];
#pragma unroll
        for (int d0 = 0; d0 < 4; ++d0) gn[d0] = A.out_gain[h * 128 + d0 * 32 + r32];
        bf16* Ow = A.obuf + (rowbase + qw0) * DM + h * 128;
#pragma unroll
        for (int r = 0; r < 16; ++r) { const int orow = crow(r, hi); const float rn = 1.0f / sqrtf(ssq[r] * (1.0f / 128.0f) + 1e-6f);
#pragma unroll
            for (int d0 = 0; d0 < 4; ++d0) { const float v = o[d0][r] * rn * gn[d0]; const float vn = xor_get<1>(v);
                if ((r32 & 1) == 0) *(unsigned*)(Ow + (size_t)orow * DM + d0 * 32 + r32) = cvtpk(v, vn); } }
    }
}

__device__ __forceinline__ void moba_select(const AttnArgs& A, const int b, const int h, const int qb, char* shm, const int wave_) {
    const int tid = tid_of(wave_), wid = wave_, lane = tid & 63, r32 = lane & 31, hi = lane >> 5;
    float* KM = (float*)(shm + L_KM); int* LC = (int*)(shm + L_TL); int* LB = LC + 16;
    const int pos = qb * 256 + wid * 32 + r32;
    const bf16* Qp = A.qkv + ((size_t)b * SEQ + pos) * QS + h * 128;
    bf16x8 qr[8];
#pragma unroll
    for (int d0 = 0; d0 < 8; ++d0) qr[d0] = *reinterpret_cast<const bf16x8*>(Qp + d0 * 16 + hi * 8);
    if (tid < 16) LC[tid] = 0;
    { const float* src = A.kmean + (size_t)((b * 5 + (h - 6)) * 16) * 128; *(f32x4*)(KM + tid * 4) = *(const f32x4*)(src + tid * 4); }
    __syncthreads();
    float gate[16];
#pragma unroll
    for (int j = 0; j < 16; ++j) gate[j] = 0.f;
#pragma unroll
    for (int d0 = 0; d0 < 8; ++d0) {
        float qv[8];
#pragma unroll
        for (int e = 0; e < 8; ++e) qv[e] = bf2f(qr[d0][e]);
#pragma unroll
        for (int j = 0; j < 16; ++j) { const f32x4 k0 = *(const f32x4*)(KM + j * 128 + d0 * 16 + hi * 8), k1 = *(const f32x4*)(KM + j * 128 + d0 * 16 + hi * 8 + 4);
            float a = gate[j];
            a = fmaf(qv[0], k0[0], a); a = fmaf(qv[1], k0[1], a); a = fmaf(qv[2], k0[2], a); a = fmaf(qv[3], k0[3], a);
            a = fmaf(qv[4], k1[0], a); a = fmaf(qv[5], k1[1], a); a = fmaf(qv[6], k1[2], a); a = fmaf(qv[7], k1[3], a);
            gate[j] = a; }
    }
#pragma unroll
    for (int j = 0; j < 16; ++j) gate[j] = xor32_sum(gate[j]);
    unsigned sel = 0u;
#pragma unroll
    for (int it = 0; it < 3; ++it) { float best = -__builtin_inff(); int bi = -1;
#pragma unroll
        for (int j = 0; j < 16; ++j) { const bool ok = (j < qb) && (((sel >> j) & 1u) == 0u) && (gate[j] > best); if (ok) { best = gate[j]; bi = j; } }
        if (bi >= 0) sel |= 1u << bi; }
    int jj0 = -1, jj1 = -1, jj2 = -1, ll0 = 0, ll1 = 0, ll2 = 0;
    if (hi == 0) { unsigned s_ = sel;
        if (s_) { jj0 = __builtin_ctz(s_); s_ &= s_ - 1u; ll0 = __hip_atomic_fetch_add(LC + jj0, 1, __ATOMIC_RELAXED, __HIP_MEMORY_SCOPE_WORKGROUP); }
        if (s_) { jj1 = __builtin_ctz(s_); s_ &= s_ - 1u; ll1 = __hip_atomic_fetch_add(LC + jj1, 1, __ATOMIC_RELAXED, __HIP_MEMORY_SCOPE_WORKGROUP); }
        if (s_) { jj2 = __builtin_ctz(s_); ll2 = __hip_atomic_fetch_add(LC + jj2, 1, __ATOMIC_RELAXED, __HIP_MEMORY_SCOPE_WORKGROUP); } }
    __syncthreads();
    const int lbase = (b * 5 + (h - 6)) * 15;
    if (tid < 15) { const int n = LC[tid]; LB[tid] = n ? (int)__hip_atomic_fetch_add(A.mcnt + lbase + tid, (unsigned)n, __ATOMIC_RELAXED, __HIP_MEMORY_SCOPE_AGENT) : 0; }
    __syncthreads();
    if (hi == 0) {
        if (jj0 >= 0) st_sc1(A.mlist + (size_t)(lbase + jj0) * MLCAP + LB[jj0] + ll0, (unsigned)pos);
        if (jj1 >= 0) st_sc1(A.mlist + (size_t)(lbase + jj1) * MLCAP + LB[jj1] + ll1, (unsigned)pos | (1u << 12));
        if (jj2 >= 0) st_sc1(A.mlist + (size_t)(lbase + jj2) * MLCAP + LB[jj2] + ll2, (unsigned)pos | (2u << 12)); }
    asm volatile("s_waitcnt vmcnt(0)" ::: "memory");
    __syncthreads();
    if (tid == 0) __hip_atomic_fetch_add(A.mdone, 1u, __ATOMIC_RELAXED, __HIP_MEMORY_SCOPE_AGENT);
}

constexpr bool unit_valid(int mode, int sub) { return mode == 0 ? sub < 48 : sub < 16; }
constexpr int unit_cost(int mode, int sub) {
    if (mode == 0) return 4;
    if (mode == 2) return 4 * (sub + 1) < 6 ? 4 * (sub + 1) : 6;
    return 4;
}
constexpr int gath_expected(int kb) { int len = 0; for (int qb = kb + 1; qb < 16; ++qb) len += (qb <= 3) ? 256 : 768 / qb; return (len + 255) / 256; }
constexpr int N_GATH = 2 * 5 * 120;
constexpr int N_UNITS = 2 * 6 * 48 + 2 * 5 * 16 + 2 * 5 * 16;
constexpr int CHUNK_TILES = 2, N_CHUNKS = 2240;
constexpr int N_TICKETS = N_SEL + N_UNITS + N_GATH + N_CHUNKS;
struct OrderTab { unsigned short v[N_TICKETS]; };
constexpr OrderTab make_order() {
    OrderTab T{}; int n = 0, nc = 0; long tot = 0, acc = 0;
    for (int b = 0; b < 2; ++b) for (int hr = 0; hr < 5; ++hr) for (int qb = 15; qb >= 1; --qb) T.v[n++] = (unsigned short)(0x2000 | (b << 9) | (hr << 6) | qb);
    for (int mode = 0; mode < 3; ++mode) { const int nh = (mode == 0) ? 6 : 5; for (int sub = 0; sub < 64; ++sub) if (unit_valid(mode, sub)) tot += 2L * nh * unit_cost(mode, sub); }
    for (int kb = 0; kb < 15; ++kb) tot += 2L * 5 * 4 * (gath_expected(kb) < 15 - kb ? gath_expected(kb) : 15 - kb);
    for (int cost = 64; cost >= 1; --cost)
        for (int mode = 2; mode >= 0; --mode) { const int nh = (mode == 0) ? 6 : 5;
            for (int sub = 63; sub >= 0; --sub) { if (!unit_valid(mode, sub) || unit_cost(mode, sub) != cost) continue;
                for (int b = 0; b < 2; ++b) for (int hr = 0; hr < nh; ++hr) { T.v[n++] = (unsigned short)((mode << 10) | (b << 9) | (hr << 6) | sub);
                    acc += (long)cost * N_CHUNKS; while (acc >= tot && nc < N_CHUNKS) { T.v[n++] = (unsigned short)(0x8000 | nc); ++nc; acc -= tot; } } } }
    for (int c = 0; c < 15; ++c) for (int kb = 0; kb + c < 15; ++kb) { if (c >= gath_expected(kb)) continue;
        for (int b = 0; b < 2; ++b) for (int hr = 0; hr < 5; ++hr) { T.v[n++] = (unsigned short)(0x4000 | (b << 11) | (hr << 8) | (kb << 4) | c);
            acc += 4L * N_CHUNKS; while (acc >= tot && nc < N_CHUNKS) { T.v[n++] = (unsigned short)(0x8000 | nc); ++nc; acc -= tot; } } }
    while (nc < N_CHUNKS) { T.v[n++] = (unsigned short)(0x8000 | nc); ++nc; }
    for (int c = 0; c < 15; ++c) for (int kb = 0; kb + c < 15; ++kb) { if (c < gath_expected(kb)) continue;
        for (int b = 0; b < 2; ++b) for (int hr = 0; hr < 5; ++hr) T.v[n++] = (unsigned short)(0x4000 | (b << 11) | (hr << 8) | (kb << 4) | c); }
    return T;
}
__device__ const OrderTab ATT_ORDER = make_order();
#undef KSWZ
#undef SBAR
}


constexpr int NWAVES = 8;
#ifndef MK_SPLIT
#define MK_SPLIT 0
#endif
constexpr int BATCH = 2, SEQ = 4096, D = 2048, FF = 5632, NE = 8;
constexpr int M = BATCH * SEQ;
constexpr int NQKV = 3 * D, NGU = 2 * FF;
constexpr int MPAD = 18432;
constexpr float EPS = 1e-6f;
constexpr size_t MiB = 1u << 20;
constexpr size_t WS_CTL = 0, CTL_ZERO_BYTES = 1 * MiB;
constexpr size_t WS_WQKV = 1 * MiB;
constexpr size_t WS_WO = 49 * MiB;
constexpr size_t WS_WGU_D = 65 * MiB;
constexpr size_t WS_WD_D = 109 * MiB;
constexpr size_t WS_WGU_M = 131 * MiB;
constexpr size_t WS_WD_M = 483 * MiB;
constexpr size_t WS_H = 659 * MiB;
constexpr size_t WS_QKV = 723 * MiB;
constexpr size_t WS_O = 819 * MiB;
constexpr size_t WS_A = 851 * MiB;
constexpr size_t WS_YS = WS_QKV;
constexpr size_t WS_ACT = 883 * MiB;
constexpr size_t WS_XS = 1081 * MiB;
constexpr size_t WS_MISC = 1153 * MiB;
constexpr size_t WS_DPO = 1154 * MiB;
constexpr size_t WS_DPL = 1242 * MiB;
constexpr size_t WS_MLIST = 1244 * MiB;
constexpr size_t WS_END = 1249 * MiB;
constexpr size_t MISC_KMEAN = 0, MISC_SELE = 131072, MISC_SELREL = MISC_SELE + 32768, MISC_SELG = MISC_SELREL + 65536, MISC_SELPOS = MISC_SELG + 65536, MISC_RSQ = 393216  , MISC_RSQ2 = MISC_RSQ + 262144;
static_assert(MISC_SELPOS + 65536 <= MISC_RSQ && MISC_RSQ2 + 262144 <= MiB && (size_t)MPAD * D * 4 <= 160 * MiB && (size_t)MPAD * FF * 2 <= 198 * MiB, "ws map");
constexpr int CW_TMO = 0, CW_CODE = 1;
constexpr int CW_BAR = 4096;
constexpr int CW_ATTQ = 8192;
constexpr int CW_CNT = 8448;
constexpr int CW_MCNT = 9216;
constexpr int CW_MDONE = 10240;
constexpr int RING_OFF = 0, RING_BYTES = 131072;
constexpr int LDSCTL_OFF = 143360, MISC_OFF = LDSCTL_OFF + 320;
constexpr int LDS_BYTES = 147456;
constexpr int PPL = 11, N_PHASES = 2 * PPL;

#define GAS __attribute__((address_space(1)))
#define LAS __attribute__((address_space(3)))
typedef unsigned short bf16;
typedef unsigned v4u __attribute__((ext_vector_type(4)));
typedef float f32x4 __attribute__((ext_vector_type(4)));
typedef short bf16x8 __attribute__((ext_vector_type(8)));
typedef GAS unsigned gu32;
typedef GAS unsigned long long gu64;
#define RLX_AGENT __ATOMIC_RELAXED, __HIP_MEMORY_SCOPE_AGENT
#define LDS_WAIT() asm volatile("s_waitcnt lgkmcnt(0)" ::: "memory")
#define VM_WAIT() asm volatile("s_waitcnt vmcnt(0)" ::: "memory")
__device__ __forceinline__ unsigned long long rt() { return __builtin_amdgcn_s_memrealtime(); }
__device__ __forceinline__ unsigned f2bf(float f) { unsigned u = __builtin_bit_cast(unsigned, f); return (u + 0x7fffu + ((u >> 16) & 1u)) >> 16; }
__device__ __forceinline__ unsigned pk2(float lo, float hi) { return f2bf(lo) | (f2bf(hi) << 16); }

#define XB_TMO      128
#define XB_XCNT(j)  (256  + 64 * (j))
#define XB_XSUB(j)  (1280 + 64 * (j))
#define XB_XGEN(j)  (2304 + 64 * (j))
#define XB_TOP      3328
#define XB_TOPGEN   3392
#define XCD_BAR_WORDS 3456
#define XB_SPIN_CAP (1u << 18)

__device__ __forceinline__ unsigned xb_ld(unsigned* p)              { return __hip_atomic_load(p, __ATOMIC_RELAXED, __HIP_MEMORY_SCOPE_AGENT); }
__device__ __forceinline__ unsigned xb_add(unsigned* p, unsigned v) { return __hip_atomic_fetch_add(p, v, __ATOMIC_RELAXED, __HIP_MEMORY_SCOPE_AGENT); }
__device__ __forceinline__ unsigned xb_xcc_id() { return (unsigned)__builtin_amdgcn_s_getreg((3 << 11) | 20) & 0xFu; }
#define XB_SPIN(cond, bar) do { unsigned _sp = 0; while (cond) { __builtin_amdgcn_s_sleep(1); \
    if ((++_sp & 255u) == 0u) { if (xb_ld(&(bar)[XB_TMO])) break; if (_sp > XB_SPIN_CAP) { atomicAdd(&(bar)[XB_TMO], 1u); break; } } } } while (0)

#define XB_IS_T0 (b.wv == 0 && lane_id() == 0)
struct XcdBarrier {
    int wv;
    unsigned* bar; unsigned x;
    volatile LAS unsigned* st;
};

__device__ __forceinline__ XcdBarrier xcd_barrier_post(unsigned* bar, volatile LAS unsigned* st, int wv) {
    XcdBarrier b; b.bar = bar; b.x = xb_xcc_id(); b.st = st; b.wv = wv;
    if (XB_IS_T0) (void)xb_add(&bar[XB_XCNT(b.x)], 1u);
    return b;
}
__device__ __forceinline__ void xcd_barrier_complete(unsigned* bar, unsigned x, unsigned& nloc, unsigned& nx) {
    const unsigned G = gridDim.x * gridDim.y * gridDim.z;
    unsigned sum, cnt, mine, sp = 0u;
    for (;;) {
        sum = 0u; cnt = 0u; mine = 0u;
#pragma unroll
        for (unsigned j = 0; j < 16; ++j) { const unsigned c = xb_ld(&bar[XB_XCNT(j)]); sum += c; cnt += (c > 0u) ? 1u : 0u; mine = (j == x) ? c : mine; }
        if (sum == G) break;
        __builtin_amdgcn_s_sleep(1);
        if ((++sp & 255u) == 0u) { if (xb_ld(&bar[XB_TMO])) break; if (sp > XB_SPIN_CAP) { atomicAdd(&bar[XB_TMO], 1u); break; } }
    }
    nloc = mine > 0u ? mine : 1u; nx = cnt > 0u ? cnt : 1u;
}

__device__ __forceinline__ void xcd_barrier(const XcdBarrier& b) {
    asm volatile("s_waitcnt vmcnt(0)" ::: "memory");
    __syncthreads();
    if (XB_IS_T0) {
        unsigned* bar = b.bar;
        __builtin_amdgcn_s_waitcnt(0);
        unsigned nloc = b.st[0], nx = b.st[1];
        if (nloc == 0u) { xcd_barrier_complete(bar, b.x, nloc, nx); b.st[0] = nloc; b.st[1] = nx; }
        const unsigned old = xb_add(&bar[XB_XSUB(b.x)], 1u);
        const unsigned gen = old / nloc;
        if (old + 1u == (gen + 1u) * nloc) {
            __builtin_amdgcn_fence(__ATOMIC_RELEASE, "agent");
            asm volatile("s_waitcnt vmcnt(0)" ::: "memory");
            const unsigned og = xb_add(&bar[XB_TOP], 1u);
            const unsigned tg = og / nx;
            if (og + 1u == (tg + 1u) * nx) xb_add(&bar[XB_TOPGEN], 1u);
            else XB_SPIN(xb_ld(&bar[XB_TOPGEN]) == tg, bar);
            __builtin_amdgcn_fence(__ATOMIC_ACQUIRE, "agent");
            xb_add(&bar[XB_XGEN(b.x)], 1u);
            asm volatile("s_waitcnt vmcnt(0)" ::: "memory");
        } else {
            XB_SPIN(xb_ld(&bar[XB_XGEN(b.x)]) == gen, bar);
            __builtin_amdgcn_fence(__ATOMIC_ACQUIRE, "agent");
            asm volatile("s_waitcnt vmcnt(0)" ::: "memory");
        }
    }
    __syncthreads();
}


__device__ __forceinline__ float wave_sum(float v) {
    v += xor_get<1>(v); v += xor_get<2>(v); v += xor_get<4>(v); v += xor_get<8>(v); v += xor_get<16>(v);
    return xor32_sum(v);
}
__device__ __forceinline__ float bf2f_u(unsigned short s) { return __uint_as_float(((unsigned)s) << 16); }
typedef unsigned u32x2_g __attribute__((ext_vector_type(2)));
__device__ __forceinline__ f32x4 bf4_to_f32(u32x2_g a) { return (f32x4){__uint_as_float(a.x << 16), __uint_as_float(a.x & 0xffff0000u), __uint_as_float(a.y << 16), __uint_as_float(a.y & 0xffff0000u)}; }

__device__ __forceinline__ void p0_transpose_item(const float* W, int K, int N, bf16* WT, int mode, LAS float* scr, int item, int lane) {
    const int nblk = N / 32, kb = item / nblk, nb = item % nblk, k0 = 64 * kb, n0 = 32 * nb;
#pragma unroll 8
    for (int i = 0; i < 32; ++i) { const int kk = 2 * i + (lane >> 5); scr[kk * 33 + (lane & 31)] = W[(size_t)(k0 + kk) * N + n0 + (lane & 31)]; }
    LDS_WAIT(); asm volatile("" ::: "memory");
    const int drow0 = (mode == 0) ? n0 : (256 * (n0 >> 7) + (n0 & 127) + (mode == 2 ? 128 : 0));
    const int c = lane & 7;
#pragma unroll
    for (int j = 0; j < 4; ++j) { const int n = (lane >> 3) + 8 * j; const LAS float* s = scr + (8 * c) * 33 + n;
        v4u o; o.x = pk2(s[0 * 33], s[1 * 33]); o.y = pk2(s[2 * 33], s[3 * 33]); o.z = pk2(s[4 * 33], s[5 * 33]); o.w = pk2(s[6 * 33], s[7 * 33]);
        *(GAS v4u*)(WT + (size_t)(drow0 + n) * K + k0 + 8 * c) = o; }
    LDS_WAIT(); asm volatile("" ::: "memory");
}

__device__ __forceinline__ void p0_transpose_item_fp8(const float* W, int K, int N, unsigned char* WT, int mode, LAS float* scr, int item, int lane) {
    const int nblk = N / 32, kb = item / nblk, nb = item % nblk, k0 = 64 * kb, n0 = 32 * nb;
#pragma unroll 8
    for (int i = 0; i < 32; ++i) { const int kk = 2 * i + (lane >> 5); scr[kk * 33 + (lane & 31)] = W[(size_t)(k0 + kk) * N + n0 + (lane & 31)]; }
    LDS_WAIT(); asm volatile("" ::: "memory");
    const int drow0 = (mode == 0) ? n0 : (256 * (n0 >> 7) + (n0 & 127) + (mode == 2 ? 128 : 0));
    const int n = lane & 31, kq = lane >> 5; const LAS float* sp = scr + (32 * kq) * 33 + n;
    v4u o0, o1;
#define P4(j) pg8::pk4_fp8(sp[(4 * (j)) * 33] * 256.f, sp[(4 * (j) + 1) * 33] * 256.f, sp[(4 * (j) + 2) * 33] * 256.f, sp[(4 * (j) + 3) * 33] * 256.f)
    o0.x = P4(0); o0.y = P4(1); o0.z = P4(2); o0.w = P4(3); o1.x = P4(4); o1.y = P4(5); o1.z = P4(6); o1.w = P4(7);
#undef P4
    GAS v4u* dst = (GAS v4u*)(WT + (size_t)(drow0 + n) * K + k0 + 32 * kq);
    dst[0] = o0; dst[1] = o1;
    LDS_WAIT(); asm volatile("" ::: "memory");
}

struct Ptrs {
    const float *x, *attn_norm, *w_in, *q_gain, *k_gain, *out_gain, *w_out, *ffn_norm, *dwg, *dwu, *dwd, *router, *mwg, *mwu, *mwd;
    float* out;
    bf16 *Wqkv_t, *Wo_t, *QKV, *OB, *AB;
    unsigned char *Wgu_d, *Wd_d, *Wgu_m, *Wd_m, *AB8, *ACT, *XS;
    float *kmean, *DPL; bf16 *DPO, *YS, *H; unsigned* sel_e; int* sel_rel; float* sel_g; int* sel_pos;
    gu32* ctl; float* rsq;
};

struct CvTile { const float* W; unsigned char* WT; int K, N, mode, f8, r; const float* gain; };
__device__ __forceinline__ CvTile cv_decode(const Ptrs& P, int it) {
    constexpr int T_IN = (D / 128) * (NQKV / 256), T_O = (D / 128) * (D / 256), T_G = (D / 128) * (FF / 256), T_D = (FF / 128) * (D / 256), T_E = 2 * T_G + T_D;
    CvTile c; int r = it; c.gain = nullptr;
    if (r < T_IN) { c.W = P.w_in; c.WT = (unsigned char*)P.Wqkv_t; c.K = D; c.N = NQKV; c.mode = 0; c.f8 = 0; c.r = r; return c; } r -= T_IN;
    if (r < T_O) { c.W = P.w_out; c.WT = (unsigned char*)P.Wo_t; c.K = D; c.N = D; c.mode = 0; c.f8 = 0; c.r = r; return c; } r -= T_O;
    if (r < T_G) { c.W = P.dwg; c.WT = P.Wgu_d; c.K = D; c.N = FF; c.mode = 1; c.f8 = 1; c.r = r; return c; } r -= T_G;
    if (r < T_G) { c.W = P.dwu; c.WT = P.Wgu_d; c.K = D; c.N = FF; c.mode = 2; c.f8 = 1; c.r = r; return c; } r -= T_G;
    if (r < T_D) { c.W = P.dwd; c.WT = P.Wd_d; c.K = FF; c.N = D; c.mode = 0; c.f8 = 1; c.r = r; return c; } r -= T_D;
    if (r < T_IN) { c.W = P.w_in + (size_t)D * NQKV; c.WT = (unsigned char*)(P.Wqkv_t + (size_t)NQKV * D); c.K = D; c.N = NQKV; c.mode = 0; c.f8 = 0; c.r = r; c.gain = P.attn_norm + D; return c; } r -= T_IN;
    if (r < T_O) { c.W = P.w_out + (size_t)D * D; c.WT = (unsigned char*)(P.Wo_t + (size_t)D * D); c.K = D; c.N = D; c.mode = 0; c.f8 = 0; c.r = r; return c; } r -= T_O;
    const int e = r / T_E; r -= e * T_E; c.f8 = 1;
    if (r < T_G) { c.W = P.mwg + (size_t)e * D * FF; c.WT = P.Wgu_m + (size_t)e * NGU * D; c.K = D; c.N = FF; c.mode = 1; c.r = r; return c; } r -= T_G;
    if (r < T_G) { c.W = P.mwu + (size_t)e * D * FF; c.WT = P.Wgu_m + (size_t)e * NGU * D; c.K = D; c.N = FF; c.mode = 2; c.r = r; return c; } r -= T_G;
    c.W = P.mwd + (size_t)e * FF * D; c.WT = P.Wd_m + (size_t)e * D * FF; c.K = FF; c.N = D; c.mode = 0; c.r = r; return c;
}
constexpr int CV_T_IN = (D / 128) * (NQKV / 256), CV_T_O = (D / 128) * (D / 256), CV_T_G = (D / 128) * (FF / 256), CV_T_D = (FF / 128) * (D / 256);
constexpr int CV_L0 = CV_T_IN + CV_T_O + 2 * CV_T_G + CV_T_D, CV_DEF = CV_T_IN + CV_T_O + NE * (2 * CV_T_G + CV_T_D);
static_assert(CV_DEF == 2 * att::N_CHUNKS * att::CHUNK_TILES, "deferred conversion tiles = 2 phases x N_CHUNKS x CHUNK_TILES");
__device__ __forceinline__ void cv_tile_out(const CvTile& cur, LAS float* S, int tid_) {
    constexpr int LS = 260;
    const int nbl = cur.N / 256, kb = cur.r / nbl, nb = cur.r - kb * nbl;
    if (cur.f8) {
#pragma unroll
        for (int i = 0; i < 4; ++i) { const int p = tid_ + 512 * i, kq = p & 7, n = p >> 3, nn = 256 * nb + n;
            const int drow = (cur.mode == 0) ? nn : (256 * (nn >> 7) + (nn & 127) + (cur.mode == 2 ? 128 : 0));
            const LAS float* sp = S + (16 * kq) * LS + (n ^ (4 * kq)); v4u o;
#define P4(j) pg8::pk4_fp8(sp[(4 * (j)) * LS] * 256.f, sp[(4 * (j) + 1) * LS] * 256.f, sp[(4 * (j) + 2) * LS] * 256.f, sp[(4 * (j) + 3) * LS] * 256.f)
            o.x = P4(0); o.y = P4(1); o.z = P4(2); o.w = P4(3);
#undef P4
            __builtin_nontemporal_store(o, (GAS v4u*)(cur.WT + (size_t)drow * cur.K + 128 * kb + 16 * kq)); } }
    else {
#pragma unroll
        for (int i = 0; i < 8; ++i) { const int p = tid_ + 512 * i, kc = p & 15, n = p >> 4, nn = 256 * nb + n;
            const int drow = (cur.mode == 0) ? nn : (256 * (nn >> 7) + (nn & 127) + (cur.mode == 2 ? 128 : 0));
            const LAS float* sp = S + (8 * kc) * LS + (n ^ (4 * (kc >> 1))); v4u o;
            o.x = pk2(sp[0], sp[LS]); o.y = pk2(sp[2 * LS], sp[3 * LS]); o.z = pk2(sp[4 * LS], sp[5 * LS]); o.w = pk2(sp[6 * LS], sp[7 * LS]);
            *(GAS v4u*)((bf16*)cur.WT + (size_t)drow * cur.K + 128 * kb + 8 * kc) = o; } }
}
__device__ __forceinline__ void cv8_to_lds(const f32x4 (&v)[16], LAS unsigned char* T, int wave, int lane) {
    unsigned d[16];
#pragma unroll
    for (int i = 0; i < 16; ++i) d[i] = pg8::pk4_fp8(v[i].x * 256.f, v[i].y * 256.f, v[i].z * 256.f, v[i].w * 256.f);
    unsigned o[4][4];
#pragma unroll
    for (int q = 0; q < 4; ++q) { const unsigned a = d[4 * q], b = d[4 * q + 1], c = d[4 * q + 2], e = d[4 * q + 3];
        const unsigned t0 = __builtin_amdgcn_perm(b, a, 0x05010400u), t1 = __builtin_amdgcn_perm(b, a, 0x07030602u), t2 = __builtin_amdgcn_perm(e, c, 0x05010400u), t3 = __builtin_amdgcn_perm(e, c, 0x07030602u);
        o[0][q] = __builtin_amdgcn_perm(t2, t0, 0x05040100u); o[1][q] = __builtin_amdgcn_perm(t2, t0, 0x07060302u); o[2][q] = __builtin_amdgcn_perm(t3, t1, 0x05040100u); o[3][q] = __builtin_amdgcn_perm(t3, t1, 0x07060302u); }
#pragma unroll
    for (int j = 0; j < 4; ++j) { v4u w; w.x = o[j][0]; w.y = o[j][1]; w.z = o[j][2]; w.w = o[j][3];
        *(LAS v4u*)(T + (4 * lane + j) * 128 + 16 * (wave ^ (lane & 7))) = w; }
}
__device__ __forceinline__ void cv8_out(const CvTile& cur, const LAS unsigned char* T, int tid_) {
    const int nbl = cur.N / 256, kb = cur.r / nbl, nb = cur.r - kb * nbl;
#pragma unroll
    for (int i = 0; i < 4; ++i) { const int p = tid_ + 512 * i, c = p & 7, n = p >> 3, nn = 256 * nb + n;
        const int drow = (cur.mode == 0) ? nn : (256 * (nn >> 7) + (nn & 127) + (cur.mode == 2 ? 128 : 0));
        const v4u w = *(const LAS v4u*)(T + n * 128 + 16 * (c ^ ((n >> 2) & 7)));
        __builtin_nontemporal_store(w, (GAS v4u*)(cur.WT + (size_t)drow * cur.K + 128 * kb + 16 * c)); }
}
__device__ __forceinline__ void convert_weights(const Ptrs& P, LAS unsigned char* lds, int t0, int step, int t1, int wave, int lane) {
    asm volatile("" : "+v"(lane));
    constexpr int LS = 260;
    LAS float* S = (LAS float*)(lds + RING_OFF);
    LAS unsigned char* T8 = lds + RING_OFF;
    const int tid_ = wave * 64 + lane;
    if (t0 >= t1) return;
    f32x4 va[16], vb[16];
#define CV_LOAD(v, c) do { const int nbl_ = (c).N / 256, kb_ = (c).r / nbl_, nb_ = (c).r - kb_ * nbl_; const float* p_ = (c).W + (size_t)(128 * kb_ + wave * 16) * (c).N + 256 * nb_ + 4 * lane; \
        _Pragma("unroll") for (int i_ = 0; i_ < 16; ++i_) (v)[i_] = __builtin_nontemporal_load((const f32x4*)(p_ + (size_t)i_ * (c).N)); } while (0)
#define CV_TOLDS(v) do { _Pragma("unroll") for (int i_ = 0; i_ < 16; ++i_) *(LAS f32x4*)(S + (wave * 16 + i_) * LS + ((4 * lane) ^ (4 * wave))) = (v)[i_]; LDS_WAIT(); __syncthreads(); } while (0)
#define CV_STEP(v, c, tcur, tnext_is_f8) do { const CvTile done_ = (c); \
        if (done_.gain) { const int nbl_ = done_.N / 256; const float* gp_ = done_.gain + 128 * (done_.r / nbl_) + wave * 16; _Pragma("unroll") for (int i_ = 0; i_ < 16; ++i_) (v)[i_] = (v)[i_] * gp_[i_]; } \
        if (done_.f8) { cv8_to_lds(v, T8 + par * 32768, wave, lane); LDS_WAIT(); __syncthreads(); } else { CV_TOLDS(v); } \
        tcur += 2 * step; if (tcur < t1) { (c) = cv_decode(P, tcur); CV_LOAD(v, c); } \
        if (done_.f8) { cv8_out(done_, T8 + par * 32768, tid_); par ^= 1; if (!(tnext_is_f8)) { LDS_WAIT(); __syncthreads(); } } \
        else { cv_tile_out(done_, S, tid_); LDS_WAIT(); __syncthreads(); } } while (0)
    int ta = t0, tb = t0 + step, par = 0;
    CvTile ca = cv_decode(P, ta), cb = ca; CV_LOAD(va, ca);
    if (tb < t1) { cb = cv_decode(P, tb); CV_LOAD(vb, cb); }
    for (;;) {
        { const bool nf8 = (tb < t1) && cb.f8; CV_STEP(va, ca, ta, nf8); }
        if (tb >= t1) break;
        { const bool nf8 = (ta < t1) && ca.f8; CV_STEP(vb, cb, tb, nf8); }
        if (ta >= t1) break;
    }
#undef CV_LOAD
#undef CV_TOLDS
#undef CV_STEP
}
__device__ __forceinline__ void attn_conv_phase(const Ptrs& P, const att::AttnArgs& A, int layer, unsigned* qctr, unsigned char* lds, const int wave_) {
    char* shm = (char*)lds + RING_OFF;
    int* TK = (int*)(shm + att::L_MSK) + 4;
    const bool t0_ = (wave_ == 0 && lane_id() == 0);
    int nxt_ = 0; if (t0_) nxt_ = (int)__hip_atomic_fetch_add(qctr, 1u, __ATOMIC_RELAXED, __HIP_MEMORY_SCOPE_AGENT);
    bool selrdy = false;
    for (;;) {
        __syncthreads();
        if (t0_) TK[0] = nxt_;
        __syncthreads();
        const int tk = __builtin_amdgcn_readfirstlane(TK[0]);
        if (tk >= att::N_TICKETS) break;
        if (t0_) nxt_ = (int)__hip_atomic_fetch_add(qctr, 1u, __ATOMIC_RELAXED, __HIP_MEMORY_SCOPE_AGENT);
        const int code = att::ATT_ORDER.v[tk];
        if (code & 0x8000) {
            const int t0 = CV_L0 + (layer * att::N_CHUNKS + (code & 0x7fff)) * att::CHUNK_TILES;
            convert_weights(P, (LAS unsigned char*)lds, t0, 1, t0 + att::CHUNK_TILES, wave_, lane_id());
        } else if (code & 0x4000) {
            if (!selrdy) { if (t0_) { unsigned spins = 0; while (att::ld_sc1(A.mdone) < (unsigned)att::N_SEL && ++spins < (1u << 24)) __builtin_amdgcn_s_sleep(8); } selrdy = true; __syncthreads(); }
            att::attn_unit<3>(A, (code >> 11) & 1, 6 + ((code >> 8) & 7), code & 0xff, shm, wave_);
        } else if (code & 0x2000) {
            att::moba_select(A, (code >> 9) & 1, 6 + ((code >> 6) & 7), code & 63, shm, wave_);
        } else {
            const int mode = code >> 10, b = (code >> 9) & 1, hr = (code >> 6) & 7, sub = code & 63;
            const int h = (mode == 0) ? hr : ((mode == 1) ? 6 + hr : 11 + hr);
            if (mode == 0) att::attn_unit<0>(A, b, h, sub, shm, wave_); else if (mode == 1) att::attn_unit<1>(A, b, h, sub, shm, wave_); else att::attn_unit<2>(A, b, h, sub, shm, wave_);
        }
    }
}
template <bool F8, bool SRC16, int NR> __device__ __forceinline__ void norm_rows(const void* srcv, const float* gain, void* dstv, int vcu, int G, int wave, int lane) {
    asm volatile("" : "+v"(lane));
    const int gw = vcu * NWAVES + wave, NGW = G * NWAVES;
    f32x4 g[8];
#pragma unroll
    for (int j = 0; j < 8; ++j) g[j] = ((const GAS f32x4*)gain)[lane + 64 * j];
    for (int m0 = gw; m0 < M; m0 += NR * NGW) {
        f32x4 v[NR][8];
#pragma unroll
        for (int q = 0; q < NR; ++q) { const int mq = m0 + q * NGW; const int m = mq < M ? mq : m0;
            if constexpr (SRC16) { const GAS u32x2_g* xr = (const GAS u32x2_g*)((const bf16*)srcv + (size_t)m * D) + lane;
#pragma unroll
                for (int j = 0; j < 8; ++j) v[q][j] = bf4_to_f32(xr[64 * j]); }
            else { const GAS f32x4* xr = (const GAS f32x4*)((const float*)srcv + (size_t)m * D) + lane;
#pragma unroll
                for (int j = 0; j < 8; ++j) v[q][j] = xr[64 * j]; } }
#pragma unroll
        for (int q = 0; q < NR; ++q) { const int m = m0 + q * NGW; if (m >= M) break;
            float s = 0.f;
#pragma unroll
            for (int j = 0; j < 8; ++j) s += (v[q][j].x * v[q][j].x + v[q][j].y * v[q][j].y) + (v[q][j].z * v[q][j].z + v[q][j].w * v[q][j].w);
            const float r = 1.0f / sqrtf(wave_sum(s) * (1.0f / D) + EPS);
            if constexpr (F8) { GAS unsigned* o4 = (GAS unsigned*)((unsigned char*)dstv + (size_t)m * D) + lane;
#pragma unroll
                for (int j = 0; j < 8; ++j) o4[64 * j] = pg8::pk4_fp8(v[q][j].x * r * g[j].x, v[q][j].y * r * g[j].y, v[q][j].z * r * g[j].z, v[q][j].w * r * g[j].w); }
            else { GAS unsigned long long* o8 = (GAS unsigned long long*)((bf16*)dstv + (size_t)m * D) + lane;
#pragma unroll
                for (int j = 0; j < 8; ++j) o8[64 * j] = (unsigned long long)pk2(v[q][j].x * r * g[j].x, v[q][j].y * r * g[j].y) | ((unsigned long long)pk2(v[q][j].z * r * g[j].z, v[q][j].w * r * g[j].w) << 32); }
        }
    }
}
__device__ __forceinline__ void prep_phase(const Ptrs& P, int layer, LAS unsigned char* lds, int vcu, int G, int tid, int wave, int lane) {
    asm volatile("" : "+v"(lane), "+v"(tid));
    LAS float* red = (LAS float*)(lds + RING_OFF);
    const int tsub = lane >> 4, c = lane & 15;
#define PREP_ADDR(it_) (P.QKV + ((size_t)(((it_) / 22) >> 4) * SEQ + (((it_) / 22) & 15) * 256 + wave * 32 + tsub) * NQKV + ((((it_) % 22) >= 11) ? 2048 + (((it_) % 22) - 11) * 128 : ((it_) % 22) * 128) + 8 * c)
    v4u raws[8], rawn[8];
    if (vcu < 32 * 22) { bf16* const q0_ = PREP_ADDR(vcu);
#pragma unroll
        for (int i8 = 0; i8 < 8; ++i8) raws[i8] = *(const GAS v4u*)(q0_ + (size_t)(i8 * 4) * NQKV); }
    for (int it = vcu; it < 32 * 22; it += G) {
        const int v = it % 22, blk = it / 22, b = blk >> 4, n = blk & 15;
        if (it + G < 32 * 22) { bf16* const q1_ = PREP_ADDR(it + G);
#pragma unroll
            for (int i8 = 0; i8 < 8; ++i8) rawn[i8] = *(const GAS v4u*)(q1_ + (size_t)(i8 * 4) * NQKV); }
        const bool isk = v >= 11; const int hh = isk ? v - 11 : v;
        const int col0 = (isk ? 2048 : 0) + hh * 128;
        const float* gp = (isk ? P.k_gain : P.q_gain) + layer * 256 + (hh >= 6 ? 128 : 0) + 8 * c;
        const f32x4 g0 = *(const f32x4*)gp, g1 = *(const f32x4*)(gp + 4);
        const bool km = isk && hh >= 6;
        float cs[8];
#pragma unroll
        for (int e = 0; e < 8; ++e) cs[e] = 0.f;
        bf16* const p0_ = P.QKV + ((size_t)b * SEQ + n * 256 + wave * 32 + tsub) * NQKV + col0 + 8 * c;
#pragma unroll
        for (int i8 = 0; i8 < 8; ++i8) {
            bf16* p = p0_ + (size_t)(i8 * 4) * NQKV;
            const v4u raw = raws[i8];
            float x[8]; x[0] = bf2f_u((unsigned short)(raw.x & 0xffff)); x[1] = bf2f_u((unsigned short)(raw.x >> 16)); x[2] = bf2f_u((unsigned short)(raw.y & 0xffff)); x[3] = bf2f_u((unsigned short)(raw.y >> 16));
            x[4] = bf2f_u((unsigned short)(raw.z & 0xffff)); x[5] = bf2f_u((unsigned short)(raw.z >> 16)); x[6] = bf2f_u((unsigned short)(raw.w & 0xffff)); x[7] = bf2f_u((unsigned short)(raw.w >> 16));
            float ss = 0.f;
#pragma unroll
            for (int e = 0; e < 8; ++e) ss = fmaf(x[e], x[e], ss);
            ss += xor_get<1>(ss); ss += xor_get<2>(ss); ss += xor_get<4>(ss); ss += xor_get<8>(ss);
            const float r = (isk ? 1.0f : att::C2) / sqrtf(ss * (1.0f / 128.0f) + EPS);
            float y[8];
            y[0] = x[0] * r * g0.x; y[1] = x[1] * r * g0.y; y[2] = x[2] * r * g0.z; y[3] = x[3] * r * g0.w;
            y[4] = x[4] * r * g1.x; y[5] = x[5] * r * g1.y; y[6] = x[6] * r * g1.z; y[7] = x[7] * r * g1.w;
            v4u o; o.x = pk2(y[0], y[1]); o.y = pk2(y[2], y[3]); o.z = pk2(y[4], y[5]); o.w = pk2(y[6], y[7]);
            *(GAS v4u*)p = o;
#pragma unroll
            for (int e = 0; e < 8; ++e) cs[e] += y[e];
        }
        if (km) {
#pragma unroll
            for (int e = 0; e < 8; ++e) { cs[e] += xor_get<16>(cs[e]); cs[e] = xor32_sum(cs[e]); }
            if (lane < 16) {
#pragma unroll
                for (int e = 0; e < 8; ++e) red[wave * 128 + 8 * c + e] = cs[e]; }
            LDS_WAIT(); __syncthreads();
            if (tid < 128) { float s = 0.f;
#pragma unroll
                for (int w = 0; w < 8; ++w) s += red[w * 128 + tid];
                P.kmean[(size_t)((b * 5 + (hh - 6)) * 16 + n) * 128 + tid] = s * (1.0f / 256.0f); }
            LDS_WAIT(); __syncthreads();
        }
#pragma unroll
        for (int i8 = 0; i8 < 8; ++i8) raws[i8] = rawn[i8];
    }
#undef PREP_ADDR
}
__device__ __forceinline__ void dcombine_phase(const Ptrs& P, const float* gain, int vcu, int G, int wave, int lane) {
    asm volatile("" : "+v"(lane));
    const int gw = vcu * NWAVES + wave, NGW = G * NWAVES; const int c = lane & 15; constexpr int NIT = M * 11 / 4;
    constexpr int NQ = 4;
    for (int it0 = gw; it0 < NIT; it0 += NQ * NGW) {
        int tok[NQ], hh[NQ]; float ls[NQ][4]; v4u raw[NQ][4];
#pragma unroll
        for (int q = 0; q < NQ; ++q) { const int itq = it0 + q * NGW; const int it = itq < NIT ? itq : it0; const int pair = it * 4 + (lane >> 4); tok[q] = pair / 11; hh[q] = pair - tok[q] * 11;
#pragma unroll
            for (int p = 0; p < 3; ++p) { ls[q][p] = P.DPL[((size_t)p * M + tok[q]) * 16 + hh[q]]; raw[q][p] = *(const GAS v4u*)(P.DPO + ((size_t)p * M + tok[q]) * 1408 + hh[q] * 128 + 8 * c); }
            ls[q][3] = -__builtin_inff(); raw[q][3] = (v4u){0u, 0u, 0u, 0u};
            if (hh[q] >= 6) { ls[q][3] = P.DPL[((size_t)3 * M + tok[q]) * 16 + hh[q]]; raw[q][3] = *(const GAS v4u*)(P.DPO + ((size_t)3 * M + tok[q]) * 1408 + hh[q] * 128 + 8 * c); } }
#pragma unroll
        for (int q = 0; q < NQ; ++q) { if (it0 + q * NGW >= NIT) break;
            const float mx = fmaxf(fmaxf(ls[q][0], ls[q][1]), fmaxf(ls[q][2], ls[q][3]));
            float w0 = __builtin_amdgcn_exp2f(ls[q][0] - mx), w1 = __builtin_amdgcn_exp2f(ls[q][1] - mx), w2 = __builtin_amdgcn_exp2f(ls[q][2] - mx), w3 = __builtin_amdgcn_exp2f(ls[q][3] - mx);
            const float inv = 1.0f / (w0 + w1 + w2 + w3); w0 *= inv; w1 *= inv; w2 *= inv; w3 *= inv;
            float acc[8];
#pragma unroll
            for (int e = 0; e < 8; ++e) acc[e] = 0.f;
#pragma unroll
            for (int p = 0; p < 4; ++p) { const v4u r_ = raw[q][p]; const float w = (p == 0) ? w0 : ((p == 1) ? w1 : ((p == 2) ? w2 : w3));
                acc[0] += w * bf2f_u((unsigned short)(r_.x & 0xffff)); acc[1] += w * bf2f_u((unsigned short)(r_.x >> 16)); acc[2] += w * bf2f_u((unsigned short)(r_.y & 0xffff)); acc[3] += w * bf2f_u((unsigned short)(r_.y >> 16));
                acc[4] += w * bf2f_u((unsigned short)(r_.z & 0xffff)); acc[5] += w * bf2f_u((unsigned short)(r_.z >> 16)); acc[6] += w * bf2f_u((unsigned short)(r_.w & 0xffff)); acc[7] += w * bf2f_u((unsigned short)(r_.w >> 16)); }
            float ss = 0.f;
#pragma unroll
            for (int e = 0; e < 8; ++e) ss = fmaf(acc[e], acc[e], ss);
            ss += xor_get<1>(ss); ss += xor_get<2>(ss); ss += xor_get<4>(ss); ss += xor_get<8>(ss);
            const float rn = 1.0f / sqrtf(ss * (1.0f / 128.0f) + EPS);
            const f32x4 g0 = *(const f32x4*)(gain + hh[q] * 128 + 8 * c), g1 = *(const f32x4*)(gain + hh[q] * 128 + 8 * c + 4);
            v4u o; o.x = pk2(acc[0] * rn * g0.x, acc[1] * rn * g0.y); o.y = pk2(acc[2] * rn * g0.z, acc[3] * rn * g0.w); o.z = pk2(acc[4] * rn * g1.x, acc[5] * rn * g1.y); o.w = pk2(acc[6] * rn * g1.z, acc[7] * rn * g1.w);
            *(GAS v4u*)(P.OB + (size_t)tok[q] * D + hh[q] * 128 + 8 * c) = o; }
    }
}
__device__ __forceinline__ void router_phase(const Ptrs& P, const float* gain, LAS unsigned char* lds, int vcu, int G, int tid, int wave, int lane) {
    asm volatile("" : "+v"(lane), "+v"(tid));
    LAS unsigned* lcnt = (LAS unsigned*)(lds + RING_OFF);
    LAS unsigned* rinfo = (LAS unsigned*)(lds + RING_OFF + 256);
    if (tid < 16) lcnt[tid] = 0u;
    LAS f32x4* LT = (LAS f32x4*)(lds + RING_OFF + 4096);
    for (int i = tid; i < 2 * D; i += NWAVES * 64) { const int d = i >> 1, eq = i & 1; LT[eq * D + d] = ((const GAS f32x4*)P.router)[i]; }
    LDS_WAIT(); __syncthreads();
    int gw = vcu * NWAVES + wave; asm volatile("" : "+s"(gw));
    const int NGW = G * NWAVES;
    int li = wave;
    for (int m = gw; m < M; m += NGW, li += NWAVES) {
        const GAS u32x2_g* xr = (const GAS u32x2_g*)(P.H + (size_t)m * D) + lane;
        f32x4 v[8]; float s = 0.f;
#pragma unroll
        for (int j = 0; j < 8; ++j) { v[j] = bf4_to_f32(xr[64 * j]); s += (v[j].x * v[j].x + v[j].y * v[j].y) + (v[j].z * v[j].z + v[j].w * v[j].w); }
        const float r = 1.0f / sqrtf(wave_sum(s) * (1.0f / D) + EPS);
        float lg[8];
#pragma unroll
        for (int e = 0; e < 8; ++e) lg[e] = 0.f;
        GAS unsigned* o4 = (GAS unsigned*)(P.AB8 + (size_t)m * D) + lane;
#pragma unroll
        for (int j = 0; j < 8; ++j) { const f32x4 g = ((const GAS f32x4*)gain)[lane + 64 * j];
            const float f0 = v[j].x * r * g.x, f1 = v[j].y * r * g.y, f2 = v[j].z * r * g.z, f3 = v[j].w * r * g.w;
            o4[64 * j] = pg8::pk4_fp8(f0, f1, f2, f3);
            const LAS f32x4* rw = LT + 256 * j + 4 * lane;
            const f32x4 a0 = rw[0], a1 = rw[D], b0 = rw[1], b1 = rw[D + 1], c0 = rw[2], c1 = rw[D + 2], d0 = rw[3], d1 = rw[D + 3];
            lg[0] += f0 * a0.x + f1 * b0.x + f2 * c0.x + f3 * d0.x; lg[1] += f0 * a0.y + f1 * b0.y + f2 * c0.y + f3 * d0.y;
            lg[2] += f0 * a0.z + f1 * b0.z + f2 * c0.z + f3 * d0.z; lg[3] += f0 * a0.w + f1 * b0.w + f2 * c0.w + f3 * d0.w;
            lg[4] += f0 * a1.x + f1 * b1.x + f2 * c1.x + f3 * d1.x; lg[5] += f0 * a1.y + f1 * b1.y + f2 * c1.y + f3 * d1.y;
            lg[6] += f0 * a1.z + f1 * b1.z + f2 * c1.z + f3 * d1.z; lg[7] += f0 * a1.w + f1 * b1.w + f2 * c1.w + f3 * d1.w; }
#pragma unroll
        for (int e = 0; e < 8; ++e) lg[e] = wave_sum(lg[e]);
        int e0 = 0; float b0v = lg[0];
#pragma unroll
        for (int e = 1; e < 8; ++e) if (lg[e] > b0v) { b0v = lg[e]; e0 = e; }
        int e1 = -1; float b1v = -__builtin_inff();
#pragma unroll
        for (int e = 0; e < 8; ++e) if (e != e0 && lg[e] > b1v) { b1v = lg[e]; e1 = e; }
        const float g1 = 1.0f / (1.0f + __expf(b0v - b1v)), g0 = 1.0f - g1;
        if (lane == 0) {
            const unsigned k0 = __hip_atomic_fetch_add(lcnt + e0, 1u, __ATOMIC_RELAXED, __HIP_MEMORY_SCOPE_WORKGROUP);
            const unsigned k1 = __hip_atomic_fetch_add(lcnt + e1, 1u, __ATOMIC_RELAXED, __HIP_MEMORY_SCOPE_WORKGROUP);
            rinfo[li * 4 + 0] = (unsigned)e0 | ((unsigned)e1 << 8); rinfo[li * 4 + 1] = k0; rinfo[li * 4 + 2] = k1;
            P.sel_g[2 * m] = g0; P.sel_g[2 * m + 1] = g1;
        }
    }
    LDS_WAIT(); __syncthreads();
    if (tid < 8) lcnt[8 + tid] = __hip_atomic_fetch_add(P.ctl + CW_CNT + 64 * tid, lcnt[tid], RLX_AGENT);
    LDS_WAIT(); __syncthreads();
    li = wave;
    for (int m = gw; m < M; m += NGW, li += NWAVES) {
        if (lane == 0) { const unsigned ee = rinfo[li * 4 + 0]; const unsigned e0 = ee & 0xffu, e1 = ee >> 8;
            P.sel_e[m] = ee; P.sel_rel[2 * m] = (int)(lcnt[8 + e0] + rinfo[li * 4 + 1]); P.sel_rel[2 * m + 1] = (int)(lcnt[8 + e1] + rinfo[li * 4 + 2]); }
    }
}
__device__ __forceinline__ void build_tile_table(const Ptrs& P, bool moe, volatile LAS unsigned* MISC, int tid) {
    if (tid == 0) { unsigned t = 0u; MISC[16] = 0u;
        for (int e = 0; e < 8; ++e) { const unsigned cnt = moe ? __hip_atomic_load(P.ctl + CW_CNT + 64 * e, RLX_AGENT) : (e == 0 ? (unsigned)M : 0u); t += (cnt + 255u) >> 8; if (t > (unsigned)(MPAD / 256)) t = MPAD / 256; MISC[17 + e] = t; } }
    LDS_WAIT(); __syncthreads();
}
__device__ __forceinline__ void scatter_phase(const Ptrs& P, volatile LAS unsigned* MISC, int vcu, int G, int wave, int lane) {
    asm volatile("" : "+v"(lane));
    const int gw = vcu * NWAVES + wave, NGW = G * NWAVES;
    constexpr int NR = 4;
    for (int m0 = gw; m0 < M; m0 += NR * NGW) {
        unsigned ee[NR]; int r0[NR], r1[NR]; v4u a0[NR], a1[NR];
#pragma unroll
        for (int q = 0; q < NR; ++q) { const int mq = m0 + q * NGW; const int m = mq < M ? mq : m0;
            ee[q] = P.sel_e[m]; r0[q] = P.sel_rel[2 * m]; r1[q] = P.sel_rel[2 * m + 1];
            const GAS v4u* sp = (const GAS v4u*)(P.AB8 + (size_t)m * D) + lane; a0[q] = sp[0]; a1[q] = sp[64]; }
#pragma unroll
        for (int q = 0; q < NR; ++q) { const int m = m0 + q * NGW; if (m >= M) break;
            const int p0 = (int)(256u * MISC[16 + (ee[q] & 0xffu)]) + r0[q], p1 = (int)(256u * MISC[16 + ((ee[q] >> 8) & 0xffu)]) + r1[q];
            if (lane == 0) { P.sel_pos[2 * m] = p0; P.sel_pos[2 * m + 1] = p1; }
            GAS v4u* d0 = (GAS v4u*)(P.XS + (size_t)p0 * D) + lane; GAS v4u* d1 = (GAS v4u*)(P.XS + (size_t)p1 * D) + lane;
            d0[0] = a0[q]; d0[64] = a1[q]; d1[0] = a0[q]; d1[64] = a1[q]; }
    }
}
__device__ __forceinline__ void combine_phase(const Ptrs& P, int vcu, int G, int wave, int lane) {
    asm volatile("" : "+v"(lane));
    const int gw = vcu * NWAVES + wave, NGW = G * NWAVES;
    typedef unsigned u32x2_t __attribute__((ext_vector_type(2)));
    for (int m0 = gw; m0 < M; m0 += 2 * NGW) {
        const int m1 = m0 + NGW; const bool has1 = m1 < M; const int mm[2] = {m0, has1 ? m1 : m0};
        int pa[2], pb[2]; float ga[2], gb[2];
#pragma unroll
        for (int q = 0; q < 2; ++q) { pa[q] = P.sel_pos[2 * mm[q]]; pb[q] = P.sel_pos[2 * mm[q] + 1]; ga[q] = P.sel_g[2 * mm[q]]; gb[q] = P.sel_g[2 * mm[q] + 1]; }
        f32x4 ya[2][8], yb[2][8], hv[2][8];
#pragma unroll
        for (int q = 0; q < 2; ++q) { const GAS u32x2_t* y0 = (const GAS u32x2_t*)(P.YS + (size_t)pa[q] * D) + lane; const GAS u32x2_t* y1 = (const GAS u32x2_t*)(P.YS + (size_t)pb[q] * D) + lane;
            const GAS u32x2_g* hr = (const GAS u32x2_g*)(P.H + (size_t)mm[q] * D) + lane;
#pragma unroll
            for (int j = 0; j < 8; ++j) { ya[q][j] = bf4_to_f32(y0[64 * j]); yb[q][j] = bf4_to_f32(y1[64 * j]); hv[q][j] = bf4_to_f32(hr[64 * j]); } }
#pragma unroll
        for (int q = 0; q < 2; ++q) { if (q == 1 && !has1) break;
            if (pa[q] >= 16384) { const GAS u32x2_t* z0 = (const GAS u32x2_t*)(P.YS + (size_t)MPAD * D + (size_t)pa[q] * D) + lane;
#pragma unroll
                for (int j = 0; j < 8; ++j) ya[q][j] += bf4_to_f32(z0[64 * j]); }
            if (pb[q] >= 16384) { const GAS u32x2_t* z1 = (const GAS u32x2_t*)(P.YS + (size_t)MPAD * D + (size_t)pb[q] * D) + lane;
#pragma unroll
                for (int j = 0; j < 8; ++j) yb[q][j] += bf4_to_f32(z1[64 * j]); }
            GAS f32x4* orow = (GAS f32x4*)(P.out + (size_t)mm[q] * D) + lane;
#pragma unroll
            for (int j = 0; j < 8; ++j) orow[64 * j] = hv[q][j] + ya[q][j] * ga[q] + yb[q][j] * gb[q]; }
    }
}

struct Args { const float* in[15]; float* out; unsigned char* ws; int ph_lo, ph_hi, qoff, pad; };
__device__ __forceinline__ Ptrs make_ptrs(const Args& args, unsigned char* ws0) {
    int z = 0; asm volatile("" : "+s"(z));
    const float* const* in = args.in + z;
    unsigned char* ws = ws0 + z;
    Ptrs P;
    P.x = in[0]; P.attn_norm = in[1]; P.w_in = in[2]; P.q_gain = in[3]; P.k_gain = in[4]; P.out_gain = in[5]; P.w_out = in[6]; P.ffn_norm = in[7];
    P.dwg = in[8]; P.dwu = in[9]; P.dwd = in[10]; P.router = in[11]; P.mwg = in[12]; P.mwu = in[13]; P.mwd = in[14];
    P.out = args.out; P.ctl = (gu32*)(ws + WS_CTL);
    P.Wqkv_t = (bf16*)(ws + WS_WQKV); P.Wo_t = (bf16*)(ws + WS_WO); P.Wgu_d = ws + WS_WGU_D; P.Wd_d = ws + WS_WD_D; P.Wgu_m = ws + WS_WGU_M; P.Wd_m = ws + WS_WD_M;
    P.QKV = (bf16*)(ws + WS_QKV); P.OB = (bf16*)(ws + WS_O); P.AB = (bf16*)(ws + WS_A); P.AB8 = ws + WS_A; P.ACT = ws + WS_ACT; P.XS = ws + WS_XS;
    P.H = (bf16*)(ws + WS_H); P.YS = (bf16*)(ws + WS_YS); P.kmean = (float*)(ws + WS_MISC + MISC_KMEAN); P.DPO = (bf16*)(ws + WS_DPO); P.DPL = (float*)(ws + WS_DPL);
    P.rsq = (float*)(ws + WS_MISC + MISC_RSQ);
    P.sel_e = (unsigned*)(ws + WS_MISC + MISC_SELE); P.sel_rel = (int*)(ws + WS_MISC + MISC_SELREL); P.sel_g = (float*)(ws + WS_MISC + MISC_SELG); P.sel_pos = (int*)(ws + WS_MISC + MISC_SELPOS);
    return P;
}
__global__ void __launch_bounds__(NWAVES * 64, 2) hybrid_fwd(Args args) {
    extern __shared__ __attribute__((aligned(16))) unsigned char lds[];
    LAS unsigned char* ldsL = (LAS unsigned char*)lds;
    volatile LAS unsigned* MISC = (volatile LAS unsigned*)(ldsL + MISC_OFF);
    const int wave = __builtin_amdgcn_readfirstlane((int)threadIdx.x >> 6);
#define tid (tid_of(wave))
#define lane (lane_id())
    const int G = gridDim.x; int vcu; { const int bx = blockIdx.x; vcu = (G % 8 == 0) ? (bx % 8) * (G / 8) + bx / 8 : bx; }
    for (int u = tid; u < (LDS_BYTES - LDSCTL_OFF) / 4; u += NWAVES * 64) ((LAS unsigned*)(ldsL + LDSCTL_OFF))[u] = 0u;
    __syncthreads();
    int z0 = 0; asm volatile("" : "+s"(z0)); unsigned char* ws0 = args.ws + z0;
    unsigned* const barw = (unsigned*)(ws0 + WS_CTL) + CW_BAR;
    XcdBarrier bar; bar.bar = barw; bar.x = 0; bar.st = nullptr; bar.wv = wave;
    if (!MK_SPLIT) { bar = xcd_barrier_post(barw, MISC + 8, wave); }
    const int lo = args.ph_lo, hi = args.ph_hi;
#define PH(k) (lo <= (k) && (k) < hi)
#define SEAM(a, b) do { if (PH(a) && PH(b)) { int zb_ = 0; asm volatile("" : "+s"(zb_)); XcdBarrier b2_ = bar; b2_.bar = bar.bar + zb_; xcd_barrier(b2_); } } while (0)

    for (int layer = 0; layer < 2; ++layer) {
        const int PB = layer * PPL;
        if (layer == 0 && PH(PB + 0)) {
            const Ptrs P = make_ptrs(args, ws0);
            #ifndef NO_P0
            if (layer == 0) convert_weights(P, ldsL, vcu, G, CV_L0, wave, lane);
            if (layer == 0) norm_rows<false, false, 4>(P.x, P.attn_norm, P.AB, vcu, G, wave, lane);
#endif
        }
        if (layer == 0) SEAM(PB + 0, PB + 1);
        if (PH(PB + 1)) {
            const Ptrs P = make_ptrs(args, ws0);
            pg8::Gemm g{layer == 0 ? P.AB : P.H, P.Wqkv_t + (size_t)layer * NQKV * D, M, NQKV, D}; pg8::StaticOrder S; S.init(M, NQKV, G, (int)blockIdx.x);
            pg8::EpiQKV E{P.QKV, NQKV, P.q_gain + layer * 256, P.k_gain + layer * 256, P.kmean, (LAS float*)(ldsL + RING_OFF + RING_BYTES), layer == 0 ? nullptr : P.rsq};
#ifndef NO_P1
            pg8::gemm_phase<pg8::EpiQKV, pg8::StaticOrder, true, true>(ldsL + RING_OFF, g, S, E, wave);
#endif
        }
        SEAM(PB + 1, PB + 3);
        if (PH(PB + 3)) {
            const Ptrs P = make_ptrs(args, ws0);
            const att::AttnArgs AA{P.QKV, P.OB, P.kmean, P.out_gain + layer * D, P.DPO, P.DPL, (unsigned*)((unsigned char*)P.DPL + (WS_MLIST - WS_DPL)) + (size_t)layer * att::N_SEL * att::MLCAP, (unsigned*)(P.ctl + CW_MCNT + 256 * (layer + args.qoff)), (unsigned*)(P.ctl + CW_MDONE + 64 * (layer + args.qoff))};
#ifndef NO_P3
            attn_conv_phase(P, AA, layer, (unsigned*)(P.ctl + CW_ATTQ + 64 * (layer + args.qoff)), lds, wave);
#endif
        }
        SEAM(PB + 3, PB + 4);
#ifndef NO_P4B
        if (PH(PB + 4)) { const Ptrs P = make_ptrs(args, ws0); dcombine_phase(P, P.out_gain + layer * D, vcu, G, wave, lane); }
#endif
        SEAM(PB + 4, PB + 5);
        if (PH(PB + 5)) {
            const Ptrs P = make_ptrs(args, ws0);
            pg8::Gemm g{P.OB, P.Wo_t + (size_t)layer * D * D, M, D, D}; pg8::StaticOrder S; S.init(M, D, G, (int)blockIdx.x);
            pg8::EpiResF32 E{layer == 0 ? P.x : nullptr, layer == 0 ? nullptr : P.H, P.H, D, nullptr, nullptr, (LAS float*)(ldsL + RING_OFF + RING_BYTES)};
#ifndef NO_P4
            pg8::gemm_phase<pg8::EpiResF32, pg8::StaticOrder, true, true>(ldsL + RING_OFF, g, S, E, wave);
#endif
        }
        SEAM(PB + 5, PB + 6);
        if (PH(PB + 6)) {
            const Ptrs P = make_ptrs(args, ws0);
#ifndef NO_P5
            if (layer == 0) norm_rows<true, true, 4>(P.H, P.ffn_norm, P.AB8, vcu, G, wave, lane);
            else router_phase(P, P.ffn_norm + D, ldsL, vcu, G, tid, wave, lane);
#endif
        }
        if (layer == 1) {
            SEAM(PB + 6, PB + 7);
#ifndef NO_P6
            if (PH(PB + 7)) { const Ptrs P = make_ptrs(args, ws0); build_tile_table(P, true, MISC, tid); scatter_phase(P, MISC, vcu, G, wave, lane); }
#endif
            SEAM(PB + 7, PB + 8);
        } else SEAM(PB + 6, PB + 8);
        if (PH(PB + 8)) {
            const Ptrs P = make_ptrs(args, ws0);
            build_tile_table(P, layer == 1, MISC, tid);
            pg8::GroupSched S; S.nMt = __builtin_amdgcn_readfirstlane((int)MISC[24]); S.nN = NGU / 256; S.nwg = S.nMt * S.nN; S.G = G; S.c = (int)blockIdx.x;
            S.t1 = __builtin_amdgcn_readfirstlane((int)MISC[17]); S.t2 = __builtin_amdgcn_readfirstlane((int)MISC[18]); S.t3 = __builtin_amdgcn_readfirstlane((int)MISC[19]); S.t4 = __builtin_amdgcn_readfirstlane((int)MISC[20]);
            S.t5 = __builtin_amdgcn_readfirstlane((int)MISC[21]); S.t6 = __builtin_amdgcn_readfirstlane((int)MISC[22]); S.t7 = __builtin_amdgcn_readfirstlane((int)MISC[23]); S.estride = (size_t)NGU * D; S.nfullM = 1 << 20; S.ntail = 0; S.khalf = 0;
            pg8::Gemm g{(const bf16*)(layer == 0 ? P.AB8 : P.XS), (const bf16*)(layer == 0 ? P.Wgu_d : P.Wgu_m), MPAD, NGU, D / 2};
            pg8::EpiSwiGLU8 E{P.ACT, FF};
#ifndef NO_P7
            pg8::gemm_phase<pg8::EpiSwiGLU8, pg8::GroupSched, true, true, true>(ldsL + RING_OFF, g, S, E, wave);
#endif
        }
        SEAM(PB + 8, PB + 9);
        if (PH(PB + 9)) {
            const Ptrs P = make_ptrs(args, ws0);
            build_tile_table(P, layer == 1, MISC, tid);
            pg8::GroupSched S; S.nMt = __builtin_amdgcn_readfirstlane((int)MISC[24]); S.nN = D / 256; S.nwg = S.nMt * S.nN; S.G = G; S.c = (int)blockIdx.x;
            S.t1 = __builtin_amdgcn_readfirstlane((int)MISC[17]); S.t2 = __builtin_amdgcn_readfirstlane((int)MISC[18]); S.t3 = __builtin_amdgcn_readfirstlane((int)MISC[19]); S.t4 = __builtin_amdgcn_readfirstlane((int)MISC[20]);
            S.t5 = __builtin_amdgcn_readfirstlane((int)MISC[21]); S.t6 = __builtin_amdgcn_readfirstlane((int)MISC[22]); S.t7 = __builtin_amdgcn_readfirstlane((int)MISC[23]); S.estride = (size_t)D * FF;
            if (layer == 1 && S.nMt > 64) { S.nfullM = 64; S.ntail = FF / 128 / 2; S.khalf = FF / 2; S.nwg = 64 * S.nN + 2 * S.nN * (S.nMt - 64); } else { S.nfullM = 1 << 20; S.ntail = 0; S.khalf = 0; }
            pg8::Gemm g{(const bf16*)P.ACT, (const bf16*)(layer == 0 ? P.Wd_d : P.Wd_m), MPAD, D, FF / 2};
            pg8::EpiResF32 E{nullptr, layer == 0 ? P.H : nullptr, layer == 0 ? P.H : P.YS, D, P.YS + (size_t)MPAD * D, layer == 0 ? P.rsq : nullptr, (LAS float*)(ldsL + RING_OFF + RING_BYTES)};
#ifndef NO_P8
            pg8::gemm_phase<pg8::EpiResF32, pg8::GroupSched, true, true, true>(ldsL + RING_OFF, g, S, E, wave);
#endif
        }
        if (layer == 0) SEAM(PB + 9, PB + 12);
        else { SEAM(PB + 9, PB + 10);
#ifndef NO_P9
            if (PH(PB + 10)) { const Ptrs P = make_ptrs(args, ws0); combine_phase(P, vcu, G, wave, lane); }
#endif
        }
    }
#undef PH
#undef SEAM
#undef tid
#undef lane
}

extern "C" void kernel_launch(void* const* d_in, const int* in_sizes, int n_in, void* d_out, int out_size, void* d_ws, size_t ws_size, hipStream_t stream) {
    static int grid = 0;
    if (grid == 0) {
        if (n_in != 15 || in_sizes[0] != M * D || out_size != M * D || ws_size < WS_END) { fprintf(stderr, "kernel_launch: unexpected shapes / workspace (n_in %d, in0 %d, out %d, ws %zu < %zu); nothing launched\n", n_in, n_in > 0 ? in_sizes[0] : -1, out_size, ws_size, (size_t)WS_END); grid = -1; return; }
        int dev = 0, cus = 0, per_cu = 0;
        if (hipGetDevice(&dev) != hipSuccess || hipDeviceGetAttribute(&cus, hipDeviceAttributeMultiprocessorCount, dev) != hipSuccess) { fprintf(stderr, "kernel_launch: device query failed\n"); grid = -1; return; }
        if (hipFuncSetAttribute((const void*)hybrid_fwd, hipFuncAttributeMaxDynamicSharedMemorySize, LDS_BYTES) != hipSuccess) { fprintf(stderr, "kernel_launch: hipFuncSetAttribute failed\n"); grid = -1; return; }
        if (hipOccupancyMaxActiveBlocksPerMultiprocessor(&per_cu, (const void*)hybrid_fwd, NWAVES * 64, LDS_BYTES) != hipSuccess || per_cu < 1) fprintf(stderr, "kernel_launch: note: occupancy query reports %d workgroups per CU\n", per_cu);
        (void)hipGetLastError();
        grid = cus;
    }
    if (grid < 0) return;
    if (hipMemsetAsync((char*)d_ws + WS_CTL, 0, CTL_ZERO_BYTES, stream) != hipSuccess) { fprintf(stderr, "kernel_launch: memset failed\n"); return; }
    Args a{};
    for (int i = 0; i < 15; ++i) a.in[i] = (const float*)d_in[i];
    a.out = (float*)d_out; a.ws = (unsigned char*)d_ws;
#if MK_SPLIT
    for (int ph = 0; ph < N_PHASES; ++ph) {
        if (ph == 7 || ph == 10 || ph == 2 || ph == PPL + 2 || ph == PPL) continue;
        a.ph_lo = ph; a.ph_hi = ph + 1; a.qoff = 0;
        hipLaunchKernelGGL(hybrid_fwd, dim3(grid), dim3(NWAVES * 64), LDS_BYTES, stream, a);
#ifdef MK_PROBE_REPEAT
        if (((MK_PROBE_REPEAT) >> ph) & 1) { a.qoff = 2; hipLaunchKernelGGL(hybrid_fwd, dim3(grid), dim3(NWAVES * 64), LDS_BYTES, stream, a); }
#endif
    }
#else
    a.ph_lo = 0; a.ph_hi = N_PHASES;
    hipLaunchKernelGGL(hybrid_fwd, dim3(grid), dim3(NWAVES * 64), LDS_BYTES, stream, a);
#endif
    const hipError_t le = hipPeekAtLastError();
    if (le != hipSuccess) fprintf(stderr, "kernel_launch: launch failed: %s\n", hipGetErrorName(le));
}
```

```cpp
#include <hip/hip_runtime.h>
#include <cstdio>
#include <cstdint>
__device__ __forceinline__ int lane_id() { int l; asm volatile("v_mbcnt_lo_u32_b32 %0, -1, 0\n\tv_mbcnt_hi_u32_b32 %0, -1, %0" : "=v"(l)); return l; }
template <int MSK> __device__ __forceinline__ float xor_get(float v) {
    static_assert(MSK == 1 || MSK == 2 || MSK == 4 || MSK == 8 || MSK == 16, "xor_get: 1..16");
    if constexpr (MSK == 1) return __int_as_float(__builtin_amdgcn_update_dpp(0, __float_as_int(v), 0xB1, 0xF, 0xF, true));
    else if constexpr (MSK == 2) return __int_as_float(__builtin_amdgcn_update_dpp(0, __float_as_int(v), 0x4E, 0xF, 0xF, true));
    else return __int_as_float(__builtin_amdgcn_ds_swizzle(__float_as_int(v), 0x1F | (MSK << 10)));
}
__device__ __forceinline__ float xor32_sum(float v) { auto rr = __builtin_amdgcn_permlane32_swap(__float_as_uint(v), __float_as_uint(v), false, false); return __uint_as_float(rr[0]) + __uint_as_float(rr[1]); }
__device__ __forceinline__ float xor32_get(float v, int hi) { auto rr = __builtin_amdgcn_permlane32_swap(__float_as_uint(v), __float_as_uint(v), false, false); return __uint_as_float(hi ? rr[0] : rr[1]); }
__device__ __forceinline__ int tid_of(int wave) { int t = wave * 64 + lane_id(); asm volatile("" : "+v"(t)); return t; }
namespace pg8 {
#define PG8_LAS __attribute__((address_space(3)))
typedef unsigned short bf16_t;
typedef short bf16x8 __attribute__((ext_vector_type(8)));
typedef float f32x4 __attribute__((ext_vector_type(4)));
typedef unsigned u32x4 __attribute__((ext_vector_type(4)));
constexpr int BM = 256, BK = 64, HALF = 128, HTB = HALF * BK * 2  , STAGE_BYTES = 8 * HTB, NXCD = 8, WGM = 8;

__host__ __device__ __forceinline__ int lds_byte(int r, int c) { const int st = (r >> 4) * 2 + (c >> 5), rr = r & 15, cc = c & 31, ob = rr * 64 + cc * 2; return st * 1024 + (ob ^ (((ob >> 9) & 1) << 5)); }
__host__ __device__ __forceinline__ void stage_rc(int b, int& R, int& C) { const int st = b / 1024, sb = b % 1024, swz = sb ^ (((sb >> 9) & 1) << 5); R = (st >> 1) * 16 + swz / 64; C = (st & 1) * 32 + (swz % 64) / 2; }
__host__ __device__ __forceinline__ int perm32(int rho) { const int n = rho >> 4, i = rho & 15; return 8 * (i >> 2) + 4 * n + (i & 3); }

struct Unit { int pm, pn; size_t bofs; int kofs, ntu, kh; };
struct Gemm { const bf16_t* A; const bf16_t* Bt; int M, N, K; };

struct StaticOrder {
    int nM, nN, nwg, G, c;
    __host__ __device__ void init(int M, int N, int G_, int c_) { nM = M / BM; nN = N / BM; nwg = nM * nN; G = G_; c = c_; }
    __host__ __device__ bool next(int i, Unit& u) const {
        const long L = (long)i * G + c; if (L >= nwg) return false;
        int wgid = (int)L; { const int q = nwg / NXCD, r = nwg % NXCD, xcd = wgid % NXCD, off = wgid / NXCD; wgid = (xcd < r ? xcd * (q + 1) : r * (q + 1) + (xcd - r) * q) + off; }
        const int nig = WGM * nN, gid = wgid / nig, fm = gid * WGM, gsz = (nM - fm) < WGM ? (nM - fm) : WGM;
        u.pm = fm + ((wgid % nig) % gsz); u.pn = (wgid % nig) / gsz; u.bofs = 0; u.kofs = 0; u.ntu = 0; u.kh = 0; return true;
    }
    __device__ __forceinline__ void a_ready(const Unit&) const {}
    __device__ __forceinline__ void done(const Unit&) const {}
};

__device__ __forceinline__ unsigned cvt_pk_bf16(float lo, float hi) { unsigned r; asm volatile("v_cvt_pk_bf16_f32 %0, %1, %2" : "=v"(r) : "v"(lo), "v"(hi)); return r; }

typedef int i32x8 __attribute__((ext_vector_type(8)));
typedef int i32x4v __attribute__((ext_vector_type(4)));
__device__ __forceinline__ i32x8 cat8(bf16x8 a, bf16x8 b) { const i32x4v x = __builtin_bit_cast(i32x4v, a), y = __builtin_bit_cast(i32x4v, b); return (i32x8){x[0], x[1], x[2], x[3], y[0], y[1], y[2], y[3]}; }
__device__ __forceinline__ unsigned pk4_fp8(float a, float b, float c, float d) { int w = 0; w = __builtin_amdgcn_cvt_pk_fp8_f32(a, b, w, false); w = __builtin_amdgcn_cvt_pk_fp8_f32(c, d, w, true); return (unsigned)w; }
struct GroupSched {
    int nMt, nN, nwg, G, c; int t1, t2, t3, t4, t5, t6, t7; size_t estride;
    int nfullM, ntail, khalf;
    __device__ __forceinline__ bool next(int i, Unit& u) const {
        const long L = (long)i * G + c; if (L >= nwg) return false;
        const int nMf = nMt < nfullM ? nMt : nfullM, nwf = nMf * nN;
        if (L < nwf) {
            int wgid = (int)L; { const int q = nwf / NXCD, r = nwf % NXCD, xcd = wgid % NXCD, off = wgid / NXCD; wgid = (xcd < r ? xcd * (q + 1) : r * (q + 1) + (xcd - r) * q) + off; }
            const int nig = WGM * nN, gid = wgid / nig, fm = gid * WGM, gsz = (nMf - fm) < WGM ? (nMf - fm) : WGM;
            u.pm = fm + ((wgid % nig) % gsz); u.pn = (wgid % nig) / gsz; u.kofs = 0; u.ntu = 0; u.kh = 0;
        } else { const int r = (int)L - nwf, t = r >> 1; u.kh = r & 1; u.pm = nMf + t / nN; u.pn = t % nN; u.kofs = u.kh * khalf; u.ntu = ntail; }
        const int pm = u.pm;
        const int e = (pm >= t1) + (pm >= t2) + (pm >= t3) + (pm >= t4) + (pm >= t5) + (pm >= t6) + (pm >= t7);
        u.bofs = (size_t)__builtin_amdgcn_readfirstlane(e) * estride; return true;
    }
    __device__ __forceinline__ void a_ready(const Unit&) const {}
    __device__ __forceinline__ void done(const Unit&) const {}
};

struct EpiStoreBf16 {
    static constexpr bool PERM = true, AFTER_DRAIN = false;
    bf16_t* O; int ldc;
    __device__ __forceinline__ void operator()(const f32x4 (&acc)[2][2][4][2], const Unit& u, int wr, int wc, int fr, int fq) const {
        const int row0 = u.pm * BM + wr * 64 + fr, col0 = u.pn * BM + wc * 32 + 8 * fq;
#pragma unroll
        for (int ai = 0; ai < 2; ++ai)
#pragma unroll
            for (int m = 0; m < 4; ++m) { bf16_t* rowp = O + (size_t)(row0 + ai * HALF + m * 16) * ldc + col0;
#pragma unroll
                for (int bj = 0; bj < 2; ++bj) { const f32x4 v0 = acc[ai][bj][m][0], v1 = acc[ai][bj][m][1];
                    u32x4 w; w.x = cvt_pk_bf16(v0[0], v0[1]); w.y = cvt_pk_bf16(v0[2], v0[3]); w.z = cvt_pk_bf16(v1[0], v1[1]); w.w = cvt_pk_bf16(v1[2], v1[3]);
                    *(u32x4*)(rowp + bj * HALF) = w; } }
    }
};
struct EpiQKV {
    static constexpr bool PERM = true, AFTER_DRAIN = false;
    bf16_t* O; int ldc; const float* qg; const float* kg; float* kmean; PG8_LAS float* scr; const float* rsq;
    __device__ __forceinline__ void operator()(const f32x4 (&acc)[2][2][4][2], const Unit& u, int wr, int wc, int fr, int fq) const {
        const int row0 = u.pm * BM + wr * 64 + fr, col0 = u.pn * BM + wc * 32 + 8 * fq;
        const int part = u.pn >> 3, hp = u.pn & 7, h0 = 2 * hp;
        float rr[2][4];
#pragma unroll
        for (int ai = 0; ai < 2; ++ai)
#pragma unroll
            for (int m = 0; m < 4; ++m) { rr[ai][m] = 1.0f;
                if (rsq) { const f32x4 t_ = *(const f32x4*)(rsq + (size_t)(row0 + ai * HALF + m * 16) * 8 + 4 * (fq & 1)); float s_ = (t_[0] + t_[1]) + (t_[2] + t_[3]); s_ += xor_get<16>(s_);
                    rr[ai][m] = 1.0f / sqrtf(s_ * (1.0f / 2048.0f) + 1e-6f); } }
        if (!(part < 2 && hp <= 5)) {
#pragma unroll
            for (int ai = 0; ai < 2; ++ai)
#pragma unroll
                for (int m = 0; m < 4; ++m) { bf16_t* rowp = O + (size_t)(row0 + ai * HALF + m * 16) * ldc + col0;
#pragma unroll
                    for (int bj = 0; bj < 2; ++bj) { const f32x4 v0 = acc[ai][bj][m][0] * rr[ai][m], v1 = acc[ai][bj][m][1] * rr[ai][m];
                        u32x4 w; w.x = cvt_pk_bf16(v0[0], v0[1]); w.y = cvt_pk_bf16(v0[2], v0[3]); w.z = cvt_pk_bf16(v1[0], v1[1]); w.w = cvt_pk_bf16(v1[2], v1[3]);
                        *(u32x4*)(rowp + bj * HALF) = w; } }
            return;
        }
#pragma unroll
        for (int ai = 0; ai < 2; ++ai)
#pragma unroll
            for (int m = 0; m < 4; ++m)
#pragma unroll
                for (int bj = 0; bj < 2; ++bj) { const f32x4 v0 = acc[ai][bj][m][0] * rr[ai][m], v1 = acc[ai][bj][m][1] * rr[ai][m];
                    float s_ = v0[0] * v0[0]; s_ = fmaf(v0[1], v0[1], s_); s_ = fmaf(v0[2], v0[2], s_); s_ = fmaf(v0[3], v0[3], s_);
                    s_ = fmaf(v1[0], v1[0], s_); s_ = fmaf(v1[1], v1[1], s_); s_ = fmaf(v1[2], v1[2], s_); s_ = fmaf(v1[3], v1[3], s_);
                    s_ += xor_get<16>(s_); s_ = xor32_sum(s_);
                    if (fq == 0) scr[((wr * 16 + (ai * 4 + m) * 2 + bj) * 16 + fr) * 4 + wc] = s_; }
        asm volatile("s_waitcnt lgkmcnt(0)" ::: "memory"); __builtin_amdgcn_s_barrier();
        const float* gp = (part == 0) ? qg : kg; const float qs = (part == 0) ? 0.08838834764831845f * 1.4426950408889634f : 1.0f;
        f32x4 g[2][2];
#pragma unroll
        for (int bj = 0; bj < 2; ++bj) { const float* p_ = gp + ((h0 + bj) >= 6 ? 128 : 0) + wc * 32 + 8 * fq; g[bj][0] = *(const f32x4*)p_; g[bj][1] = *(const f32x4*)(p_ + 4); }
        const bool pass1 = (h0 + 1 > 10);
        f32x4 cs[2][2];
#pragma unroll
        for (int bj = 0; bj < 2; ++bj) { cs[bj][0] = (f32x4){0.f, 0.f, 0.f, 0.f}; cs[bj][1] = (f32x4){0.f, 0.f, 0.f, 0.f}; }
#pragma unroll
        for (int ai = 0; ai < 2; ++ai)
#pragma unroll
            for (int m = 0; m < 4; ++m) { bf16_t* rowp = O + (size_t)(row0 + ai * HALF + m * 16) * ldc + col0;
#pragma unroll
                for (int bj = 0; bj < 2; ++bj) { const f32x4 t_ = *(const PG8_LAS f32x4*)(scr + ((wr * 16 + (ai * 4 + m) * 2 + bj) * 16 + fr) * 4);
                    float rn = qs / sqrtf(((t_[0] + t_[1]) + (t_[2] + t_[3])) * (1.0f / 128.0f) + 1e-6f);
                    f32x4 y0 = acc[ai][bj][m][0] * rr[ai][m], y1 = acc[ai][bj][m][1] * rr[ai][m];
                    if (!(bj == 1 && pass1)) { y0 = y0 * rn * g[bj][0]; y1 = y1 * rn * g[bj][1]; }
                    cs[bj][0] += y0; cs[bj][1] += y1;
                    u32x4 w; w.x = cvt_pk_bf16(y0[0], y0[1]); w.y = cvt_pk_bf16(y0[2], y0[3]); w.z = cvt_pk_bf16(y1[0], y1[1]); w.w = cvt_pk_bf16(y1[2], y1[3]);
                    *(u32x4*)(rowp + bj * HALF) = w; } }
        if (part == 1 && hp >= 3) {
            PG8_LAS float* scr2 = scr + 2048;
#pragma unroll
            for (int bj = 0; bj < 2; ++bj)
#pragma unroll
                for (int n = 0; n < 2; ++n)
#pragma unroll
                    for (int j = 0; j < 4; ++j) { float c_ = cs[bj][n][j]; c_ += xor_get<1>(c_); c_ += xor_get<2>(c_); c_ += xor_get<4>(c_); c_ += xor_get<8>(c_);
                        if (fr == 0) scr2[wr * 256 + bj * HALF + wc * 32 + 8 * fq + 4 * n + j] = c_; }
            asm volatile("s_waitcnt lgkmcnt(0)" ::: "memory"); __builtin_amdgcn_s_barrier();
            const int t_ = (wr * 4 + wc) * 64 + fq * 16 + fr;
            if (t_ < 256) { const int hh = h0 + (t_ >> 7);
                if (hh >= 6 && hh <= 10) kmean[(size_t)(((u.pm >> 4) * 5 + (hh - 6)) * 16 + (u.pm & 15)) * 128 + (t_ & 127)] = (scr2[t_] + scr2[256 + t_]) * (1.0f / 256.0f); }
        }
    }
};
__device__ __forceinline__ float silu_mul(float g, float u) { const float e = __builtin_amdgcn_exp2f(g * -1.4426950408889634f); return g * __builtin_amdgcn_rcpf(1.0f + e) * u; }
struct EpiSwiGLU {
    static constexpr bool PERM = true, AFTER_DRAIN = false;
    bf16_t* O; int ldc;
    __device__ __forceinline__ void operator()(const f32x4 (&acc)[2][2][4][2], const Unit& u, int wr, int wc, int fr, int fq) const {
        const int row0 = u.pm * BM + wr * 64 + fr, col0 = u.pn * HALF + wc * 32 + 8 * fq;
#pragma unroll
        for (int ai = 0; ai < 2; ++ai)
#pragma unroll
            for (int m = 0; m < 4; ++m) { bf16_t* rowp = O + (size_t)(row0 + ai * HALF + m * 16) * ldc + col0;
                const f32x4 g0 = acc[ai][0][m][0], g1 = acc[ai][0][m][1], u0 = acc[ai][1][m][0], u1 = acc[ai][1][m][1];
                u32x4 w; w.x = cvt_pk_bf16(silu_mul(g0[0], u0[0]), silu_mul(g0[1], u0[1])); w.y = cvt_pk_bf16(silu_mul(g0[2], u0[2]), silu_mul(g0[3], u0[3]));
                w.z = cvt_pk_bf16(silu_mul(g1[0], u1[0]), silu_mul(g1[1], u1[1])); w.w = cvt_pk_bf16(silu_mul(g1[2], u1[2]), silu_mul(g1[3], u1[3]));
                *(u32x4*)rowp = w; }
    }
};
struct EpiSwiGLU8 {
    static constexpr bool PERM = true, AFTER_DRAIN = false;
    unsigned char* O; int ldc;
    __device__ __forceinline__ void operator()(const f32x4 (&acc)[2][2][4][2], const Unit& u, int wr, int wc, int fr, int fq) const {
        typedef unsigned u32x2 __attribute__((ext_vector_type(2)));
        const int row0 = u.pm * BM + wr * 64 + fr, col0 = u.pn * HALF + wc * 32 + 8 * fq;
#pragma unroll
        for (int ai = 0; ai < 2; ++ai)
#pragma unroll
            for (int m = 0; m < 4; ++m) { unsigned char* rowp = O + (size_t)(row0 + ai * HALF + m * 16) * ldc + col0;
                const f32x4 g0 = acc[ai][0][m][0], g1 = acc[ai][0][m][1], u0 = acc[ai][1][m][0], u1 = acc[ai][1][m][1];
                u32x2 w; w.x = pk4_fp8(silu_mul(g0[0], u0[0]), silu_mul(g0[1], u0[1]), silu_mul(g0[2], u0[2]), silu_mul(g0[3], u0[3]));
                w.y = pk4_fp8(silu_mul(g1[0], u1[0]), silu_mul(g1[1], u1[1]), silu_mul(g1[2], u1[2]), silu_mul(g1[3], u1[3]));
                *(u32x2*)rowp = w; }
    }
};
struct EpiResF32 {
    static constexpr bool PERM = true, AFTER_DRAIN = false;
    const float* base32; const bf16_t* base16; bf16_t* out16; int ldc; bf16_t* out16b; float* ssq; PG8_LAS float* scr;
    __device__ __forceinline__ void operator()(const f32x4 (&acc)[2][2][4][2], const Unit& u, int wr, int wc, int fr, int fq) const {
        const int row0 = u.pm * BM + wr * 64 + fr, col0 = u.pn * BM + wc * 32 + 8 * fq;
#pragma unroll
        for (int ai = 0; ai < 2; ++ai)
#pragma unroll
            for (int m = 0; m < 4; ++m) { const size_t off = (size_t)(row0 + ai * HALF + m * 16) * ldc + col0; float sq_ = 0.f;
#pragma unroll
                for (int bj = 0; bj < 2; ++bj) { f32x4 v0 = acc[ai][bj][m][0], v1 = acc[ai][bj][m][1];
                    if (base32) { v0 += *(const f32x4*)(base32 + off + bj * HALF); v1 += *(const f32x4*)(base32 + off + bj * HALF + 4); }
                    else if (base16) { const u32x4 b = *(const u32x4*)(base16 + off + bj * HALF);
                        v0 += (f32x4){__uint_as_float(b.x << 16), __uint_as_float(b.x & 0xffff0000u), __uint_as_float(b.y << 16), __uint_as_float(b.y & 0xffff0000u)};
                        v1 += (f32x4){__uint_as_float(b.z << 16), __uint_as_float(b.z & 0xffff0000u), __uint_as_float(b.w << 16), __uint_as_float(b.w & 0xffff0000u)}; }
                    if (ssq) { float s_ = sq_; s_ = fmaf(v0[0], v0[0], s_); s_ = fmaf(v0[1], v0[1], s_); s_ = fmaf(v0[2], v0[2], s_); s_ = fmaf(v0[3], v0[3], s_);
                      s_ = fmaf(v1[0], v1[0], s_); s_ = fmaf(v1[1], v1[1], s_); s_ = fmaf(v1[2], v1[2], s_); s_ = fmaf(v1[3], v1[3], s_); sq_ = s_; }
                    u32x4 w; w.x = cvt_pk_bf16(v0[0], v0[1]); w.y = cvt_pk_bf16(v0[2], v0[3]); w.z = cvt_pk_bf16(v1[0], v1[1]); w.w = cvt_pk_bf16(v1[2], v1[3]);
                    *(u32x4*)((u.kh ? out16b : out16) + off + bj * HALF) = w; }
                if (ssq) { float s_ = sq_; s_ += xor_get<16>(s_); s_ = xor32_sum(s_);
                    if (fq == 0) scr[((wr * 8 + ai * 4 + m) * 16 + fr) * 4 + wc] = s_; } }
        if (ssq) {
            asm volatile("s_waitcnt lgkmcnt(0)" ::: "memory"); __builtin_amdgcn_s_barrier();
            if (wc == 0 && fq == 0) {
#pragma unroll
                for (int ai = 0; ai < 2; ++ai)
#pragma unroll
                    for (int m = 0; m < 4; ++m) { const f32x4 t_ = *(const PG8_LAS f32x4*)(scr + ((wr * 8 + ai * 4 + m) * 16 + fr) * 4);
                        ssq[(size_t)(row0 + ai * HALF + m * 16) * 8 + u.pn] = (t_[0] + t_[1]) + (t_[2] + t_[3]); } }
        }
    }
};

template <class Epi, class Sched, bool ALIGN_EPI = false, bool SP2 = false, bool FP8 = false>
__device__ __forceinline__ void gemm_phase(PG8_LAS unsigned char* lds, const Gemm g, const Sched& S, const Epi& E, const int wave_) {
    const int tid = tid_of(wave_), wid = wave_, lane = tid & 63, wr = wid >> 2, wc = wid & 3, fr = lane & 15, fq = lane >> 4;
    const int K = g.K, nt = K / BK;
    unsigned voffA[2], voffB[2];
#pragma unroll
    for (int i = 0; i < 2; ++i) { int R, C; stage_rc(tid * 16 + i * 8192, R, C); const int Rb = Epi::PERM ? ((R & ~31) + perm32(R & 31)) : R;
        voffA[i] = (unsigned)(R * K + C) * 2u; voffB[i] = (unsigned)(Rb * K + C) * 2u; }
    const size_t kstep = (size_t)(BK * 2);
    const size_t hstep = (size_t)HALF * K * 2;
    const size_t tstep = 2 * hstep;
    const unsigned ldsw = (unsigned)wid * 1024u;
    const int aoff = lds_byte(wr * 64 + fr, fq * 8), boff = lds_byte(wc * 32 + fr, fq * 8);
#define PG8_SA(b, h) (((b) * 2 + (h)) * HTB)
#define PG8_SB(b, h) ((4 + (b) * 2 + (h)) * HTB)
#define PG8_STAGE(bufoff, gbase, voff) do { _Pragma("unroll") for (int _i = 0; _i < 2; ++_i) { unsigned _vo = (voff)[_i]; asm volatile("" : "+v"(_vo));     \
        __builtin_amdgcn_global_load_lds((const unsigned*)((const char*)(gbase) + _vo), (PG8_LAS unsigned*)(lds + (bufoff) + ldsw + _i * 8192), 16, 0, 0); } } while (0)
#define PG8_LDA(dst, b, h) do { _Pragma("unroll") for (int m = 0; m < 4; ++m) _Pragma("unroll") for (int k = 0; k < 2; ++k) dst[m][k] = *(const PG8_LAS bf16x8*)(lds + PG8_SA(b, h) + aoff + m * 2048 + k * 1024); } while (0)
#define PG8_LDB(dst, b, h) do { _Pragma("unroll") for (int n = 0; n < 2; ++n) _Pragma("unroll") for (int k = 0; k < 2; ++k) dst[n][k] = *(const PG8_LAS bf16x8*)(lds + PG8_SB(b, h) + boff + n * 2048 + k * 1024); } while (0)
#define PG8_MMA(ai, bj, At, Bt) do { __builtin_amdgcn_s_setprio(1); _Pragma("unroll") for (int m = 0; m < 4; ++m) _Pragma("unroll") for (int n = 0; n < 2; ++n) { \
        if constexpr (FP8) { acc[ai][bj][m][n] = __builtin_amdgcn_mfma_scale_f32_16x16x128_f8f6f4(cat8(Bt[n][0], Bt[n][1]), cat8(At[m][0], At[m][1]), acc[ai][bj][m][n], 0, 0, 0, 0x77777777, 0, 0x7f7f7f7f); } \
        else { _Pragma("unroll") for (int k = 0; k < 2; ++k) acc[ai][bj][m][n] = __builtin_amdgcn_mfma_f32_16x16x32_bf16(Bt[n][k], At[m][k], acc[ai][bj][m][n], 0, 0, 0); } } __builtin_amdgcn_s_setprio(0); } while (0)
#define PG8_WAIT_V(n) asm volatile("s_waitcnt vmcnt(" #n ")" ::: "memory")
#define PG8_WAIT_L(n) asm volatile("s_waitcnt lgkmcnt(" #n ")" ::: "memory")
#define PG8_BAR __builtin_amdgcn_s_barrier()
#define PG8_SCHED __builtin_amdgcn_sched_barrier(0)
    Unit cur, nxt; int ui = 0;
    if (!S.next(0, cur)) return;
    f32x4 acc[2][2][4][2];
#pragma unroll
    for (int a = 0; a < 2; ++a)
#pragma unroll
        for (int b = 0; b < 2; ++b)
#pragma unroll
            for (int m = 0; m < 4; ++m)
#pragma unroll
                for (int n = 0; n < 2; ++n) acc[a][b][m][n] = (f32x4){0.f, 0.f, 0.f, 0.f};
    bf16x8 At[4][2], B0[2][2], B1[2][2];
    const char* cA = (const char*)g.A + (size_t)cur.pm * tstep + cur.kofs; const char* cB = (const char*)g.Bt + cur.bofs + (size_t)cur.pn * tstep + cur.kofs;
    S.a_ready(cur);
    if constexpr (SP2) {
        PG8_STAGE(PG8_SB(0, 0), cB, voffB); PG8_STAGE(PG8_SB(0, 1), cB + hstep, voffB); PG8_STAGE(PG8_SA(0, 0), cA, voffA); PG8_STAGE(PG8_SA(0, 1), cA + hstep, voffA);
        if (wr == 1) PG8_BAR;
        PG8_WAIT_V(2); PG8_BAR;
        PG8_STAGE(PG8_SB(1, 0), cB + kstep, voffB); PG8_STAGE(PG8_SA(1, 0), cA + kstep, voffA); PG8_STAGE(PG8_SB(1, 1), cB + hstep + kstep, voffB);
        PG8_WAIT_V(6); PG8_BAR;
    } else {
        PG8_STAGE(PG8_SB(0, 0), cB, voffB); PG8_STAGE(PG8_SA(0, 0), cA, voffA); PG8_STAGE(PG8_SB(0, 1), cB + hstep, voffB); PG8_STAGE(PG8_SA(0, 1), cA + hstep, voffA);
        if (wr == 1) PG8_BAR;
        PG8_WAIT_V(4); PG8_BAR;
        PG8_STAGE(PG8_SB(1, 0), cB + kstep, voffB); PG8_STAGE(PG8_SA(1, 0), cA + kstep, voffA); PG8_STAGE(PG8_SB(1, 1), cB + hstep + kstep, voffB);
        PG8_WAIT_V(6); PG8_BAR;
    }
    for (;;) {
        const bool has_next = S.next(ui + 1, nxt);
        const char* nA = has_next ? (const char*)g.A + (size_t)nxt.pm * tstep + nxt.kofs : cA; const char* nB = has_next ? (const char*)g.Bt + nxt.bofs + (size_t)nxt.pn * tstep + nxt.kofs : cB;
        const int ntc = cur.ntu ? cur.ntu : nt;
        for (int t = 0; t < ntc; t += 2) {
            const bool last = (t == ntc - 2);
            const char* a1 = cA + (size_t)(t + 1) * kstep;
            const char* a2 = last ? nA : cA + (size_t)(t + 2) * kstep; const char* b2 = last ? nB : cB + (size_t)(t + 2) * kstep;
            const char* a3 = a2 + kstep; const char* b3 = b2 + kstep;
            if (last && has_next) S.a_ready(nxt);
            if constexpr (SP2) {
            PG8_LDB(B0, 0, 0); PG8_LDB(B1, 0, 1); PG8_SCHED; PG8_LDA(At, 0, 0); PG8_STAGE(PG8_SA(1, 1), a1 + hstep, voffA);
            PG8_WAIT_V(8); PG8_WAIT_L(0); PG8_BAR; PG8_MMA(0, 0, At, B0); PG8_MMA(0, 1, At, B1); PG8_BAR; PG8_SCHED;
            PG8_LDA(At, 0, 1); PG8_STAGE(PG8_SB(0, 0), b2, voffB); PG8_STAGE(PG8_SB(0, 1), b2 + hstep, voffB); PG8_STAGE(PG8_SA(0, 0), a2, voffA);
            PG8_WAIT_V(8); PG8_WAIT_L(0); PG8_BAR; PG8_MMA(1, 0, At, B0); PG8_MMA(1, 1, At, B1); PG8_BAR; PG8_SCHED;
            PG8_LDB(B0, 1, 0); PG8_LDB(B1, 1, 1); PG8_SCHED; PG8_LDA(At, 1, 0); PG8_STAGE(PG8_SA(0, 1), a2 + hstep, voffA);
            PG8_WAIT_V(8); PG8_WAIT_L(0); PG8_BAR; PG8_MMA(0, 0, At, B0); PG8_MMA(0, 1, At, B1); PG8_BAR; PG8_SCHED;
            PG8_LDA(At, 1, 1); PG8_STAGE(PG8_SB(1, 0), b3, voffB); PG8_STAGE(PG8_SB(1, 1), b3 + hstep, voffB); PG8_STAGE(PG8_SA(1, 0), a3, voffA);
            PG8_WAIT_V(8); PG8_WAIT_L(0); PG8_BAR; PG8_MMA(1, 0, At, B0); PG8_MMA(1, 1, At, B1); PG8_BAR; PG8_SCHED;
            } else {
            PG8_LDB(B0, 0, 0); PG8_SCHED; PG8_LDA(At, 0, 0); PG8_STAGE(PG8_SA(1, 1), a1 + hstep, voffA);
            PG8_WAIT_L(8); PG8_BAR; PG8_WAIT_L(0); PG8_MMA(0, 0, At, B0); PG8_BAR; PG8_SCHED;
            PG8_LDB(B1, 0, 1); PG8_STAGE(PG8_SB(0, 0), b2, voffB);
            PG8_BAR; PG8_WAIT_L(0); PG8_MMA(0, 1, At, B1); PG8_BAR;
            PG8_LDA(At, 0, 1); PG8_STAGE(PG8_SA(0, 0), a2, voffA);
            PG8_BAR; PG8_WAIT_L(0); PG8_MMA(1, 0, At, B0); PG8_BAR; PG8_SCHED;
            PG8_STAGE(PG8_SB(0, 1), b2 + hstep, voffB);
            PG8_WAIT_V(6); PG8_BAR; PG8_MMA(1, 1, At, B1); PG8_BAR;
            PG8_LDB(B0, 1, 0); PG8_SCHED; PG8_LDA(At, 1, 0); PG8_STAGE(PG8_SA(0, 1), a2 + hstep, voffA);
            PG8_WAIT_L(8); PG8_BAR; PG8_WAIT_L(0); PG8_MMA(0, 0, At, B0); PG8_BAR; PG8_SCHED;
            PG8_LDB(B1, 1, 1); PG8_STAGE(PG8_SB(1, 0), b3, voffB);
            PG8_BAR; PG8_WAIT_L(0); PG8_MMA(0, 1, At, B1); PG8_BAR;
            PG8_LDA(At, 1, 1); PG8_STAGE(PG8_SA(1, 0), a3, voffA);
            PG8_BAR; PG8_WAIT_L(0); PG8_MMA(1, 0, At, B0); PG8_BAR; PG8_SCHED;
            PG8_STAGE(PG8_SB(1, 1), b3 + hstep, voffB);
            PG8_WAIT_V(6); PG8_BAR; PG8_MMA(1, 1, At, B1); PG8_BAR;
            }
        }
        if constexpr (ALIGN_EPI) { if (wr == 0) PG8_BAR; }
        if constexpr (!Epi::AFTER_DRAIN) { const int l2_ = lane_id(); E(acc, cur, wr, wc, l2_ & 15, l2_ >> 4); S.done(cur); }
        if (!has_next) break;
#pragma unroll
        for (int a = 0; a < 2; ++a)
#pragma unroll
            for (int b = 0; b < 2; ++b)
#pragma unroll
                for (int m = 0; m < 4; ++m)
#pragma unroll
                    for (int n = 0; n < 2; ++n) acc[a][b][m][n] = (f32x4){0.f, 0.f, 0.f, 0.f};
        cur = nxt; cA = nA; cB = nB; ++ui;
        if constexpr (ALIGN_EPI) { if (wr == 1) PG8_BAR; }
    }
    PG8_WAIT_V(0);
    if constexpr (!ALIGN_EPI) { if (wr == 0) PG8_BAR; }
    PG8_BAR;
    if constexpr (Epi::AFTER_DRAIN) { E.fused(acc, cur, wr, wc, fr, fq, lds, wid, lane); S.done(cur); }
#undef PG8_SA
#undef PG8_SB
#undef PG8_STAGE
#undef PG8_LDA
#undef PG8_LDB
#undef PG8_MMA
#undef PG8_WAIT_V
#undef PG8_WAIT_L
#undef PG8_BAR
#undef PG8_SCHED
}
}

namespace att {
typedef unsigned short bf16;
typedef short bf16x8 __attribute__((ext_vector_type(8)));
typedef short s16x4 __attribute__((ext_vector_type(4)));
typedef float f32x16 __attribute__((ext_vector_type(16)));
typedef float f32x4 __attribute__((ext_vector_type(4)));
typedef unsigned u32x4 __attribute__((ext_vector_type(4)));
typedef int i32x4 __attribute__((ext_vector_type(4)));
constexpr int QS = 6144, SEQ = 4096, DM = 2048;
constexpr int DPW = 1408, DPLW = 16, NTOK = 8192;
constexpr int SHM_T = 16384;
constexpr int L_V = 0, L_K = 2 * SHM_T, L_Q = 4 * SHM_T, L_WS = L_Q + 65536, L_TL = L_WS + 2048, L_FLG = L_TL + 256, L_MSK = L_FLG + 64, L_KM = L_V, L_END = L_MSK + 64;
static_assert(L_END <= 140 * 1024, "attention LDS map");
constexpr float C2 = 0.08838834764831845f * 1.4426950408889634f;
#define KSWZ(row, colB) ((row) * 256 + ((colB) ^ (((row) & 7) << 4)))
#define SBAR() __builtin_amdgcn_sched_barrier(0)
__device__ __forceinline__ int v_st(int k, int c) { const int kk = (k & ~0xC) | ((k & 4) << 1) | ((k & 8) >> 1); return ((kk >> 3) * 4 + (c >> 5)) * 512 + ((kk & 7) * 32 + (c & 31)) * 2; }
__device__ __forceinline__ int v_rd_base(int lane) { return ((lane & 3) << 3) | (((lane >> 2) & 3) << 6) | (((lane >> 4) & 1) << 5) | (((lane >> 5) & 1) << 8); }
constexpr int v_rd_off(int d0, int ks, int half) { return d0 * 512 + ks * 4096 + half * 2048; }
__device__ __forceinline__ int crow(int r, int hi) { return (r & 3) + 8 * (r >> 2) + 4 * hi; }
__device__ __forceinline__ unsigned cvtpk(float lo, float hi) { unsigned r; asm volatile("v_cvt_pk_bf16_f32 %0, %1, %2" : "=v"(r) : "v"(lo), "v"(hi)); return r; }
__device__ __forceinline__ float bf2f(short s) { return __uint_as_float(((unsigned)(unsigned short)s) << 16); }

__device__ __forceinline__ void qkt(f32x16& p0, f32x16& p1, const f32x16& init, const char* Kt, int r32, int hi, const char* qf  ) {
    p0 = init; p1 = init;
    const char* kb[4];
#pragma unroll
    for (int dd = 0; dd < 4; ++dd) kb[dd] = Kt + KSWZ(r32, (dd * 16 + hi * 8) * 2);
#pragma unroll
    for (int d0 = 0; d0 < 8; ++d0) { const char* a = kb[d0 & 3] + (d0 >> 2) * 128;
        bf16x8 b0 = *reinterpret_cast<const bf16x8*>(a);
        bf16x8 b1 = *reinterpret_cast<const bf16x8*>(a + 32 * 256);
        const bf16x8 q = *reinterpret_cast<const bf16x8*>(qf + d0 * 1024);
        p0 = __builtin_amdgcn_mfma_f32_32x32x16_bf16(b0, q, p0, 0, 0, 0);
        p1 = __builtin_amdgcn_mfma_f32_32x32x16_bf16(b1, q, p1, 0, 0, 0); }
}
__device__ __forceinline__ void pv_tile(f32x16* o, int vb, bf16x8 pa0, bf16x8 pa1, bf16x8 pa2, bf16x8 pa3) {
#define TRRD(dst, off) asm volatile("ds_read_b64_tr_b16 %0, %1 offset:%2" : "=&v"(dst) : "v"(vb), "i"(off) : "memory")
#define PV_D0(d0) do { s16x4 l0, l1, l2, l3, h0, h1, h2, h3; constexpr int b_ = v_rd_off(d0, 0, 0); \
        TRRD(l0, b_); TRRD(h0, b_ + 2048); TRRD(l1, b_ + 4096); TRRD(h1, b_ + 6144); TRRD(l2, b_ + 8192); TRRD(h2, b_ + 10240); TRRD(l3, b_ + 12288); TRRD(h3, b_ + 14336); \
        asm volatile("s_waitcnt lgkmcnt(0)" ::: "memory"); SBAR(); \
        o[d0] = __builtin_amdgcn_mfma_f32_32x32x16_bf16(pa0, (bf16x8){l0[0], l0[1], l0[2], l0[3], h0[0], h0[1], h0[2], h0[3]}, o[d0], 0, 0, 0);   \
        o[d0] = __builtin_amdgcn_mfma_f32_32x32x16_bf16(pa1, (bf16x8){l1[0], l1[1], l1[2], l1[3], h1[0], h1[1], h1[2], h1[3]}, o[d0], 0, 0, 0);   \
        o[d0] = __builtin_amdgcn_mfma_f32_32x32x16_bf16(pa2, (bf16x8){l2[0], l2[1], l2[2], l2[3], h2[0], h2[1], h2[2], h2[3]}, o[d0], 0, 0, 0);   \
        o[d0] = __builtin_amdgcn_mfma_f32_32x32x16_bf16(pa3, (bf16x8){l3[0], l3[1], l3[2], l3[3], h3[0], h3[1], h3[2], h3[3]}, o[d0], 0, 0, 0); } while (0)
    PV_D0(0); PV_D0(1); PV_D0(2); PV_D0(3);
#undef PV_D0
#undef TRRD
}
__device__ __forceinline__ void pack_p(const f32x16& p0, const f32x16& p1, bf16x8& pa0, bf16x8& pa1, bf16x8& pa2, bf16x8& pa3) {
#define PK4(P, B_, OUT) do { unsigned a0 = cvtpk(P[B_+0], P[B_+1]), a1 = cvtpk(P[B_+2], P[B_+3]);                          \
        unsigned b0 = cvtpk(P[B_+4], P[B_+5]), b1 = cvtpk(P[B_+6], P[B_+7]);                                             \
        auto r0 = __builtin_amdgcn_permlane32_swap(a0, b0, false, false); auto r1 = __builtin_amdgcn_permlane32_swap(a1, b1, false, false); \
        u32x4 w = {r0[0], r1[0], r0[1], r1[1]}; OUT = *reinterpret_cast<bf16x8*>(&w); } while (0)
    PK4(p0, 0, pa0); PK4(p0, 8, pa1); PK4(p1, 0, pa2); PK4(p1, 8, pa3);
#undef PK4
}
__device__ __forceinline__ float softplus2(float y) { return fmaxf(y, 0.f) + __builtin_amdgcn_logf(1.0f + __builtin_amdgcn_exp2f(-fabsf(y))); }

struct AttnArgs { const bf16* qkv; bf16* obuf; const float* kmean; const float* out_gain; bf16* dpo; float* dpl; unsigned* mlist; unsigned* mcnt; unsigned* mdone; };
constexpr int MLCAP = 3840, N_SEL = 2 * 5 * 15;
__device__ __forceinline__ unsigned ld_sc1(const unsigned* p) { return __hip_atomic_load(p, __ATOMIC_RELAXED, __HIP_MEMORY_SCOPE_AGENT); }
__device__ __forceinline__ void st_sc1(unsigned* p, unsigned v) { __hip_atomic_store(p, v, __ATOMIC_RELAXED, __HIP_MEMORY_SCOPE_AGENT); }

template <int mode> __device__ __forceinline__ void attn_unit(const AttnArgs& A, const int b, const int h, const int sub, char* shm, const int wave_) {
    const int tid = tid_of(wave_), wid = wave_, lane = tid & 63, r32 = lane & 31, hi = lane >> 5;
    int dil = 1, res = 0, qb = sub, br = 0;
    int gk = 0, gcnt = 0; unsigned gent = 0u; bool gvalid = true, wvalid = true;
    if (mode == 0) { br = sub >> 4; const int x = sub & 15; if (br == 0) { qb = x; } else if (br == 1) { dil = 4; res = x >> 2; qb = x & 3; } else { dil = 16; res = x; qb = 0; } }
    if (mode == 3) { gk = sub >> 4; const int c = sub & 15; const int li = (b * 5 + (h - 6)) * 15 + gk;
        gcnt = __builtin_amdgcn_readfirstlane((int)ld_sc1(A.mcnt + li));
        if (c * 256 >= gcnt) return;
        const int gi = c * 256 + wid * 32 + r32; gvalid = gi < gcnt; wvalid = (c * 256 + wid * 32) < gcnt;
        gent = ld_sc1(A.mlist + (size_t)li * MLCAP + (gvalid ? gi : 0)); qb = 0; }
    const size_t rowbase = (size_t)b * SEQ + res; const int q0 = qb * 256;
    const bf16* Qp = A.qkv + (rowbase + (size_t)dil * ((mode == 3) ? (int)(gent & 4095u) : (q0 + wid * 32 + r32))) * QS + h * 128;
    const bf16* Kh = A.qkv + rowbase * QS + 2048 + h * 128;
    const bf16* Vh = A.qkv + rowbase * QS + 4096 + h * 128;
    const size_t rstep = (size_t)dil * QS;
    char* V_lds = shm + L_V; char* K_lds = shm + L_K;
    float* wsf = (float*)(shm + L_WS) + wid * 64; float* li_l = wsf; float* al_l = wsf + 32;
    int* TL = (int*)(shm + L_TL); int* FLG = (int*)(shm + L_FLG); unsigned* MSK = (unsigned*)(shm + L_MSK); float* KM = (float*)(shm + L_KM);
    char* qf = shm + L_Q + wid * 8192 + lane * 16;
    const int qw0 = q0 + wid * 32;
    const int pos = qw0 + r32;
    const int vb0 = (int)(uintptr_t)V_lds + v_rd_base(lane);
    unsigned koffb[2], voffb[2];
#pragma unroll
    for (int i = 0; i < 2; ++i) { const int Lb = (2 * wid + i) * 1024 + lane * 16;
        const int rowk = Lb >> 8, ck = ((Lb >> 4) & 15) ^ (rowk & 7);
        koffb[i] = (unsigned)(((size_t)rowk * rstep + ck * 8) * 2);
        const int sub_ = Lb >> 9, win_ = Lb & 511, kk = (sub_ >> 2) * 8 + (win_ >> 6), kv = (kk & ~0xC) | ((kk & 4) << 1) | ((kk & 8) >> 1), cc = (sub_ & 3) * 4 + ((win_ & 63) >> 4);
        voffb[i] = (unsigned)(((size_t)kv * rstep + cc * 8) * 2); }
    typedef __attribute__((address_space(3))) unsigned lds_u32;
    lds_u32* const Kdst = (lds_u32*)(K_lds + wid * 2048); lds_u32* const Vdst = (lds_u32*)(V_lds + wid * 2048);
#define TDMA(k0_, bf_) do { const char* kt_ = (const char*)(Kh + (size_t)(k0_) * rstep); const char* vt_ = (const char*)(Vh + (size_t)(k0_) * rstep); \
        _Pragma("unroll") for (int i_ = 0; i_ < 2; ++i_) { unsigned ko_ = koffb[i_], vo_ = voffb[i_]; asm volatile("" : "+v"(ko_), "+v"(vo_)); \
            __builtin_amdgcn_global_load_lds((const unsigned*)(kt_ + ko_), (lds_u32*)((__attribute__((address_space(3))) char*)Kdst + (bf_) * SHM_T + i_ * 1024), 16, 0, 0); \
            __builtin_amdgcn_global_load_lds((const unsigned*)(vt_ + vo_), (lds_u32*)((__attribute__((address_space(3))) char*)Vdst + (bf_) * SHM_T + i_ * 1024), 16, 0, 0); } } while (0)
    { const int kf_ = ((mode == 3) ? gk * 256 : q0) + 192; TDMA(kf_, 0); }
    bf16x8 qr[8];
#pragma unroll
    for (int d0 = 0; d0 < 8; ++d0) { qr[d0] = *reinterpret_cast<const bf16x8*>(Qp + d0 * 16 + hi * 8); *reinterpret_cast<bf16x8*>(qf + d0 * 1024) = qr[d0]; }
    const float sl = (mode == 2) ? 0.f : __builtin_amdgcn_exp2f(-8.0f * (float)(h + 1) / 11.0f) * 1.4426950408889634f * (float)dil;
    f32x16 binit;
#pragma unroll
    for (int r = 0; r < 16; ++r) binit[r] = sl * (float)((r & 3) + 8 * (r >> 2) + 4 * hi);
    const float sl32 = 32.f * sl;

    int NT = 0;
    if (mode == 1) { NT = 4; if (tid < 4) TL[tid] = q0 + 192 - 64 * tid; }
    else if (mode == 3) { NT = 4; if (tid < 4) TL[tid] = gk * 256 + 192 - 64 * tid; }
    else if (mode == 0) {
        const int lo = q0 >= 128 ? q0 - 128 : 0; NT = (q0 + 256 - lo) / 64;
        if (tid < NT) TL[NT - 1 - tid] = lo + 64 * tid;
    } else {
        NT = (q0 + 256) / 64;
        if (tid < NT) TL[tid] = q0 + 192 - 64 * tid;
    }
    __syncthreads();

    float m_reg = -1e30f, l_reg = 0.f, carry = 0.f; asm volatile("" : "+v"(m_reg), "+v"(l_reg), "+v"(carry));
    f32x16 o[4];
#pragma unroll
    for (int d0 = 0; d0 < 4; ++d0) o[d0] = f32x16{};
    bool wdone = false;
    for (int t = 0; t < NT; ++t) {
        const int buf = t & 1; const int kb = __builtin_amdgcn_readfirstlane(TL[t]);
        const bool more = (t + 1 < NT);
        if (more) { const int k1 = __builtin_amdgcn_readfirstlane(TL[t + 1]); TDMA(k1, buf ^ 1); }
        bool act;
        if (mode == 0) act = (kb <= qw0 + 31) && (kb + 63 >= qw0 - 128);
        else if (mode == 1) act = (kb <= qw0 + 31);
        else if (mode == 3) act = wvalid;
        else act = (kb < qw0 + 32) && !wdone;
        if (act) {
            f32x16 p0, p1;
            qkt(p0, p1, binit, K_lds + buf * SHM_T, r32, hi, qf);
            bf16x8 pa0, pa1, pa2, pa3;
            const int dq = pos - kb - 4 * hi;
            if (mode == 2) {
                float Og[8], Pg[8];
#pragma unroll
                for (int i = 0; i < 8; ++i) { float ye[4], le[4];
#pragma unroll
                    for (int e = 0; e < 4; ++e) { const int c = (i < 4) ? (8 * i + e) : (8 * (i - 4) + 32 + e); const float y = ((i < 4) ? p0[4 * i + e] : p1[4 * (i - 4) + e]) * C2;
                        ye[e] = y; le[e] = (dq - c >= 1) ? -softplus2(y) : 0.f; }
                    const float w2 = le[3], w1 = w2 + le[2], w0 = w1 + le[1];
                    Og[i] = w0 + le[0];
                    const float x0 = ye[0] + le[0] + w0, x1 = ye[1] + le[1] + w1, x2 = ye[2] + le[2] + w2, x3 = ye[3] + le[3];
                    if (i < 4) { p0[4 * i] = x0; p0[4 * i + 1] = x1; p0[4 * i + 2] = x2; p0[4 * i + 3] = x3; } else { p1[4 * (i - 4)] = x0; p1[4 * (i - 4) + 1] = x1; p1[4 * (i - 4) + 2] = x2; p1[4 * (i - 4) + 3] = x3; } }
#pragma unroll
                for (int i = 0; i < 8; ++i) Pg[i] = xor32_get(Og[i], hi);
                float run = carry;
#pragma unroll
                for (int i = 7; i >= 0; --i) { const float ab = run + (hi == 0 ? Pg[i] : 0.f);
#pragma unroll
                    for (int e = 0; e < 4; ++e) { const int c = (i < 4) ? (8 * i + e) : (8 * (i - 4) + 32 + e);
                        if (i < 4) p0[4 * i + e] = (dq - c >= 1) ? __builtin_amdgcn_exp2f(p0[4 * i + e] + ab) : 0.f;
                        else p1[4 * (i - 4) + e] = (dq - c >= 1) ? __builtin_amdgcn_exp2f(p1[4 * (i - 4) + e] + ab) : 0.f; }
                    run += Og[i] + Pg[i]; }
                carry = run;
                wdone = __all(carry < -160.f) != 0;
                pack_p(p0, p1, pa0, pa1, pa2, pa3);
            } else {
                const float NEG = -__builtin_inff();
                bool rowok = true;
                if (mode == 0) {
                    if (!((kb + 63 <= qw0) && (qw0 + 31 - kb <= 128))) {
#pragma unroll
                        for (int r = 0; r < 16; ++r) { const int c = (r & 3) + 8 * (r >> 2);
                            p0[r] = ((unsigned)(dq - c) <= 128u) ? p0[r] : NEG; p1[r] = ((unsigned)(dq - c - 32) <= 128u) ? p1[r] : NEG; } }
                } else if (mode == 1) {
                    if (kb + 63 > qw0) {
#pragma unroll
                        for (int r = 0; r < 16; ++r) { const int c = (r & 3) + 8 * (r >> 2);
                            p0[r] = (dq - c >= 0) ? p0[r] : NEG; p1[r] = (dq - c - 32 >= 0) ? p1[r] : NEG; } }
                } else rowok = gvalid;
                const float tb = sl * (float)kb;
                float pm0 = p0[0], pm1 = p1[0];
#pragma unroll
                for (int r = 1; r < 16; ++r) { pm0 = fmaxf(pm0, p0[r]); pm1 = fmaxf(pm1, p1[r]); }
                float pmax = fmaxf(pm0, pm1 + sl32);
                { auto rr = __builtin_amdgcn_permlane32_swap(__float_as_uint(pmax), __float_as_uint(pmax), false, false); pmax = fmaxf(__uint_as_float(rr[0]), __uint_as_float(rr[1])); }
                pmax = rowok ? pmax : NEG;
                const float m_loc = m_reg - tb;
                const float mn = fmaxf(m_loc, pmax); const float alpha = __builtin_amdgcn_exp2f(m_loc - mn); m_reg = mn + tb;
                const float ref0 = rowok ? mn : __builtin_inff(), ref1 = ref0 - sl32;
                float ps = 0.f;
#pragma unroll
                for (int r = 0; r < 16; ++r) { p0[r] = __builtin_amdgcn_exp2f(p0[r] - ref0); p1[r] = __builtin_amdgcn_exp2f(p1[r] - ref1); ps += p0[r] + p1[r]; }
                { auto rr = __builtin_amdgcn_permlane32_swap(__float_as_uint(ps), __float_as_uint(ps), false, false); ps = __uint_as_float(rr[0]) + __uint_as_float(rr[1]); }
                l_reg = l_reg * alpha + ps;
                pack_p(p0, p1, pa0, pa1, pa2, pa3);
                if (__any(alpha < 1.f)) { if (hi == 0) al_l[r32] = alpha; asm volatile("s_waitcnt lgkmcnt(0)" ::: "memory");
#pragma unroll
                    for (int d_ = 0; d_ < 4; ++d_)
#pragma unroll
                        for (int r = 0; r < 16; ++r) o[d_][r] *= al_l[crow(r, hi)]; }
            }
            SBAR();
            pv_tile(o, vb0 + buf * SHM_T, pa0, pa1, pa2, pa3);
        }
        if (mode == 2) { if (lane == 0) FLG[buf * 8 + wid] = wdone ? 1 : 0; }
        __syncthreads();
        if (mode == 2) { const i32x4 fa = *(const i32x4*)(FLG + buf * 8), fb = *(const i32x4*)(FLG + buf * 8 + 4);
            if ((fa[0] & fa[1] & fa[2] & fa[3] & fb[0] & fb[1] & fb[2] & fb[3]) != 0) break; }
    }
#undef TDMA
    if (mode != 2) {
        const int slot = (mode == 0) ? br : 0;
        const size_t tok0 = rowbase + (size_t)dil * qw0;
        int* ts_l = (int*)al_l;
        if (hi == 0) { const float lse = (l_reg > 0.f) ? (m_reg + __builtin_amdgcn_logf(l_reg) - ((mode == 0) ? sl * (float)pos : 0.f)) : -__builtin_inff();
            if (mode == 3) { const int ts = gvalid ? (int)((1u + (gent >> 12)) * (unsigned)NTOK + (unsigned)rowbase + (gent & 4095u)) : -1; ts_l[r32] = ts; if (gvalid) A.dpl[(size_t)ts * DPLW + h] = lse; }
            else A.dpl[((size_t)slot * NTOK + tok0 + (size_t)dil * r32) * DPLW + h] = lse;
            if (mode == 1) { for (int s_ = 1 + (qb < 3 ? qb : 3); s_ < 4; ++s_) A.dpl[((size_t)s_ * NTOK + tok0 + r32) * DPLW + h] = -__builtin_inff(); }
            li_l[r32] = (l_reg > 0.f) ? __builtin_amdgcn_rcpf(l_reg) : 0.f; }
        asm volatile("s_waitcnt lgkmcnt(0)" ::: "memory");
        float rli[16];
#pragma unroll
        for (int r = 0; r < 16; ++r) rli[r] = li_l[crow(r, hi)];
        if (mode == 3) {
#pragma unroll
            for (int r = 0; r < 16; ++r) { const int ts = ts_l[crow(r, hi)]; bf16* Ow = A.dpo + (size_t)(ts < 0 ? 0 : ts) * DPW + h * 128;
#pragma unroll
                for (int d0 = 0; d0 < 4; ++d0) { const float v = o[d0][r] * rli[r]; const float vn = xor_get<1>(v);
                    if ((r32 & 1) == 0 && ts >= 0) *(unsigned*)(Ow + d0 * 32 + r32) = cvtpk(v, vn); } }
        } else {
        bf16* Ow = A.dpo + ((size_t)slot * NTOK + tok0) * DPW + h * 128;
#pragma unroll
        for (int r = 0; r < 16; ++r) { const int orow = crow(r, hi);
#pragma unroll
            for (int d0 = 0; d0 < 4; ++d0) { const float v = o[d0][r] * rli[r]; const float vn = xor_get<1>(v);
                if ((r32 & 1) == 0) *(unsigned*)(Ow + (size_t)orow * dil * DPW + d0 * 32 + r32) = cvtpk(v, vn); } }
        }
    } else {
        float ssq[16];
#pragma unroll
        for (int r = 0; r < 16; ++r) { float a = 0.f;
#pragma unroll
            for (int d0 = 0; d0 < 4; ++d0) { const float v = o[d0][r]; a = fmaf(v, v, a); }
            ssq[r] = a; }
#pragma unroll
        for (int r = 0; r < 16; ++r) { float a = ssq[r]; a += xor_get<1>(a); a += xor_get<2>(a); a += xor_get<4>(a); a += xor_get<8>(a); a += xor_get<16>(a); ssq[r] = a; }
        float gn[4];
#pragma unroll
        for (int d0 = 0; d0 < 4; ++d0) gn[d0] = A.out_gain[h * 128 + d0 * 32 + r32];
        bf16* Ow = A.obuf + (rowbase + qw0) * DM + h * 128;
#pragma unroll
        for (int r = 0; r < 16; ++r) { const int orow = crow(r, hi); const float rn = 1.0f / sqrtf(ssq[r] * (1.0f / 128.0f) + 1e-6f);
#pragma unroll
            for (int d0 = 0; d0 < 4; ++d0) { const float v = o[d0][r] * rn * gn[d0]; const float vn = xor_get<1>(v);
                if ((r32 & 1) == 0) *(unsigned*)(Ow + (size_t)orow * DM + d0 * 32 + r32) = cvtpk(v, vn); } }
    }
}

__device__ __forceinline__ void moba_select(const AttnArgs& A, const int b, const int h, const int qb, char* shm, const int wave_) {
    const int tid = tid_of(wave_), wid = wave_, lane = tid & 63, r32 = lane & 31, hi = lane >> 5;
    float* KM = (float*)(shm + L_KM); int* LC = (int*)(shm + L_TL); int* LB = LC + 16;
    const int pos = qb * 256 + wid * 32 + r32;
    const bf16* Qp = A.qkv + ((size_t)b * SEQ + pos) * QS + h * 128;
    bf16x8 qr[8];
#pragma unroll
    for (int d0 = 0; d0 < 8; ++d0) qr[d0] = *reinterpret_cast<const bf16x8*>(Qp + d0 * 16 + hi * 8);
    if (tid < 16) LC[tid] = 0;
    { const float* src = A.kmean + (size_t)((b * 5 + (h - 6)) * 16) * 128; *(f32x4*)(KM + tid * 4) = *(const f32x4*)(src + tid * 4); }
    __syncthreads();
    float gate[16];
#pragma unroll
    for (int j = 0; j < 16; ++j) gate[j] = 0.f;
#pragma unroll
    for (int d0 = 0; d0 < 8; ++d0) {
        float qv[8];
#pragma unroll
        for (int e = 0; e < 8; ++e) qv[e] = bf2f(qr[d0][e]);
#pragma unroll
        for (int j = 0; j < 16; ++j) { const f32x4 k0 = *(const f32x4*)(KM + j * 128 + d0 * 16 + hi * 8), k1 = *(const f32x4*)(KM + j * 128 + d0 * 16 + hi * 8 + 4);
            float a = gate[j];
            a = fmaf(qv[0], k0[0], a); a = fmaf(qv[1], k0[1], a); a = fmaf(qv[2], k0[2], a); a = fmaf(qv[3], k0[3], a);
            a = fmaf(qv[4], k1[0], a); a = fmaf(qv[5], k1[1], a); a = fmaf(qv[6], k1[2], a); a = fmaf(qv[7], k1[3], a);
            gate[j] = a; }
    }
#pragma unroll
    for (int j = 0; j < 16; ++j) gate[j] = xor32_sum(gate[j]);
    unsigned sel = 0u;
#pragma unroll
    for (int it = 0; it < 3; ++it) { float best = -__builtin_inff(); int bi = -1;
#pragma unroll
        for (int j = 0; j < 16; ++j) { const bool ok = (j < qb) && (((sel >> j) & 1u) == 0u) && (gate[j] > best); if (ok) { best = gate[j]; bi = j; } }
        if (bi >= 0) sel |= 1u << bi; }
    int jj0 = -1, jj1 = -1, jj2 = -1, ll0 = 0, ll1 = 0, ll2 = 0;
    if (hi == 0) { unsigned s_ = sel;
        if (s_) { jj0 = __builtin_ctz(s_); s_ &= s_ - 1u; ll0 = __hip_atomic_fetch_add(LC + jj0, 1, __ATOMIC_RELAXED, __HIP_MEMORY_SCOPE_WORKGROUP); }
        if (s_) { jj1 = __builtin_ctz(s_); s_ &= s_ - 1u; ll1 = __hip_atomic_fetch_add(LC + jj1, 1, __ATOMIC_RELAXED, __HIP_MEMORY_SCOPE_WORKGROUP); }
        if (s_) { jj2 = __builtin_ctz(s_); ll2 = __hip_atomic_fetch_add(LC + jj2, 1, __ATOMIC_RELAXED, __HIP_MEMORY_SCOPE_WORKGROUP); } }
    __syncthreads();
    const int lbase = (b * 5 + (h - 6)) * 15;
    if (tid < 15) { const int n = LC[tid]; LB[tid] = n ? (int)__hip_atomic_fetch_add(A.mcnt + lbase + tid, (unsigned)n, __ATOMIC_RELAXED, __HIP_MEMORY_SCOPE_AGENT) : 0; }
    __syncthreads();
    if (hi == 0) {
        if (jj0 >= 0) st_sc1(A.mlist + (size_t)(lbase + jj0) * MLCAP + LB[jj0] + ll0, (unsigned)pos);
        if (jj1 >= 0) st_sc1(A.mlist + (size_t)(lbase + jj1) * MLCAP + LB[jj1] + ll1, (unsigned)pos | (1u << 12));
        if (jj2 >= 0) st_sc1(A.mlist + (size_t)(lbase + jj2) * MLCAP + LB[jj2] + ll2, (unsigned)pos | (2u << 12)); }
    asm volatile("s_waitcnt vmcnt(0)" ::: "memory");
    __syncthreads();
    if (tid == 0) __hip_atomic_fetch_add(A.mdone, 1u, __ATOMIC_RELAXED, __HIP_MEMORY_SCOPE_AGENT);
}

constexpr bool unit_valid(int mode, int sub) { return mode == 0 ? sub < 48 : sub < 16; }
constexpr int unit_cost(int mode, int sub) {
    if (mode == 0) return 4;
    if (mode == 2) return 4 * (sub + 1) < 6 ? 4 * (sub + 1) : 6;
    return 4;
}
constexpr int gath_expected(int kb) { int len = 0; for (int qb = kb + 1; qb < 16; ++qb) len += (qb <= 3) ? 256 : 768 / qb; return (len + 255) / 256; }
constexpr int N_GATH = 2 * 5 * 120;
constexpr int N_UNITS = 2 * 6 * 48 + 2 * 5 * 16 + 2 * 5 * 16;
constexpr int CHUNK_TILES = 2, N_CHUNKS = 2240;
constexpr int N_TICKETS = N_SEL + N_UNITS + N_GATH + N_CHUNKS;
struct OrderTab { unsigned short v[N_TICKETS]; };
constexpr OrderTab make_order() {
    OrderTab T{}; int n = 0, nc = 0; long tot = 0, acc = 0;
    for (int b = 0; b < 2; ++b) for (int hr = 0; hr < 5; ++hr) for (int qb = 15; qb >= 1; --qb) T.v[n++] = (unsigned short)(0x2000 | (b << 9) | (hr << 6) | qb);
    for (int mode = 0; mode < 3; ++mode) { const int nh = (mode == 0) ? 6 : 5; for (int sub = 0; sub < 64; ++sub) if (unit_valid(mode, sub)) tot += 2L * nh * unit_cost(mode, sub); }
    for (int kb = 0; kb < 15; ++kb) tot += 2L * 5 * 4 * (gath_expected(kb) < 15 - kb ? gath_expected(kb) : 15 - kb);
    for (int cost = 64; cost >= 1; --cost)
        for (int mode = 2; mode >= 0; --mode) { const int nh = (mode == 0) ? 6 : 5;
            for (int sub = 63; sub >= 0; --sub) { if (!unit_valid(mode, sub) || unit_cost(mode, sub) != cost) continue;
                for (int b = 0; b < 2; ++b) for (int hr = 0; hr < nh; ++hr) { T.v[n++] = (unsigned short)((mode << 10) | (b << 9) | (hr << 6) | sub);
                    acc += (long)cost * N_CHUNKS; while (acc >= tot && nc < N_CHUNKS) { T.v[n++] = (unsigned short)(0x8000 | nc); ++nc; acc -= tot; } } } }
    for (int c = 0; c < 15; ++c) for (int kb = 0; kb + c < 15; ++kb) { if (c >= gath_expected(kb)) continue;
        for (int b = 0; b < 2; ++b) for (int hr = 0; hr < 5; ++hr) { T.v[n++] = (unsigned short)(0x4000 | (b << 11) | (hr << 8) | (kb << 4) | c);
            acc += 4L * N_CHUNKS; while (acc >= tot && nc < N_CHUNKS) { T.v[n++] = (unsigned short)(0x8000 | nc); ++nc; acc -= tot; } } }
    while (nc < N_CHUNKS) { T.v[n++] = (unsigned short)(0x8000 | nc); ++nc; }
    for (int c = 0; c < 15; ++c) for (int kb = 0; kb + c < 15; ++kb) { if (c < gath_expected(kb)) continue;
        for (int b = 0; b < 2; ++b) for (int hr = 0; hr < 5; ++hr) T.v[n++] = (unsigned short)(0x4000 | (b << 11) | (hr << 8) | (kb << 4) | c); }
    return T;
}
__device__ const OrderTab ATT_ORDER = make_order();
#undef KSWZ
#undef SBAR
}


constexpr int NWAVES = 8;
#ifndef MK_SPLIT
#define MK_SPLIT 0
#endif
constexpr int BATCH = 2, SEQ = 4096, D = 2048, FF = 5632, NE = 8;
constexpr int M = BATCH * SEQ;
constexpr int NQKV = 3 * D, NGU = 2 * FF;
constexpr int MPAD = 18432;
constexpr float EPS = 1e-6f;
constexpr size_t MiB = 1u << 20;
constexpr size_t WS_CTL = 0, CTL_ZERO_BYTES = 1 * MiB;
constexpr size_t WS_WQKV = 1 * MiB;
constexpr size_t WS_WO = 49 * MiB;
constexpr size_t WS_WGU_D = 65 * MiB;
constexpr size_t WS_WD_D = 109 * MiB;
constexpr size_t WS_WGU_M = 131 * MiB;
constexpr size_t WS_WD_M = 483 * MiB;
constexpr size_t WS_H = 659 * MiB;
constexpr size_t WS_QKV = 723 * MiB;
constexpr size_t WS_O = 819 * MiB;
constexpr size_t WS_A = 851 * MiB;
constexpr size_t WS_YS = WS_QKV;
constexpr size_t WS_ACT = 883 * MiB;
constexpr size_t WS_XS = 1081 * MiB;
constexpr size_t WS_MISC = 1153 * MiB;
constexpr size_t WS_DPO = 1154 * MiB;
constexpr size_t WS_DPL = 1242 * MiB;
constexpr size_t WS_MLIST = 1244 * MiB;
constexpr size_t WS_END = 1249 * MiB;
constexpr size_t MISC_KMEAN = 0, MISC_SELE = 131072, MISC_SELREL = MISC_SELE + 32768, MISC_SELG = MISC_SELREL + 65536, MISC_SELPOS = MISC_SELG + 65536, MISC_RSQ = 393216  , MISC_RSQ2 = MISC_RSQ + 262144;
static_assert(MISC_SELPOS + 65536 <= MISC_RSQ && MISC_RSQ2 + 262144 <= MiB && (size_t)MPAD * D * 4 <= 160 * MiB && (size_t)MPAD * FF * 2 <= 198 * MiB, "ws map");
constexpr int CW_TMO = 0, CW_CODE = 1;
constexpr int CW_BAR = 4096;
constexpr int CW_ATTQ = 8192;
constexpr int CW_CNT = 8448;
constexpr int CW_MCNT = 9216;
constexpr int CW_MDONE = 10240;
constexpr int RING_OFF = 0, RING_BYTES = 131072;
constexpr int LDSCTL_OFF = 143360, MISC_OFF = LDSCTL_OFF + 320;
constexpr int LDS_BYTES = 147456;
constexpr int PPL = 11, N_PHASES = 2 * PPL;

#define GAS __attribute__((address_space(1)))
#define LAS __attribute__((address_space(3)))
typedef unsigned short bf16;
typedef unsigned v4u __attribute__((ext_vector_type(4)));
typedef float f32x4 __attribute__((ext_vector_type(4)));
typedef short bf16x8 __attribute__((ext_vector_type(8)));
typedef GAS unsigned gu32;
typedef GAS unsigned long long gu64;
#define RLX_AGENT __ATOMIC_RELAXED, __HIP_MEMORY_SCOPE_AGENT
#define LDS_WAIT() asm volatile("s_waitcnt lgkmcnt(0)" ::: "memory")
#define VM_WAIT() asm volatile("s_waitcnt vmcnt(0)" ::: "memory")
__device__ __forceinline__ unsigned long long rt() { return __builtin_amdgcn_s_memrealtime(); }
__device__ __forceinline__ unsigned f2bf(float f) { unsigned u = __builtin_bit_cast(unsigned, f); return (u + 0x7fffu + ((u >> 16) & 1u)) >> 16; }
__device__ __forceinline__ unsigned pk2(float lo, float hi) { return f2bf(lo) | (f2bf(hi) << 16); }

#define XB_TMO      128
#define XB_XCNT(j)  (256  + 64 * (j))
#define XB_XSUB(j)  (1280 + 64 * (j))
#define XB_XGEN(j)  (2304 + 64 * (j))
#define XB_TOP      3328
#define XB_TOPGEN   3392
#define XCD_BAR_WORDS 3456
#define XB_SPIN_CAP (1u << 18)

__device__ __forceinline__ unsigned xb_ld(unsigned* p)              { return __hip_atomic_load(p, __ATOMIC_RELAXED, __HIP_MEMORY_SCOPE_AGENT); }
__device__ __forceinline__ unsigned xb_add(unsigned* p, unsigned v) { return __hip_atomic_fetch_add(p, v, __ATOMIC_RELAXED, __HIP_MEMORY_SCOPE_AGENT); }
__device__ __forceinline__ unsigned xb_xcc_id() { return (unsigned)__builtin_amdgcn_s_getreg((3 << 11) | 20) & 0xFu; }
#define XB_SPIN(cond, bar) do { unsigned _sp = 0; while (cond) { __builtin_amdgcn_s_sleep(1); \
    if ((++_sp & 255u) == 0u) { if (xb_ld(&(bar)[XB_TMO])) break; if (_sp > XB_SPIN_CAP) { atomicAdd(&(bar)[XB_TMO], 1u); break; } } } } while (0)

#define XB_IS_T0 (b.wv == 0 && lane_id() == 0)
struct XcdBarrier {
    int wv;
    unsigned* bar; unsigned x;
    volatile LAS unsigned* st;
};

__device__ __forceinline__ XcdBarrier xcd_barrier_post(unsigned* bar, volatile LAS unsigned* st, int wv) {
    XcdBarrier b; b.bar = bar; b.x = xb_xcc_id(); b.st = st; b.wv = wv;
    if (XB_IS_T0) (void)xb_add(&bar[XB_XCNT(b.x)], 1u);
    return b;
}
__device__ __forceinline__ void xcd_barrier_complete(unsigned* bar, unsigned x, unsigned& nloc, unsigned& nx) {
    const unsigned G = gridDim.x * gridDim.y * gridDim.z;
    unsigned sum, cnt, mine, sp = 0u;
    for (;;) {
        sum = 0u; cnt = 0u; mine = 0u;
#pragma unroll
        for (unsigned j = 0; j < 16; ++j) { const unsigned c = xb_ld(&bar[XB_XCNT(j)]); sum += c; cnt += (c > 0u) ? 1u : 0u; mine = (j == x) ? c : mine; }
        if (sum == G) break;
        __builtin_amdgcn_s_sleep(1);
        if ((++sp & 255u) == 0u) { if (xb_ld(&bar[XB_TMO])) break; if (sp > XB_SPIN_CAP) { atomicAdd(&bar[XB_TMO], 1u); break; } }
    }
    nloc = mine > 0u ? mine : 1u; nx = cnt > 0u ? cnt : 1u;
}

__device__ __forceinline__ void xcd_barrier(const XcdBarrier& b) {
    asm volatile("s_waitcnt vmcnt(0)" ::: "memory");
    __syncthreads();
    if (XB_IS_T0) {
        unsigned* bar = b.bar;
        __builtin_amdgcn_s_waitcnt(0);
        unsigned nloc = b.st[0], nx = b.st[1];
        if (nloc == 0u) { xcd_barrier_complete(bar, b.x, nloc, nx); b.st[0] = nloc; b.st[1] = nx; }
        const unsigned old = xb_add(&bar[XB_XSUB(b.x)], 1u);
        const unsigned gen = old / nloc;
        if (old + 1u == (gen + 1u) * nloc) {
            __builtin_amdgcn_fence(__ATOMIC_RELEASE, "agent");
            asm volatile("s_waitcnt vmcnt(0)" ::: "memory");
            const unsigned og = xb_add(&bar[XB_TOP], 1u);
            const unsigned tg = og / nx;
            if (og + 1u == (tg + 1u) * nx) xb_add(&bar[XB_TOPGEN], 1u);
            else XB_SPIN(xb_ld(&bar[XB_TOPGEN]) == tg, bar);
            __builtin_amdgcn_fence(__ATOMIC_ACQUIRE, "agent");
            xb_add(&bar[XB_XGEN(b.x)], 1u);
            asm volatile("s_waitcnt vmcnt(0)" ::: "memory");
        } else {
            XB_SPIN(xb_ld(&bar[XB_XGEN(b.x)]) == gen, bar);
            __builtin_amdgcn_fence(__ATOMIC_ACQUIRE, "agent");
            asm volatile("s_waitcnt vmcnt(0)" ::: "memory");
        }
    }
    __syncthreads();
}


__device__ __forceinline__ float wave_sum(float v) {
    v += xor_get<1>(v); v += xor_get<2>(v); v += xor_get<4>(v); v += xor_get<8>(v); v += xor_get<16>(v);
    return xor32_sum(v);
}
__device__ __forceinline__ float bf2f_u(unsigned short s) { return __uint_as_float(((unsigned)s) << 16); }
typedef unsigned u32x2_g __attribute__((ext_vector_type(2)));
__device__ __forceinline__ f32x4 bf4_to_f32(u32x2_g a) { return (f32x4){__uint_as_float(a.x << 16), __uint_as_float(a.x & 0xffff0000u), __uint_as_float(a.y << 16), __uint_as_float(a.y & 0xffff0000u)}; }

__device__ __forceinline__ void p0_transpose_item(const float* W, int K, int N, bf16* WT, int mode, LAS float* scr, int item, int lane) {
    const int nblk = N / 32, kb = item / nblk, nb = item % nblk, k0 = 64 * kb, n0 = 32 * nb;
#pragma unroll 8
    for (int i = 0; i < 32; ++i) { const int kk = 2 * i + (lane >> 5); scr[kk * 33 + (lane & 31)] = W[(size_t)(k0 + kk) * N + n0 + (lane & 31)]; }
    LDS_WAIT(); asm volatile("" ::: "memory");
    const int drow0 = (mode == 0) ? n0 : (256 * (n0 >> 7) + (n0 & 127) + (mode == 2 ? 128 : 0));
    const int c = lane & 7;
#pragma unroll
    for (int j = 0; j < 4; ++j) { const int n = (lane >> 3) + 8 * j; const LAS float* s = scr + (8 * c) * 33 + n;
        v4u o; o.x = pk2(s[0 * 33], s[1 * 33]); o.y = pk2(s[2 * 33], s[3 * 33]); o.z = pk2(s[4 * 33], s[5 * 33]); o.w = pk2(s[6 * 33], s[7 * 33]);
        *(GAS v4u*)(WT + (size_t)(drow0 + n) * K + k0 + 8 * c) = o; }
    LDS_WAIT(); asm volatile("" ::: "memory");
}

__device__ __forceinline__ void p0_transpose_item_fp8(const float* W, int K, int N, unsigned char* WT, int mode, LAS float* scr, int item, int lane) {
    const int nblk = N / 32, kb = item / nblk, nb = item % nblk, k0 = 64 * kb, n0 = 32 * nb;
#pragma unroll 8
    for (int i = 0; i < 32; ++i) { const int kk = 2 * i + (lane >> 5); scr[kk * 33 + (lane & 31)] = W[(size_t)(k0 + kk) * N + n0 + (lane & 31)]; }
    LDS_WAIT(); asm volatile("" ::: "memory");
    const int drow0 = (mode == 0) ? n0 : (256 * (n0 >> 7) + (n0 & 127) + (mode == 2 ? 128 : 0));
    const int n = lane & 31, kq = lane >> 5; const LAS float* sp = scr + (32 * kq) * 33 + n;
    v4u o0, o1;
#define P4(j) pg8::pk4_fp8(sp[(4 * (j)) * 33] * 256.f, sp[(4 * (j) + 1) * 33] * 256.f, sp[(4 * (j) + 2) * 33] * 256.f, sp[(4 * (j) + 3) * 33] * 256.f)
    o0.x = P4(0); o0.y = P4(1); o0.z = P4(2); o0.w = P4(3); o1.x = P4(4); o1.y = P4(5); o1.z = P4(6); o1.w = P4(7);
#undef P4
    GAS v4u* dst = (GAS v4u*)(WT + (size_t)(drow0 + n) * K + k0 + 32 * kq);
    dst[0] = o0; dst[1] = o1;
    LDS_WAIT(); asm volatile("" ::: "memory");
}

struct Ptrs {
    const float *x, *attn_norm, *w_in, *q_gain, *k_gain, *out_gain, *w_out, *ffn_norm, *dwg, *dwu, *dwd, *router, *mwg, *mwu, *mwd;
    float* out;
    bf16 *Wqkv_t, *Wo_t, *QKV, *OB, *AB;
    unsigned char *Wgu_d, *Wd_d, *Wgu_m, *Wd_m, *AB8, *ACT, *XS;
    float *kmean, *DPL; bf16 *DPO, *YS, *H; unsigned* sel_e; int* sel_rel; float* sel_g; int* sel_pos;
    gu32* ctl; float* rsq;
};

struct CvTile { const float* W; unsigned char* WT; int K, N, mode, f8, r; const float* gain; };
__device__ __forceinline__ CvTile cv_decode(const Ptrs& P, int it) {
    constexpr int T_IN = (D / 128) * (NQKV / 256), T_O = (D / 128) * (D / 256), T_G = (D / 128) * (FF / 256), T_D = (FF / 128) * (D / 256), T_E = 2 * T_G + T_D;
    CvTile c; int r = it; c.gain = nullptr;
    if (r < T_IN) { c.W = P.w_in; c.WT = (unsigned char*)P.Wqkv_t; c.K = D; c.N = NQKV; c.mode = 0; c.f8 = 0; c.r = r; return c; } r -= T_IN;
    if (r < T_O) { c.W = P.w_out; c.WT = (unsigned char*)P.Wo_t; c.K = D; c.N = D; c.mode = 0; c.f8 = 0; c.r = r; return c; } r -= T_O;
    if (r < T_G) { c.W = P.dwg; c.WT = P.Wgu_d; c.K = D; c.N = FF; c.mode = 1; c.f8 = 1; c.r = r; return c; } r -= T_G;
    if (r < T_G) { c.W = P.dwu; c.WT = P.Wgu_d; c.K = D; c.N = FF; c.mode = 2; c.f8 = 1; c.r = r; return c; } r -= T_G;
    if (r < T_D) { c.W = P.dwd; c.WT = P.Wd_d; c.K = FF; c.N = D; c.mode = 0; c.f8 = 1; c.r = r; return c; } r -= T_D;
    if (r < T_IN) { c.W = P.w_in + (size_t)D * NQKV; c.WT = (unsigned char*)(P.Wqkv_t + (size_t)NQKV * D); c.K = D; c.N = NQKV; c.mode = 0; c.f8 = 0; c.r = r; c.gain = P.attn_norm + D; return c; } r -= T_IN;
    if (r < T_O) { c.W = P.w_out + (size_t)D * D; c.WT = (unsigned char*)(P.Wo_t + (size_t)D * D); c.K = D; c.N = D; c.mode = 0; c.f8 = 0; c.r = r; return c; } r -= T_O;
    const int e = r / T_E; r -= e * T_E; c.f8 = 1;
    if (r < T_G) { c.W = P.mwg + (size_t)e * D * FF; c.WT = P.Wgu_m + (size_t)e * NGU * D; c.K = D; c.N = FF; c.mode = 1; c.r = r; return c; } r -= T_G;
    if (r < T_G) { c.W = P.mwu + (size_t)e * D * FF; c.WT = P.Wgu_m + (size_t)e * NGU * D; c.K = D; c.N = FF; c.mode = 2; c.r = r; return c; } r -= T_G;
    c.W = P.mwd + (size_t)e * FF * D; c.WT = P.Wd_m + (size_t)e * D * FF; c.K = FF; c.N = D; c.mode = 0; c.r = r; return c;
}
constexpr int CV_T_IN = (D / 128) * (NQKV / 256), CV_T_O = (D / 128) * (D / 256), CV_T_G = (D / 128) * (FF / 256), CV_T_D = (FF / 128) * (D / 256);
constexpr int CV_L0 = CV_T_IN + CV_T_O + 2 * CV_T_G + CV_T_D, CV_DEF = CV_T_IN + CV_T_O + NE * (2 * CV_T_G + CV_T_D);
static_assert(CV_DEF == 2 * att::N_CHUNKS * att::CHUNK_TILES, "deferred conversion tiles = 2 phases x N_CHUNKS x CHUNK_TILES");
__device__ __forceinline__ void cv_tile_out(const CvTile& cur, LAS float* S, int tid_) {
    constexpr int LS = 260;
    const int nbl = cur.N / 256, kb = cur.r / nbl, nb = cur.r - kb * nbl;
    if (cur.f8) {
#pragma unroll
        for (int i = 0; i < 4; ++i) { const int p = tid_ + 512 * i, kq = p & 7, n = p >> 3, nn = 256 * nb + n;
            const int drow = (cur.mode == 0) ? nn : (256 * (nn >> 7) + (nn & 127) + (cur.mode == 2 ? 128 : 0));
            const LAS float* sp = S + (16 * kq) * LS + (n ^ (4 * kq)); v4u o;
#define P4(j) pg8::pk4_fp8(sp[(4 * (j)) * LS] * 256.f, sp[(4 * (j) + 1) * LS] * 256.f, sp[(4 * (j) + 2) * LS] * 256.f, sp[(4 * (j) + 3) * LS] * 256.f)
            o.x = P4(0); o.y = P4(1); o.z = P4(2); o.w = P4(3);
#undef P4
            __builtin_nontemporal_store(o, (GAS v4u*)(cur.WT + (size_t)drow * cur.K + 128 * kb + 16 * kq)); } }
    else {
#pragma unroll
        for (int i = 0; i < 8; ++i) { const int p = tid_ + 512 * i, kc = p & 15, n = p >> 4, nn = 256 * nb + n;
            const int drow = (cur.mode == 0) ? nn : (256 * (nn >> 7) + (nn & 127) + (cur.mode == 2 ? 128 : 0));
            const LAS float* sp = S + (8 * kc) * LS + (n ^ (4 * (kc >> 1))); v4u o;
            o.x = pk2(sp[0], sp[LS]); o.y = pk2(sp[2 * LS], sp[3 * LS]); o.z = pk2(sp[4 * LS], sp[5 * LS]); o.w = pk2(sp[6 * LS], sp[7 * LS]);
            *(GAS v4u*)((bf16*)cur.WT + (size_t)drow * cur.K + 128 * kb + 8 * kc) = o; } }
}
__device__ __forceinline__ void cv8_to_lds(const f32x4 (&v)[16], LAS unsigned char* T, int wave, int lane) {
    unsigned d[16];
#pragma unroll
    for (int i = 0; i < 16; ++i) d[i] = pg8::pk4_fp8(v[i].x * 256.f, v[i].y * 256.f, v[i].z * 256.f, v[i].w * 256.f);
    unsigned o[4][4];
#pragma unroll
    for (int q = 0; q < 4; ++q) { const unsigned a = d[4 * q], b = d[4 * q + 1], c = d[4 * q + 2], e = d[4 * q + 3];
        const unsigned t0 = __builtin_amdgcn_perm(b, a, 0x05010400u), t1 = __builtin_amdgcn_perm(b, a, 0x07030602u), t2 = __builtin_amdgcn_perm(e, c, 0x05010400u), t3 = __builtin_amdgcn_perm(e, c, 0x07030602u);
        o[0][q] = __builtin_amdgcn_perm(t2, t0, 0x05040100u); o[1][q] = __builtin_amdgcn_perm(t2, t0, 0x07060302u); o[2][q] = __builtin_amdgcn_perm(t3, t1, 0x05040100u); o[3][q] = __builtin_amdgcn_perm(t3, t1, 0x07060302u); }
#pragma unroll
    for (int j = 0; j < 4; ++j) { v4u w; w.x = o[j][0]; w.y = o[j][1]; w.z = o[j][2]; w.w = o[j][3];
        *(LAS v4u*)(T + (4 * lane + j) * 128 + 16 * (wave ^ (lane & 7))) = w; }
}
__device__ __forceinline__ void cv8_out(const CvTile& cur, const LAS unsigned char* T, int tid_) {
    const int nbl = cur.N / 256, kb = cur.r / nbl, nb = cur.r - kb * nbl;
#pragma unroll
    for (int i = 0; i < 4; ++i) { const int p = tid_ + 512 * i, c = p & 7, n = p >> 3, nn = 256 * nb + n;
        const int drow = (cur.mode == 0) ? nn : (256 * (nn >> 7) + (nn & 127) + (cur.mode == 2 ? 128 : 0));
        const v4u w = *(const LAS v4u*)(T + n * 128 + 16 * (c ^ ((n >> 2) & 7)));
        __builtin_nontemporal_store(w, (GAS v4u*)(cur.WT + (size_t)drow * cur.K + 128 * kb + 16 * c)); }
}
__device__ __forceinline__ void convert_weights(const Ptrs& P, LAS unsigned char* lds, int t0, int step, int t1, int wave, int lane) {
    asm volatile("" : "+v"(lane));
    constexpr int LS = 260;
    LAS float* S = (LAS float*)(lds + RING_OFF);
    LAS unsigned char* T8 = lds + RING_OFF;
    const int tid_ = wave * 64 + lane;
    if (t0 >= t1) return;
    f32x4 va[16], vb[16];
#define CV_LOAD(v, c) do { const int nbl_ = (c).N / 256, kb_ = (c).r / nbl_, nb_ = (c).r - kb_ * nbl_; const float* p_ = (c).W + (size_t)(128 * kb_ + wave * 16) * (c).N + 256 * nb_ + 4 * lane; \
        _Pragma("unroll") for (int i_ = 0; i_ < 16; ++i_) (v)[i_] = __builtin_nontemporal_load((const f32x4*)(p_ + (size_t)i_ * (c).N)); } while (0)
#define CV_TOLDS(v) do { _Pragma("unroll") for (int i_ = 0; i_ < 16; ++i_) *(LAS f32x4*)(S + (wave * 16 + i_) * LS + ((4 * lane) ^ (4 * wave))) = (v)[i_]; LDS_WAIT(); __syncthreads(); } while (0)
#define CV_STEP(v, c, tcur, tnext_is_f8) do { const CvTile done_ = (c); \
        if (done_.gain) { const int nbl_ = done_.N / 256; const float* gp_ = done_.gain + 128 * (done_.r / nbl_) + wave * 16; _Pragma("unroll") for (int i_ = 0; i_ < 16; ++i_) (v)[i_] = (v)[i_] * gp_[i_]; } \
        if (done_.f8) { cv8_to_lds(v, T8 + par * 32768, wave, lane); LDS_WAIT(); __syncthreads(); } else { CV_TOLDS(v); } \
        tcur += 2 * step; if (tcur < t1) { (c) = cv_decode(P, tcur); CV_LOAD(v, c); } \
        if (done_.f8) { cv8_out(done_, T8 + par * 32768, tid_); par ^= 1; if (!(tnext_is_f8)) { LDS_WAIT(); __syncthreads(); } } \
        else { cv_tile_out(done_, S, tid_); LDS_WAIT(); __syncthreads(); } } while (0)
    int ta = t0, tb = t0 + step, par = 0;
    CvTile ca = cv_decode(P, ta), cb = ca; CV_LOAD(va, ca);
    if (tb < t1) { cb = cv_decode(P, tb); CV_LOAD(vb, cb); }
    for (;;) {
        { const bool nf8 = (tb < t1) && cb.f8; CV_STEP(va, ca, ta, nf8); }
        if (tb >= t1) break;
        { const bool nf8 = (ta < t1) && ca.f8; CV_STEP(vb, cb, tb, nf8); }
        if (ta >= t1) break;
    }
#undef CV_LOAD
#undef CV_TOLDS
#undef CV_STEP
}
__device__ __forceinline__ void attn_conv_phase(const Ptrs& P, const att::AttnArgs& A, int layer, unsigned* qctr, unsigned char* lds, const int wave_) {
    char* shm = (char*)lds + RING_OFF;
    int* TK = (int*)(shm + att::L_MSK) + 4;
    const bool t0_ = (wave_ == 0 && lane_id() == 0);
    int nxt_ = 0; if (t0_) nxt_ = (int)__hip_atomic_fetch_add(qctr, 1u, __ATOMIC_RELAXED, __HIP_MEMORY_SCOPE_AGENT);
    bool selrdy = false;
    for (;;) {
        __syncthreads();
        if (t0_) TK[0] = nxt_;
        __syncthreads();
        const int tk = __builtin_amdgcn_readfirstlane(TK[0]);
        if (tk >= att::N_TICKETS) break;
        if (t0_) nxt_ = (int)__hip_atomic_fetch_add(qctr, 1u, __ATOMIC_RELAXED, __HIP_MEMORY_SCOPE_AGENT);
        const int code = att::ATT_ORDER.v[tk];
        if (code & 0x8000) {
            const int t0 = CV_L0 + (layer * att::N_CHUNKS + (code & 0x7fff)) * att::CHUNK_TILES;
            convert_weights(P, (LAS unsigned char*)lds, t0, 1, t0 + att::CHUNK_TILES, wave_, lane_id());
        } else if (code & 0x4000) {
            if (!selrdy) { if (t0_) { unsigned spins = 0; while (att::ld_sc1(A.mdone) < (unsigned)att::N_SEL && ++spins < (1u << 24)) __builtin_amdgcn_s_sleep(8); } selrdy = true; __syncthreads(); }
            att::attn_unit<3>(A, (code >> 11) & 1, 6 + ((code >> 8) & 7), code & 0xff, shm, wave_);
        } else if (code & 0x2000) {
            att::moba_select(A, (code >> 9) & 1, 6 + ((code >> 6) & 7), code & 63, shm, wave_);
        } else {
            const int mode = code >> 10, b = (code >> 9) & 1, hr = (code >> 6) & 7, sub = code & 63;
            const int h = (mode == 0) ? hr : ((mode == 1) ? 6 + hr : 11 + hr);
            if (mode == 0) att::attn_unit<0>(A, b, h, sub, shm, wave_); else if (mode == 1) att::attn_unit<1>(A, b, h, sub, shm, wave_); else att::attn_unit<2>(A, b, h, sub, shm, wave_);
        }
    }
}
template <bool F8, bool SRC16, int NR> __device__ __forceinline__ void norm_rows(const void* srcv, const float* gain, void* dstv, int vcu, int G, int wave, int lane) {
    asm volatile("" : "+v"(lane));
    const int gw = vcu * NWAVES + wave, NGW = G * NWAVES;
    f32x4 g[8];
#pragma unroll
    for (int j = 0; j < 8; ++j) g[j] = ((const GAS f32x4*)gain)[lane + 64 * j];
    for (int m0 = gw; m0 < M; m0 += NR * NGW) {
        f32x4 v[NR][8];
#pragma unroll
        for (int q = 0; q < NR; ++q) { const int mq = m0 + q * NGW; const int m = mq < M ? mq : m0;
            if constexpr (SRC16) { const GAS u32x2_g* xr = (const GAS u32x2_g*)((const bf16*)srcv + (size_t)m * D) + lane;
#pragma unroll
                for (int j = 0; j < 8; ++j) v[q][j] = bf4_to_f32(xr[64 * j]); }
            else { const GAS f32x4* xr = (const GAS f32x4*)((const float*)srcv + (size_t)m * D) + lane;
#pragma unroll
                for (int j = 0; j < 8; ++j) v[q][j] = xr[64 * j]; } }
#pragma unroll
        for (int q = 0; q < NR; ++q) { const int m = m0 + q * NGW; if (m >= M) break;
            float s = 0.f;
#pragma unroll
            for (int j = 0; j < 8; ++j) s += (v[q][j].x * v[q][j].x + v[q][j].y * v[q][j].y) + (v[q][j].z * v[q][j].z + v[q][j].w * v[q][j].w);
            const float r = 1.0f / sqrtf(wave_sum(s) * (1.0f / D) + EPS);
            if constexpr (F8) { GAS unsigned* o4 = (GAS unsigned*)((unsigned char*)dstv + (size_t)m * D) + lane;
#pragma unroll
                for (int j = 0; j < 8; ++j) o4[64 * j] = pg8::pk4_fp8(v[q][j].x * r * g[j].x, v[q][j].y * r * g[j].y, v[q][j].z * r * g[j].z, v[q][j].w * r * g[j].w); }
            else { GAS unsigned long long* o8 = (GAS unsigned long long*)((bf16*)dstv + (size_t)m * D) + lane;
#pragma unroll
                for (int j = 0; j < 8; ++j) o8[64 * j] = (unsigned long long)pk2(v[q][j].x * r * g[j].x, v[q][j].y * r * g[j].y) | ((unsigned long long)pk2(v[q][j].z * r * g[j].z, v[q][j].w * r * g[j].w) << 32); }
        }
    }
}
__device__ __forceinline__ void prep_phase(const Ptrs& P, int layer, LAS unsigned char* lds, int vcu, int G, int tid, int wave, int lane) {
    asm volatile("" : "+v"(lane), "+v"(tid));
    LAS float* red = (LAS float*)(lds + RING_OFF);
    const int tsub = lane >> 4, c = lane & 15;
#define PREP_ADDR(it_) (P.QKV + ((size_t)(((it_) / 22) >> 4) * SEQ + (((it_) / 22) & 15) * 256 + wave * 32 + tsub) * NQKV + ((((it_) % 22) >= 11) ? 2048 + (((it_) % 22) - 11) * 128 : ((it_) % 22) * 128) + 8 * c)
    v4u raws[8], rawn[8];
    if (vcu < 32 * 22) { bf16* const q0_ = PREP_ADDR(vcu);
#pragma unroll
        for (int i8 = 0; i8 < 8; ++i8) raws[i8] = *(const GAS v4u*)(q0_ + (size_t)(i8 * 4) * NQKV); }
    for (int it = vcu; it < 32 * 22; it += G) {
        const int v = it % 22, blk = it / 22, b = blk >> 4, n = blk & 15;
        if (it + G < 32 * 22) { bf16* const q1_ = PREP_ADDR(it + G);
#pragma unroll
            for (int i8 = 0; i8 < 8; ++i8) rawn[i8] = *(const GAS v4u*)(q1_ + (size_t)(i8 * 4) * NQKV); }
        const bool isk = v >= 11; const int hh = isk ? v - 11 : v;
        const int col0 = (isk ? 2048 : 0) + hh * 128;
        const float* gp = (isk ? P.k_gain : P.q_gain) + layer * 256 + (hh >= 6 ? 128 : 0) + 8 * c;
        const f32x4 g0 = *(const f32x4*)gp, g1 = *(const f32x4*)(gp + 4);
        const bool km = isk && hh >= 6;
        float cs[8];
#pragma unroll
        for (int e = 0; e < 8; ++e) cs[e] = 0.f;
        bf16* const p0_ = P.QKV + ((size_t)b * SEQ + n * 256 + wave * 32 + tsub) * NQKV + col0 + 8 * c;
#pragma unroll
        for (int i8 = 0; i8 < 8; ++i8) {
            bf16* p = p0_ + (size_t)(i8 * 4) * NQKV;
            const v4u raw = raws[i8];
            float x[8]; x[0] = bf2f_u((unsigned short)(raw.x & 0xffff)); x[1] = bf2f_u((unsigned short)(raw.x >> 16)); x[2] = bf2f_u((unsigned short)(raw.y & 0xffff)); x[3] = bf2f_u((unsigned short)(raw.y >> 16));
            x[4] = bf2f_u((unsigned short)(raw.z & 0xffff)); x[5] = bf2f_u((unsigned short)(raw.z >> 16)); x[6] = bf2f_u((unsigned short)(raw.w & 0xffff)); x[7] = bf2f_u((unsigned short)(raw.w >> 16));
            float ss = 0.f;
#pragma unroll
            for (int e = 0; e < 8; ++e) ss = fmaf(x[e], x[e], ss);
            ss += xor_get<1>(ss); ss += xor_get<2>(ss); ss += xor_get<4>(ss); ss += xor_get<8>(ss);
            const float r = (isk ? 1.0f : att::C2) / sqrtf(ss * (1.0f / 128.0f) + EPS);
            float y[8];
            y[0] = x[0] * r * g0.x; y[1] = x[1] * r * g0.y; y[2] = x[2] * r * g0.z; y[3] = x[3] * r * g0.w;
            y[4] = x[4] * r * g1.x; y[5] = x[5] * r * g1.y; y[6] = x[6] * r * g1.z; y[7] = x[7] * r * g1.w;
            v4u o; o.x = pk2(y[0], y[1]); o.y = pk2(y[2], y[3]); o.z = pk2(y[4], y[5]); o.w = pk2(y[6], y[7]);
            *(GAS v4u*)p = o;
#pragma unroll
            for (int e = 0; e < 8; ++e) cs[e] += y[e];
        }
        if (km) {
#pragma unroll
            for (int e = 0; e < 8; ++e) { cs[e] += xor_get<16>(cs[e]); cs[e] = xor32_sum(cs[e]); }
            if (lane < 16) {
#pragma unroll
                for (int e = 0; e < 8; ++e) red[wave * 128 + 8 * c + e] = cs[e]; }
            LDS_WAIT(); __syncthreads();
            if (tid < 128) { float s = 0.f;
#pragma unroll
                for (int w = 0; w < 8; ++w) s += red[w * 128 + tid];
                P.kmean[(size_t)((b * 5 + (hh - 6)) * 16 + n) * 128 + tid] = s * (1.0f / 256.0f); }
            LDS_WAIT(); __syncthreads();
        }
#pragma unroll
        for (int i8 = 0; i8 < 8; ++i8) raws[i8] = rawn[i8];
    }
#undef PREP_ADDR
}
__device__ __forceinline__ void dcombine_phase(const Ptrs& P, const float* gain, int vcu, int G, int wave, int lane) {
    asm volatile("" : "+v"(lane));
    const int gw = vcu * NWAVES + wave, NGW = G * NWAVES; const int c = lane & 15; constexpr int NIT = M * 11 / 4;
    constexpr int NQ = 4;
    for (int it0 = gw; it0 < NIT; it0 += NQ * NGW) {
        int tok[NQ], hh[NQ]; float ls[NQ][4]; v4u raw[NQ][4];
#pragma unroll
        for (int q = 0; q < NQ; ++q) { const int itq = it0 + q * NGW; const int it = itq < NIT ? itq : it0; const int pair = it * 4 + (lane >> 4); tok[q] = pair / 11; hh[q] = pair - tok[q] * 11;
#pragma unroll
            for (int p = 0; p < 3; ++p) { ls[q][p] = P.DPL[((size_t)p * M + tok[q]) * 16 + hh[q]]; raw[q][p] = *(const GAS v4u*)(P.DPO + ((size_t)p * M + tok[q]) * 1408 + hh[q] * 128 + 8 * c); }
            ls[q][3] = -__builtin_inff(); raw[q][3] = (v4u){0u, 0u, 0u, 0u};
            if (hh[q] >= 6) { ls[q][3] = P.DPL[((size_t)3 * M + tok[q]) * 16 + hh[q]]; raw[q][3] = *(const GAS v4u*)(P.DPO + ((size_t)3 * M + tok[q]) * 1408 + hh[q] * 128 + 8 * c); } }
#pragma unroll
        for (int q = 0; q < NQ; ++q) { if (it0 + q * NGW >= NIT) break;
            const float mx = fmaxf(fmaxf(ls[q][0], ls[q][1]), fmaxf(ls[q][2], ls[q][3]));
            float w0 = __builtin_amdgcn_exp2f(ls[q][0] - mx), w1 = __builtin_amdgcn_exp2f(ls[q][1] - mx), w2 = __builtin_amdgcn_exp2f(ls[q][2] - mx), w3 = __builtin_amdgcn_exp2f(ls[q][3] - mx);
            const float inv = 1.0f / (w0 + w1 + w2 + w3); w0 *= inv; w1 *= inv; w2 *= inv; w3 *= inv;
            float acc[8];
#pragma unroll
            for (int e = 0; e < 8; ++e) acc[e] = 0.f;
#pragma unroll
            for (int p = 0; p < 4; ++p) { const v4u r_ = raw[q][p]; const float w = (p == 0) ? w0 : ((p == 1) ? w1 : ((p == 2) ? w2 : w3));
                acc[0] += w * bf2f_u((unsigned short)(r_.x & 0xffff)); acc[1] += w * bf2f_u((unsigned short)(r_.x >> 16)); acc[2] += w * bf2f_u((unsigned short)(r_.y & 0xffff)); acc[3] += w * bf2f_u((unsigned short)(r_.y >> 16));
                acc[4] += w * bf2f_u((unsigned short)(r_.z & 0xffff)); acc[5] += w * bf2f_u((unsigned short)(r_.z >> 16)); acc[6] += w * bf2f_u((unsigned short)(r_.w & 0xffff)); acc[7] += w * bf2f_u((unsigned short)(r_.w >> 16)); }
            float ss = 0.f;
#pragma unroll
            for (int e = 0; e < 8; ++e) ss = fmaf(acc[e], acc[e], ss);
            ss += xor_get<1>(ss); ss += xor_get<2>(ss); ss += xor_get<4>(ss); ss += xor_get<8>(ss);
            const float rn = 1.0f / sqrtf(ss * (1.0f / 128.0f) + EPS);
            const f32x4 g0 = *(const f32x4*)(gain + hh[q] * 128 + 8 * c), g1 = *(const f32x4*)(gain + hh[q] * 128 + 8 * c + 4);
            v4u o; o.x = pk2(acc[0] * rn * g0.x, acc[1] * rn * g0.y); o.y = pk2(acc[2] * rn * g0.z, acc[3] * rn * g0.w); o.z = pk2(acc[4] * rn * g1.x, acc[5] * rn * g1.y); o.w = pk2(acc[6] * rn * g1.z, acc[7] * rn * g1.w);
            *(GAS v4u*)(P.OB + (size_t)tok[q] * D + hh[q] * 128 + 8 * c) = o; }
    }
}
__device__ __forceinline__ void router_phase(const Ptrs& P, const float* gain, LAS unsigned char* lds, int vcu, int G, int tid, int wave, int lane) {
    asm volatile("" : "+v"(lane), "+v"(tid));
    LAS unsigned* lcnt = (LAS unsigned*)(lds + RING_OFF);
    LAS unsigned* rinfo = (LAS unsigned*)(lds + RING_OFF + 256);
    if (tid < 16) lcnt[tid] = 0u;
    LAS f32x4* LT = (LAS f32x4*)(lds + RING_OFF + 4096);
    for (int i = tid; i < 2 * D; i += NWAVES * 64) { const int d = i >> 1, eq = i & 1; LT[eq * D + d] = ((const GAS f32x4*)P.router)[i]; }
    LDS_WAIT(); __syncthreads();
    int gw = vcu * NWAVES + wave; asm volatile("" : "+s"(gw));
    const int NGW = G * NWAVES;
    int li = wave;
    for (int m = gw; m < M; m += NGW, li += NWAVES) {
        const GAS u32x2_g* xr = (const GAS u32x2_g*)(P.H + (size_t)m * D) + lane;
        f32x4 v[8]; float s = 0.f;
#pragma unroll
        for (int j = 0; j < 8; ++j) { v[j] = bf4_to_f32(xr[64 * j]); s += (v[j].x * v[j].x + v[j].y * v[j].y) + (v[j].z * v[j].z + v[j].w * v[j].w); }
        const float r = 1.0f / sqrtf(wave_sum(s) * (1.0f / D) + EPS);
        float lg[8];
#pragma unroll
        for (int e = 0; e < 8; ++e) lg[e] = 0.f;
        GAS unsigned* o4 = (GAS unsigned*)(P.AB8 + (size_t)m * D) + lane;
#pragma unroll
        for (int j = 0; j < 8; ++j) { const f32x4 g = ((const GAS f32x4*)gain)[lane + 64 * j];
            const float f0 = v[j].x * r * g.x, f1 = v[j].y * r * g.y, f2 = v[j].z * r * g.z, f3 = v[j].w * r * g.w;
            o4[64 * j] = pg8::pk4_fp8(f0, f1, f2, f3);
            const LAS f32x4* rw = LT + 256 * j + 4 * lane;
            const f32x4 a0 = rw[0], a1 = rw[D], b0 = rw[1], b1 = rw[D + 1], c0 = rw[2], c1 = rw[D + 2], d0 = rw[3], d1 = rw[D + 3];
            lg[0] += f0 * a0.x + f1 * b0.x + f2 * c0.x + f3 * d0.x; lg[1] += f0 * a0.y + f1 * b0.y + f2 * c0.y + f3 * d0.y;
            lg[2] += f0 * a0.z + f1 * b0.z + f2 * c0.z + f3 * d0.z; lg[3] += f0 * a0.w + f1 * b0.w + f2 * c0.w + f3 * d0.w;
            lg[4] += f0 * a1.x + f1 * b1.x + f2 * c1.x + f3 * d1.x; lg[5] += f0 * a1.y + f1 * b1.y + f2 * c1.y + f3 * d1.y;
            lg[6] += f0 * a1.z + f1 * b1.z + f2 * c1.z + f3 * d1.z; lg[7] += f0 * a1.w + f1 * b1.w + f2 * c1.w + f3 * d1.w; }
#pragma unroll
        for (int e = 0; e < 8; ++e) lg[e] = wave_sum(lg[e]);
        int e0 = 0; float b0v = lg[0];
#pragma unroll
        for (int e = 1; e < 8; ++e) if (lg[e] > b0v) { b0v = lg[e]; e0 = e; }
        int e1 = -1; float b1v = -__builtin_inff();
#pragma unroll
        for (int e = 0; e < 8; ++e) if (e != e0 && lg[e] > b1v) { b1v = lg[e]; e1 = e; }
        const float g1 = 1.0f / (1.0f + __expf(b0v - b1v)), g0 = 1.0f - g1;
        if (lane == 0) {
            const unsigned k0 = __hip_atomic_fetch_add(lcnt + e0, 1u, __ATOMIC_RELAXED, __HIP_MEMORY_SCOPE_WORKGROUP);
            const unsigned k1 = __hip_atomic_fetch_add(lcnt + e1, 1u, __ATOMIC_RELAXED, __HIP_MEMORY_SCOPE_WORKGROUP);
            rinfo[li * 4 + 0] = (unsigned)e0 | ((unsigned)e1 << 8); rinfo[li * 4 + 1] = k0; rinfo[li * 4 + 2] = k1;
            P.sel_g[2 * m] = g0; P.sel_g[2 * m + 1] = g1;
        }
    }
    LDS_WAIT(); __syncthreads();
    if (tid < 8) lcnt[8 + tid] = __hip_atomic_fetch_add(P.ctl + CW_CNT + 64 * tid, lcnt[tid], RLX_AGENT);
    LDS_WAIT(); __syncthreads();
    li = wave;
    for (int m = gw; m < M; m += NGW, li += NWAVES) {
        if (lane == 0) { const unsigned ee = rinfo[li * 4 + 0]; const unsigned e0 = ee & 0xffu, e1 = ee >> 8;
            P.sel_e[m] = ee; P.sel_rel[2 * m] = (int)(lcnt[8 + e0] + rinfo[li * 4 + 1]); P.sel_rel[2 * m + 1] = (int)(lcnt[8 + e1] + rinfo[li * 4 + 2]); }
    }
}
__device__ __forceinline__ void build_tile_table(const Ptrs& P, bool moe, volatile LAS unsigned* MISC, int tid) {
    if (tid == 0) { unsigned t = 0u; MISC[16] = 0u;
        for (int e = 0; e < 8; ++e) { const unsigned cnt = moe ? __hip_atomic_load(P.ctl + CW_CNT + 64 * e, RLX_AGENT) : (e == 0 ? (unsigned)M : 0u); t += (cnt + 255u) >> 8; if (t > (unsigned)(MPAD / 256)) t = MPAD / 256; MISC[17 + e] = t; } }
    LDS_WAIT(); __syncthreads();
}
__device__ __forceinline__ void scatter_phase(const Ptrs& P, volatile LAS unsigned* MISC, int vcu, int G, int wave, int lane) {
    asm volatile("" : "+v"(lane));
    const int gw = vcu * NWAVES + wave, NGW = G * NWAVES;
    constexpr int NR = 4;
    for (int m0 = gw; m0 < M; m0 += NR * NGW) {
        unsigned ee[NR]; int r0[NR], r1[NR]; v4u a0[NR], a1[NR];
#pragma unroll
        for (int q = 0; q < NR; ++q) { const int mq = m0 + q * NGW; const int m = mq < M ? mq : m0;
            ee[q] = P.sel_e[m]; r0[q] = P.sel_rel[2 * m]; r1[q] = P.sel_rel[2 * m + 1];
            const GAS v4u* sp = (const GAS v4u*)(P.AB8 + (size_t)m * D) + lane; a0[q] = sp[0]; a1[q] = sp[64]; }
#pragma unroll
        for (int q = 0; q < NR; ++q) { const int m = m0 + q * NGW; if (m >= M) break;
            const int p0 = (int)(256u * MISC[16 + (ee[q] & 0xffu)]) + r0[q], p1 = (int)(256u * MISC[16 + ((ee[q] >> 8) & 0xffu)]) + r1[q];
            if (lane == 0) { P.sel_pos[2 * m] = p0; P.sel_pos[2 * m + 1] = p1; }
            GAS v4u* d0 = (GAS v4u*)(P.XS + (size_t)p0 * D) + lane; GAS v4u* d1 = (GAS v4u*)(P.XS + (size_t)p1 * D) + lane;
            d0[0] = a0[q]; d0[64] = a1[q]; d1[0] = a0[q]; d1[64] = a1[q]; }
    }
}
__device__ __forceinline__ void combine_phase(const Ptrs& P, int vcu, int G, int wave, int lane) {
    asm volatile("" : "+v"(lane));
    const int gw = vcu * NWAVES + wave, NGW = G * NWAVES;
    typedef unsigned u32x2_t __attribute__((ext_vector_type(2)));
    for (int m0 = gw; m0 < M; m0 += 2 * NGW) {
        const int m1 = m0 + NGW; const bool has1 = m1 < M; const int mm[2] = {m0, has1 ? m1 : m0};
        int pa[2], pb[2]; float ga[2], gb[2];
#pragma unroll
        for (int q = 0; q < 2; ++q) { pa[q] = P.sel_pos[2 * mm[q]]; pb[q] = P.sel_pos[2 * mm[q] + 1]; ga[q] = P.sel_g[2 * mm[q]]; gb[q] = P.sel_g[2 * mm[q] + 1]; }
        f32x4 ya[2][8], yb[2][8], hv[2][8];
#pragma unroll
        for (int q = 0; q < 2; ++q) { const GAS u32x2_t* y0 = (const GAS u32x2_t*)(P.YS + (size_t)pa[q] * D) + lane; const GAS u32x2_t* y1 = (const GAS u32x2_t*)(P.YS + (size_t)pb[q] * D) + lane;
            const GAS u32x2_g* hr = (const GAS u32x2_g*)(P.H + (size_t)mm[q] * D) + lane;
#pragma unroll
            for (int j = 0; j < 8; ++j) { ya[q][j] = bf4_to_f32(y0[64 * j]); yb[q][j] = bf4_to_f32(y1[64 * j]); hv[q][j] = bf4_to_f32(hr[64 * j]); } }
#pragma unroll
        for (int q = 0; q < 2; ++q) { if (q == 1 && !has1) break;
            if (pa[q] >= 16384) { const GAS u32x2_t* z0 = (const GAS u32x2_t*)(P.YS + (size_t)MPAD * D + (size_t)pa[q] * D) + lane;
#pragma unroll
                for (int j = 0; j < 8; ++j) ya[q][j] += bf4_to_f32(z0[64 * j]); }
            if (pb[q] >= 16384) { const GAS u32x2_t* z1 = (const GAS u32x2_t*)(P.YS + (size_t)MPAD * D + (size_t)pb[q] * D) + lane;
#pragma unroll
                for (int j = 0; j < 8; ++j) yb[q][j] += bf4_to_f32(z1[64 * j]); }
            GAS f32x4* orow = (GAS f32x4*)(P.out + (size_t)mm[q] * D) + lane;
#pragma unroll
            for (int j = 0; j < 8; ++j) orow[64 * j] = hv[q][j] + ya[q][j] * ga[q] + yb[q][j] * gb[q]; }
    }
}

struct Args { const float* in[15]; float* out; unsigned char* ws; int ph_lo, ph_hi, qoff, pad; };
__device__ __forceinline__ Ptrs make_ptrs(const Args& args, unsigned char* ws0) {
    int z = 0; asm volatile("" : "+s"(z));
    const float* const* in = args.in + z;
    unsigned char* ws = ws0 + z;
    Ptrs P;
    P.x = in[0]; P.attn_norm = in[1]; P.w_in = in[2]; P.q_gain = in[3]; P.k_gain = in[4]; P.out_gain = in[5]; P.w_out = in[6]; P.ffn_norm = in[7];
    P.dwg = in[8]; P.dwu = in[9]; P.dwd = in[10]; P.router = in[11]; P.mwg = in[12]; P.mwu = in[13]; P.mwd = in[14];
    P.out = args.out; P.ctl = (gu32*)(ws + WS_CTL);
    P.Wqkv_t = (bf16*)(ws + WS_WQKV); P.Wo_t = (bf16*)(ws + WS_WO); P.Wgu_d = ws + WS_WGU_D; P.Wd_d = ws + WS_WD_D; P.Wgu_m = ws + WS_WGU_M; P.Wd_m = ws + WS_WD_M;
    P.QKV = (bf16*)(ws + WS_QKV); P.OB = (bf16*)(ws + WS_O); P.AB = (bf16*)(ws + WS_A); P.AB8 = ws + WS_A; P.ACT = ws + WS_ACT; P.XS = ws + WS_XS;
    P.H = (bf16*)(ws + WS_H); P.YS = (bf16*)(ws + WS_YS); P.kmean = (float*)(ws + WS_MISC + MISC_KMEAN); P.DPO = (bf16*)(ws + WS_DPO); P.DPL = (float*)(ws + WS_DPL);
    P.rsq = (float*)(ws + WS_MISC + MISC_RSQ);
    P.sel_e = (unsigned*)(ws + WS_MISC + MISC_SELE); P.sel_rel = (int*)(ws + WS_MISC + MISC_SELREL); P.sel_g = (float*)(ws + WS_MISC + MISC_SELG); P.sel_pos = (int*)(ws + WS_MISC + MISC_SELPOS);
    return P;
}
__global__ void __launch_bounds__(NWAVES * 64, 2) hybrid_fwd(Args args) {
    extern __shared__ __attribute__((aligned(16))) unsigned char lds[];
    LAS unsigned char* ldsL = (LAS unsigned char*)lds;
    volatile LAS unsigned* MISC = (volatile LAS unsigned*)(ldsL + MISC_OFF);
    const int wave = __builtin_amdgcn_readfirstlane((int)threadIdx.x >> 6);
#define tid (tid_of(wave))
#define lane (lane_id())
    const int G = gridDim.x; int vcu; { const int bx = blockIdx.x; vcu = (G % 8 == 0) ? (bx % 8) * (G / 8) + bx / 8 : bx; }
    for (int u = tid; u < (LDS_BYTES - LDSCTL_OFF) / 4; u += NWAVES * 64) ((LAS unsigned*)(ldsL + LDSCTL_OFF))[u] = 0u;
    __syncthreads();
    int z0 = 0; asm volatile("" : "+s"(z0)); unsigned char* ws0 = args.ws + z0;
    unsigned* const barw = (unsigned*)(ws0 + WS_CTL) + CW_BAR;
    XcdBarrier bar; bar.bar = barw; bar.x = 0; bar.st = nullptr; bar.wv = wave;
    if (!MK_SPLIT) { bar = xcd_barrier_post(barw, MISC + 8, wave); }
    const int lo = args.ph_lo, hi = args.ph_hi;
#define PH(k) (lo <= (k) && (k) < hi)
#define SEAM(a, b) do { if (PH(a) && PH(b)) { int zb_ = 0; asm volatile("" : "+s"(zb_)); XcdBarrier b2_ = bar; b2_.bar = bar.bar + zb_; xcd_barrier(b2_); } } while (0)

    for (int layer = 0; layer < 2; ++layer) {
        const int PB = layer * PPL;
        if (layer == 0 && PH(PB + 0)) {
            const Ptrs P = make_ptrs(args, ws0);
            #ifndef NO_P0
            if (layer == 0) convert_weights(P, ldsL, vcu, G, CV_L0, wave, lane);
            if (layer == 0) norm_rows<false, false, 4>(P.x, P.attn_norm, P.AB, vcu, G, wave, lane);
#endif
        }
        if (layer == 0) SEAM(PB + 0, PB + 1);
        if (PH(PB + 1)) {
            const Ptrs P = make_ptrs(args, ws0);
            pg8::Gemm g{layer == 0 ? P.AB : P.H, P.Wqkv_t + (size_t)layer * NQKV * D, M, NQKV, D}; pg8::StaticOrder S; S.init(M, NQKV, G, (int)blockIdx.x);
            pg8::EpiQKV E{P.QKV, NQKV, P.q_gain + layer * 256, P.k_gain + layer * 256, P.kmean, (LAS float*)(ldsL + RING_OFF + RING_BYTES), layer == 0 ? nullptr : P.rsq};
#ifndef NO_P1
            pg8::gemm_phase<pg8::EpiQKV, pg8::StaticOrder, true, true>(ldsL + RING_OFF, g, S, E, wave);
#endif
        }
        SEAM(PB + 1, PB + 3);
        if (PH(PB + 3)) {
            const Ptrs P = make_ptrs(args, ws0);
            const att::AttnArgs AA{P.QKV, P.OB, P.kmean, P.out_gain + layer * D, P.DPO, P.DPL, (unsigned*)((unsigned char*)P.DPL + (WS_MLIST - WS_DPL)) + (size_t)layer * att::N_SEL * att::MLCAP, (unsigned*)(P.ctl + CW_MCNT + 256 * (layer + args.qoff)), (unsigned*)(P.ctl + CW_MDONE + 64 * (layer + args.qoff))};
#ifndef NO_P3
            attn_conv_phase(P, AA, layer, (unsigned*)(P.ctl + CW_ATTQ + 64 * (layer + args.qoff)), lds, wave);
#endif
        }
        SEAM(PB + 3, PB + 4);
#ifndef NO_P4B
        if (PH(PB + 4)) { const Ptrs P = make_ptrs(args, ws0); dcombine_phase(P, P.out_gain + layer * D, vcu, G, wave, lane); }
#endif
        SEAM(PB + 4, PB + 5);
        if (PH(PB + 5)) {
            const Ptrs P = make_ptrs(args, ws0);
            pg8::Gemm g{P.OB, P.Wo_t + (size_t)layer * D * D, M, D, D}; pg8::StaticOrder S; S.init(M, D, G, (int)blockIdx.x);
            pg8::EpiResF32 E{layer == 0 ? P.x : nullptr, layer == 0 ? nullptr : P.H, P.H, D, nullptr, nullptr, (LAS float*)(ldsL + RING_OFF + RING_BYTES)};
#ifndef NO_P4
            pg8::gemm_phase<pg8::EpiResF32, pg8::StaticOrder, true, true>(ldsL + RING_OFF, g, S, E, wave);
#endif
        }
        SEAM(PB + 5, PB + 6);
        if (PH(PB + 6)) {
            const Ptrs P = make_ptrs(args, ws0);
#ifndef NO_P5
            if (layer == 0) norm_rows<true, true, 4>(P.H, P.ffn_norm, P.AB8, vcu, G, wave, lane);
            else router_phase(P, P.ffn_norm + D, ldsL, vcu, G, tid, wave, lane);
#endif
        }
        if (layer == 1) {
            SEAM(PB + 6, PB + 7);
#ifndef NO_P6
            if (PH(PB + 7)) { const Ptrs P = make_ptrs(args, ws0); build_tile_table(P, true, MISC, tid); scatter_phase(P, MISC, vcu, G, wave, lane); }
#endif
            SEAM(PB + 7, PB + 8);
        } else SEAM(PB + 6, PB + 8);
        if (PH(PB + 8)) {
            const Ptrs P = make_ptrs(args, ws0);
            build_tile_table(P, layer == 1, MISC, tid);
            pg8::GroupSched S; S.nMt = __builtin_amdgcn_readfirstlane((int)MISC[24]); S.nN = NGU / 256; S.nwg = S.nMt * S.nN; S.G = G; S.c = (int)blockIdx.x;
            S.t1 = __builtin_amdgcn_readfirstlane((int)MISC[17]); S.t2 = __builtin_amdgcn_readfirstlane((int)MISC[18]); S.t3 = __builtin_amdgcn_readfirstlane((int)MISC[19]); S.t4 = __builtin_amdgcn_readfirstlane((int)MISC[20]);
            S.t5 = __builtin_amdgcn_readfirstlane((int)MISC[21]); S.t6 = __builtin_amdgcn_readfirstlane((int)MISC[22]); S.t7 = __builtin_amdgcn_readfirstlane((int)MISC[23]); S.estride = (size_t)NGU * D; S.nfullM = 1 << 20; S.ntail = 0; S.khalf = 0;
            pg8::Gemm g{(const bf16*)(layer == 0 ? P.AB8 : P.XS), (const bf16*)(layer == 0 ? P.Wgu_d : P.Wgu_m), MPAD, NGU, D / 2};
            pg8::EpiSwiGLU8 E{P.ACT, FF};
#ifndef NO_P7
            pg8::gemm_phase<pg8::EpiSwiGLU8, pg8::GroupSched, true, true, true>(ldsL + RING_OFF, g, S, E, wave);
#endif
        }
        SEAM(PB + 8, PB + 9);
        if (PH(PB + 9)) {
            const Ptrs P = make_ptrs(args, ws0);
            build_tile_table(P, layer == 1, MISC, tid);
            pg8::GroupSched S; S.nMt = __builtin_amdgcn_readfirstlane((int)MISC[24]); S.nN = D / 256; S.nwg = S.nMt * S.nN; S.G = G; S.c = (int)blockIdx.x;
            S.t1 = __builtin_amdgcn_readfirstlane((int)MISC[17]); S.t2 = __builtin_amdgcn_readfirstlane((int)MISC[18]); S.t3 = __builtin_amdgcn_readfirstlane((int)MISC[19]); S.t4 = __builtin_amdgcn_readfirstlane((int)MISC[20]);
            S.t5 = __builtin_amdgcn_readfirstlane((int)MISC[21]); S.t6 = __builtin_amdgcn_readfirstlane((int)MISC[22]); S.t7 = __builtin_amdgcn_readfirstlane((int)MISC[23]); S.estride = (size_t)D * FF;
            if (layer == 1 && S.nMt > 64) { S.nfullM = 64; S.ntail = FF / 128 / 2; S.khalf = FF / 2; S.nwg = 64 * S.nN + 2 * S.nN * (S.nMt - 64); } else { S.nfullM = 1 << 20; S.ntail = 0; S.khalf = 0; }
            pg8::Gemm g{(const bf16*)P.ACT, (const bf16*)(layer == 0 ? P.Wd_d : P.Wd_m), MPAD, D, FF / 2};
            pg8::EpiResF32 E{nullptr, layer == 0 ? P.H : nullptr, layer == 0 ? P.H : P.YS, D, P.YS + (size_t)MPAD * D, layer == 0 ? P.rsq : nullptr, (LAS float*)(ldsL + RING_OFF + RING_BYTES)};
#ifndef NO_P8
            pg8::gemm_phase<pg8::EpiResF32, pg8::GroupSched, true, true, true>(ldsL + RING_OFF, g, S, E, wave);
#endif
        }
        if (layer == 0) SEAM(PB + 9, PB + 12);
        else { SEAM(PB + 9, PB + 10);
#ifndef NO_P9
            if (PH(PB + 10)) { const Ptrs P = make_ptrs(args, ws0); combine_phase(P, vcu, G, wave, lane); }
#endif
        }
    }
#undef PH
#undef SEAM
#undef tid
#undef lane
}

extern "C" void kernel_launch(void* const* d_in, const int* in_sizes, int n_in, void* d_out, int out_size, void* d_ws, size_t ws_size, hipStream_t stream) {
    static int grid = 0;
    if (grid == 0) {
        if (n_in != 15 || in_sizes[0] != M * D || out_size != M * D || ws_size < WS_END) { fprintf(stderr, "kernel_launch: unexpected shapes / workspace (n_in %d, in0 %d, out %d, ws %zu < %zu); nothing launched\n", n_in, n_in > 0 ? in_sizes[0] : -1, out_size, ws_size, (size_t)WS_END); grid = -1; return; }
        int dev = 0, cus = 0, per_cu = 0;
        if (hipGetDevice(&dev) != hipSuccess || hipDeviceGetAttribute(&cus, hipDeviceAttributeMultiprocessorCount, dev) != hipSuccess) { fprintf(stderr, "kernel_launch: device query failed\n"); grid = -1; return; }
        if (hipFuncSetAttribute((const void*)hybrid_fwd, hipFuncAttributeMaxDynamicSharedMemorySize, LDS_BYTES) != hipSuccess) { fprintf(stderr, "kernel_launch: hipFuncSetAttribute failed\n"); grid = -1; return; }
        if (hipOccupancyMaxActiveBlocksPerMultiprocessor(&per_cu, (const void*)hybrid_fwd, NWAVES * 64, LDS_BYTES) != hipSuccess || per_cu < 1) fprintf(stderr, "kernel_launch: note: occupancy query reports %d workgroups per CU\n", per_cu);
        (void)hipGetLastError();
        grid = cus;
    }
    if (grid < 0) return;
    if (hipMemsetAsync((char*)d_ws + WS_CTL, 0, CTL_ZERO_BYTES, stream) != hipSuccess) { fprintf(stderr, "kernel_launch: memset failed\n"); return; }
    Args a{};
    for (int i = 0; i < 15; ++i) a.in[i] = (const float*)d_in[i];
    a.out = (float*)d_out; a.ws = (unsigned char*)d_ws;
#if MK_SPLIT
    for (int ph = 0; ph < N_PHASES; ++ph) {
        if (ph == 7 || ph == 10 || ph == 2 || ph == PPL + 2 || ph == PPL) continue;
        a.ph_lo = ph; a.ph_hi = ph + 1; a.qoff = 0;
        hipLaunchKernelGGL(hybrid_fwd, dim3(grid), dim3(NWAVES * 64), LDS_BYTES, stream, a);
#ifdef MK_PROBE_REPEAT
        if (((MK_PROBE_REPEAT) >> ph) & 1) { a.qoff = 2; hipLaunchKernelGGL(hybrid_fwd, dim3(grid), dim3(NWAVES * 64), LDS_BYTES, stream, a); }
#endif
    }
#else
    a.ph_lo = 0; a.ph_hi = N_PHASES;
    hipLaunchKernelGGL(hybrid_fwd, dim3(grid), dim3(NWAVES * 64), LDS_BYTES, stream, a);
#endif
    const hipError_t le = hipPeekAtLastError();
    if (le != hipSuccess) fprintf(stderr, "kernel_launch: launch failed: %s\n", hipGetErrorName(le));
}
```

```cpp
#include <hip/hip_runtime.h>
#include <cstdio>
#include <cstdint>
__device__ __forceinline__ int lane_id() { int l; asm volatile("v_mbcnt_lo_u32_b32 %0, -1, 0\n\tv_mbcnt_hi_u32_b32 %0, -1, %0" : "=v"(l)); return l; }
template <int MSK> __device__ __forceinline__ float xor_get(float v) {
    static_assert(MSK == 1 || MSK == 2 || MSK == 4 || MSK == 8 || MSK == 16, "xor_get: 1..16");
    if constexpr (MSK == 1) return __int_as_float(__builtin_amdgcn_update_dpp(0, __float_as_int(v), 0xB1, 0xF, 0xF, true));
    else if constexpr (MSK == 2) return __int_as_float(__builtin_amdgcn_update_dpp(0, __float_as_int(v), 0x4E, 0xF, 0xF, true));
    else return __int_as_float(__builtin_amdgcn_ds_swizzle(__float_as_int(v), 0x1F | (MSK << 10)));
}
__device__ __forceinline__ float xor32_sum(float v) { auto rr = __builtin_amdgcn_permlane32_swap(__float_as_uint(v), __float_as_uint(v), false, false); return __uint_as_float(rr[0]) + __uint_as_float(rr[1]); }
__device__ __forceinline__ float xor32_get(float v, int hi) { auto rr = __builtin_amdgcn_permlane32_swap(__float_as_uint(v), __float_as_uint(v), false, false); return __uint_as_float(hi ? rr[0] : rr[1]); }
__device__ __forceinline__ int tid_of(int wave) { int t = wave * 64 + lane_id(); asm volatile("" : "+v"(t)); return t; }
namespace pg8 {
#define PG8_LAS __attribute__((address_space(3)))
typedef unsigned short bf16_t;
typedef short bf16x8 __attribute__((ext_vector_type(8)));
typedef float f32x4 __attribute__((ext_vector_type(4)));
typedef unsigned u32x4 __attribute__((ext_vector_type(4)));
constexpr int BM = 256, BK = 64, HALF = 128, HTB = HALF * BK * 2  , STAGE_BYTES = 8 * HTB, NXCD = 8, WGM = 8;

__host__ __device__ __forceinline__ int lds_byte(int r, int c) { const int st = (r >> 4) * 2 + (c >> 5), rr = r & 15, cc = c & 31, ob = rr * 64 + cc * 2; return st * 1024 + (ob ^ (((ob >> 9) & 1) << 5)); }
__host__ __device__ __forceinline__ void stage_rc(int b, int& R, int& C) { const int st = b / 1024, sb = b % 1024, swz = sb ^ (((sb >> 9) & 1) << 5); R = (st >> 1) * 16 + swz / 64; C = (st & 1) * 32 + (swz % 64) / 2; }
__host__ __device__ __forceinline__ int perm32(int rho) { const int n = rho >> 4, i = rho & 15; return 8 * (i >> 2) + 4 * n + (i & 3); }

struct Unit { int pm, pn; size_t bofs; int kofs, ntu, kh; };
struct Gemm { const bf16_t* A; const bf16_t* Bt; int M, N, K; };

struct StaticOrder {
    int nM, nN, nwg, G, c;
    __host__ __device__ void init(int M, int N, int G_, int c_) { nM = M / BM; nN = N / BM; nwg = nM * nN; G = G_; c = c_; }
    __host__ __device__ bool next(int i, Unit& u) const {
        const long L = (long)i * G + c; if (L >= nwg) return false;
        int wgid = (int)L; { const int q = nwg / NXCD, r = nwg % NXCD, xcd = wgid % NXCD, off = wgid / NXCD; wgid = (xcd < r ? xcd * (q + 1) : r * (q + 1) + (xcd - r) * q) + off; }
        const int nig = WGM * nN, gid = wgid / nig, fm = gid * WGM, gsz = (nM - fm) < WGM ? (nM - fm) : WGM;
        u.pm = fm + ((wgid % nig) % gsz); u.pn = (wgid % nig) / gsz; u.bofs = 0; u.kofs = 0; u.ntu = 0; u.kh = 0; return true;
    }
    __device__ __forceinline__ void a_ready(const Unit&) const {}
    __device__ __forceinline__ void done(const Unit&) const {}
};

__device__ __forceinline__ unsigned cvt_pk_bf16(float lo, float hi) { unsigned r; asm volatile("v_cvt_pk_bf16_f32 %0, %1, %2" : "=v"(r) : "v"(lo), "v"(hi)); return r; }

typedef int i32x8 __attribute__((ext_vector_type(8)));
typedef int i32x4v __attribute__((ext_vector_type(4)));
__device__ __forceinline__ i32x8 cat8(bf16x8 a, bf16x8 b) { const i32x4v x = __builtin_bit_cast(i32x4v, a), y = __builtin_bit_cast(i32x4v, b); return (i32x8){x[0], x[1], x[2], x[3], y[0], y[1], y[2], y[3]}; }
__device__ __forceinline__ unsigned pk4_fp8(float a, float b, float c, float d) { int w = 0; w = __builtin_amdgcn_cvt_pk_fp8_f32(a, b, w, false); w = __builtin_amdgcn_cvt_pk_fp8_f32(c, d, w, true); return (unsigned)w; }
struct GroupSched {
    int nMt, nN, nwg, G, c; int t1, t2, t3, t4, t5, t6, t7; size_t estride;
    int nfullM, ntail, khalf;
    __device__ __forceinline__ bool next(int i, Unit& u) const {
        const long L = (long)i * G + c; if (L >= nwg) return false;
        const int nMf = nMt < nfullM ? nMt : nfullM, nwf = nMf * nN;
        if (L < nwf) {
            int wgid = (int)L; { const int q = nwf / NXCD, r = nwf % NXCD, xcd = wgid % NXCD, off = wgid / NXCD; wgid = (xcd < r ? xcd * (q + 1) : r * (q + 1) + (xcd - r) * q) + off; }
            const int nig = WGM * nN, gid = wgid / nig, fm = gid * WGM, gsz = (nMf - fm) < WGM ? (nMf - fm) : WGM;
            u.pm = fm + ((wgid % nig) % gsz); u.pn = (wgid % nig) / gsz; u.kofs = 0; u.ntu = 0; u.kh = 0;
        } else { const int r = (int)L - nwf, t = r >> 1; u.kh = r & 1; u.pm = nMf + t / nN; u.pn = t % nN; u.kofs = u.kh * khalf; u.ntu = ntail; }
        const int pm = u.pm;
        const int e = (pm >= t1) + (pm >= t2) + (pm >= t3) + (pm >= t4) + (pm >= t5) + (pm >= t6) + (pm >= t7);
        u.bofs = (size_t)__builtin_amdgcn_readfirstlane(e) * estride; return true;
    }
    __device__ __forceinline__ void a_ready(const Unit&) const {}
    __device__ __forceinline__ void done(const Unit&) const {}
};

struct EpiStoreBf16 {
    static constexpr bool PERM = true, AFTER_DRAIN = false;
    bf16_t* O; int ldc;
    __device__ __forceinline__ void operator()(const f32x4 (&acc)[2][2][4][2], const Unit& u, int wr, int wc, int fr, int fq) const {
        const int row0 = u.pm * BM + wr * 64 + fr, col0 = u.pn * BM + wc * 32 + 8 * fq;
#pragma unroll
        for (int ai = 0; ai < 2; ++ai)
#pragma unroll
            for (int m = 0; m < 4; ++m) { bf16_t* rowp = O + (size_t)(row0 + ai * HALF + m * 16) * ldc + col0;
#pragma unroll
                for (int bj = 0; bj < 2; ++bj) { const f32x4 v0 = acc[ai][bj][m][0], v1 = acc[ai][bj][m][1];
                    u32x4 w; w.x = cvt_pk_bf16(v0[0], v0[1]); w.y = cvt_pk_bf16(v0[2], v0[3]); w.z = cvt_pk_bf16(v1[0], v1[1]); w.w = cvt_pk_bf16(v1[2], v1[3]);
                    *(u32x4*)(rowp + bj * HALF) = w; } }
    }
};
struct EpiQKV {
    static constexpr bool PERM = true, AFTER_DRAIN = false;
    bf16_t* O; int ldc; const float* qg; const float* kg; float* kmean; PG8_LAS float* scr; const float* rsq;
    __device__ __forceinline__ void operator()(const f32x4 (&acc)[2][2][4][2], const Unit& u, int wr, int wc, int fr, int fq) const {
        const int row0 = u.pm * BM + wr * 64 + fr, col0 = u.pn * BM + wc * 32 + 8 * fq;
        const int part = u.pn >> 3, hp = u.pn & 7, h0 = 2 * hp;
        float rr[2][4];
#pragma unroll
        for (int ai = 0; ai < 2; ++ai)
#pragma unroll
            for (int m = 0; m < 4; ++m) { rr[ai][m] = 1.0f;
                if (rsq) { const f32x4 t_ = *(const f32x4*)(rsq + (size_t)(row0 + ai * HALF + m * 16) * 8 + 4 * (fq & 1)); float s_ = (t_[0] + t_[1]) + (t_[2] + t_[3]); s_ += xor_get<16>(s_);
                    rr[ai][m] = 1.0f / sqrtf(s_ * (1.0f / 2048.0f) + 1e-6f); } }
        if (!(part < 2 && hp <= 5)) {
#pragma unroll
            for (int ai = 0; ai < 2; ++ai)
#pragma unroll
                for (int m = 0; m < 4; ++m) { bf16_t* rowp = O + (size_t)(row0 + ai * HALF + m * 16) * ldc + col0;
#pragma unroll
                    for (int bj = 0; bj < 2; ++bj) { const f32x4 v0 = acc[ai][bj][m][0] * rr[ai][m], v1 = acc[ai][bj][m][1] * rr[ai][m];
                        u32x4 w; w.x = cvt_pk_bf16(v0[0], v0[1]); w.y = cvt_pk_bf16(v0[2], v0[3]); w.z = cvt_pk_bf16(v1[0], v1[1]); w.w = cvt_pk_bf16(v1[2], v1[3]);
                        *(u32x4*)(rowp + bj * HALF) = w; } }
            return;
        }
#pragma unroll
        for (int ai = 0; ai < 2; ++ai)
#pragma unroll
            for (int m = 0; m < 4; ++m)
#pragma unroll
                for (int bj = 0; bj < 2; ++bj) { const f32x4 v0 = acc[ai][bj][m][0] * rr[ai][m], v1 = acc[ai][bj][m][1] * rr[ai][m];
                    float s_ = v0[0] * v0[0]; s_ = fmaf(v0[1], v0[1], s_); s_ = fmaf(v0[2], v0[2], s_); s_ = fmaf(v0[3], v0[3], s_);
                    s_ = fmaf(v1[0], v1[0], s_); s_ = fmaf(v1[1], v1[1], s_); s_ = fmaf(v1[2], v1[2], s_); s_ = fmaf(v1[3], v1[3], s_);
                    s_ += xor_get<16>(s_); s_ = xor32_sum(s_);
                    if (fq == 0) scr[((wr * 16 + (ai * 4 + m) * 2 + bj) * 16 + fr) * 4 + wc] = s_; }
        asm volatile("s_waitcnt lgkmcnt(0)" ::: "memory"); __builtin_amdgcn_s_barrier();
        const float* gp = (part == 0) ? qg : kg; const float qs = (part == 0) ? 0.08838834764831845f * 1.4426950408889634f : 1.0f;
        f32x4 g[2][2];
#pragma unroll
        for (int bj = 0; bj < 2; ++bj) { const float* p_ = gp + ((h0 + bj) >= 6 ? 128 : 0) + wc * 32 + 8 * fq; g[bj][0] = *(const f32x4*)p_; g[bj][1] = *(const f32x4*)(p_ + 4); }
        const bool pass1 = (h0 + 1 > 10);
        f32x4 cs[2][2];
#pragma unroll
        for (int bj = 0; bj < 2; ++bj) { cs[bj][0] = (f32x4){0.f, 0.f, 0.f, 0.f}; cs[bj][1] = (f32x4){0.f, 0.f, 0.f, 0.f}; }
#pragma unroll
        for (int ai = 0; ai < 2; ++ai)
#pragma unroll
            for (int m = 0; m < 4; ++m) { bf16_t* rowp = O + (size_t)(row0 + ai * HALF + m * 16) * ldc + col0;
#pragma unroll
                for (int bj = 0; bj < 2; ++bj) { const f32x4 t_ = *(const PG8_LAS f32x4*)(scr + ((wr * 16 + (ai * 4 + m) * 2 + bj) * 16 + fr) * 4);
                    float rn = qs / sqrtf(((t_[0] + t_[1]) + (t_[2] + t_[3])) * (1.0f / 128.0f) + 1e-6f);
                    f32x4 y0 = acc[ai][bj][m][0] * rr[ai][m], y1 = acc[ai][bj][m][1] * rr[ai][m];
                    if (!(bj == 1 && pass1)) { y0 = y0 * rn * g[bj][0]; y1 = y1 * rn * g[bj][1]; }
                    cs[bj][0] += y0; cs[bj][1] += y1;
                    u32x4 w; w.x = cvt_pk_bf16(y0[0], y0[1]); w.y = cvt_pk_bf16(y0[2], y0[3]); w.z = cvt_pk_bf16(y1[0], y1[1]); w.w = cvt_pk_bf16(y1[2], y1[3]);
                    *(u32x4*)(rowp + bj * HALF) = w; } }
        if (part == 1 && hp >= 3) {
            PG8_LAS float* scr2 = scr + 2048;
#pragma unroll
            for (int bj = 0; bj < 2; ++bj)
#pragma unroll
                for (int n = 0; n < 2; ++n)
#pragma unroll
                    for (int j = 0; j < 4; ++j) { float c_ = cs[bj][n][j]; c_ += xor_get<1>(c_); c_ += xor_get<2>(c_); c_ += xor_get<4>(c_); c_ += xor_get<8>(c_);
                        if (fr == 0) scr2[wr * 256 + bj * HALF + wc * 32 + 8 * fq + 4 * n + j] = c_; }
            asm volatile("s_waitcnt lgkmcnt(0)" ::: "memory"); __builtin_amdgcn_s_barrier();
            const int t_ = (wr * 4 + wc) * 64 + fq * 16 + fr;
            if (t_ < 256) { const int hh = h0 + (t_ >> 7);
                if (hh >= 6 && hh <= 10) kmean[(size_t)(((u.pm >> 4) * 5 + (hh - 6)) * 16 + (u.pm & 15)) * 128 + (t_ & 127)] = (scr2[t_] + scr2[256 + t_]) * (1.0f / 256.0f); }
        }
    }
};
__device__ __forceinline__ float silu_mul(float g, float u) { const float e = __builtin_amdgcn_exp2f(g * -1.4426950408889634f); return g * __builtin_amdgcn_rcpf(1.0f + e) * u; }
struct EpiSwiGLU {
    static constexpr bool PERM = true, AFTER_DRAIN = false;
    bf16_t* O; int ldc;
    __device__ __forceinline__ void operator()(const f32x4 (&acc)[2][2][4][2], const Unit& u, int wr, int wc, int fr, int fq) const {
        const int row0 = u.pm * BM + wr * 64 + fr, col0 = u.pn * HALF + wc * 32 + 8 * fq;
#pragma unroll
        for (int ai = 0; ai < 2; ++ai)
#pragma unroll
            for (int m = 0; m < 4; ++m) { bf16_t* rowp = O + (size_t)(row0 + ai * HALF + m * 16) * ldc + col0;
                const f32x4 g0 = acc[ai][0][m][0], g1 = acc[ai][0][m][1], u0 = acc[ai][1][m][0], u1 = acc[ai][1][m][1];
                u32x4 w; w.x = cvt_pk_bf16(silu_mul(g0[0], u0[0]), silu_mul(g0[1], u0[1])); w.y = cvt_pk_bf16(silu_mul(g0[2], u0[2]), silu_mul(g0[3], u0[3]));
                w.z = cvt_pk_bf16(silu_mul(g1[0], u1[0]), silu_mul(g1[1], u1[1])); w.w = cvt_pk_bf16(silu_mul(g1[2], u1[2]), silu_mul(g1[3], u1[3]));
                *(u32x4*)rowp = w; }
    }
};
struct EpiSwiGLU8 {
    static constexpr bool PERM = true, AFTER_DRAIN = false;
    unsigned char* O; int ldc;
    __device__ __forceinline__ void operator()(const f32x4 (&acc)[2][2][4][2], const Unit& u, int wr, int wc, int fr, int fq) const {
        typedef unsigned u32x2 __attribute__((ext_vector_type(2)));
        const int row0 = u.pm * BM + wr * 64 + fr, col0 = u.pn * HALF + wc * 32 + 8 * fq;
#pragma unroll
        for (int ai = 0; ai < 2; ++ai)
#pragma unroll
            for (int m = 0; m < 4; ++m) { unsigned char* rowp = O + (size_t)(row0 + ai * HALF + m * 16) * ldc + col0;
                const f32x4 g0 = acc[ai][0][m][0], g1 = acc[ai][0][m][1], u0 = acc[ai][1][m][0], u1 = acc[ai][1][m][1];
                u32x2 w; w.x = pk4_fp8(silu_mul(g0[0], u0[0]), silu_mul(g0[1], u0[1]), silu_mul(g0[2], u0[2]), silu_mul(g0[3], u0[3]));
                w.y = pk4_fp8(silu_mul(g1[0], u1[0]), silu_mul(g1[1], u1[1]), silu_mul(g1[2], u1[2]), silu_mul(g1[3], u1[3]));
                *(u32x2*)rowp = w; }
    }
};
struct EpiResF32 {
    static constexpr bool PERM = true, AFTER_DRAIN = false;
    const float* base32; const bf16_t* base16; bf16_t* out16; int ldc; bf16_t* out16b; float* ssq; PG8_LAS float* scr;
    __device__ __forceinline__ void operator()(const f32x4 (&acc)[2][2][4][2], const Unit& u, int wr, int wc, int fr, int fq) const {
        const int row0 = u.pm * BM + wr * 64 + fr, col0 = u.pn * BM + wc * 32 + 8 * fq;
#pragma unroll
        for (int ai = 0; ai < 2; ++ai)
#pragma unroll
            for (int m = 0; m < 4; ++m) { const size_t off = (size_t)(row0 + ai * HALF + m * 16) * ldc + col0; float sq_ = 0.f;
#pragma unroll
                for (int bj = 0; bj < 2; ++bj) { f32x4 v0 = acc[ai][bj][m][0], v1 = acc[ai][bj][m][1];
                    if (base32) { v0 += *(const f32x4*)(base32 + off + bj * HALF); v1 += *(const f32x4*)(base32 + off + bj * HALF + 4); }
                    else if (base16) { const u32x4 b = *(const u32x4*)(base16 + off + bj * HALF);
                        v0 += (f32x4){__uint_as_float(b.x << 16), __uint_as_float(b.x & 0xffff0000u), __uint_as_float(b.y << 16), __uint_as_float(b.y & 0xffff0000u)};
                        v1 += (f32x4){__uint_as_float(b.z << 16), __uint_as_float(b.z & 0xffff0000u), __uint_as_float(b.w << 16), __uint_as_float(b.w & 0xffff0000u)}; }
                    if (ssq) { float s_ = sq_; s_ = fmaf(v0[0], v0[0], s_); s_ = fmaf(v0[1], v0[1], s_); s_ = fmaf(v0[2], v0[2], s_); s_ = fmaf(v0[3], v0[3], s_);
                      s_ = fmaf(v1[0], v1[0], s_); s_ = fmaf(v1[1], v1[1], s_); s_ = fmaf(v1[2], v1[2], s_); s_ = fmaf(v1[3], v1[3], s_); sq_ = s_; }
                    u32x4 w; w.x = cvt_pk_bf16(v0[0], v0[1]); w.y = cvt_pk_bf16(v0[2], v0[3]); w.z = cvt_pk_bf16(v1[0], v1[1]); w.w = cvt_pk_bf16(v1[2], v1[3]);
                    *(u32x4*)((u.kh ? out16b : out16) + off + bj * HALF) = w; }
                if (ssq) { float s_ = sq_; s_ += xor_get<16>(s_); s_ = xor32_sum(s_);
                    if (fq == 0) scr[((wr * 8 + ai * 4 + m) * 16 + fr) * 4 + wc] = s_; } }
        if (ssq) {
            asm volatile("s_waitcnt lgkmcnt(0)" ::: "memory"); __builtin_amdgcn_s_barrier();
            if (wc == 0 && fq == 0) {
#pragma unroll
                for (int ai = 0; ai < 2; ++ai)
#pragma unroll
                    for (int m = 0; m < 4; ++m) { const f32x4 t_ = *(const PG8_LAS f32x4*)(scr + ((wr * 8 + ai * 4 + m) * 16 + fr) * 4);
                        ssq[(size_t)(row0 + ai * HALF + m * 16) * 8 + u.pn] = (t_[0] + t_[1]) + (t_[2] + t_[3]); } }
        }
    }
};

template <class Epi, class Sched, bool ALIGN_EPI = false, bool SP2 = false, bool FP8 = false>
__device__ __forceinline__ void gemm_phase(PG8_LAS unsigned char* lds, const Gemm g, const Sched& S, const Epi& E, const int wave_) {
    const int tid = tid_of(wave_), wid = wave_, lane = tid & 63, wr = wid >> 2, wc = wid & 3, fr = lane & 15, fq = lane >> 4;
    const int K = g.K, nt = K / BK;
    unsigned voffA[2], voffB[2];
#pragma unroll
    for (int i = 0; i < 2; ++i) { int R, C; stage_rc(tid * 16 + i * 8192, R, C); const int Rb = Epi::PERM ? ((R & ~31) + perm32(R & 31)) : R;
        voffA[i] = (unsigned)(R * K + C) * 2u; voffB[i] = (unsigned)(Rb * K + C) * 2u; }
    const size_t kstep = (size_t)(BK * 2);
    const size_t hstep = (size_t)HALF * K * 2;
    const size_t tstep = 2 * hstep;
    const unsigned ldsw = (unsigned)wid * 1024u;
    const int aoff = lds_byte(wr * 64 + fr, fq * 8), boff = lds_byte(wc * 32 + fr, fq * 8);
#define PG8_SA(b, h) (((b) * 2 + (h)) * HTB)
#define PG8_SB(b, h) ((4 + (b) * 2 + (h)) * HTB)
#define PG8_STAGE(bufoff, gbase, voff) do { _Pragma("unroll") for (int _i = 0; _i < 2; ++_i) { unsigned _vo = (voff)[_i]; asm volatile("" : "+v"(_vo));     \
        __builtin_amdgcn_global_load_lds((const unsigned*)((const char*)(gbase) + _vo), (PG8_LAS unsigned*)(lds + (bufoff) + ldsw + _i * 8192), 16, 0, 0); } } while (0)
#define PG8_LDA(dst, b, h) do { _Pragma("unroll") for (int m = 0; m < 4; ++m) _Pragma("unroll") for (int k = 0; k < 2; ++k) dst[m][k] = *(const PG8_LAS bf16x8*)(lds + PG8_SA(b, h) + aoff + m * 2048 + k * 1024); } while (0)
#define PG8_LDB(dst, b, h) do { _Pragma("unroll") for (int n = 0; n < 2; ++n) _Pragma("unroll") for (int k = 0; k < 2; ++k) dst[n][k] = *(const PG8_LAS bf16x8*)(lds + PG8_SB(b, h) + boff + n * 2048 + k * 1024); } while (0)
#define PG8_MMA(ai, bj, At, Bt) do { __builtin_amdgcn_s_setprio(1); _Pragma("unroll") for (int m = 0; m < 4; ++m) _Pragma("unroll") for (int n = 0; n < 2; ++n) { \
        if constexpr (FP8) { acc[ai][bj][m][n] = __builtin_amdgcn_mfma_scale_f32_16x16x128_f8f6f4(cat8(Bt[n][0], Bt[n][1]), cat8(At[m][0], At[m][1]), acc[ai][bj][m][n], 0, 0, 0, 0x77777777, 0, 0x7f7f7f7f); } \
        else { _Pragma("unroll") for (int k = 0; k < 2; ++k) acc[ai][bj][m][n] = __builtin_amdgcn_mfma_f32_16x16x32_bf16(Bt[n][k], At[m][k], acc[ai][bj][m][n], 0, 0, 0); } } __builtin_amdgcn_s_setprio(0); } while (0)
#define PG8_WAIT_V(n) asm volatile("s_waitcnt vmcnt(" #n ")" ::: "memory")
#define PG8_WAIT_L(n) asm volatile("s_waitcnt lgkmcnt(" #n ")" ::: "memory")
#define PG8_BAR __builtin_amdgcn_s_barrier()
#define PG8_SCHED __builtin_amdgcn_sched_barrier(0)
    Unit cur, nxt; int ui = 0;
    if (!S.next(0, cur)) return;
    f32x4 acc[2][2][4][2];
#pragma unroll
    for (int a = 0; a < 2; ++a)
#pragma unroll
        for (int b = 0; b < 2; ++b)
#pragma unroll
            for (int m = 0; m < 4; ++m)
#pragma unroll
                for (int n = 0; n < 2; ++n) acc[a][b][m][n] = (f32x4){0.f, 0.f, 0.f, 0.f};
    bf16x8 At[4][2], B0[2][2], B1[2][2];
    const char* cA = (const char*)g.A + (size_t)cur.pm * tstep + cur.kofs; const char* cB = (const char*)g.Bt + cur.bofs + (size_t)cur.pn * tstep + cur.kofs;
    S.a_ready(cur);
    if constexpr (SP2) {
        PG8_STAGE(PG8_SB(0, 0), cB, voffB); PG8_STAGE(PG8_SB(0, 1), cB + hstep, voffB); PG8_STAGE(PG8_SA(0, 0), cA, voffA); PG8_STAGE(PG8_SA(0, 1), cA + hstep, voffA);
        if (wr == 1) PG8_BAR;
        PG8_WAIT_V(2); PG8_BAR;
        PG8_STAGE(PG8_SB(1, 0), cB + kstep, voffB); PG8_STAGE(PG8_SA(1, 0), cA + kstep, voffA); PG8_STAGE(PG8_SB(1, 1), cB + hstep + kstep, voffB);
        PG8_WAIT_V(6); PG8_BAR;
    } else {
        PG8_STAGE(PG8_SB(0, 0), cB, voffB); PG8_STAGE(PG8_SA(0, 0), cA, voffA); PG8_STAGE(PG8_SB(0, 1), cB + hstep, voffB); PG8_STAGE(PG8_SA(0, 1), cA + hstep, voffA);
        if (wr == 1) PG8_BAR;
        PG8_WAIT_V(4); PG8_BAR;
        PG8_STAGE(PG8_SB(1, 0), cB + kstep, voffB); PG8_STAGE(PG8_SA(1, 0), cA + kstep, voffA); PG8_STAGE(PG8_SB(1, 1), cB + hstep + kstep, voffB);
        PG8_WAIT_V(6); PG8_BAR;
    }
    for (;;) {
        const bool has_next = S.next(ui + 1, nxt);
        const char* nA = has_next ? (const char*)g.A + (size_t)nxt.pm * tstep + nxt.kofs : cA; const char* nB = has_next ? (const char*)g.Bt + nxt.bofs + (size_t)nxt.pn * tstep + nxt.kofs : cB;
        const int ntc = cur.ntu ? cur.ntu : nt;
        for (int t = 0; t < ntc; t += 2) {
            const bool last = (t == ntc - 2);
            const char* a1 = cA + (size_t)(t + 1) * kstep;
            const char* a2 = last ? nA : cA + (size_t)(t + 2) * kstep; const char* b2 = last ? nB : cB + (size_t)(t + 2) * kstep;
            const char* a3 = a2 + kstep; const char* b3 = b2 + kstep;
            if (last && has_next) S.a_ready(nxt);
            if constexpr (SP2) {
            PG8_LDB(B0, 0, 0); PG8_LDB(B1, 0, 1); PG8_SCHED; PG8_LDA(At, 0, 0); PG8_STAGE(PG8_SA(1, 1), a1 + hstep, voffA);
            PG8_WAIT_V(8); PG8_WAIT_L(0); PG8_BAR; PG8_MMA(0, 0, At, B0); PG8_MMA(0, 1, At, B1); PG8_BAR; PG8_SCHED;
            PG8_LDA(At, 0, 1); PG8_STAGE(PG8_SB(0, 0), b2, voffB); PG8_STAGE(PG8_SB(0, 1), b2 + hstep, voffB); PG8_STAGE(PG8_SA(0, 0), a2, voffA);
            PG8_WAIT_V(8); PG8_WAIT_L(0); PG8_BAR; PG8_MMA(1, 0, At, B0); PG8_MMA(1, 1, At, B1); PG8_BAR; PG8_SCHED;
            PG8_LDB(B0, 1, 0); PG8_LDB(B1, 1, 1); PG8_SCHED; PG8_LDA(At, 1, 0); PG8_STAGE(PG8_SA(0, 1), a2 + hstep, voffA);
            PG8_WAIT_V(8); PG8_WAIT_L(0); PG8_BAR; PG8_MMA(0, 0, At, B0); PG8_MMA(0, 1, At, B1); PG8_BAR; PG8_SCHED;
            PG8_LDA(At, 1, 1); PG8_STAGE(PG8_SB(1, 0), b3, voffB); PG8_STAGE(PG8_SB(1, 1), b3 + hstep, voffB); PG8_STAGE(PG8_SA(1, 0), a3, voffA);
            PG8_WAIT_V(8); PG8_WAIT_L(0); PG8_BAR; PG8_MMA(1, 0, At, B0); PG8_MMA(1, 1, At, B1); PG8_BAR; PG8_SCHED;
            } else {
            PG8_LDB(B0, 0, 0); PG8_SCHED; PG8_LDA(At, 0, 0); PG8_STAGE(PG8_SA(1, 1), a1 + hstep, voffA);
            PG8_WAIT_L(8); PG8_BAR; PG8_WAIT_L(0); PG8_MMA(0, 0, At, B0); PG8_BAR; PG8_SCHED;
            PG8_LDB(B1, 0, 1); PG8_STAGE(PG8_SB(0, 0), b2, voffB);
            PG8_BAR; PG8_WAIT_L(0); PG8_MMA(0, 1, At, B1); PG8_BAR;
            PG8_LDA(At, 0, 1); PG8_STAGE(PG8_SA(0, 0), a2, voffA);
            PG8_BAR; PG8_WAIT_L(0); PG8_MMA(1, 0, At, B0); PG8_BAR; PG8_SCHED;
            PG8_STAGE(PG8_SB(0, 1), b2 + hstep, voffB);
            PG8_WAIT_V(6); PG8_BAR; PG8_MMA(1, 1, At, B1); PG8_BAR;
            PG8_LDB(B0, 1, 0); PG8_SCHED; PG8_LDA(At, 1, 0); PG8_STAGE(PG8_SA(0, 1), a2 + hstep, voffA);
            PG8_WAIT_L(8); PG8_BAR; PG8_WAIT_L(0); PG8_MMA(0, 0, At, B0); PG8_BAR; PG8_SCHED;
            PG8_LDB(B1, 1, 1); PG8_STAGE(PG8_SB(1, 0), b3, voffB);
            PG8_BAR; PG8_WAIT_L(0); PG8_MMA(0, 1, At, B1); PG8_BAR;
            PG8_LDA(At, 1, 1); PG8_STAGE(PG8_SA(1, 0), a3, voffA);
            PG8_BAR; PG8_WAIT_L(0); PG8_MMA(1, 0, At, B0); PG8_BAR; PG8_SCHED;
            PG8_STAGE(PG8_SB(1, 1), b3 + hstep, voffB);
            PG8_WAIT_V(6); PG8_BAR; PG8_MMA(1, 1, At, B1); PG8_BAR;
            }
        }
        if constexpr (ALIGN_EPI) { if (wr == 0) PG8_BAR; }
        if constexpr (!Epi::AFTER_DRAIN) { const int l2_ = lane_id(); E(acc, cur, wr, wc, l2_ & 15, l2_ >> 4); S.done(cur); }
        if (!has_next) break;
#pragma unroll
        for (int a = 0; a < 2; ++a)
#pragma unroll
            for (int b = 0; b < 2; ++b)
#pragma unroll
                for (int m = 0; m < 4; ++m)
#pragma unroll
                    for (int n = 0; n < 2; ++n) acc[a][b][m][n] = (f32x4){0.f, 0.f, 0.f, 0.f};
        cur = nxt; cA = nA; cB = nB; ++ui;
        if constexpr (ALIGN_EPI) { if (wr == 1) PG8_BAR; }
    }
    PG8_WAIT_V(0);
    if constexpr (!ALIGN_EPI) { if (wr == 0) PG8_BAR; }
    PG8_BAR;
    if constexpr (Epi::AFTER_DRAIN) { E.fused(acc, cur, wr, wc, fr, fq, lds, wid, lane); S.done(cur); }
#undef PG8_SA
#undef PG8_SB
#undef PG8_STAGE
#undef PG8_LDA
#undef PG8_LDB
#undef PG8_MMA
#undef PG8_WAIT_V
#undef PG8_WAIT_L
#undef PG8_BAR
#undef PG8_SCHED
}
}

namespace att {
typedef unsigned short bf16;
typedef short bf16x8 __attribute__((ext_vector_type(8)));
typedef short s16x4 __attribute__((ext_vector_type(4)));
typedef float f32x16 __attribute__((ext_vector_type(16)));
typedef float f32x4 __attribute__((ext_vector_type(4)));
typedef unsigned u32x4 __attribute__((ext_vector_type(4)));
typedef int i32x4 __attribute__((ext_vector_type(4)));
constexpr int QS = 6144, SEQ = 4096, DM = 2048;
constexpr int DPW = 1408, DPLW = 16, NTOK = 8192;
constexpr int SHM_T = 16384;
constexpr int L_V = 0, L_K = 2 * SHM_T, L_Q = 4 * SHM_T, L_WS = L_Q + 65536, L_TL = L_WS + 2048, L_FLG = L_TL + 256, L_MSK = L_FLG + 64, L_KM = L_V, L_END = L_MSK + 64;
static_assert(L_END <= 140 * 1024, "attention LDS map");
constexpr float C2 = 0.08838834764831845f * 1.4426950408889634f;
#define KSWZ(row, colB) ((row) * 256 + ((colB) ^ (((row) & 7) << 4)))
#define SBAR() __builtin_amdgcn_sched_barrier(0)
__device__ __forceinline__ int v_st(int k, int c) { const int kk = (k & ~0xC) | ((k & 4) << 1) | ((k & 8) >> 1); return ((kk >> 3) * 4 + (c >> 5)) * 512 + ((kk & 7) * 32 + (c & 31)) * 2; }
__device__ __forceinline__ int v_rd_base(int lane) { return ((lane & 3) << 3) | (((lane >> 2) & 3) << 6) | (((lane >> 4) & 1) << 5) | (((lane >> 5) & 1) << 8); }
constexpr int v_rd_off(int d0, int ks, int half) { return d0 * 512 + ks * 4096 + half * 2048; }
__device__ __forceinline__ int crow(int r, int hi) { return (r & 3) + 8 * (r >> 2) + 4 * hi; }
__device__ __forceinline__ unsigned cvtpk(float lo, float hi) { unsigned r; asm volatile("v_cvt_pk_bf16_f32 %0, %1, %2" : "=v"(r) : "v"(lo), "v"(hi)); return r; }
__device__ __forceinline__ float bf2f(short s) { return __uint_as_float(((unsigned)(unsigned short)s) << 16); }

__device__ __forceinline__ void qkt(f32x16& p0, f32x16& p1, const f32x16& init, const char* Kt, int r32, int hi, const char* qf  ) {
    p0 = init; p1 = init;
    const char* kb[4];
#pragma unroll
    for (int dd = 0; dd < 4; ++dd) kb[dd] = Kt + KSWZ(r32, (dd * 16 + hi * 8) * 2);
#pragma unroll
    for (int d0 = 0; d0 < 8; ++d0) { const char* a = kb[d0 & 3] + (d0 >> 2) * 128;
        bf16x8 b0 = *reinterpret_cast<const bf16x8*>(a);
        bf16x8 b1 = *reinterpret_cast<const bf16x8*>(a + 32 * 256);
        const bf16x8 q = *reinterpret_cast<const bf16x8*>(qf + d0 * 1024);
        p0 = __builtin_amdgcn_mfma_f32_32x32x16_bf16(b0, q, p0, 0, 0, 0);
        p1 = __builtin_amdgcn_mfma_f32_32x32x16_bf16(b1, q, p1, 0, 0, 0); }
}
__device__ __forceinline__ void pv_tile(f32x16* o, int vb, bf16x8 pa0, bf16x8 pa1, bf16x8 pa2, bf16x8 pa3) {
#define TRRD(dst, off) asm volatile("ds_read_b64_tr_b16 %0, %1 offset:%2" : "=&v"(dst) : "v"(vb), "i"(off) : "memory")
#define PV_D0(d0) do { s16x4 l0, l1, l2, l3, h0, h1, h2, h3; constexpr int b_ = v_rd_off(d0, 0, 0); \
        TRRD(l0, b_); TRRD(h0, b_ + 2048); TRRD(l1, b_ + 4096); TRRD(h1, b_ + 6144); TRRD(l2, b_ + 8192); TRRD(h2, b_ + 10240); TRRD(l3, b_ + 12288); TRRD(h3, b_ + 14336); \
        asm volatile("s_waitcnt lgkmcnt(0)" ::: "memory"); SBAR(); \
        o[d0] = __builtin_amdgcn_mfma_f32_32x32x16_bf16(pa0, (bf16x8){l0[0], l0[1], l0[2], l0[3], h0[0], h0[1], h0[2], h0[3]}, o[d0], 0, 0, 0);   \
        o[d0] = __builtin_amdgcn_mfma_f32_32x32x16_bf16(pa1, (bf16x8){l1[0], l1[1], l1[2], l1[3], h1[0], h1[1], h1[2], h1[3]}, o[d0], 0, 0, 0);   \
        o[d0] = __builtin_amdgcn_mfma_f32_32x32x16_bf16(pa2, (bf16x8){l2[0], l2[1], l2[2], l2[3], h2[0], h2[1], h2[2], h2[3]}, o[d0], 0, 0, 0);   \
        o[d0] = __builtin_amdgcn_mfma_f32_32x32x16_bf16(pa3, (bf16x8){l3[0], l3[1], l3[2], l3[3], h3[0], h3[1], h3[2], h3[3]}, o[d0], 0, 0, 0); } while (0)
    PV_D0(0); PV_D0(1); PV_D0(2); PV_D0(3);
#undef PV_D0
#undef TRRD
}
__device__ __forceinline__ void pack_p(const f32x16& p0, const f32x16& p1, bf16x8& pa0, bf16x8& pa1, bf16x8& pa2, bf16x8& pa3) {
#define PK4(P, B_, OUT) do { unsigned a0 = cvtpk(P[B_+0], P[B_+1]), a1 = cvtpk(P[B_+2], P[B_+3]);                          \
        unsigned b0 = cvtpk(P[B_+4], P[B_+5]), b1 = cvtpk(P[B_+6], P[B_+7]);                                             \
        auto r0 = __builtin_amdgcn_permlane32_swap(a0, b0, false, false); auto r1 = __builtin_amdgcn_permlane32_swap(a1, b1, false, false); \
        u32x4 w = {r0[0], r1[0], r0[1], r1[1]}; OUT = *reinterpret_cast<bf16x8*>(&w); } while (0)
    PK4(p0, 0, pa0); PK4(p0, 8, pa1); PK4(p1, 0, pa2); PK4(p1, 8, pa3);
#undef PK4
}
__device__ __forceinline__ float softplus2(float y) { return fmaxf(y, 0.f) + __builtin_amdgcn_logf(1.0f + __builtin_amdgcn_exp2f(-fabsf(y))); }

struct AttnArgs { const bf16* qkv; bf16* obuf; const float* kmean; const float* out_gain; bf16* dpo; float* dpl; unsigned* mlist; unsigned* mcnt; unsigned* mdone; };
constexpr int MLCAP = 3840, N_SEL = 2 * 5 * 15;
__device__ __forceinline__ unsigned ld_sc1(const unsigned* p) { return __hip_atomic_load(p, __ATOMIC_RELAXED, __HIP_MEMORY_SCOPE_AGENT); }
__device__ __forceinline__ void st_sc1(unsigned* p, unsigned v) { __hip_atomic_store(p, v, __ATOMIC_RELAXED, __HIP_MEMORY_SCOPE_AGENT); }

template <int mode> __device__ __forceinline__ void attn_unit(const AttnArgs& A, const int b, const int h, const int sub, char* shm, const int wave_) {
    const int tid = tid_of(wave_), wid = wave_, lane = tid & 63, r32 = lane & 31, hi = lane >> 5;
    int dil = 1, res = 0, qb = sub, br = 0;
    int gk = 0, gcnt = 0; unsigned gent = 0u; bool gvalid = true, wvalid = true;
    if (mode == 0) { br = sub >> 4; const int x = sub & 15; if (br == 0) { qb = x; } else if (br == 1) { dil = 4; res = x >> 2; qb = x & 3; } else { dil = 16; res = x; qb = 0; } }
    if (mode == 3) { gk = sub >> 4; const int c = sub & 15; const int li = (b * 5 + (h - 6)) * 15 + gk;
        gcnt = __builtin_amdgcn_readfirstlane((int)ld_sc1(A.mcnt + li));
        if (c * 256 >= gcnt) return;
        const int gi = c * 256 + wid * 32 + r32; gvalid = gi < gcnt; wvalid = (c * 256 + wid * 32) < gcnt;
        gent = ld_sc1(A.mlist + (size_t)li * MLCAP + (gvalid ? gi : 0)); qb = 0; }
    const size_t rowbase = (size_t)b * SEQ + res; const int q0 = qb * 256;
    const bf16* Qp = A.qkv + (rowbase + (size_t)dil * ((mode == 3) ? (int)(gent & 4095u) : (q0 + wid * 32 + r32))) * QS + h * 128;
    const bf16* Kh = A.qkv + rowbase * QS + 2048 + h * 128;
    const bf16* Vh = A.qkv + rowbase * QS + 4096 + h * 128;
    const size_t rstep = (size_t)dil * QS;
    char* V_lds = shm + L_V; char* K_lds = shm + L_K;
    float* wsf = (float*)(shm + L_WS) + wid * 64; float* li_l = wsf; float* al_l = wsf + 32;
    int* TL = (int*)(shm + L_TL); int* FLG = (int*)(shm + L_FLG); unsigned* MSK = (unsigned*)(shm + L_MSK); float* KM = (float*)(shm + L_KM);
    char* qf = shm + L_Q + wid * 8192 + lane * 16;
    const int qw0 = q0 + wid * 32;
    const int pos = qw0 + r32;
    const int vb0 = (int)(uintptr_t)V_lds + v_rd_base(lane);
    unsigned koffb[2], voffb[2];
#pragma unroll
    for (int i = 0; i < 2; ++i) { const int Lb = (2 * wid + i) * 1024 + lane * 16;
        const int rowk = Lb >> 8, ck = ((Lb >> 4) & 15) ^ (rowk & 7);
        koffb[i] = (unsigned)(((size_t)rowk * rstep + ck * 8) * 2);
        const int sub_ = Lb >> 9, win_ = Lb & 511, kk = (sub_ >> 2) * 8 + (win_ >> 6), kv = (kk & ~0xC) | ((kk & 4) << 1) | ((kk & 8) >> 1), cc = (sub_ & 3) * 4 + ((win_ & 63) >> 4);
        voffb[i] = (unsigned)(((size_t)kv * rstep + cc * 8) * 2); }
    typedef __attribute__((address_space(3))) unsigned lds_u32;
    lds_u32* const Kdst = (lds_u32*)(K_lds + wid * 2048); lds_u32* const Vdst = (lds_u32*)(V_lds + wid * 2048);
#define TDMA(k0_, bf_) do { const char* kt_ = (const char*)(Kh + (size_t)(k0_) * rstep); const char* vt_ = (const char*)(Vh + (size_t)(k0_) * rstep); \
        _Pragma("unroll") for (int i_ = 0; i_ < 2; ++i_) { unsigned ko_ = koffb[i_], vo_ = voffb[i_]; asm volatile("" : "+v"(ko_), "+v"(vo_)); \
            __builtin_amdgcn_global_load_lds((const unsigned*)(kt_ + ko_), (lds_u32*)((__attribute__((address_space(3))) char*)Kdst + (bf_) * SHM_T + i_ * 1024), 16, 0, 0); \
            __builtin_amdgcn_global_load_lds((const unsigned*)(vt_ + vo_), (lds_u32*)((__attribute__((address_space(3))) char*)Vdst + (bf_) * SHM_T + i_ * 1024), 16, 0, 0); } } while (0)
    { const int kf_ = ((mode == 3) ? gk * 256 : q0) + 192; TDMA(kf_, 0); }
    bf16x8 qr[8];
#pragma unroll
    for (int d0 = 0; d0 < 8; ++d0) { qr[d0] = *reinterpret_cast<const bf16x8*>(Qp + d0 * 16 + hi * 8); *reinterpret_cast<bf16x8*>(qf + d0 * 1024) = qr[d0]; }
    const float sl = (mode == 2) ? 0.f : __builtin_amdgcn_exp2f(-8.0f * (float)(h + 1) / 11.0f) * 1.4426950408889634f * (float)dil;
    f32x16 binit;
#pragma unroll
    for (int r = 0; r < 16; ++r) binit[r] = sl * (float)((r & 3) + 8 * (r >> 2) + 4 * hi);
    const float sl32 = 32.f * sl;

    int NT = 0;
    if (mode == 1) { NT = 4; if (tid < 4) TL[tid] = q0 + 192 - 64 * tid; }
    else if (mode == 3) { NT = 4; if (tid < 4) TL[tid] = gk * 256 + 192 - 64 * tid; }
    else if (mode == 0) {
        const int lo = q0 >= 128 ? q0 - 128 : 0; NT = (q0 + 256 - lo) / 64;
        if (tid < NT) TL[NT - 1 - tid] = lo + 64 * tid;
    } else {
        NT = (q0 + 256) / 64;
        if (tid < NT) TL[tid] = q0 + 192 - 64 * tid;
    }
    __syncthreads();

    float m_reg = -1e30f, l_reg = 0.f, carry = 0.f; asm volatile("" : "+v"(m_reg), "+v"(l_reg), "+v"(carry));
    f32x16 o[4];
#pragma unroll
    for (int d0 = 0; d0 < 4; ++d0) o[d0] = f32x16{};
    bool wdone = false;
    for (int t = 0; t < NT; ++t) {
        const int buf = t & 1; const int kb = __builtin_amdgcn_readfirstlane(TL[t]);
        const bool more = (t + 1 < NT);
        if (more) { const int k1 = __builtin_amdgcn_readfirstlane(TL[t + 1]); TDMA(k1, buf ^ 1); }
        bool act;
        if (mode == 0) act = (kb <= qw0 + 31) && (kb + 63 >= qw0 - 128);
        else if (mode == 1) act = (kb <= qw0 + 31);
        else if (mode == 3) act = wvalid;
        else act = (kb < qw0 + 32) && !wdone;
        if (act) {
            f32x16 p0, p1;
            qkt(p0, p1, binit, K_lds + buf * SHM_T, r32, hi, qf);
            bf16x8 pa0, pa1, pa2, pa3;
            const int dq = pos - kb - 4 * hi;
            if (mode == 2) {
                float Og[8], Pg[8];
#pragma unroll
                for (int i = 0; i < 8; ++i) { float ye[4], le[4];
#pragma unroll
                    for (int e = 0; e < 4; ++e) { const int c = (i < 4) ? (8 * i + e) : (8 * (i - 4) + 32 + e); const float y = ((i < 4) ? p0[4 * i + e] : p1[4 * (i - 4) + e]) * C2;
                        ye[e] = y; le[e] = (dq - c >= 1) ? -softplus2(y) : 0.f; }
                    const float w2 = le[3], w1 = w2 + le[2], w0 = w1 + le[1];
                    Og[i] = w0 + le[0];
                    const float x0 = ye[0] + le[0] + w0, x1 = ye[1] + le[1] + w1, x2 = ye[2] + le[2] + w2, x3 = ye[3] + le[3];
                    if (i < 4) { p0[4 * i] = x0; p0[4 * i + 1] = x1; p0[4 * i + 2] = x2; p0[4 * i + 3] = x3; } else { p1[4 * (i - 4)] = x0; p1[4 * (i - 4) + 1] = x1; p1[4 * (i - 4) + 2] = x2; p1[4 * (i - 4) + 3] = x3; } }
#pragma unroll
                for (int i = 0; i < 8; ++i) Pg[i] = xor32_get(Og[i], hi);
                float run = carry;
#pragma unroll
                for (int i = 7; i >= 0; --i) { const float ab = run + (hi == 0 ? Pg[i] : 0.f);
#pragma unroll
                    for (int e = 0; e < 4; ++e) { const int c = (i < 4) ? (8 * i + e) : (8 * (i - 4) + 32 + e);
                        if (i < 4) p0[4 * i + e] = (dq - c >= 1) ? __builtin_amdgcn_exp2f(p0[4 * i + e] + ab) : 0.f;
                        else p1[4 * (i - 4) + e] = (dq - c >= 1) ? __builtin_amdgcn_exp2f(p1[4 * (i - 4) + e] + ab) : 0.f; }
                    run += Og[i] + Pg[i]; }
                carry = run;
                wdone = __all(carry < -160.f) != 0;
                pack_p(p0, p1, pa0, pa1, pa2, pa3);
            } else {
                const float NEG = -__builtin_inff();
                bool rowok = true;
                if (mode == 0) {
                    if (!((kb + 63 <= qw0) && (qw0 + 31 - kb <= 128))) {
#pragma unroll
                        for (int r = 0; r < 16; ++r) { const int c = (r & 3) + 8 * (r >> 2);
                            p0[r] = ((unsigned)(dq - c) <= 128u) ? p0[r] : NEG; p1[r] = ((unsigned)(dq - c - 32) <= 128u) ? p1[r] : NEG; } }
                } else if (mode == 1) {
                    if (kb + 63 > qw0) {
#pragma unroll
                        for (int r = 0; r < 16; ++r) { const int c = (r & 3) + 8 * (r >> 2);
                            p0[r] = (dq - c >= 0) ? p0[r] : NEG; p1[r] = (dq - c - 32 >= 0) ? p1[r] : NEG; } }
                } else rowok = gvalid;
                const float tb = sl * (float)kb;
                float pm0 = p0[0], pm1 = p1[0];
#pragma unroll
                for (int r = 1; r < 16; ++r) { pm0 = fmaxf(pm0, p0[r]); pm1 = fmaxf(pm1, p1[r]); }
                float pmax = fmaxf(pm0, pm1 + sl32);
                { auto rr = __builtin_amdgcn_permlane32_swap(__float_as_uint(pmax), __float_as_uint(pmax), false, false); pmax = fmaxf(__uint_as_float(rr[0]), __uint_as_float(rr[1])); }
                pmax = rowok ? pmax : NEG;
                const float m_loc = m_reg - tb;
                const float mn = fmaxf(m_loc, pmax); const float alpha = __builtin_amdgcn_exp2f(m_loc - mn); m_reg = mn + tb;
                const float ref0 = rowok ? mn : __builtin_inff(), ref1 = ref0 - sl32;
                float ps = 0.f;
#pragma unroll
                for (int r = 0; r < 16; ++r) { p0[r] = __builtin_amdgcn_exp2f(p0[r] - ref0); p1[r] = __builtin_amdgcn_exp2f(p1[r] - ref1); ps += p0[r] + p1[r]; }
                { auto rr = __builtin_amdgcn_permlane32_swap(__float_as_uint(ps), __float_as_uint(ps), false, false); ps = __uint_as_float(rr[0]) + __uint_as_float(rr[1]); }
                l_reg = l_reg * alpha + ps;
                pack_p(p0, p1, pa0, pa1, pa2, pa3);
                if (__any(alpha < 1.f)) { if (hi == 0) al_l[r32] = alpha; asm volatile("s_waitcnt lgkmcnt(0)" ::: "memory");
#pragma unroll
                    for (int d_ = 0; d_ < 4; ++d_)
#pragma unroll
                        for (int r = 0; r < 16; ++r) o[d_][r] *= al_l[crow(r, hi)]; }
            }
            SBAR();
            pv_tile(o, vb0 + buf * SHM_T, pa0, pa1, pa2, pa3);
        }
        if (mode == 2) { if (lane == 0) FLG[buf * 8 + wid] = wdone ? 1 : 0; }
        __syncthreads();
        if (mode == 2) { const i32x4 fa = *(const i32x4*)(FLG + buf * 8), fb = *(const i32x4*)(FLG + buf * 8 + 4);
            if ((fa[0] & fa[1] & fa[2] & fa[3] & fb[0] & fb[1] & fb[2] & fb[3]) != 0) break; }
    }
#undef TDMA
    if (mode != 2) {
        const int slot = (mode == 0) ? br : 0;
        const size_t tok0 = rowbase + (size_t)dil * qw0;
        int* ts_l = (int*)al_l;
        if (hi == 0) { const float lse = (l_reg > 0.f) ? (m_reg + __builtin_amdgcn_logf(l_reg) - ((mode == 0) ? sl * (float)pos : 0.f)) : -__builtin_inff();
            if (mode == 3) { const int ts = gvalid ? (int)((1u + (gent >> 12)) * (unsigned)NTOK + (unsigned)rowbase + (gent & 4095u)) : -1; ts_l[r32] = ts; if (gvalid) A.dpl[(size_t)ts * DPLW + h] = lse; }
            else A.dpl[((size_t)slot * NTOK + tok0 + (size_t)dil * r32) * DPLW + h] = lse;
            if (mode == 1) { for (int s_ = 1 + (qb < 3 ? qb : 3); s_ < 4; ++s_) A.dpl[((size_t)s_ * NTOK + tok0 + r32) * DPLW + h] = -__builtin_inff(); }
            li_l[r32] = (l_reg > 0.f) ? __builtin_amdgcn_rcpf(l_reg) : 0.f; }
        asm volatile("s_waitcnt lgkmcnt(0)" ::: "memory");
        float rli[16];
#pragma unroll
        for (int r = 0; r < 16; ++r) rli[r] = li_l[crow(r, hi)];
        if (mode == 3) {
#pragma unroll
            for (int r = 0; r < 16; ++r) { const int ts = ts_l[crow(r, hi)]; bf16* Ow = A.dpo + (size_t)(ts < 0 ? 0 : ts) * DPW + h * 128;
#pragma unroll
                for (int d0 = 0; d0 < 4; ++d0) { const float v = o[d0][r] * rli[r]; const float vn = xor_get<1>(v);
                    if ((r32 & 1) == 0 && ts >= 0) *(unsigned*)(Ow + d0 * 32 + r32) = cvtpk(v, vn); } }
        } else {
        bf16* Ow = A.dpo + ((size_t)slot * NTOK + tok0) * DPW + h * 128;
#pragma unroll
        for (int r = 0; r < 16; ++r) { const int orow = crow(r, hi);
#pragma unroll
            for (int d0 = 0; d0 < 4; ++d0) { const float v = o[d0][r] * rli[r]; const float vn = xor_get<1>(v);
                if ((r32 & 1) == 0) *(unsigned*)(Ow + (size_t)orow * dil * DPW + d0 * 32 + r32) = cvtpk(v, vn); } }
        }
    } else {
        float ssq[16];
#pragma unroll
        for (int r = 0; r < 16; ++r) { float a = 0.f;
#pragma unroll
            for (int d0 = 0; d0 < 4; ++d0) { const float v = o[d0][r]; a = fmaf(v, v, a); }
            ssq[r] = a; }
#pragma unroll
        for (int r = 0; r < 16; ++r) { float a = ssq[r]; a += xor_get<1>(a); a += xor_get<2>(a); a += xor_get<4>(a); a += xor_get<8>(a); a += xor_get<16>(a); ssq[r] = a; }
        float gn[4];
#pragma unroll
        for (int d0 = 0; d0 < 4; ++d0) gn[d0] = A.out_gain[h * 128 + d0 * 32 + r32];
        bf16* Ow = A.obuf + (rowbase + qw0) * DM + h * 128;
#pragma unroll
        for (int r = 0; r < 16; ++r) { const int orow = crow(r, hi); const float rn = 1.0f / sqrtf(ssq[r] * (1.0f / 128.0f) + 1e-6f);
#pragma unroll
            for (int d0 = 0; d0 < 4; ++d0) { const float v = o[d0][r] * rn * gn[d0]; const float vn = xor_get<1>(v);
                if ((r32 & 1) == 0) *(unsigned*)(Ow + (size_t)orow * DM + d0 * 32 + r32) = cvtpk(v, vn); } }
    }
}

__device__ __forceinline__ void moba_select(const AttnArgs& A, const int b, const int h, const int qb, char* shm, const int wave_) {
    const int tid = tid_of(wave_), wid = wave_, lane = tid & 63, r32 = lane & 31, hi = lane >> 5;
    float* KM = (float*)(shm + L_KM); int* LC = (int*)(shm + L_TL); int* LB = LC + 16;
    const int pos = qb * 256 + wid * 32 + r32;
    const bf16* Qp = A.qkv + ((size_t)b * SEQ + pos) * QS + h * 128;
    bf16x8 qr[8];
#pragma unroll
    for (int d0 = 0; d0 < 8; ++d0) qr[d0] = *reinterpret_cast<const bf16x8*>(Qp + d0 * 16 + hi * 8);
    if (tid < 16) LC[tid] = 0;
    { const float* src = A.kmean + (size_t)((b * 5 + (h - 6)) * 16) * 128; *(f32x4*)(KM + tid * 4) = *(const f32x4*)(src + tid * 4); }
    __syncthreads();
    float gate[16];
#pragma unroll
    for (int j = 0; j < 16; ++j) gate[j] = 0.f;
#pragma unroll
    for (int d0 = 0; d0 < 8; ++d0) {
        float qv[8];
#pragma unroll
        for (int e = 0; e < 8; ++e) qv[e] = bf2f(qr[d0][e]);
#pragma unroll
        for (int j = 0; j < 16; ++j) { const f32x4 k0 = *(const f32x4*)(KM + j * 128 + d0 * 16 + hi * 8), k1 = *(const f32x4*)(KM + j * 128 + d0 * 16 + hi * 8 + 4);
            float a = gate[j];
            a = fmaf(qv[0], k0[0], a); a = fmaf(qv[1], k0[1], a); a = fmaf(qv[2], k0[2], a); a = fmaf(qv[3], k0[3], a);
            a = fmaf(qv[4], k1[0], a); a = fmaf(qv[5], k1[1], a); a = fmaf(qv[6], k1[2], a); a = fmaf(qv[7], k1[3], a);
            gate[j] = a; }
    }
#pragma unroll
    for (int j = 0; j < 16; ++j) gate[j] = xor32_sum(gate[j]);
    unsigned sel = 0u;
#pragma unroll
    for (int it = 0; it < 3; ++it) { float best = -__builtin_inff(); int bi = -1;
#pragma unroll
        for (int j = 0; j < 16; ++j) { const bool ok = (j < qb) && (((sel >> j) & 1u) == 0u) && (gate[j] > best); if (ok) { best = gate[j]; bi = j; } }
        if (bi >= 0) sel |= 1u << bi; }
    int jj0 = -1, jj1 = -1, jj2 = -1, ll0 = 0, ll1 = 0, ll2 = 0;
    if (hi == 0) { unsigned s_ = sel;
        if (s_) { jj0 = __builtin_ctz(s_); s_ &= s_ - 1u; ll0 = __hip_atomic_fetch_add(LC + jj0, 1, __ATOMIC_RELAXED, __HIP_MEMORY_SCOPE_WORKGROUP); }
        if (s_) { jj1 = __builtin_ctz(s_); s_ &= s_ - 1u; ll1 = __hip_atomic_fetch_add(LC + jj1, 1, __ATOMIC_RELAXED, __HIP_MEMORY_SCOPE_WORKGROUP); }
        if (s_) { jj2 = __builtin_ctz(s_); ll2 = __hip_atomic_fetch_add(LC + jj2, 1, __ATOMIC_RELAXED, __HIP_MEMORY_SCOPE_WORKGROUP); } }
    __syncthreads();
    const int lbase = (b * 5 + (h - 6)) * 15;
    if (tid < 15) { const int n = LC[tid]; LB[tid] = n ? (int)__hip_atomic_fetch_add(A.mcnt + lbase + tid, (unsigned)n, __ATOMIC_RELAXED, __HIP_MEMORY_SCOPE_AGENT) : 0; }
    __syncthreads();
    if (hi == 0) {
        if (jj0 >= 0) st_sc1(A.mlist + (size_t)(lbase + jj0) * MLCAP + LB[jj0] + ll0, (unsigned)pos);
        if (jj1 >= 0) st_sc1(A.mlist + (size_t)(lbase + jj1) * MLCAP + LB[jj1] + ll1, (unsigned)pos | (1u << 12));
        if (jj2 >= 0) st_sc1(A.mlist + (size_t)(lbase + jj2) * MLCAP + LB[jj2] + ll2, (unsigned)pos | (2u << 12)); }
    asm volatile("s_waitcnt vmcnt(0)" ::: "memory");
    __syncthreads();
    if (tid == 0) __hip_atomic_fetch_add(A.mdone, 1u, __ATOMIC_RELAXED, __HIP_MEMORY_SCOPE_AGENT);
}

constexpr bool unit_valid(int mode, int sub) { return mode == 0 ? sub < 48 : sub < 16; }
constexpr int unit_cost(int mode, int sub) {
    if (mode == 0) return 4;
    if (mode == 2) return 4 * (sub + 1) < 6 ? 4 * (sub + 1) : 6;
    return 4;
}
constexpr int gath_expected(int kb) { int len = 0; for (int qb = kb + 1; qb < 16; ++qb) len += (qb <= 3) ? 256 : 768 / qb; return (len + 255) / 256; }
constexpr int N_GATH = 2 * 5 * 120;
constexpr int N_UNITS = 2 * 6 * 48 + 2 * 5 * 16 + 2 * 5 * 16;
constexpr int CHUNK_TILES = 2, N_CHUNKS = 2240;
constexpr int N_TICKETS = N_SEL + N_UNITS + N_GATH + N_CHUNKS;
struct OrderTab { unsigned short v[N_TICKETS]; };
constexpr OrderTab make_order() {
    OrderTab T{}; int n = 0, nc = 0; long tot = 0, acc = 0;
    for (int b = 0; b < 2; ++b) for (int hr = 0; hr < 5; ++hr) for (int qb = 15; qb >= 1; --qb) T.v[n++] = (unsigned short)(0x2000 | (b << 9) | (hr << 6) | qb);
    for (int mode = 0; mode < 3; ++mode) { const int nh = (mode == 0) ? 6 : 5; for (int sub = 0; sub < 64; ++sub) if (unit_valid(mode, sub)) tot += 2L * nh * unit_cost(mode, sub); }
    for (int kb = 0; kb < 15; ++kb) tot += 2L * 5 * 4 * (gath_expected(kb) < 15 - kb ? gath_expected(kb) : 15 - kb);
    for (int cost = 64; cost >= 1; --cost)
        for (int mode = 2; mode >= 0; --mode) { const int nh = (mode == 0) ? 6 : 5;
            for (int sub = 63; sub >= 0; --sub) { if (!unit_valid(mode, sub) || unit_cost(mode, sub) != cost) continue;
                for (int b = 0; b < 2; ++b) for (int hr = 0; hr < nh; ++hr) { T.v[n++] = (unsigned short)((mode << 10) | (b << 9) | (hr << 6) | sub);
                    acc += (long)cost * N_CHUNKS; while (acc >= tot && nc < N_CHUNKS) { T.v[n++] = (unsigned short)(0x8000 | nc); ++nc; acc -= tot; } } } }
    for (int c = 0; c < 15; ++c) for (int kb = 0; kb + c < 15; ++kb) { if (c >= gath_expected(kb)) continue;
        for (int b = 0; b < 2; ++b) for (int hr = 0; hr < 5; ++hr) { T.v[n++] = (unsigned short)(0x4000 | (b << 11) | (hr << 8) | (kb << 4) | c);
            acc += 4L * N_CHUNKS; while (acc >= tot && nc < N_CHUNKS) { T.v[n++] = (unsigned short)(0x8000 | nc); ++nc; acc -= tot; } } }
    while (nc < N_CHUNKS) { T.v[n++] = (unsigned short)(0x8000 | nc); ++nc; }
    for (int c = 0; c < 15; ++c) for (int kb = 0; kb + c < 15; ++kb) { if (c < gath_expected(kb)) continue;
        for (int b = 0; b < 2; ++b) for (int hr = 0; hr < 5; ++hr) T.v[n++] = (unsigned short)(0x4000 | (b << 11) | (hr << 8) | (kb << 4) | c); }
    return T;
}
__device__ const OrderTab ATT_ORDER = make_order();
#undef KSWZ
#undef SBAR
}


constexpr int NWAVES = 8;
#ifndef MK_SPLIT
#define MK_SPLIT 0
#endif
constexpr int BATCH = 2, SEQ = 4096, D = 2048, FF = 5632, NE = 8;
constexpr int M = BATCH * SEQ;
constexpr int NQKV = 3 * D, NGU = 2 * FF;
constexpr int MPAD = 18432;
constexpr float EPS = 1e-6f;
constexpr size_t MiB = 1u << 20;
constexpr size_t WS_CTL = 0, CTL_ZERO_BYTES = 1 * MiB;
constexpr size_t WS_WQKV = 1 * MiB;
constexpr size_t WS_WO = 49 * MiB;
constexpr size_t WS_WGU_D = 65 * MiB;
constexpr size_t WS_WD_D = 109 * MiB;
constexpr size_t WS_WGU_M = 131 * MiB;
constexpr size_t WS_WD_M = 483 * MiB;
constexpr size_t WS_H = 659 * MiB;
constexpr size_t WS_QKV = 723 * MiB;
constexpr size_t WS_O = 819 * MiB;
constexpr size_t WS_A = 851 * MiB;
constexpr size_t WS_YS = WS_QKV;
constexpr size_t WS_ACT = 883 * MiB;
constexpr size_t WS_XS = 1081 * MiB;
constexpr size_t WS_MISC = 1153 * MiB;
constexpr size_t WS_DPO = 1154 * MiB;
constexpr size_t WS_DPL = 1242 * MiB;
constexpr size_t WS_MLIST = 1244 * MiB;
constexpr size_t WS_END = 1249 * MiB;
constexpr size_t MISC_KMEAN = 0, MISC_SELE = 131072, MISC_SELREL = MISC_SELE + 32768, MISC_SELG = MISC_SELREL + 65536, MISC_SELPOS = MISC_SELG + 65536, MISC_RSQ = 393216  , MISC_RSQ2 = MISC_RSQ + 262144;
static_assert(MISC_SELPOS + 65536 <= MISC_RSQ && MISC_RSQ2 + 262144 <= MiB && (size_t)MPAD * D * 4 <= 160 * MiB && (size_t)MPAD * FF * 2 <= 198 * MiB, "ws map");
constexpr int CW_TMO = 0, CW_CODE = 1;
constexpr int CW_BAR = 4096;
constexpr int CW_ATTQ = 8192;
constexpr int CW_CNT = 8448;
constexpr int CW_MCNT = 9216;
constexpr int CW_MDONE = 10240;
constexpr int RING_OFF = 0, RING_BYTES = 131072;
constexpr int LDSCTL_OFF = 143360, MISC_OFF = LDSCTL_OFF + 320;
constexpr int LDS_BYTES = 147456;
constexpr int PPL = 11, N_PHASES = 2 * PPL;

#define GAS __attribute__((address_space(1)))
#define LAS __attribute__((address_space(3)))
typedef unsigned short bf16;
typedef unsigned v4u __attribute__((ext_vector_type(4)));
typedef float f32x4 __attribute__((ext_vector_type(4)));
typedef short bf16x8 __attribute__((ext_vector_type(8)));
typedef GAS unsigned gu32;
typedef GAS unsigned long long gu64;
#define RLX_AGENT __ATOMIC_RELAXED, __HIP_MEMORY_SCOPE_AGENT
#define LDS_WAIT() asm volatile("s_waitcnt lgkmcnt(0)" ::: "memory")
#define VM_WAIT() asm volatile("s_waitcnt vmcnt(0)" ::: "memory")
__device__ __forceinline__ unsigned long long rt() { return __builtin_amdgcn_s_memrealtime(); }
__device__ __forceinline__ unsigned f2bf(float f) { unsigned u = __builtin_bit_cast(unsigned, f); return (u + 0x7fffu + ((u >> 16) & 1u)) >> 16; }
__device__ __forceinline__ unsigned pk2(float lo, float hi) { return f2bf(lo) | (f2bf(hi) << 16); }

#define XB_TMO      128
#define XB_XCNT(j)  (256  + 64 * (j))
#define XB_XSUB(j)  (1280 + 64 * (j))
#define XB_XGEN(j)  (2304 + 64 * (j))
#define XB_TOP      3328
#define XB_TOPGEN   3392
#define XCD_BAR_WORDS 3456
#define XB_SPIN_CAP (1u << 18)

__device__ __forceinline__ unsigned xb_ld(unsigned* p)              { return __hip_atomic_load(p, __ATOMIC_RELAXED, __HIP_MEMORY_SCOPE_AGENT); }
__device__ __forceinline__ unsigned xb_add(unsigned* p, unsigned v) { return __hip_atomic_fetch_add(p, v, __ATOMIC_RELAXED, __HIP_MEMORY_SCOPE_AGENT); }
__device__ __forceinline__ unsigned xb_xcc_id() { return (unsigned)__builtin_amdgcn_s_getreg((3 << 11) | 20) & 0xFu; }
#define XB_SPIN(cond, bar) do { unsigned _sp = 0; while (cond) { __builtin_amdgcn_s_sleep(1); \
    if ((++_sp & 255u) == 0u) { if (xb_ld(&(bar)[XB_TMO])) break; if (_sp > XB_SPIN_CAP) { atomicAdd(&(bar)[XB_TMO], 1u); break; } } } } while (0)

#define XB_IS_T0 (b.wv == 0 && lane_id() == 0)
struct XcdBarrier {
    int wv;
    unsigned* bar; unsigned x;
    volatile LAS unsigned* st;
};

__device__ __forceinline__ XcdBarrier xcd_barrier_post(unsigned* bar, volatile LAS unsigned* st, int wv) {
    XcdBarrier b; b.bar = bar; b.x = xb_xcc_id(); b.st = st; b.wv = wv;
    if (XB_IS_T0) (void)xb_add(&bar[XB_XCNT(b.x)], 1u);
    return b;
}
__device__ __forceinline__ void xcd_barrier_complete(unsigned* bar, unsigned x, unsigned& nloc, unsigned& nx) {
    const unsigned G = gridDim.x * gridDim.y * gridDim.z;
    unsigned sum, cnt, mine, sp = 0u;
    for (;;) {
        sum = 0u; cnt = 0u; mine = 0u;
#pragma unroll
        for (unsigned j = 0; j < 16; ++j) { const unsigned c = xb_ld(&bar[XB_XCNT(j)]); sum += c; cnt += (c > 0u) ? 1u : 0u; mine = (j == x) ? c : mine; }
        if (sum == G) break;
        __builtin_amdgcn_s_sleep(1);
        if ((++sp & 255u) == 0u) { if (xb_ld(&bar[XB_TMO])) break; if (sp > XB_SPIN_CAP) { atomicAdd(&bar[XB_TMO], 1u); break; } }
    }
    nloc = mine > 0u ? mine : 1u; nx = cnt > 0u ? cnt : 1u;
}

__device__ __forceinline__ void xcd_barrier(const XcdBarrier& b) {
    asm volatile("s_waitcnt vmcnt(0)" ::: "memory");
    __syncthreads();
    if (XB_IS_T0) {
        unsigned* bar = b.bar;
        __builtin_amdgcn_s_waitcnt(0);
        unsigned nloc = b.st[0], nx = b.st[1];
        if (nloc == 0u) { xcd_barrier_complete(bar, b.x, nloc, nx); b.st[0] = nloc; b.st[1] = nx; }
        const unsigned old = xb_add(&bar[XB_XSUB(b.x)], 1u);
        const unsigned gen = old / nloc;
        if (old + 1u == (gen + 1u) * nloc) {
            __builtin_amdgcn_fence(__ATOMIC_RELEASE, "agent");
            asm volatile("s_waitcnt vmcnt(0)" ::: "memory");
            const unsigned og = xb_add(&bar[XB_TOP], 1u);
            const unsigned tg = og / nx;
            if (og + 1u == (tg + 1u) * nx) xb_add(&bar[XB_TOPGEN], 1u);
            else XB_SPIN(xb_ld(&bar[XB_TOPGEN]) == tg, bar);
            __builtin_amdgcn_fence(__ATOMIC_ACQUIRE, "agent");
            xb_add(&bar[XB_XGEN(b.x)], 1u);
            asm volatile("s_waitcnt vmcnt(0)" ::: "memory");
        } else {
            XB_SPIN(xb_ld(&bar[XB_XGEN(b.x)]) == gen, bar);
            __builtin_amdgcn_fence(__ATOMIC_ACQUIRE, "agent");
            asm volatile("s_waitcnt vmcnt(0)" ::: "memory");
        }
    }
    __syncthreads();
}


__device__ __forceinline__ float wave_sum(float v) {
    v += xor_get<1>(v); v += xor_get<2>(v); v += xor_get<4>(v); v += xor_get<8>(v); v += xor_get<16>(v);
    return xor32_sum(v);
}
__device__ __forceinline__ float bf2f_u(unsigned short s) { return __uint_as_float(((unsigned)s) << 16); }
typedef unsigned u32x2_g __attribute__((ext_vector_type(2)));
__device__ __forceinline__ f32x4 bf4_to_f32(u32x2_g a) { return (f32x4){__uint_as_float(a.x << 16), __uint_as_float(a.x & 0xffff0000u), __uint_as_float(a.y << 16), __uint_as_float(a.y & 0xffff0000u)}; }

__device__ __forceinline__ void p0_transpose_item(const float* W, int K, int N, bf16* WT, int mode, LAS float* scr, int item, int lane) {
    const int nblk = N / 32, kb = item / nblk, nb = item % nblk, k0 = 64 * kb, n0 = 32 * nb;
#pragma unroll 8
    for (int i = 0; i < 32; ++i) { const int kk = 2 * i + (lane >> 5); scr[kk * 33 + (lane & 31)] = W[(size_t)(k0 + kk) * N + n0 + (lane & 31)]; }
    LDS_WAIT(); asm volatile("" ::: "memory");
    const int drow0 = (mode == 0) ? n0 : (256 * (n0 >> 7) + (n0 & 127) + (mode == 2 ? 128 : 0));
    const int c = lane & 7;
#pragma unroll
    for (int j = 0; j < 4; ++j) { const int n = (lane >> 3) + 8 * j; const LAS float* s = scr + (8 * c) * 33 + n;
        v4u o; o.x = pk2(s[0 * 33], s[1 * 33]); o.y = pk2(s[2 * 33], s[3 * 33]); o.z = pk2(s[4 * 33], s[5 * 33]); o.w = pk2(s[6 * 33], s[7 * 33]);
        *(GAS v4u*)(WT + (size_t)(drow0 + n) * K + k0 + 8 * c) = o; }
    LDS_WAIT(); asm volatile("" ::: "memory");
}

__device__ __forceinline__ void p0_transpose_item_fp8(const float* W, int K, int N, unsigned char* WT, int mode, LAS float* scr, int item, int lane) {
    const int nblk = N / 32, kb = item / nblk, nb = item % nblk, k0 = 64 * kb, n0 = 32 * nb;
#pragma unroll 8
    for (int i = 0; i < 32; ++i) { const int kk = 2 * i + (lane >> 5); scr[kk * 33 + (lane & 31)] = W[(size_t)(k0 + kk) * N + n0 + (lane & 31)]; }
    LDS_WAIT(); asm volatile("" ::: "memory");
    const int drow0 = (mode == 0) ? n0 : (256 * (n0 >> 7) + (n0 & 127) + (mode == 2 ? 128 : 0));
    const int n = lane & 31, kq = lane >> 5; const LAS float* sp = scr + (32 * kq) * 33 + n;
    v4u o0, o1;
#define P4(j) pg8::pk4_fp8(sp[(4 * (j)) * 33] * 256.f, sp[(4 * (j) + 1) * 33] * 256.f, sp[(4 * (j) + 2) * 33] * 256.f, sp[(4 * (j) + 3) * 33] * 256.f)
    o0.x = P4(0); o0.y = P4(1); o0.z = P4(2); o0.w = P4(3); o1.x = P4(4); o1.y = P4(5); o1.z = P4(6); o1.w = P4(7);
#undef P4
    GAS v4u* dst = (GAS v4u*)(WT + (size_t)(drow0 + n) * K + k0 + 32 * kq);
    dst[0] = o0; dst[1] = o1;
    LDS_WAIT(); asm volatile("" ::: "memory");
}

struct Ptrs {
    const float *x, *attn_norm, *w_in, *q_gain, *k_gain, *out_gain, *w_out, *ffn_norm, *dwg, *dwu, *dwd, *router, *mwg, *mwu, *mwd;
    float* out;
    bf16 *Wqkv_t, *Wo_t, *QKV, *OB, *AB;
    unsigned char *Wgu_d, *Wd_d, *Wgu_m, *Wd_m, *AB8, *ACT, *XS;
    float *kmean, *DPL; bf16 *DPO, *YS, *H; unsigned* sel_e; int* sel_rel; float* sel_g; int* sel_pos;
    gu32* ctl; float* rsq;
};

struct CvTile { const float* W; unsigned char* WT; int K, N, mode, f8, r; const float* gain; };
__device__ __forceinline__ CvTile cv_decode(const Ptrs& P, int it) {
    constexpr int T_IN = (D / 128) * (NQKV / 256), T_O = (D / 128) * (D / 256), T_G = (D / 128) * (FF / 256), T_D = (FF / 128) * (D / 256), T_E = 2 * T_G + T_D;
    CvTile c; int r = it; c.gain = nullptr;
    if (r < T_IN) { c.W = P.w_in; c.WT = (unsigned char*)P.Wqkv_t; c.K = D; c.N = NQKV; c.mode = 0; c.f8 = 0; c.r = r; return c; } r -= T_IN;
    if (r < T_O) { c.W = P.w_out; c.WT = (unsigned char*)P.Wo_t; c.K = D; c.N = D; c.mode = 0; c.f8 = 0; c.r = r; return c; } r -= T_O;
    if (r < T_G) { c.W = P.dwg; c.WT = P.Wgu_d; c.K = D; c.N = FF; c.mode = 1; c.f8 = 1; c.r = r; return c; } r -= T_G;
    if (r < T_G) { c.W = P.dwu; c.WT = P.Wgu_d; c.K = D; c.N = FF; c.mode = 2; c.f8 = 1; c.r = r; return c; } r -= T_G;
    if (r < T_D) { c.W = P.dwd; c.WT = P.Wd_d; c.K = FF; c.N = D; c.mode = 0; c.f8 = 1; c.r = r; return c; } r -= T_D;
    if (r < T_IN) { c.W = P.w_in + (size_t)D * NQKV; c.WT = (unsigned char*)(P.Wqkv_t + (size_t)NQKV * D); c.K = D; c.N = NQKV; c.mode = 0; c.f8 = 0; c.r = r; c.gain = P.attn_norm + D; return c; } r -= T_IN;
    if (r < T_O) { c.W = P.w_out + (size_t)D * D; c.WT = (unsigned char*)(P.Wo_t + (size_t)D * D); c.K = D; c.N = D; c.mode = 0; c.f8 = 0; c.r = r; return c; } r -= T_O;
    const int e = r / T_E; r -= e * T_E; c.f8 = 1;
    if (r < T_G) { c.W = P.mwg + (size_t)e * D * FF; c.WT = P.Wgu_m + (size_t)e * NGU * D; c.K = D; c.N = FF; c.mode = 1; c.r = r; return c; } r -= T_G;
    if (r < T_G) { c.W = P.mwu + (size_t)e * D * FF; c.WT = P.Wgu_m + (size_t)e * NGU * D; c.K = D; c.N = FF; c.mode = 2; c.r = r; return c; } r -= T_G;
    c.W = P.mwd + (size_t)e * FF * D; c.WT = P.Wd_m + (size_t)e * D * FF; c.K = FF; c.N = D; c.mode = 0; c.r = r; return c;
}
constexpr int CV_T_IN = (D / 128) * (NQKV / 256), CV_T_O = (D / 128) * (D / 256), CV_T_G = (D / 128) * (FF / 256), CV_T_D = (FF / 128) * (D / 256);
constexpr int CV_L0 = CV_T_IN + CV_T_O + 2 * CV_T_G + CV_T_D, CV_DEF = CV_T_IN + CV_T_O + NE * (2 * CV_T_G + CV_T_D);
static_assert(CV_DEF == 2 * att::N_CHUNKS * att::CHUNK_TILES, "deferred conversion tiles = 2 phases x N_CHUNKS x CHUNK_TILES");
__device__ __forceinline__ void cv_tile_out(const CvTile& cur, LAS float* S, int tid_) {
    constexpr int LS = 260;
    const int nbl = cur.N / 256, kb = cur.r / nbl, nb = cur.r - kb * nbl;
    if (cur.f8) {
#pragma unroll
        for (int i = 0; i < 4; ++i) { const int p = tid_ + 512 * i, kq = p & 7, n = p >> 3, nn = 256 * nb + n;
            const int drow = (cur.mode == 0) ? nn : (256 * (nn >> 7) + (nn & 127) + (cur.mode == 2 ? 128 : 0));
            const LAS float* sp = S + (16 * kq) * LS + (n ^ (4 * kq)); v4u o;
#define P4(j) pg8::pk4_fp8(sp[(4 * (j)) * LS] * 256.f, sp[(4 * (j) + 1) * LS] * 256.f, sp[(4 * (j) + 2) * LS] * 256.f, sp[(4 * (j) + 3) * LS] * 256.f)
            o.x = P4(0); o.y = P4(1); o.z = P4(2); o.w = P4(3);
#undef P4
            __builtin_nontemporal_store(o, (GAS v4u*)(cur.WT + (size_t)drow * cur.K + 128 * kb + 16 * kq)); } }
    else {
#pragma unroll
        for (int i = 0; i < 8; ++i) { const int p = tid_ + 512 * i, kc = p & 15, n = p >> 4, nn = 256 * nb + n;
            const int drow = (cur.mode == 0) ? nn : (256 * (nn >> 7) + (nn & 127) + (cur.mode == 2 ? 128 : 0));
            const LAS float* sp = S + (8 * kc) * LS + (n ^ (4 * (kc >> 1))); v4u o;
            o.x = pk2(sp[0], sp[LS]); o.y = pk2(sp[2 * LS], sp[3 * LS]); o.z = pk2(sp[4 * LS], sp[5 * LS]); o.w = pk2(sp[6 * LS], sp[7 * LS]);
            *(GAS v4u*)((bf16*)cur.WT + (size_t)drow * cur.K + 128 * kb + 8 * kc) = o; } }
}
__device__ __forceinline__ void cv8_to_lds(const f32x4 (&v)[16], LAS unsigned char* T, int wave, int lane) {
    unsigned d[16];
#pragma unroll
    for (int i = 0; i < 16; ++i) d[i] = pg8::pk4_fp8(v[i].x * 256.f, v[i].y * 256.f, v[i].z * 256.f, v[i].w * 256.f);
    unsigned o[4][4];
#pragma unroll
    for (int q = 0; q < 4; ++q) { const unsigned a = d[4 * q], b = d[4 * q + 1], c = d[4 * q + 2], e = d[4 * q + 3];
        const unsigned t0 = __builtin_amdgcn_perm(b, a, 0x05010400u), t1 = __builtin_amdgcn_perm(b, a, 0x07030602u), t2 = __builtin_amdgcn_perm(e, c, 0x05010400u), t3 = __builtin_amdgcn_perm(e, c, 0x07030602u);
        o[0][q] = __builtin_amdgcn_perm(t2, t0, 0x05040100u); o[1][q] = __builtin_amdgcn_perm(t2, t0, 0x07060302u); o[2][q] = __builtin_amdgcn_perm(t3, t1, 0x05040100u); o[3][q] = __builtin_amdgcn_perm(t3, t1, 0x07060302u); }
#pragma unroll
    for (int j = 0; j < 4; ++j) { v4u w; w.x = o[j][0]; w.y = o[j][1]; w.z = o[j][2]; w.w = o[j][3];
        *(LAS v4u*)(T + (4 * lane + j) * 128 + 16 * (wave ^ (lane & 7))) = w; }
}
__device__ __forceinline__ void cv8_out(const CvTile& cur, const LAS unsigned char* T, int tid_) {
    const int nbl = cur.N / 256, kb = cur.r / nbl, nb = cur.r - kb * nbl;
#pragma unroll
    for (int i = 0; i < 4; ++i) { const int p = tid_ + 512 * i, c = p & 7, n = p >> 3, nn = 256 * nb + n;
        const int drow = (cur.mode == 0) ? nn : (256 * (nn >> 7) + (nn & 127) + (cur.mode == 2 ? 128 : 0));
        const v4u w = *(const LAS v4u*)(T + n * 128 + 16 * (c ^ ((n >> 2) & 7)));
        __builtin_nontemporal_store(w, (GAS v4u*)(cur.WT + (size_t)drow * cur.K + 128 * kb + 16 * c)); }
}
__device__ __forceinline__ void convert_weights(const Ptrs& P, LAS unsigned char* lds, int t0, int step, int t1, int wave, int lane) {
    asm volatile("" : "+v"(lane));
    constexpr int LS = 260;
    LAS float* S = (LAS float*)(lds + RING_OFF);
    LAS unsigned char* T8 = lds + RING_OFF;
    const int tid_ = wave * 64 + lane;
    if (t0 >= t1) return;
    f32x4 va[16], vb[16];
#define CV_LOAD(v, c) do { const int nbl_ = (c).N / 256, kb_ = (c).r / nbl_, nb_ = (c).r - kb_ * nbl_; const float* p_ = (c).W + (size_t)(128 * kb_ + wave * 16) * (c).N + 256 * nb_ + 4 * lane; \
        _Pragma("unroll") for (int i_ = 0; i_ < 16; ++i_) (v)[i_] = __builtin_nontemporal_load((const f32x4*)(p_ + (size_t)i_ * (c).N)); } while (0)
#define CV_TOLDS(v) do { _Pragma("unroll") for (int i_ = 0; i_ < 16; ++i_) *(LAS f32x4*)(S + (wave * 16 + i_) * LS + ((4 * lane) ^ (4 * wave))) = (v)[i_]; LDS_WAIT(); __syncthreads(); } while (0)
#define CV_STEP(v, c, tcur, tnext_is_f8) do { const CvTile done_ = (c); \
        if (done_.gain) { const int nbl_ = done_.N / 256; typedef __attribute__((address_space(4))) const float cfloat_; const cfloat_* gp_ = (const cfloat_*)(done_.gain + 128 * (done_.r / nbl_) + wave * 16);     \
            _Pragma("unroll") for (int i_ = 0; i_ < 16; ++i_) (v)[i_] = (v)[i_] * gp_[i_]; } \
        if (done_.f8) { cv8_to_lds(v, T8 + par * 32768, wave, lane); LDS_WAIT(); __syncthreads(); } else { CV_TOLDS(v); } \
        tcur += 2 * step; if (tcur < t1) { (c) = cv_decode(P, tcur); CV_LOAD(v, c); } \
        if (done_.f8) { cv8_out(done_, T8 + par * 32768, tid_); par ^= 1; if (!(tnext_is_f8)) { LDS_WAIT(); __syncthreads(); } } \
        else { cv_tile_out(done_, S, tid_); LDS_WAIT(); __syncthreads(); } } while (0)
    int ta = t0, tb = t0 + step, par = 0;
    CvTile ca = cv_decode(P, ta), cb = ca; CV_LOAD(va, ca);
    if (tb < t1) { cb = cv_decode(P, tb); CV_LOAD(vb, cb); }
    for (;;) {
        { const bool nf8 = (tb < t1) && cb.f8; CV_STEP(va, ca, ta, nf8); }
        if (tb >= t1) break;
        { const bool nf8 = (ta < t1) && ca.f8; CV_STEP(vb, cb, tb, nf8); }
        if (ta >= t1) break;
    }
#undef CV_LOAD
#undef CV_TOLDS
#undef CV_STEP
}
__device__ __forceinline__ void attn_conv_phase(const Ptrs& P, const att::AttnArgs& A, int layer, unsigned* qctr, unsigned char* lds, const int wave_) {
    char* shm = (char*)lds + RING_OFF;
    int* TK = (int*)(shm + att::L_MSK) + 4;
    const bool t0_ = (wave_ == 0 && lane_id() == 0);
    int nxt_ = 0; if (t0_) nxt_ = (int)__hip_atomic_fetch_add(qctr, 1u, __ATOMIC_RELAXED, __HIP_MEMORY_SCOPE_AGENT);
    bool selrdy = false;
    for (;;) {
        __syncthreads();
        if (t0_) TK[0] = nxt_;
        __syncthreads();
        const int tk = __builtin_amdgcn_readfirstlane(TK[0]);
        if (tk >= att::N_TICKETS) break;
        if (t0_) nxt_ = (int)__hip_atomic_fetch_add(qctr, 1u, __ATOMIC_RELAXED, __HIP_MEMORY_SCOPE_AGENT);
        const int code = att::ATT_ORDER.v[tk];
        if (code & 0x8000) {
            const int t0 = CV_L0 + (layer * att::N_CHUNKS + (code & 0x7fff)) * att::CHUNK_TILES;
            convert_weights(P, (LAS unsigned char*)lds, t0, 1, t0 + att::CHUNK_TILES, wave_, lane_id());
        } else if (code & 0x4000) {
            if (!selrdy) { if (t0_) { unsigned spins = 0; while (att::ld_sc1(A.mdone) < (unsigned)att::N_SEL && ++spins < (1u << 24)) __builtin_amdgcn_s_sleep(8); } selrdy = true; __syncthreads(); }
            att::attn_unit<3>(A, (code >> 11) & 1, 6 + ((code >> 8) & 7), code & 0xff, shm, wave_);
        } else if (code & 0x2000) {
            att::moba_select(A, (code >> 9) & 1, 6 + ((code >> 6) & 7), code & 63, shm, wave_);
        } else {
            const int mode = code >> 10, b = (code >> 9) & 1, hr = (code >> 6) & 7, sub = code & 63;
            const int h = (mode == 0) ? hr : ((mode == 1) ? 6 + hr : 11 + hr);
            if (mode == 0) att::attn_unit<0>(A, b, h, sub, shm, wave_); else if (mode == 1) att::attn_unit<1>(A, b, h, sub, shm, wave_); else att::attn_unit<2>(A, b, h, sub, shm, wave_);
        }
    }
}
template <bool F8, bool SRC16, int NR> __device__ __forceinline__ void norm_rows(const void* srcv, const float* gain, void* dstv, int vcu, int G, int wave, int lane) {
    asm volatile("" : "+v"(lane));
    const int gw = vcu * NWAVES + wave, NGW = G * NWAVES;
    f32x4 g[8];
#pragma unroll
    for (int j = 0; j < 8; ++j) g[j] = ((const GAS f32x4*)gain)[lane + 64 * j];
    for (int m0 = gw; m0 < M; m0 += NR * NGW) {
        f32x4 v[NR][8];
#pragma unroll
        for (int q = 0; q < NR; ++q) { const int mq = m0 + q * NGW; const int m = mq < M ? mq : m0;
            if constexpr (SRC16) { const GAS u32x2_g* xr = (const GAS u32x2_g*)((const bf16*)srcv + (size_t)m * D) + lane;
#pragma unroll
                for (int j = 0; j < 8; ++j) v[q][j] = bf4_to_f32(xr[64 * j]); }
            else { const GAS f32x4* xr = (const GAS f32x4*)((const float*)srcv + (size_t)m * D) + lane;
#pragma unroll
                for (int j = 0; j < 8; ++j) v[q][j] = xr[64 * j]; } }
#pragma unroll
        for (int q = 0; q < NR; ++q) { const int m = m0 + q * NGW; if (m >= M) break;
            float s = 0.f;
#pragma unroll
            for (int j = 0; j < 8; ++j) s += (v[q][j].x * v[q][j].x + v[q][j].y * v[q][j].y) + (v[q][j].z * v[q][j].z + v[q][j].w * v[q][j].w);
            const float r = 1.0f / sqrtf(wave_sum(s) * (1.0f / D) + EPS);
            if constexpr (F8) { GAS unsigned* o4 = (GAS unsigned*)((unsigned char*)dstv + (size_t)m * D) + lane;
#pragma unroll
                for (int j = 0; j < 8; ++j) o4[64 * j] = pg8::pk4_fp8(v[q][j].x * r * g[j].x, v[q][j].y * r * g[j].y, v[q][j].z * r * g[j].z, v[q][j].w * r * g[j].w); }
            else { GAS unsigned long long* o8 = (GAS unsigned long long*)((bf16*)dstv + (size_t)m * D) + lane;
#pragma unroll
                for (int j = 0; j < 8; ++j) o8[64 * j] = (unsigned long long)pk2(v[q][j].x * r * g[j].x, v[q][j].y * r * g[j].y) | ((unsigned long long)pk2(v[q][j].z * r * g[j].z, v[q][j].w * r * g[j].w) << 32); }
        }
    }
}
__device__ __forceinline__ void prep_phase(const Ptrs& P, int layer, LAS unsigned char* lds, int vcu, int G, int tid, int wave, int lane) {
    asm volatile("" : "+v"(lane), "+v"(tid));
    LAS float* red = (LAS float*)(lds + RING_OFF);
    const int tsub = lane >> 4, c = lane & 15;
#define PREP_ADDR(it_) (P.QKV + ((size_t)(((it_) / 22) >> 4) * SEQ + (((it_) / 22) & 15) * 256 + wave * 32 + tsub) * NQKV + ((((it_) % 22) >= 11) ? 2048 + (((it_) % 22) - 11) * 128 : ((it_) % 22) * 128) + 8 * c)
    v4u raws[8], rawn[8];
    if (vcu < 32 * 22) { bf16* const q0_ = PREP_ADDR(vcu);
#pragma unroll
        for (int i8 = 0; i8 < 8; ++i8) raws[i8] = *(const GAS v4u*)(q0_ + (size_t)(i8 * 4) * NQKV); }
    for (int it = vcu; it < 32 * 22; it += G) {
        const int v = it % 22, blk = it / 22, b = blk >> 4, n = blk & 15;
        if (it + G < 32 * 22) { bf16* const q1_ = PREP_ADDR(it + G);
#pragma unroll
            for (int i8 = 0; i8 < 8; ++i8) rawn[i8] = *(const GAS v4u*)(q1_ + (size_t)(i8 * 4) * NQKV); }
        const bool isk = v >= 11; const int hh = isk ? v - 11 : v;
        const int col0 = (isk ? 2048 : 0) + hh * 128;
        const float* gp = (isk ? P.k_gain : P.q_gain) + layer * 256 + (hh >= 6 ? 128 : 0) + 8 * c;
        const f32x4 g0 = *(const f32x4*)gp, g1 = *(const f32x4*)(gp + 4);
        const bool km = isk && hh >= 6;
        float cs[8];
#pragma unroll
        for (int e = 0; e < 8; ++e) cs[e] = 0.f;
        bf16* const p0_ = P.QKV + ((size_t)b * SEQ + n * 256 + wave * 32 + tsub) * NQKV + col0 + 8 * c;
#pragma unroll
        for (int i8 = 0; i8 < 8; ++i8) {
            bf16* p = p0_ + (size_t)(i8 * 4) * NQKV;
            const v4u raw = raws[i8];
            float x[8]; x[0] = bf2f_u((unsigned short)(raw.x & 0xffff)); x[1] = bf2f_u((unsigned short)(raw.x >> 16)); x[2] = bf2f_u((unsigned short)(raw.y & 0xffff)); x[3] = bf2f_u((unsigned short)(raw.y >> 16));
            x[4] = bf2f_u((unsigned short)(raw.z & 0xffff)); x[5] = bf2f_u((unsigned short)(raw.z >> 16)); x[6] = bf2f_u((unsigned short)(raw.w & 0xffff)); x[7] = bf2f_u((unsigned short)(raw.w >> 16));
            float ss = 0.f;
#pragma unroll
            for (int e = 0; e < 8; ++e) ss = fmaf(x[e], x[e], ss);
            ss += xor_get<1>(ss); ss += xor_get<2>(ss); ss += xor_get<4>(ss); ss += xor_get<8>(ss);
            const float r = (isk ? 1.0f : att::C2) / sqrtf(ss * (1.0f / 128.0f) + EPS);
            float y[8];
            y[0] = x[0] * r * g0.x; y[1] = x[1] * r * g0.y; y[2] = x[2] * r * g0.z; y[3] = x[3] * r * g0.w;
            y[4] = x[4] * r * g1.x; y[5] = x[5] * r * g1.y; y[6] = x[6] * r * g1.z; y[7] = x[7] * r * g1.w;
            v4u o; o.x = pk2(y[0], y[1]); o.y = pk2(y[2], y[3]); o.z = pk2(y[4], y[5]); o.w = pk2(y[6], y[7]);
            *(GAS v4u*)p = o;
#pragma unroll
            for (int e = 0; e < 8; ++e) cs[e] += y[e];
        }
        if (km) {
#pragma unroll
            for (int e = 0; e < 8; ++e) { cs[e] += xor_get<16>(cs[e]); cs[e] = xor32_sum(cs[e]); }
            if (lane < 16) {
#pragma unroll
                for (int e = 0; e < 8; ++e) red[wave * 128 + 8 * c + e] = cs[e]; }
            LDS_WAIT(); __syncthreads();
            if (tid < 128) { float s = 0.f;
#pragma unroll
                for (int w = 0; w < 8; ++w) s += red[w * 128 + tid];
                P.kmean[(size_t)((b * 5 + (hh - 6)) * 16 + n) * 128 + tid] = s * (1.0f / 256.0f); }
            LDS_WAIT(); __syncthreads();
        }
#pragma unroll
        for (int i8 = 0; i8 < 8; ++i8) raws[i8] = rawn[i8];
    }
#undef PREP_ADDR
}
__device__ __forceinline__ void dcombine_phase(const Ptrs& P, const float* gain, int vcu, int G, int wave, int lane) {
    asm volatile("" : "+v"(lane));
    const int gw = vcu * NWAVES + wave, NGW = G * NWAVES; const int c = lane & 15; constexpr int NIT = M * 11 / 4;
    constexpr int NQ = 4;
    for (int it0 = gw; it0 < NIT; it0 += NQ * NGW) {
        int tok[NQ], hh[NQ]; float ls[NQ][4]; v4u raw[NQ][4];
#pragma unroll
        for (int q = 0; q < NQ; ++q) { const int itq = it0 + q * NGW; const int it = itq < NIT ? itq : it0; const int pair = it * 4 + (lane >> 4); tok[q] = pair / 11; hh[q] = pair - tok[q] * 11;
#pragma unroll
            for (int p = 0; p < 3; ++p) { ls[q][p] = P.DPL[((size_t)p * M + tok[q]) * 16 + hh[q]]; raw[q][p] = *(const GAS v4u*)(P.DPO + ((size_t)p * M + tok[q]) * 1408 + hh[q] * 128 + 8 * c); }
            ls[q][3] = -__builtin_inff(); raw[q][3] = (v4u){0u, 0u, 0u, 0u};
            if (hh[q] >= 6) { ls[q][3] = P.DPL[((size_t)3 * M + tok[q]) * 16 + hh[q]]; raw[q][3] = *(const GAS v4u*)(P.DPO + ((size_t)3 * M + tok[q]) * 1408 + hh[q] * 128 + 8 * c); } }
#pragma unroll
        for (int q = 0; q < NQ; ++q) { if (it0 + q * NGW >= NIT) break;
            const float mx = fmaxf(fmaxf(ls[q][0], ls[q][1]), fmaxf(ls[q][2], ls[q][3]));
            float w0 = __builtin_amdgcn_exp2f(ls[q][0] - mx), w1 = __builtin_amdgcn_exp2f(ls[q][1] - mx), w2 = __builtin_amdgcn_exp2f(ls[q][2] - mx), w3 = __builtin_amdgcn_exp2f(ls[q][3] - mx);
            const float inv = 1.0f / (w0 + w1 + w2 + w3); w0 *= inv; w1 *= inv; w2 *= inv; w3 *= inv;
            float acc[8];
#pragma unroll
            for (int e = 0; e < 8; ++e) acc[e] = 0.f;
#pragma unroll
            for (int p = 0; p < 4; ++p) { const v4u r_ = raw[q][p]; const float w = (p == 0) ? w0 : ((p == 1) ? w1 : ((p == 2) ? w2 : w3));
                acc[0] += w * bf2f_u((unsigned short)(r_.x & 0xffff)); acc[1] += w * bf2f_u((unsigned short)(r_.x >> 16)); acc[2] += w * bf2f_u((unsigned short)(r_.y & 0xffff)); acc[3] += w * bf2f_u((unsigned short)(r_.y >> 16));
                acc[4] += w * bf2f_u((unsigned short)(r_.z & 0xffff)); acc[5] += w * bf2f_u((unsigned short)(r_.z >> 16)); acc[6] += w * bf2f_u((unsigned short)(r_.w & 0xffff)); acc[7] += w * bf2f_u((unsigned short)(r_.w >> 16)); }
            float ss = 0.f;
#pragma unroll
            for (int e = 0; e < 8; ++e) ss = fmaf(acc[e], acc[e], ss);
            ss += xor_get<1>(ss); ss += xor_get<2>(ss); ss += xor_get<4>(ss); ss += xor_get<8>(ss);
            const float rn = 1.0f / sqrtf(ss * (1.0f / 128.0f) + EPS);
            const f32x4 g0 = *(const f32x4*)(gain + hh[q] * 128 + 8 * c), g1 = *(const f32x4*)(gain + hh[q] * 128 + 8 * c + 4);
            v4u o; o.x = pk2(acc[0] * rn * g0.x, acc[1] * rn * g0.y); o.y = pk2(acc[2] * rn * g0.z, acc[3] * rn * g0.w); o.z = pk2(acc[4] * rn * g1.x, acc[5] * rn * g1.y); o.w = pk2(acc[6] * rn * g1.z, acc[7] * rn * g1.w);
            *(GAS v4u*)(P.OB + (size_t)tok[q] * D + hh[q] * 128 + 8 * c) = o; }
    }
}
__device__ __forceinline__ void router_phase(const Ptrs& P, const float* gain, LAS unsigned char* lds, int vcu, int G, int tid, int wave, int lane) {
    asm volatile("" : "+v"(lane), "+v"(tid));
    LAS unsigned* lcnt = (LAS unsigned*)(lds + RING_OFF);
    LAS unsigned* rinfo = (LAS unsigned*)(lds + RING_OFF + 256);
    if (tid < 16) lcnt[tid] = 0u;
    LAS f32x4* LT = (LAS f32x4*)(lds + RING_OFF + 4096);
    for (int i = tid; i < 2 * D; i += NWAVES * 64) { const int d = i >> 1, eq = i & 1; LT[eq * D + d] = ((const GAS f32x4*)P.router)[i]; }
    LDS_WAIT(); __syncthreads();
    int gw = vcu * NWAVES + wave; asm volatile("" : "+s"(gw));
    const int NGW = G * NWAVES;
    int li = wave;
    for (int m = gw; m < M; m += NGW, li += NWAVES) {
        const GAS u32x2_g* xr = (const GAS u32x2_g*)(P.H + (size_t)m * D) + lane;
        f32x4 v[8]; float s = 0.f;
#pragma unroll
        for (int j = 0; j < 8; ++j) { v[j] = bf4_to_f32(xr[64 * j]); s += (v[j].x * v[j].x + v[j].y * v[j].y) + (v[j].z * v[j].z + v[j].w * v[j].w); }
        const float r = 1.0f / sqrtf(wave_sum(s) * (1.0f / D) + EPS);
        float lg[8];
#pragma unroll
        for (int e = 0; e < 8; ++e) lg[e] = 0.f;
        GAS unsigned* o4 = (GAS unsigned*)(P.AB8 + (size_t)m * D) + lane;
#pragma unroll
        for (int j = 0; j < 8; ++j) { const f32x4 g = ((const GAS f32x4*)gain)[lane + 64 * j];
            const float f0 = v[j].x * r * g.x, f1 = v[j].y * r * g.y, f2 = v[j].z * r * g.z, f3 = v[j].w * r * g.w;
            o4[64 * j] = pg8::pk4_fp8(f0, f1, f2, f3);
            const LAS f32x4* rw = LT + 256 * j + 4 * lane;
            const f32x4 a0 = rw[0], a1 = rw[D], b0 = rw[1], b1 = rw[D + 1], c0 = rw[2], c1 = rw[D + 2], d0 = rw[3], d1 = rw[D + 3];
            lg[0] += f0 * a0.x + f1 * b0.x + f2 * c0.x + f3 * d0.x; lg[1] += f0 * a0.y + f1 * b0.y + f2 * c0.y + f3 * d0.y;
            lg[2] += f0 * a0.z + f1 * b0.z + f2 * c0.z + f3 * d0.z; lg[3] += f0 * a0.w + f1 * b0.w + f2 * c0.w + f3 * d0.w;
            lg[4] += f0 * a1.x + f1 * b1.x + f2 * c1.x + f3 * d1.x; lg[5] += f0 * a1.y + f1 * b1.y + f2 * c1.y + f3 * d1.y;
            lg[6] += f0 * a1.z + f1 * b1.z + f2 * c1.z + f3 * d1.z; lg[7] += f0 * a1.w + f1 * b1.w + f2 * c1.w + f3 * d1.w; }
#pragma unroll
        for (int e = 0; e < 8; ++e) lg[e] = wave_sum(lg[e]);
        int e0 = 0; float b0v = lg[0];
#pragma unroll
        for (int e = 1; e < 8; ++e) if (lg[e] > b0v) { b0v = lg[e]; e0 = e; }
        int e1 = -1; float b1v = -__builtin_inff();
#pragma unroll
        for (int e = 0; e < 8; ++e) if (e != e0 && lg[e] > b1v) { b1v = lg[e]; e1 = e; }
        const float g1 = 1.0f / (1.0f + __expf(b0v - b1v)), g0 = 1.0f - g1;
        if (lane == 0) {
            const unsigned k0 = __hip_atomic_fetch_add(lcnt + e0, 1u, __ATOMIC_RELAXED, __HIP_MEMORY_SCOPE_WORKGROUP);
            const unsigned k1 = __hip_atomic_fetch_add(lcnt + e1, 1u, __ATOMIC_RELAXED, __HIP_MEMORY_SCOPE_WORKGROUP);
            rinfo[li * 4 + 0] = (unsigned)e0 | ((unsigned)e1 << 8); rinfo[li * 4 + 1] = k0; rinfo[li * 4 + 2] = k1;
            P.sel_g[2 * m] = g0; P.sel_g[2 * m + 1] = g1;
        }
    }
    LDS_WAIT(); __syncthreads();
    if (tid < 8) lcnt[8 + tid] = __hip_atomic_fetch_add(P.ctl + CW_CNT + 64 * tid, lcnt[tid], RLX_AGENT);
    LDS_WAIT(); __syncthreads();
    li = wave;
    for (int m = gw; m < M; m += NGW, li += NWAVES) {
        if (lane == 0) { const unsigned ee = rinfo[li * 4 + 0]; const unsigned e0 = ee & 0xffu, e1 = ee >> 8;
            P.sel_e[m] = ee; P.sel_rel[2 * m] = (int)(lcnt[8 + e0] + rinfo[li * 4 + 1]); P.sel_rel[2 * m + 1] = (int)(lcnt[8 + e1] + rinfo[li * 4 + 2]); }
    }
}
__device__ __forceinline__ void build_tile_table(const Ptrs& P, bool moe, volatile LAS unsigned* MISC, int tid) {
    if (tid == 0) { unsigned t = 0u; MISC[16] = 0u;
        for (int e = 0; e < 8; ++e) { const unsigned cnt = moe ? __hip_atomic_load(P.ctl + CW_CNT + 64 * e, RLX_AGENT) : (e == 0 ? (unsigned)M : 0u); t += (cnt + 255u) >> 8; if (t > (unsigned)(MPAD / 256)) t = MPAD / 256; MISC[17 + e] = t; } }
    LDS_WAIT(); __syncthreads();
}
__device__ __forceinline__ void scatter_phase(const Ptrs& P, volatile LAS unsigned* MISC, int vcu, int G, int wave, int lane) {
    asm volatile("" : "+v"(lane));
    const int gw = vcu * NWAVES + wave, NGW = G * NWAVES;
    constexpr int NR = 4;
    for (int m0 = gw; m0 < M; m0 += NR * NGW) {
        unsigned ee[NR]; int r0[NR], r1[NR]; v4u a0[NR], a1[NR];
#pragma unroll
        for (int q = 0; q < NR; ++q) { const int mq = m0 + q * NGW; const int m = mq < M ? mq : m0;
            ee[q] = P.sel_e[m]; r0[q] = P.sel_rel[2 * m]; r1[q] = P.sel_rel[2 * m + 1];
            const GAS v4u* sp = (const GAS v4u*)(P.AB8 + (size_t)m * D) + lane; a0[q] = sp[0]; a1[q] = sp[64]; }
#pragma unroll
        for (int q = 0; q < NR; ++q) { const int m = m0 + q * NGW; if (m >= M) break;
            const int p0 = (int)(256u * MISC[16 + (ee[q] & 0xffu)]) + r0[q], p1 = (int)(256u * MISC[16 + ((ee[q] >> 8) & 0xffu)]) + r1[q];
            if (lane == 0) { P.sel_pos[2 * m] = p0; P.sel_pos[2 * m + 1] = p1; }
            GAS v4u* d0 = (GAS v4u*)(P.XS + (size_t)p0 * D) + lane; GAS v4u* d1 = (GAS v4u*)(P.XS + (size_t)p1 * D) + lane;
            d0[0] = a0[q]; d0[64] = a1[q]; d1[0] = a0[q]; d1[64] = a1[q]; }
    }
}
__device__ __forceinline__ void combine_phase(const Ptrs& P, int vcu, int G, int wave, int lane) {
    asm volatile("" : "+v"(lane));
    const int gw = vcu * NWAVES + wave, NGW = G * NWAVES;
    typedef unsigned u32x2_t __attribute__((ext_vector_type(2)));
    for (int m0 = gw; m0 < M; m0 += 2 * NGW) {
        const int m1 = m0 + NGW; const bool has1 = m1 < M; const int mm[2] = {m0, has1 ? m1 : m0};
        int pa[2], pb[2]; float ga[2], gb[2];
#pragma unroll
        for (int q = 0; q < 2; ++q) { pa[q] = P.sel_pos[2 * mm[q]]; pb[q] = P.sel_pos[2 * mm[q] + 1]; ga[q] = P.sel_g[2 * mm[q]]; gb[q] = P.sel_g[2 * mm[q] + 1]; }
        f32x4 ya[2][8], yb[2][8], hv[2][8];
#pragma unroll
        for (int q = 0; q < 2; ++q) { const GAS u32x2_t* y0 = (const GAS u32x2_t*)(P.YS + (size_t)pa[q] * D) + lane; const GAS u32x2_t* y1 = (const GAS u32x2_t*)(P.YS + (size_t)pb[q] * D) + lane;
            const GAS u32x2_g* hr = (const GAS u32x2_g*)(P.H + (size_t)mm[q] * D) + lane;
#pragma unroll
            for (int j = 0; j < 8; ++j) { ya[q][j] = bf4_to_f32(y0[64 * j]); yb[q][j] = bf4_to_f32(y1[64 * j]); hv[q][j] = bf4_to_f32(hr[64 * j]); } }
#pragma unroll
        for (int q = 0; q < 2; ++q) { if (q == 1 && !has1) break;
            if (pa[q] >= 16384) { const GAS u32x2_t* z0 = (const GAS u32x2_t*)(P.YS + (size_t)MPAD * D + (size_t)pa[q] * D) + lane;
#pragma unroll
                for (int j = 0; j < 8; ++j) ya[q][j] += bf4_to_f32(z0[64 * j]); }
            if (pb[q] >= 16384) { const GAS u32x2_t* z1 = (const GAS u32x2_t*)(P.YS + (size_t)MPAD * D + (size_t)pb[q] * D) + lane;
#pragma unroll
                for (int j = 0; j < 8; ++j) yb[q][j] += bf4_to_f32(z1[64 * j]); }
            GAS f32x4* orow = (GAS f32x4*)(P.out + (size_t)mm[q] * D) + lane;
#pragma unroll
            for (int j = 0; j < 8; ++j) orow[64 * j] = hv[q][j] + ya[q][j] * ga[q] + yb[q][j] * gb[q]; }
    }
}

struct Args { const float* in[15]; float* out; unsigned char* ws; int ph_lo, ph_hi, qoff, pad; };
__device__ __forceinline__ Ptrs make_ptrs(const Args& args, unsigned char* ws0) {
    int z = 0; asm volatile("" : "+s"(z));
    const float* const* in = args.in + z;
    unsigned char* ws = ws0 + z;
    Ptrs P;
    P.x = in[0]; P.attn_norm = in[1]; P.w_in = in[2]; P.q_gain = in[3]; P.k_gain = in[4]; P.out_gain = in[5]; P.w_out = in[6]; P.ffn_norm = in[7];
    P.dwg = in[8]; P.dwu = in[9]; P.dwd = in[10]; P.router = in[11]; P.mwg = in[12]; P.mwu = in[13]; P.mwd = in[14];
    P.out = args.out; P.ctl = (gu32*)(ws + WS_CTL);
    P.Wqkv_t = (bf16*)(ws + WS_WQKV); P.Wo_t = (bf16*)(ws + WS_WO); P.Wgu_d = ws + WS_WGU_D; P.Wd_d = ws + WS_WD_D; P.Wgu_m = ws + WS_WGU_M; P.Wd_m = ws + WS_WD_M;
    P.QKV = (bf16*)(ws + WS_QKV); P.OB = (bf16*)(ws + WS_O); P.AB = (bf16*)(ws + WS_A); P.AB8 = ws + WS_A; P.ACT = ws + WS_ACT; P.XS = ws + WS_XS;
    P.H = (bf16*)(ws + WS_H); P.YS = (bf16*)(ws + WS_YS); P.kmean = (float*)(ws + WS_MISC + MISC_KMEAN); P.DPO = (bf16*)(ws + WS_DPO); P.DPL = (float*)(ws + WS_DPL);
    P.rsq = (float*)(ws + WS_MISC + MISC_RSQ);
    P.sel_e = (unsigned*)(ws + WS_MISC + MISC_SELE); P.sel_rel = (int*)(ws + WS_MISC + MISC_SELREL); P.sel_g = (float*)(ws + WS_MISC + MISC_SELG); P.sel_pos = (int*)(ws + WS_MISC + MISC_SELPOS);
    return P;
}
__global__ void __launch_bounds__(NWAVES * 64, 2) hybrid_fwd(Args args) {
    extern __shared__ __attribute__((aligned(16))) unsigned char lds[];
    LAS unsigned char* ldsL = (LAS unsigned char*)lds;
    volatile LAS unsigned* MISC = (volatile LAS unsigned*)(ldsL + MISC_OFF);
    const int wave = __builtin_amdgcn_readfirstlane((int)threadIdx.x >> 6);
#define tid (tid_of(wave))
#define lane (lane_id())
    const int G = gridDim.x; int vcu; { const int bx = blockIdx.x; vcu = (G % 8 == 0) ? (bx % 8) * (G / 8) + bx / 8 : bx; }
    for (int u = tid; u < (LDS_BYTES - LDSCTL_OFF) / 4; u += NWAVES * 64) ((LAS unsigned*)(ldsL + LDSCTL_OFF))[u] = 0u;
    __syncthreads();
    int z0 = 0; asm volatile("" : "+s"(z0)); unsigned char* ws0 = args.ws + z0;
    unsigned* const barw = (unsigned*)(ws0 + WS_CTL) + CW_BAR;
    XcdBarrier bar; bar.bar = barw; bar.x = 0; bar.st = nullptr; bar.wv = wave;
    if (!MK_SPLIT) { bar = xcd_barrier_post(barw, MISC + 8, wave); }
    const int lo = args.ph_lo, hi = args.ph_hi;
#define PH(k) (lo <= (k) && (k) < hi)
#define SEAM(a, b) do { if (PH(a) && PH(b)) { int zb_ = 0; asm volatile("" : "+s"(zb_)); XcdBarrier b2_ = bar; b2_.bar = bar.bar + zb_; xcd_barrier(b2_); } } while (0)

    for (int layer = 0; layer < 2; ++layer) {
        const int PB = layer * PPL;
        if (layer == 0 && PH(PB + 0)) {
            const Ptrs P = make_ptrs(args, ws0);
            #ifndef NO_P0
            if (layer == 0) convert_weights(P, ldsL, vcu, G, CV_L0, wave, lane);
            if (layer == 0) norm_rows<false, false, 4>(P.x, P.attn_norm, P.AB, vcu, G, wave, lane);
#endif
        }
        if (layer == 0) SEAM(PB + 0, PB + 1);
        if (PH(PB + 1)) {
            const Ptrs P = make_ptrs(args, ws0);
            pg8::Gemm g{layer == 0 ? P.AB : P.H, P.Wqkv_t + (size_t)layer * NQKV * D, M, NQKV, D}; pg8::StaticOrder S; S.init(M, NQKV, G, (int)blockIdx.x);
            pg8::EpiQKV E{P.QKV, NQKV, P.q_gain + layer * 256, P.k_gain + layer * 256, P.kmean, (LAS float*)(ldsL + RING_OFF + RING_BYTES), layer == 0 ? nullptr : P.rsq};
#ifndef NO_P1
            pg8::gemm_phase<pg8::EpiQKV, pg8::StaticOrder, true, true>(ldsL + RING_OFF, g, S, E, wave);
#endif
        }
        SEAM(PB + 1, PB + 3);
        if (PH(PB + 3)) {
            const Ptrs P = make_ptrs(args, ws0);
            const att::AttnArgs AA{P.QKV, P.OB, P.kmean, P.out_gain + layer * D, P.DPO, P.DPL, (unsigned*)((unsigned char*)P.DPL + (WS_MLIST - WS_DPL)) + (size_t)layer * att::N_SEL * att::MLCAP, (unsigned*)(P.ctl + CW_MCNT + 256 * (layer + args.qoff)), (unsigned*)(P.ctl + CW_MDONE + 64 * (layer + args.qoff))};
#ifndef NO_P3
            attn_conv_phase(P, AA, layer, (unsigned*)(P.ctl + CW_ATTQ + 64 * (layer + args.qoff)), lds, wave);
#endif
        }
        SEAM(PB + 3, PB + 4);
#ifndef NO_P4B
        if (PH(PB + 4)) { const Ptrs P = make_ptrs(args, ws0); dcombine_phase(P, P.out_gain + layer * D, vcu, G, wave, lane); }
#endif
        SEAM(PB + 4, PB + 5);
        if (PH(PB + 5)) {
            const Ptrs P = make_ptrs(args, ws0);
            pg8::Gemm g{P.OB, P.Wo_t + (size_t)layer * D * D, M, D, D}; pg8::StaticOrder S; S.init(M, D, G, (int)blockIdx.x);
            pg8::EpiResF32 E{layer == 0 ? P.x : nullptr, layer == 0 ? nullptr : P.H, P.H, D, nullptr, nullptr, (LAS float*)(ldsL + RING_OFF + RING_BYTES)};
#ifndef NO_P4
            pg8::gemm_phase<pg8::EpiResF32, pg8::StaticOrder, true, true>(ldsL + RING_OFF, g, S, E, wave);
#endif
        }
        SEAM(PB + 5, PB + 6);
        if (PH(PB + 6)) {
            const Ptrs P = make_ptrs(args, ws0);
#ifndef NO_P5
            if (layer == 0) norm_rows<true, true, 4>(P.H, P.ffn_norm, P.AB8, vcu, G, wave, lane);
            else router_phase(P, P.ffn_norm + D, ldsL, vcu, G, tid, wave, lane);
#endif
        }
        if (layer == 1) {
            SEAM(PB + 6, PB + 7);
#ifndef NO_P6
            if (PH(PB + 7)) { const Ptrs P = make_ptrs(args, ws0); build_tile_table(P, true, MISC, tid); scatter_phase(P, MISC, vcu, G, wave, lane); }
#endif
            SEAM(PB + 7, PB + 8);
        } else SEAM(PB + 6, PB + 8);
        if (PH(PB + 8)) {
            const Ptrs P = make_ptrs(args, ws0);
            build_tile_table(P, layer == 1, MISC, tid);
            pg8::GroupSched S; S.nMt = __builtin_amdgcn_readfirstlane((int)MISC[24]); S.nN = NGU / 256; S.nwg = S.nMt * S.nN; S.G = G; S.c = (int)blockIdx.x;
            S.t1 = __builtin_amdgcn_readfirstlane((int)MISC[17]); S.t2 = __builtin_amdgcn_readfirstlane((int)MISC[18]); S.t3 = __builtin_amdgcn_readfirstlane((int)MISC[19]); S.t4 = __builtin_amdgcn_readfirstlane((int)MISC[20]);
            S.t5 = __builtin_amdgcn_readfirstlane((int)MISC[21]); S.t6 = __builtin_amdgcn_readfirstlane((int)MISC[22]); S.t7 = __builtin_amdgcn_readfirstlane((int)MISC[23]); S.estride = (size_t)NGU * D; S.nfullM = 1 << 20; S.ntail = 0; S.khalf = 0;
            pg8::Gemm g{(const bf16*)(layer == 0 ? P.AB8 : P.XS), (const bf16*)(layer == 0 ? P.Wgu_d : P.Wgu_m), MPAD, NGU, D / 2};
            pg8::EpiSwiGLU8 E{P.ACT, FF};
#ifndef NO_P7
            pg8::gemm_phase<pg8::EpiSwiGLU8, pg8::GroupSched, true, true, true>(ldsL + RING_OFF, g, S, E, wave);
#endif
        }
        SEAM(PB + 8, PB + 9);
        if (PH(PB + 9)) {
            const Ptrs P = make_ptrs(args, ws0);
            build_tile_table(P, layer == 1, MISC, tid);
            pg8::GroupSched S; S.nMt = __builtin_amdgcn_readfirstlane((int)MISC[24]); S.nN = D / 256; S.nwg = S.nMt * S.nN; S.G = G; S.c = (int)blockIdx.x;
            S.t1 = __builtin_amdgcn_readfirstlane((int)MISC[17]); S.t2 = __builtin_amdgcn_readfirstlane((int)MISC[18]); S.t3 = __builtin_amdgcn_readfirstlane((int)MISC[19]); S.t4 = __builtin_amdgcn_readfirstlane((int)MISC[20]);
            S.t5 = __builtin_amdgcn_readfirstlane((int)MISC[21]); S.t6 = __builtin_amdgcn_readfirstlane((int)MISC[22]); S.t7 = __builtin_amdgcn_readfirstlane((int)MISC[23]); S.estride = (size_t)D * FF;
            if (layer == 1 && S.nMt > 64) { S.nfullM = 64; S.ntail = FF / 128 / 2; S.khalf = FF / 2; S.nwg = 64 * S.nN + 2 * S.nN * (S.nMt - 64); } else { S.nfullM = 1 << 20; S.ntail = 0; S.khalf = 0; }
            pg8::Gemm g{(const bf16*)P.ACT, (const bf16*)(layer == 0 ? P.Wd_d : P.Wd_m), MPAD, D, FF / 2};
            pg8::EpiResF32 E{nullptr, layer == 0 ? P.H : nullptr, layer == 0 ? P.H : P.YS, D, P.YS + (size_t)MPAD * D, layer == 0 ? P.rsq : nullptr, (LAS float*)(ldsL + RING_OFF + RING_BYTES)};
#ifndef NO_P8
            pg8::gemm_phase<pg8::EpiResF32, pg8::GroupSched, true, true, true>(ldsL + RING_OFF, g, S, E, wave);
#endif
        }
        if (layer == 0) SEAM(PB + 9, PB + 12);
        else { SEAM(PB + 9, PB + 10);
#ifndef NO_P9
            if (PH(PB + 10)) { const Ptrs P = make_ptrs(args, ws0); combine_phase(P, vcu, G, wave, lane); }
#endif
        }
    }
#undef PH
#undef SEAM
#undef tid
#undef lane
}

extern "C" void kernel_launch(void* const* d_in, const int* in_sizes, int n_in, void* d_out, int out_size, void* d_ws, size_t ws_size, hipStream_t stream) {
    static int grid = 0;
    if (grid == 0) {
        if (n_in != 15 || in_sizes[0] != M * D || out_size != M * D || ws_size < WS_END) { fprintf(stderr, "kernel_launch: unexpected shapes / workspace (n_in %d, in0 %d, out %d, ws %zu < %zu); nothing launched\n", n_in, n_in > 0 ? in_sizes[0] : -1, out_size, ws_size, (size_t)WS_END); grid = -1; return; }
        int dev = 0, cus = 0, per_cu = 0;
        if (hipGetDevice(&dev) != hipSuccess || hipDeviceGetAttribute(&cus, hipDeviceAttributeMultiprocessorCount, dev) != hipSuccess) { fprintf(stderr, "kernel_launch: device query failed\n"); grid = -1; return; }
        if (hipFuncSetAttribute((const void*)hybrid_fwd, hipFuncAttributeMaxDynamicSharedMemorySize, LDS_BYTES) != hipSuccess) { fprintf(stderr, "kernel_launch: hipFuncSetAttribute failed\n"); grid = -1; return; }
        if (hipOccupancyMaxActiveBlocksPerMultiprocessor(&per_cu, (const void*)hybrid_fwd, NWAVES * 64, LDS_BYTES) != hipSuccess || per_cu < 1) fprintf(stderr, "kernel_launch: note: occupancy query reports %d workgroups per CU\n", per_cu);
        (void)hipGetLastError();
        grid = cus;
    }
    if (grid < 0) return;
    if (hipMemsetAsync((char*)d_ws + WS_CTL, 0, CTL_ZERO_BYTES, stream) != hipSuccess) { fprintf(stderr, "kernel_launch: memset failed\n"); return; }
    Args a{};
    for (int i = 0; i < 15; ++i) a.in[i] = (const float*)d_in[i];
    a.out = (float*)d_out; a.ws = (unsigned char*)d_ws;
#if MK_SPLIT
    for (int ph = 0; ph < N_PHASES; ++ph) {
        if (ph == 7 || ph == 10 || ph == 2 || ph == PPL + 2 || ph == PPL) continue;
        a.ph_lo = ph; a.ph_hi = ph + 1; a.qoff = 0;
        hipLaunchKernelGGL(hybrid_fwd, dim3(grid), dim3(NWAVES * 64), LDS_BYTES, stream, a);
#ifdef MK_PROBE_REPEAT
        if (((MK_PROBE_REPEAT) >> ph) & 1) { a.qoff = 2; hipLaunchKernelGGL(hybrid_fwd, dim3(grid), dim3(NWAVES * 64), LDS_BYTES, stream, a); }
#endif
    }
#else
    a.ph_lo = 0; a.ph_hi = N_PHASES;
    hipLaunchKernelGGL(hybrid_fwd, dim3(grid), dim3(NWAVES * 64), LDS_BYTES, stream, a);
#endif
    const hipError_t le = hipPeekAtLastError();
    if (le != hipSuccess) fprintf(stderr, "kernel_launch: launch failed: %s\n", hipGetErrorName(le));
}
```

```cpp
#include <hip/hip_runtime.h>
#include <cstdio>
#include <cstdint>
__device__ __forceinline__ int lane_id() { int l; asm volatile("v_mbcnt_lo_u32_b32 %0, -1, 0\n\tv_mbcnt_hi_u32_b32 %0, -1, %0" : "=v"(l)); return l; }
template <int MSK> __device__ __forceinline__ float xor_get(float v) {
    static_assert(MSK == 1 || MSK == 2 || MSK == 4 || MSK == 8 || MSK == 16, "xor_get: 1..16");
    if constexpr (MSK == 1) return __int_as_float(__builtin_amdgcn_update_dpp(0, __float_as_int(v), 0xB1, 0xF, 0xF, true));
    else if constexpr (MSK == 2) return __int_as_float(__builtin_amdgcn_update_dpp(0, __float_as_int(v), 0x4E, 0xF, 0xF, true));
    else return __int_as_float(__builtin_amdgcn_ds_swizzle(__float_as_int(v), 0x1F | (MSK << 10)));
}
__device__ __forceinline__ float xor32_sum(float v) { auto rr = __builtin_amdgcn_permlane32_swap(__float_as_uint(v), __float_as_uint(v), false, false); return __uint_as_float(rr[0]) + __uint_as_float(rr[1]); }
__device__ __forceinline__ float xor32_get(float v, int hi) { auto rr = __builtin_amdgcn_permlane32_swap(__float_as_uint(v), __float_as_uint(v), false, false); return __uint_as_float(hi ? rr[0] : rr[1]); }
__device__ __forceinline__ int tid_of(int wave) { int t = wave * 64 + lane_id(); asm volatile("" : "+v"(t)); return t; }
namespace pg8 {
#define PG8_LAS __attribute__((address_space(3)))
typedef unsigned short bf16_t;
typedef short bf16x8 __attribute__((ext_vector_type(8)));
typedef float f32x4 __attribute__((ext_vector_type(4)));
typedef unsigned u32x4 __attribute__((ext_vector_type(4)));
constexpr int BM = 256, BK = 64, HALF = 128, HTB = HALF * BK * 2  , STAGE_BYTES = 8 * HTB, NXCD = 8, WGM = 8;

__host__ __device__ __forceinline__ int lds_byte(int r, int c) { const int st = (r >> 4) * 2 + (c >> 5), rr = r & 15, cc = c & 31, ob = rr * 64 + cc * 2; return st * 1024 + (ob ^ (((ob >> 9) & 1) << 5)); }
__host__ __device__ __forceinline__ void stage_rc(int b, int& R, int& C) { const int st = b / 1024, sb = b % 1024, swz = sb ^ (((sb >> 9) & 1) << 5); R = (st >> 1) * 16 + swz / 64; C = (st & 1) * 32 + (swz % 64) / 2; }
__host__ __device__ __forceinline__ int perm32(int rho) { const int n = rho >> 4, i = rho & 15; return 8 * (i >> 2) + 4 * n + (i & 3); }

struct Unit { int pm, pn; size_t bofs; int kofs, ntu, kh; };
struct Gemm { const bf16_t* A; const bf16_t* Bt; int M, N, K; };

struct StaticOrder {
    int nM, nN, nwg, G, c;
    __host__ __device__ void init(int M, int N, int G_, int c_) { nM = M / BM; nN = N / BM; nwg = nM * nN; G = G_; c = c_; }
    __host__ __device__ bool next(int i, Unit& u) const {
        const long L = (long)i * G + c; if (L >= nwg) return false;
        int wgid = (int)L; { const int q = nwg / NXCD, r = nwg % NXCD, xcd = wgid % NXCD, off = wgid / NXCD; wgid = (xcd < r ? xcd * (q + 1) : r * (q + 1) + (xcd - r) * q) + off; }
        const int nig = WGM * nN, gid = wgid / nig, fm = gid * WGM, gsz = (nM - fm) < WGM ? (nM - fm) : WGM;
        u.pm = fm + ((wgid % nig) % gsz); u.pn = (wgid % nig) / gsz; u.bofs = 0; u.kofs = 0; u.ntu = 0; u.kh = 0; return true;
    }
    __device__ __forceinline__ void a_ready(const Unit&) const {}
    __device__ __forceinline__ void done(const Unit&) const {}
};

__device__ __forceinline__ unsigned cvt_pk_bf16(float lo, float hi) { unsigned r; asm volatile("v_cvt_pk_bf16_f32 %0, %1, %2" : "=v"(r) : "v"(lo), "v"(hi)); return r; }

typedef int i32x8 __attribute__((ext_vector_type(8)));
typedef int i32x4v __attribute__((ext_vector_type(4)));
__device__ __forceinline__ i32x8 cat8(bf16x8 a, bf16x8 b) { const i32x4v x = __builtin_bit_cast(i32x4v, a), y = __builtin_bit_cast(i32x4v, b); return (i32x8){x[0], x[1], x[2], x[3], y[0], y[1], y[2], y[3]}; }
__device__ __forceinline__ unsigned pk4_fp8(float a, float b, float c, float d) { int w = 0; w = __builtin_amdgcn_cvt_pk_fp8_f32(a, b, w, false); w = __builtin_amdgcn_cvt_pk_fp8_f32(c, d, w, true); return (unsigned)w; }
typedef unsigned u32x2w __attribute__((ext_vector_type(2)));
struct GroupSched {
    int nMt, nN, nwg, G, c; int t1, t2, t3, t4, t5, t6, t7; size_t estride;
    int nfullM, ntail, khalf;
    __device__ __forceinline__ bool next(int i, Unit& u) const {
        const long L = (long)i * G + c; if (L >= nwg) return false;
        const int nMf = nMt < nfullM ? nMt : nfullM, nwf = nMf * nN;
        if (L < nwf) {
            int wgid = (int)L; { const int q = nwf / NXCD, r = nwf % NXCD, xcd = wgid % NXCD, off = wgid / NXCD; wgid = (xcd < r ? xcd * (q + 1) : r * (q + 1) + (xcd - r) * q) + off; }
            const int nig = WGM * nN, gid = wgid / nig, fm = gid * WGM, gsz = (nMf - fm) < WGM ? (nMf - fm) : WGM;
            u.pm = fm + ((wgid % nig) % gsz); u.pn = (wgid % nig) / gsz; u.kofs = 0; u.ntu = 0; u.kh = 0;
        } else { const int r = (int)L - nwf, t = r >> 1; u.kh = r & 1; u.pm = nMf + t / nN; u.pn = t % nN; u.kofs = u.kh * khalf; u.ntu = ntail; }
        const int pm = u.pm;
        const int e = (pm >= t1) + (pm >= t2) + (pm >= t3) + (pm >= t4) + (pm >= t5) + (pm >= t6) + (pm >= t7);
        u.bofs = (size_t)__builtin_amdgcn_readfirstlane(e) * estride; return true;
    }
    __device__ __forceinline__ void a_ready(const Unit&) const {}
    __device__ __forceinline__ void done(const Unit&) const {}
};

struct EpiStoreBf16 {
    static constexpr bool PERM = true, AFTER_DRAIN = false;
    bf16_t* O; int ldc;
    __device__ __forceinline__ void operator()(const f32x4 (&acc)[2][2][4][2], const Unit& u, int wr, int wc, int fr, int fq) const {
        const int row0 = u.pm * BM + wr * 64 + fr, col0 = u.pn * BM + wc * 32 + 8 * fq;
#pragma unroll
        for (int ai = 0; ai < 2; ++ai)
#pragma unroll
            for (int m = 0; m < 4; ++m) { bf16_t* rowp = O + (size_t)(row0 + ai * HALF + m * 16) * ldc + col0;
#pragma unroll
                for (int bj = 0; bj < 2; ++bj) { const f32x4 v0 = acc[ai][bj][m][0], v1 = acc[ai][bj][m][1];
                    u32x4 w; w.x = cvt_pk_bf16(v0[0], v0[1]); w.y = cvt_pk_bf16(v0[2], v0[3]); w.z = cvt_pk_bf16(v1[0], v1[1]); w.w = cvt_pk_bf16(v1[2], v1[3]);
                    *(u32x4*)(rowp + bj * HALF) = w; } }
    }
};
struct EpiQKV {
    static constexpr bool PERM = true, AFTER_DRAIN = false;
    bf16_t* O; int ldc; const float* qg; const float* kg; float* kmean; PG8_LAS float* scr; const float* rsq; int pn0;
    __device__ __forceinline__ void operator()(const f32x4 (&acc)[2][2][4][2], const Unit& u, int wr, int wc, int fr, int fq) const {
        const int row0 = u.pm * BM + wr * 64 + fr, col0 = u.pn * BM + wc * 32 + 8 * fq;
        const int part = (u.pn + pn0) >> 3, hp = (u.pn + pn0) & 7, h0 = 2 * hp;
        float rr[2][4];
#pragma unroll
        for (int ai = 0; ai < 2; ++ai)
#pragma unroll
            for (int m = 0; m < 4; ++m) { rr[ai][m] = 1.0f;
                if (rsq) { const f32x4 t_ = *(const f32x4*)(rsq + (size_t)(row0 + ai * HALF + m * 16) * 8 + 4 * (fq & 1)); float s_ = (t_[0] + t_[1]) + (t_[2] + t_[3]); s_ += xor_get<16>(s_);
                    rr[ai][m] = 1.0f / sqrtf(s_ * (1.0f / 2048.0f) + 1e-6f); } }
        if (!(part < 2 && hp <= 5)) {
#pragma unroll
            for (int ai = 0; ai < 2; ++ai)
#pragma unroll
                for (int m = 0; m < 4; ++m) { bf16_t* rowp = O + (size_t)(row0 + ai * HALF + m * 16) * ldc + col0;
#pragma unroll
                    for (int bj = 0; bj < 2; ++bj) { const f32x4 v0 = acc[ai][bj][m][0] * rr[ai][m], v1 = acc[ai][bj][m][1] * rr[ai][m];
                        u32x4 w; w.x = cvt_pk_bf16(v0[0], v0[1]); w.y = cvt_pk_bf16(v0[2], v0[3]); w.z = cvt_pk_bf16(v1[0], v1[1]); w.w = cvt_pk_bf16(v1[2], v1[3]);
                        *(u32x4*)(rowp + bj * HALF) = w; } }
            return;
        }
#pragma unroll
        for (int ai = 0; ai < 2; ++ai)
#pragma unroll
            for (int m = 0; m < 4; ++m)
#pragma unroll
                for (int bj = 0; bj < 2; ++bj) { const f32x4 v0 = acc[ai][bj][m][0] * rr[ai][m], v1 = acc[ai][bj][m][1] * rr[ai][m];
                    float s_ = v0[0] * v0[0]; s_ = fmaf(v0[1], v0[1], s_); s_ = fmaf(v0[2], v0[2], s_); s_ = fmaf(v0[3], v0[3], s_);
                    s_ = fmaf(v1[0], v1[0], s_); s_ = fmaf(v1[1], v1[1], s_); s_ = fmaf(v1[2], v1[2], s_); s_ = fmaf(v1[3], v1[3], s_);
                    s_ += xor_get<16>(s_); s_ = xor32_sum(s_);
                    if (fq == 0) scr[((wr * 16 + (ai * 4 + m) * 2 + bj) * 16 + fr) * 4 + wc] = s_; }
        asm volatile("s_waitcnt lgkmcnt(0)" ::: "memory"); __builtin_amdgcn_s_barrier();
        const float* gp = (part == 0) ? qg : kg; const float qs = (part == 0) ? 0.08838834764831845f * 1.4426950408889634f : 1.0f;
        f32x4 g[2][2];
#pragma unroll
        for (int bj = 0; bj < 2; ++bj) { const float* p_ = gp + ((h0 + bj) >= 6 ? 128 : 0) + wc * 32 + 8 * fq; g[bj][0] = *(const f32x4*)p_; g[bj][1] = *(const f32x4*)(p_ + 4); }
        const bool pass1 = (h0 + 1 > 10);
        f32x4 cs[2][2];
#pragma unroll
        for (int bj = 0; bj < 2; ++bj) { cs[bj][0] = (f32x4){0.f, 0.f, 0.f, 0.f}; cs[bj][1] = (f32x4){0.f, 0.f, 0.f, 0.f}; }
#pragma unroll
        for (int ai = 0; ai < 2; ++ai)
#pragma unroll
            for (int m = 0; m < 4; ++m) { bf16_t* rowp = O + (size_t)(row0 + ai * HALF + m * 16) * ldc + col0;
#pragma unroll
                for (int bj = 0; bj < 2; ++bj) { const f32x4 t_ = *(const PG8_LAS f32x4*)(scr + ((wr * 16 + (ai * 4 + m) * 2 + bj) * 16 + fr) * 4);
                    float rn = qs / sqrtf(((t_[0] + t_[1]) + (t_[2] + t_[3])) * (1.0f / 128.0f) + 1e-6f);
                    f32x4 y0 = acc[ai][bj][m][0] * rr[ai][m], y1 = acc[ai][bj][m][1] * rr[ai][m];
                    if (!(bj == 1 && pass1)) { y0 = y0 * rn * g[bj][0]; y1 = y1 * rn * g[bj][1]; }
                    cs[bj][0] += y0; cs[bj][1] += y1;
                    u32x4 w; w.x = cvt_pk_bf16(y0[0], y0[1]); w.y = cvt_pk_bf16(y0[2], y0[3]); w.z = cvt_pk_bf16(y1[0], y1[1]); w.w = cvt_pk_bf16(y1[2], y1[3]);
                    *(u32x4*)(rowp + bj * HALF) = w; } }
        if (part == 1 && hp >= 3) {
            PG8_LAS float* scr2 = scr + 2048;
#pragma unroll
            for (int bj = 0; bj < 2; ++bj)
#pragma unroll
                for (int n = 0; n < 2; ++n)
#pragma unroll
                    for (int j = 0; j < 4; ++j) { float c_ = cs[bj][n][j]; c_ += xor_get<1>(c_); c_ += xor_get<2>(c_); c_ += xor_get<4>(c_); c_ += xor_get<8>(c_);
                        if (fr == 0) scr2[wr * 256 + bj * HALF + wc * 32 + 8 * fq + 4 * n + j] = c_; }
            asm volatile("s_waitcnt lgkmcnt(0)" ::: "memory"); __builtin_amdgcn_s_barrier();
            const int t_ = (wr * 4 + wc) * 64 + fq * 16 + fr;
            if (t_ < 256) { const int hh = h0 + (t_ >> 7);
                if (hh >= 6 && hh <= 10) kmean[(size_t)(((u.pm >> 4) * 5 + (hh - 6)) * 16 + (u.pm & 15)) * 128 + (t_ & 127)] = (scr2[t_] + scr2[256 + t_]) * (1.0f / 256.0f); }
        }
    }
};
__device__ __forceinline__ float silu_mul(float g, float u) { const float e = __builtin_amdgcn_exp2f(g * -1.4426950408889634f); return g * __builtin_amdgcn_rcpf(1.0f + e) * u; }
struct EpiSwiGLU {
    static constexpr bool PERM = true, AFTER_DRAIN = false;
    bf16_t* O; int ldc;
    __device__ __forceinline__ void operator()(const f32x4 (&acc)[2][2][4][2], const Unit& u, int wr, int wc, int fr, int fq) const {
        const int row0 = u.pm * BM + wr * 64 + fr, col0 = u.pn * HALF + wc * 32 + 8 * fq;
#pragma unroll
        for (int ai = 0; ai < 2; ++ai)
#pragma unroll
            for (int m = 0; m < 4; ++m) { bf16_t* rowp = O + (size_t)(row0 + ai * HALF + m * 16) * ldc + col0;
                const f32x4 g0 = acc[ai][0][m][0], g1 = acc[ai][0][m][1], u0 = acc[ai][1][m][0], u1 = acc[ai][1][m][1];
                u32x4 w; w.x = cvt_pk_bf16(silu_mul(g0[0], u0[0]), silu_mul(g0[1], u0[1])); w.y = cvt_pk_bf16(silu_mul(g0[2], u0[2]), silu_mul(g0[3], u0[3]));
                w.z = cvt_pk_bf16(silu_mul(g1[0], u1[0]), silu_mul(g1[1], u1[1])); w.w = cvt_pk_bf16(silu_mul(g1[2], u1[2]), silu_mul(g1[3], u1[3]));
                *(u32x4*)rowp = w; }
    }
};
struct EpiSwiGLU8 {
    static constexpr bool PERM = true, AFTER_DRAIN = false;
    unsigned char* O; int ldc;
    __device__ __forceinline__ void operator()(const f32x4 (&acc)[2][2][4][2], const Unit& u, int wr, int wc, int fr, int fq) const {
        typedef unsigned u32x2 __attribute__((ext_vector_type(2)));
        const int row0 = u.pm * BM + wr * 64 + fr, col0 = u.pn * HALF + wc * 32 + 8 * fq;
#pragma unroll
        for (int ai = 0; ai < 2; ++ai)
#pragma unroll
            for (int m = 0; m < 4; ++m) { unsigned char* rowp = O + (size_t)(row0 + ai * HALF + m * 16) * ldc + col0;
                const f32x4 g0 = acc[ai][0][m][0], g1 = acc[ai][0][m][1], u0 = acc[ai][1][m][0], u1 = acc[ai][1][m][1];
                u32x2 w; w.x = pk4_fp8(silu_mul(g0[0], u0[0]), silu_mul(g0[1], u0[1]), silu_mul(g0[2], u0[2]), silu_mul(g0[3], u0[3]));
                w.y = pk4_fp8(silu_mul(g1[0], u1[0]), silu_mul(g1[1], u1[1]), silu_mul(g1[2], u1[2]), silu_mul(g1[3], u1[3]));
                *(u32x2*)rowp = w; }
    }
};
struct EpiResF32 {
    static constexpr bool PERM = true, AFTER_DRAIN = false;
    const float* base32; const bf16_t* base16; bf16_t* out16; int ldc; bf16_t* out16b; float* ssq; PG8_LAS float* scr; unsigned char* out8;
    __device__ __forceinline__ void operator()(const f32x4 (&acc)[2][2][4][2], const Unit& u, int wr, int wc, int fr, int fq) const {
        const int row0 = u.pm * BM + wr * 64 + fr, col0 = u.pn * BM + wc * 32 + 8 * fq;
#pragma unroll
        for (int ai = 0; ai < 2; ++ai)
#pragma unroll
            for (int m = 0; m < 4; ++m) { const size_t off = (size_t)(row0 + ai * HALF + m * 16) * ldc + col0; float sq_ = 0.f;
#pragma unroll
                for (int bj = 0; bj < 2; ++bj) { f32x4 v0 = acc[ai][bj][m][0], v1 = acc[ai][bj][m][1];
                    if (base32) { v0 += *(const f32x4*)(base32 + off + bj * HALF); v1 += *(const f32x4*)(base32 + off + bj * HALF + 4); }
                    else if (base16) { const u32x4 b = *(const u32x4*)(base16 + off + bj * HALF);
                        v0 += (f32x4){__uint_as_float(b.x << 16), __uint_as_float(b.x & 0xffff0000u), __uint_as_float(b.y << 16), __uint_as_float(b.y & 0xffff0000u)};
                        v1 += (f32x4){__uint_as_float(b.z << 16), __uint_as_float(b.z & 0xffff0000u), __uint_as_float(b.w << 16), __uint_as_float(b.w & 0xffff0000u)}; }
                    if (ssq) { float s_ = sq_; s_ = fmaf(v0[0], v0[0], s_); s_ = fmaf(v0[1], v0[1], s_); s_ = fmaf(v0[2], v0[2], s_); s_ = fmaf(v0[3], v0[3], s_);
                      s_ = fmaf(v1[0], v1[0], s_); s_ = fmaf(v1[1], v1[1], s_); s_ = fmaf(v1[2], v1[2], s_); s_ = fmaf(v1[3], v1[3], s_); sq_ = s_; }
                    u32x4 w; w.x = cvt_pk_bf16(v0[0], v0[1]); w.y = cvt_pk_bf16(v0[2], v0[3]); w.z = cvt_pk_bf16(v1[0], v1[1]); w.w = cvt_pk_bf16(v1[2], v1[3]);
                    *(u32x4*)((u.kh ? out16b : out16) + off + bj * HALF) = w;
                    if (out8) { u32x2w w8; w8.x = pk4_fp8(v0[0], v0[1], v0[2], v0[3]); w8.y = pk4_fp8(v1[0], v1[1], v1[2], v1[3]); *(u32x2w*)(out8 + off + bj * HALF) = w8; } }
                if (ssq) { float s_ = sq_; s_ += xor_get<16>(s_); s_ = xor32_sum(s_);
                    if (fq == 0) scr[((wr * 8 + ai * 4 + m) * 16 + fr) * 4 + wc] = s_; } }
        if (ssq) {
            asm volatile("s_waitcnt lgkmcnt(0)" ::: "memory"); __builtin_amdgcn_s_barrier();
            if (wc == 0 && fq == 0) {
#pragma unroll
                for (int ai = 0; ai < 2; ++ai)
#pragma unroll
                    for (int m = 0; m < 4; ++m) { const f32x4 t_ = *(const PG8_LAS f32x4*)(scr + ((wr * 8 + ai * 4 + m) * 16 + fr) * 4);
                        ssq[(size_t)(row0 + ai * HALF + m * 16) * 8 + u.pn] = (t_[0] + t_[1]) + (t_[2] + t_[3]); } }
        }
    }
};

template <class Epi, class Sched, bool ALIGN_EPI = false, bool SP2 = false, bool FP8 = false>
__device__ __forceinline__ void gemm_phase(PG8_LAS unsigned char* lds, const Gemm g, const Sched& S, const Epi& E, const int wave_) {
    const int tid = tid_of(wave_), wid = wave_, lane = tid & 63, wr = wid >> 2, wc = wid & 3, fr = lane & 15, fq = lane >> 4;
    const int K = g.K, nt = K / BK;
    unsigned voffA[2], voffB[2];
#pragma unroll
    for (int i = 0; i < 2; ++i) { int R, C; stage_rc(tid * 16 + i * 8192, R, C); const int Rb = Epi::PERM ? ((R & ~31) + perm32(R & 31)) : R;
        voffA[i] = (unsigned)(R * K + C) * 2u; voffB[i] = (unsigned)(Rb * K + C) * 2u; }
    const size_t kstep = (size_t)(BK * 2);
    const size_t hstep = (size_t)HALF * K * 2;
    const size_t tstep = 2 * hstep;
    const unsigned ldsw = (unsigned)wid * 1024u;
    const int aoff = lds_byte(wr * 64 + fr, fq * 8), boff = lds_byte(wc * 32 + fr, fq * 8);
#define PG8_SA(b, h) (((b) * 2 + (h)) * HTB)
#define PG8_SB(b, h) ((4 + (b) * 2 + (h)) * HTB)
#define PG8_STAGE(bufoff, gbase, voff) do { _Pragma("unroll") for (int _i = 0; _i < 2; ++_i) { unsigned _vo = (voff)[_i]; asm volatile("" : "+v"(_vo));     \
        __builtin_amdgcn_global_load_lds((const unsigned*)((const char*)(gbase) + _vo), (PG8_LAS unsigned*)(lds + (bufoff) + ldsw + _i * 8192), 16, 0, 0); } } while (0)
#define PG8_LDA(dst, b, h) do { _Pragma("unroll") for (int m = 0; m < 4; ++m) _Pragma("unroll") for (int k = 0; k < 2; ++k) dst[m][k] = *(const PG8_LAS bf16x8*)(lds + PG8_SA(b, h) + aoff + m * 2048 + k * 1024); } while (0)
#define PG8_LDB(dst, b, h) do { _Pragma("unroll") for (int n = 0; n < 2; ++n) _Pragma("unroll") for (int k = 0; k < 2; ++k) dst[n][k] = *(const PG8_LAS bf16x8*)(lds + PG8_SB(b, h) + boff + n * 2048 + k * 1024); } while (0)
#define PG8_MMA(ai, bj, At, Bt) do { __builtin_amdgcn_s_setprio(1); _Pragma("unroll") for (int m = 0; m < 4; ++m) _Pragma("unroll") for (int n = 0; n < 2; ++n) { \
        if constexpr (FP8) { acc[ai][bj][m][n] = __builtin_amdgcn_mfma_scale_f32_16x16x128_f8f6f4(cat8(Bt[n][0], Bt[n][1]), cat8(At[m][0], At[m][1]), acc[ai][bj][m][n], 0, 0, 0, 0x77777777, 0, 0x7f7f7f7f); } \
        else { _Pragma("unroll") for (int k = 0; k < 2; ++k) acc[ai][bj][m][n] = __builtin_amdgcn_mfma_f32_16x16x32_bf16(Bt[n][k], At[m][k], acc[ai][bj][m][n], 0, 0, 0); } } __builtin_amdgcn_s_setprio(0); } while (0)
#define PG8_WAIT_V(n) asm volatile("s_waitcnt vmcnt(" #n ")" ::: "memory")
#define PG8_WAIT_L(n) asm volatile("s_waitcnt lgkmcnt(" #n ")" ::: "memory")
#define PG8_BAR __builtin_amdgcn_s_barrier()
#define PG8_SCHED __builtin_amdgcn_sched_barrier(0)
    Unit cur, nxt; int ui = 0;
    if (!S.next(0, cur)) return;
    f32x4 acc[2][2][4][2];
#pragma unroll
    for (int a = 0; a < 2; ++a)
#pragma unroll
        for (int b = 0; b < 2; ++b)
#pragma unroll
            for (int m = 0; m < 4; ++m)
#pragma unroll
                for (int n = 0; n < 2; ++n) acc[a][b][m][n] = (f32x4){0.f, 0.f, 0.f, 0.f};
    bf16x8 At[4][2], B0[2][2], B1[2][2];
    const char* cA = (const char*)g.A + (size_t)cur.pm * tstep + cur.kofs; const char* cB = (const char*)g.Bt + cur.bofs + (size_t)cur.pn * tstep + cur.kofs;
    S.a_ready(cur);
    if constexpr (SP2) {
        PG8_STAGE(PG8_SB(0, 0), cB, voffB); PG8_STAGE(PG8_SB(0, 1), cB + hstep, voffB); PG8_STAGE(PG8_SA(0, 0), cA, voffA); PG8_STAGE(PG8_SA(0, 1), cA + hstep, voffA);
        if (wr == 1) PG8_BAR;
        PG8_WAIT_V(2); PG8_BAR;
        PG8_STAGE(PG8_SB(1, 0), cB + kstep, voffB); PG8_STAGE(PG8_SA(1, 0), cA + kstep, voffA); PG8_STAGE(PG8_SB(1, 1), cB + hstep + kstep, voffB);
        PG8_WAIT_V(6); PG8_BAR;
    } else {
        PG8_STAGE(PG8_SB(0, 0), cB, voffB); PG8_STAGE(PG8_SA(0, 0), cA, voffA); PG8_STAGE(PG8_SB(0, 1), cB + hstep, voffB); PG8_STAGE(PG8_SA(0, 1), cA + hstep, voffA);
        if (wr == 1) PG8_BAR;
        PG8_WAIT_V(4); PG8_BAR;
        PG8_STAGE(PG8_SB(1, 0), cB + kstep, voffB); PG8_STAGE(PG8_SA(1, 0), cA + kstep, voffA); PG8_STAGE(PG8_SB(1, 1), cB + hstep + kstep, voffB);
        PG8_WAIT_V(6); PG8_BAR;
    }
    for (;;) {
        const bool has_next = S.next(ui + 1, nxt);
        const char* nA = has_next ? (const char*)g.A + (size_t)nxt.pm * tstep + nxt.kofs : cA; const char* nB = has_next ? (const char*)g.Bt + nxt.bofs + (size_t)nxt.pn * tstep + nxt.kofs : cB;
        const int ntc = cur.ntu ? cur.ntu : nt;
        for (int t = 0; t < ntc; t += 2) {
            const bool last = (t == ntc - 2);
            const char* a1 = cA + (size_t)(t + 1) * kstep;
            const char* a2 = last ? nA : cA + (size_t)(t + 2) * kstep; const char* b2 = last ? nB : cB + (size_t)(t + 2) * kstep;
            const char* a3 = a2 + kstep; const char* b3 = b2 + kstep;
            if (last && has_next) S.a_ready(nxt);
            if constexpr (SP2) {
            PG8_LDB(B0, 0, 0); PG8_LDB(B1, 0, 1); PG8_SCHED; PG8_LDA(At, 0, 0); PG8_STAGE(PG8_SA(1, 1), a1 + hstep, voffA);
            PG8_WAIT_V(8); PG8_WAIT_L(0); PG8_BAR; PG8_MMA(0, 0, At, B0); PG8_MMA(0, 1, At, B1); PG8_BAR; PG8_SCHED;
            PG8_LDA(At, 0, 1); PG8_STAGE(PG8_SB(0, 0), b2, voffB); PG8_STAGE(PG8_SB(0, 1), b2 + hstep, voffB); PG8_STAGE(PG8_SA(0, 0), a2, voffA);
            PG8_WAIT_V(8); PG8_WAIT_L(0); PG8_BAR; PG8_MMA(1, 0, At, B0); PG8_MMA(1, 1, At, B1); PG8_BAR; PG8_SCHED;
            PG8_LDB(B0, 1, 0); PG8_LDB(B1, 1, 1); PG8_SCHED; PG8_LDA(At, 1, 0); PG8_STAGE(PG8_SA(0, 1), a2 + hstep, voffA);
            PG8_WAIT_V(8); PG8_WAIT_L(0); PG8_BAR; PG8_MMA(0, 0, At, B0); PG8_MMA(0, 1, At, B1); PG8_BAR; PG8_SCHED;
            PG8_LDA(At, 1, 1); PG8_STAGE(PG8_SB(1, 0), b3, voffB); PG8_STAGE(PG8_SB(1, 1), b3 + hstep, voffB); PG8_STAGE(PG8_SA(1, 0), a3, voffA);
            PG8_WAIT_V(8); PG8_WAIT_L(0); PG8_BAR; PG8_MMA(1, 0, At, B0); PG8_MMA(1, 1, At, B1); PG8_BAR; PG8_SCHED;
            } else {
            PG8_LDB(B0, 0, 0); PG8_SCHED; PG8_LDA(At, 0, 0); PG8_STAGE(PG8_SA(1, 1), a1 + hstep, voffA);
            PG8_WAIT_L(8); PG8_BAR; PG8_WAIT_L(0); PG8_MMA(0, 0, At, B0); PG8_BAR; PG8_SCHED;
            PG8_LDB(B1, 0, 1); PG8_STAGE(PG8_SB(0, 0), b2, voffB);
            PG8_BAR; PG8_WAIT_L(0); PG8_MMA(0, 1, At, B1); PG8_BAR;
            PG8_LDA(At, 0, 1); PG8_STAGE(PG8_SA(0, 0), a2, voffA);
            PG8_BAR; PG8_WAIT_L(0); PG8_MMA(1, 0, At, B0); PG8_BAR; PG8_SCHED;
            PG8_STAGE(PG8_SB(0, 1), b2 + hstep, voffB);
            PG8_WAIT_V(6); PG8_BAR; PG8_MMA(1, 1, At, B1); PG8_BAR;
            PG8_LDB(B0, 1, 0); PG8_SCHED; PG8_LDA(At, 1, 0); PG8_STAGE(PG8_SA(0, 1), a2 + hstep, voffA);
            PG8_WAIT_L(8); PG8_BAR; PG8_WAIT_L(0); PG8_MMA(0, 0, At, B0); PG8_BAR; PG8_SCHED;
            PG8_LDB(B1, 1, 1); PG8_STAGE(PG8_SB(1, 0), b3, voffB);
            PG8_BAR; PG8_WAIT_L(0); PG8_MMA(0, 1, At, B1); PG8_BAR;
            PG8_LDA(At, 1, 1); PG8_STAGE(PG8_SA(1, 0), a3, voffA);
            PG8_BAR; PG8_WAIT_L(0); PG8_MMA(1, 0, At, B0); PG8_BAR; PG8_SCHED;
            PG8_STAGE(PG8_SB(1, 1), b3 + hstep, voffB);
            PG8_WAIT_V(6); PG8_BAR; PG8_MMA(1, 1, At, B1); PG8_BAR;
            }
        }
        if constexpr (ALIGN_EPI) { if (wr == 0) PG8_BAR; }
        if constexpr (!Epi::AFTER_DRAIN) { const int l2_ = lane_id(); E(acc, cur, wr, wc, l2_ & 15, l2_ >> 4); S.done(cur); }
        if (!has_next) break;
#pragma unroll
        for (int a = 0; a < 2; ++a)
#pragma unroll
            for (int b = 0; b < 2; ++b)
#pragma unroll
                for (int m = 0; m < 4; ++m)
#pragma unroll
                    for (int n = 0; n < 2; ++n) acc[a][b][m][n] = (f32x4){0.f, 0.f, 0.f, 0.f};
        cur = nxt; cA = nA; cB = nB; ++ui;
        if constexpr (ALIGN_EPI) { if (wr == 1) PG8_BAR; }
    }
    PG8_WAIT_V(0);
    if constexpr (!ALIGN_EPI) { if (wr == 0) PG8_BAR; }
    PG8_BAR;
    if constexpr (Epi::AFTER_DRAIN) { E.fused(acc, cur, wr, wc, fr, fq, lds, wid, lane); S.done(cur); }
#undef PG8_SA
#undef PG8_SB
#undef PG8_STAGE
#undef PG8_LDA
#undef PG8_LDB
#undef PG8_MMA
#undef PG8_WAIT_V
#undef PG8_WAIT_L
#undef PG8_BAR
#undef PG8_SCHED
}
}

#ifndef KV8_SP2
#define KV8_SP2 true
#endif
#ifndef WO8_SP2
#define WO8_SP2 false
#endif
#ifndef WO8_LAYER
#define WO8_LAYER -1
#endif
namespace att {
typedef unsigned short bf16;
typedef short bf16x8 __attribute__((ext_vector_type(8)));
typedef short s16x4 __attribute__((ext_vector_type(4)));
typedef float f32x16 __attribute__((ext_vector_type(16)));
typedef float f32x4 __attribute__((ext_vector_type(4)));
typedef unsigned u32x4 __attribute__((ext_vector_type(4)));
typedef int i32x4 __attribute__((ext_vector_type(4)));
constexpr int QS = 6144, SEQ = 4096, DM = 2048;
constexpr int DPW = 1408, DPLW = 16, NTOK = 8192;
constexpr int SHM_T = 16384;
constexpr int L_V = 0, L_K = 2 * SHM_T, L_Q = 4 * SHM_T, L_WS = L_Q + 65536, L_TL = L_WS + 2048, L_FLG = L_TL + 256, L_MSK = L_FLG + 64, L_KM = L_V, L_END = L_MSK + 64;
static_assert(L_END <= 140 * 1024, "attention LDS map");
constexpr float C2 = 0.08838834764831845f * 1.4426950408889634f;
#define KSWZ(row, colB) ((row) * 256 + ((colB) ^ (((row) & 7) << 4)))
#define SBAR() __builtin_amdgcn_sched_barrier(0)
__device__ __forceinline__ int v_st(int k, int c) { const int kk = (k & ~0xC) | ((k & 4) << 1) | ((k & 8) >> 1); return ((kk >> 3) * 4 + (c >> 5)) * 512 + ((kk & 7) * 32 + (c & 31)) * 2; }
__device__ __forceinline__ int v_rd_base(int lane) { return ((lane & 3) << 3) | (((lane >> 2) & 3) << 6) | (((lane >> 4) & 1) << 5) | (((lane >> 5) & 1) << 8); }
constexpr int v_rd_off(int d0, int ks, int half) { return d0 * 512 + ks * 4096 + half * 2048; }
__device__ __forceinline__ int crow(int r, int hi) { return (r & 3) + 8 * (r >> 2) + 4 * hi; }
__device__ __forceinline__ unsigned cvtpk(float lo, float hi) { unsigned r; asm volatile("v_cvt_pk_bf16_f32 %0, %1, %2" : "=v"(r) : "v"(lo), "v"(hi)); return r; }
__device__ __forceinline__ float bf2f(short s) { return __uint_as_float(((unsigned)(unsigned short)s) << 16); }

__device__ __forceinline__ void qkt(f32x16& p0, f32x16& p1, const f32x16& init, const char* Kt, int r32, int hi, const char* qf  ) {
    p0 = init; p1 = init;
    const char* kb[4];
#pragma unroll
    for (int dd = 0; dd < 4; ++dd) kb[dd] = Kt + KSWZ(r32, (dd * 16 + hi * 8) * 2);
#pragma unroll
    for (int d0 = 0; d0 < 8; ++d0) { const char* a = kb[d0 & 3] + (d0 >> 2) * 128;
        bf16x8 b0 = *reinterpret_cast<const bf16x8*>(a);
        bf16x8 b1 = *reinterpret_cast<const bf16x8*>(a + 32 * 256);
        const bf16x8 q = *reinterpret_cast<const bf16x8*>(qf + d0 * 1024);
        p0 = __builtin_amdgcn_mfma_f32_32x32x16_bf16(b0, q, p0, 0, 0, 0);
        p1 = __builtin_amdgcn_mfma_f32_32x32x16_bf16(b1, q, p1, 0, 0, 0); }
}
__device__ __forceinline__ void pv_tile(f32x16* o, int vb, bf16x8 pa0, bf16x8 pa1, bf16x8 pa2, bf16x8 pa3) {
#define TRRD(dst, off) asm volatile("ds_read_b64_tr_b16 %0, %1 offset:%2" : "=&v"(dst) : "v"(vb), "i"(off) : "memory")
#define PV_D0(d0) do { s16x4 l0, l1, l2, l3, h0, h1, h2, h3; constexpr int b_ = v_rd_off(d0, 0, 0); \
        TRRD(l0, b_); TRRD(h0, b_ + 2048); TRRD(l1, b_ + 4096); TRRD(h1, b_ + 6144); TRRD(l2, b_ + 8192); TRRD(h2, b_ + 10240); TRRD(l3, b_ + 12288); TRRD(h3, b_ + 14336); \
        asm volatile("s_waitcnt lgkmcnt(0)" ::: "memory"); SBAR(); \
        o[d0] = __builtin_amdgcn_mfma_f32_32x32x16_bf16(pa0, (bf16x8){l0[0], l0[1], l0[2], l0[3], h0[0], h0[1], h0[2], h0[3]}, o[d0], 0, 0, 0);   \
        o[d0] = __builtin_amdgcn_mfma_f32_32x32x16_bf16(pa1, (bf16x8){l1[0], l1[1], l1[2], l1[3], h1[0], h1[1], h1[2], h1[3]}, o[d0], 0, 0, 0);   \
        o[d0] = __builtin_amdgcn_mfma_f32_32x32x16_bf16(pa2, (bf16x8){l2[0], l2[1], l2[2], l2[3], h2[0], h2[1], h2[2], h2[3]}, o[d0], 0, 0, 0);   \
        o[d0] = __builtin_amdgcn_mfma_f32_32x32x16_bf16(pa3, (bf16x8){l3[0], l3[1], l3[2], l3[3], h3[0], h3[1], h3[2], h3[3]}, o[d0], 0, 0, 0); } while (0)
    PV_D0(0); PV_D0(1); PV_D0(2); PV_D0(3);
#undef PV_D0
#undef TRRD
}
__device__ __forceinline__ void pack_p(const f32x16& p0, const f32x16& p1, bf16x8& pa0, bf16x8& pa1, bf16x8& pa2, bf16x8& pa3) {
#define PK4(P, B_, OUT) do { unsigned a0 = cvtpk(P[B_+0], P[B_+1]), a1 = cvtpk(P[B_+2], P[B_+3]);                          \
        unsigned b0 = cvtpk(P[B_+4], P[B_+5]), b1 = cvtpk(P[B_+6], P[B_+7]);                                             \
        auto r0 = __builtin_amdgcn_permlane32_swap(a0, b0, false, false); auto r1 = __builtin_amdgcn_permlane32_swap(a1, b1, false, false); \
        u32x4 w = {r0[0], r1[0], r0[1], r1[1]}; OUT = *reinterpret_cast<bf16x8*>(&w); } while (0)
    PK4(p0, 0, pa0); PK4(p0, 8, pa1); PK4(p1, 0, pa2); PK4(p1, 8, pa3);
#undef PK4
}
__device__ __forceinline__ float softplus2(float y) { return fmaxf(y, 0.f) + __builtin_amdgcn_logf(1.0f + __builtin_amdgcn_exp2f(-fabsf(y))); }

struct AttnArgs { const bf16* qkv; bf16* obuf; const float* kmean; const float* out_gain; bf16* dpo; float* dpl; unsigned* mlist; unsigned* mcnt; unsigned* mdone; int ob8; };
constexpr int MLCAP = 3840, N_SEL = 2 * 5 * 15;
__device__ __forceinline__ unsigned ld_sc1(const unsigned* p) { return __hip_atomic_load(p, __ATOMIC_RELAXED, __HIP_MEMORY_SCOPE_AGENT); }
__device__ __forceinline__ void st_sc1(unsigned* p, unsigned v) { __hip_atomic_store(p, v, __ATOMIC_RELAXED, __HIP_MEMORY_SCOPE_AGENT); }

template <int mode> __device__ __forceinline__ void attn_unit(const AttnArgs& A, const int b, const int h, const int sub, char* shm, const int wave_) {
    const int tid = tid_of(wave_), wid = wave_, lane = tid & 63, r32 = lane & 31, hi = lane >> 5;
    int dil = 1, res = 0, qb = sub, br = 0;
    int gk = 0, gcnt = 0; unsigned gent = 0u; bool gvalid = true, wvalid = true;
    if (mode == 0) { br = sub >> 4; const int x = sub & 15; if (br == 0) { qb = x; } else if (br == 1) { dil = 4; res = x >> 2; qb = x & 3; } else { dil = 16; res = x; qb = 0; } }
    if (mode == 3) { gk = sub >> 4; const int c = sub & 15; const int li = (b * 5 + (h - 6)) * 15 + gk;
        gcnt = __builtin_amdgcn_readfirstlane((int)ld_sc1(A.mcnt + li));
        if (c * 256 >= gcnt) return;
        const int gi = c * 256 + wid * 32 + r32; gvalid = gi < gcnt; wvalid = (c * 256 + wid * 32) < gcnt;
        gent = ld_sc1(A.mlist + (size_t)li * MLCAP + (gvalid ? gi : 0)); qb = 0; }
    const size_t rowbase = (size_t)b * SEQ + res; const int q0 = qb * 256;
    const bf16* Qp = A.qkv + (rowbase + (size_t)dil * ((mode == 3) ? (int)(gent & 4095u) : (q0 + wid * 32 + r32))) * QS + h * 128;
    const bf16* Kh = A.qkv + rowbase * QS + 2048 + h * 128;
    const bf16* Vh = A.qkv + rowbase * QS + 4096 + h * 128;
    const size_t rstep = (size_t)dil * QS;
    char* V_lds = shm + L_V; char* K_lds = shm + L_K;
    float* wsf = (float*)(shm + L_WS) + wid * 64; float* li_l = wsf; float* al_l = wsf + 32;
    int* TL = (int*)(shm + L_TL); int* FLG = (int*)(shm + L_FLG); unsigned* MSK = (unsigned*)(shm + L_MSK); float* KM = (float*)(shm + L_KM);
    char* qf = shm + L_Q + wid * 8192 + lane * 16;
    const int qw0 = q0 + wid * 32;
    const int pos = qw0 + r32;
    const int vb0 = (int)(uintptr_t)V_lds + v_rd_base(lane);
    unsigned koffb[2], voffb[2];
#pragma unroll
    for (int i = 0; i < 2; ++i) { const int Lb = (2 * wid + i) * 1024 + lane * 16;
        const int rowk = Lb >> 8, ck = ((Lb >> 4) & 15) ^ (rowk & 7);
        koffb[i] = (unsigned)(((size_t)rowk * rstep + ck * 8) * 2);
        const int sub_ = Lb >> 9, win_ = Lb & 511, kk = (sub_ >> 2) * 8 + (win_ >> 6), kv = (kk & ~0xC) | ((kk & 4) << 1) | ((kk & 8) >> 1), cc = (sub_ & 3) * 4 + ((win_ & 63) >> 4);
        voffb[i] = (unsigned)(((size_t)kv * rstep + cc * 8) * 2); }
    typedef __attribute__((address_space(3))) unsigned lds_u32;
    lds_u32* const Kdst = (lds_u32*)(K_lds + wid * 2048); lds_u32* const Vdst = (lds_u32*)(V_lds + wid * 2048);
#define TDMA(k0_, bf_) do { const char* kt_ = (const char*)(Kh + (size_t)(k0_) * rstep); const char* vt_ = (const char*)(Vh + (size_t)(k0_) * rstep); \
        _Pragma("unroll") for (int i_ = 0; i_ < 2; ++i_) { unsigned ko_ = koffb[i_], vo_ = voffb[i_]; asm volatile("" : "+v"(ko_), "+v"(vo_)); \
            __builtin_amdgcn_global_load_lds((const unsigned*)(kt_ + ko_), (lds_u32*)((__attribute__((address_space(3))) char*)Kdst + (bf_) * SHM_T + i_ * 1024), 16, 0, 0); \
            __builtin_amdgcn_global_load_lds((const unsigned*)(vt_ + vo_), (lds_u32*)((__attribute__((address_space(3))) char*)Vdst + (bf_) * SHM_T + i_ * 1024), 16, 0, 0); } } while (0)
    { const int kf_ = ((mode == 3) ? gk * 256 : q0) + 192; TDMA(kf_, 0); }
    bf16x8 qr[8];
#pragma unroll
    for (int d0 = 0; d0 < 8; ++d0) { qr[d0] = *reinterpret_cast<const bf16x8*>(Qp + d0 * 16 + hi * 8); *reinterpret_cast<bf16x8*>(qf + d0 * 1024) = qr[d0]; }
    const float sl = (mode == 2) ? 0.f : __builtin_amdgcn_exp2f(-8.0f * (float)(h + 1) / 11.0f) * 1.4426950408889634f * (float)dil;
    f32x16 binit;
#pragma unroll
    for (int r = 0; r < 16; ++r) binit[r] = sl * (float)((r & 3) + 8 * (r >> 2) + 4 * hi);
    const float sl32 = 32.f * sl;

    int NT = 0;
    if (mode == 1) { NT = 4; if (tid < 4) TL[tid] = q0 + 192 - 64 * tid; }
    else if (mode == 3) { NT = 4; if (tid < 4) TL[tid] = gk * 256 + 192 - 64 * tid; }
    else if (mode == 0) {
        const int lo = q0 >= 128 ? q0 - 128 : 0; NT = (q0 + 256 - lo) / 64;
        if (tid < NT) TL[NT - 1 - tid] = lo + 64 * tid;
    } else {
        NT = (q0 + 256) / 64;
        if (tid < NT) TL[tid] = q0 + 192 - 64 * tid;
    }
    __syncthreads();

    float m_reg = -1e30f, l_reg = 0.f, carry = 0.f; asm volatile("" : "+v"(m_reg), "+v"(l_reg), "+v"(carry));
    f32x16 o[4];
#pragma unroll
    for (int d0 = 0; d0 < 4; ++d0) o[d0] = f32x16{};
    bool wdone = false;
    for (int t = 0; t < NT; ++t) {
        const int buf = t & 1; const int kb = __builtin_amdgcn_readfirstlane(TL[t]);
        const bool more = (t + 1 < NT);
        if (more) { const int k1 = __builtin_amdgcn_readfirstlane(TL[t + 1]); TDMA(k1, buf ^ 1); }
        bool act;
        if (mode == 0) act = (kb <= qw0 + 31) && (kb + 63 >= qw0 - 128);
        else if (mode == 1) act = (kb <= qw0 + 31);
        else if (mode == 3) act = wvalid;
        else act = (kb < qw0 + 32) && !wdone;
        if (act) {
            f32x16 p0, p1;
            qkt(p0, p1, binit, K_lds + buf * SHM_T, r32, hi, qf);
            bf16x8 pa0, pa1, pa2, pa3;
            const int dq = pos - kb - 4 * hi;
            if (mode == 2) {
                float Og[8], Pg[8];
#pragma unroll
                for (int i = 0; i < 8; ++i) { float ye[4], le[4];
#pragma unroll
                    for (int e = 0; e < 4; ++e) { const int c = (i < 4) ? (8 * i + e) : (8 * (i - 4) + 32 + e); const float y = ((i < 4) ? p0[4 * i + e] : p1[4 * (i - 4) + e]) * C2;
                        ye[e] = y; le[e] = (dq - c >= 1) ? -softplus2(y) : 0.f; }
                    const float w2 = le[3], w1 = w2 + le[2], w0 = w1 + le[1];
                    Og[i] = w0 + le[0];
                    const float x0 = ye[0] + le[0] + w0, x1 = ye[1] + le[1] + w1, x2 = ye[2] + le[2] + w2, x3 = ye[3] + le[3];
                    if (i < 4) { p0[4 * i] = x0; p0[4 * i + 1] = x1; p0[4 * i + 2] = x2; p0[4 * i + 3] = x3; } else { p1[4 * (i - 4)] = x0; p1[4 * (i - 4) + 1] = x1; p1[4 * (i - 4) + 2] = x2; p1[4 * (i - 4) + 3] = x3; } }
#pragma unroll
                for (int i = 0; i < 8; ++i) Pg[i] = xor32_get(Og[i], hi);
                float run = carry;
#pragma unroll
                for (int i = 7; i >= 0; --i) { const float ab = run + (hi == 0 ? Pg[i] : 0.f);
#pragma unroll
                    for (int e = 0; e < 4; ++e) { const int c = (i < 4) ? (8 * i + e) : (8 * (i - 4) + 32 + e);
                        if (i < 4) p0[4 * i + e] = (dq - c >= 1) ? __builtin_amdgcn_exp2f(p0[4 * i + e] + ab) : 0.f;
                        else p1[4 * (i - 4) + e] = (dq - c >= 1) ? __builtin_amdgcn_exp2f(p1[4 * (i - 4) + e] + ab) : 0.f; }
                    run += Og[i] + Pg[i]; }
                carry = run;
                wdone = __all(carry < -160.f) != 0;
                pack_p(p0, p1, pa0, pa1, pa2, pa3);
            } else {
                const float NEG = -__builtin_inff();
                bool rowok = true;
                if (mode == 0) {
                    if (!((kb + 63 <= qw0) && (qw0 + 31 - kb <= 128))) {
#pragma unroll
                        for (int r = 0; r < 16; ++r) { const int c = (r & 3) + 8 * (r >> 2);
                            p0[r] = ((unsigned)(dq - c) <= 128u) ? p0[r] : NEG; p1[r] = ((unsigned)(dq - c - 32) <= 128u) ? p1[r] : NEG; } }
                } else if (mode == 1) {
                    if (kb + 63 > qw0) {
#pragma unroll
                        for (int r = 0; r < 16; ++r) { const int c = (r & 3) + 8 * (r >> 2);
                            p0[r] = (dq - c >= 0) ? p0[r] : NEG; p1[r] = (dq - c - 32 >= 0) ? p1[r] : NEG; } }
                } else rowok = gvalid;
                const float tb = sl * (float)kb;
                float pm0 = p0[0], pm1 = p1[0];
#pragma unroll
                for (int r = 1; r < 16; ++r) { pm0 = fmaxf(pm0, p0[r]); pm1 = fmaxf(pm1, p1[r]); }
                float pmax = fmaxf(pm0, pm1 + sl32);
                { auto rr = __builtin_amdgcn_permlane32_swap(__float_as_uint(pmax), __float_as_uint(pmax), false, false); pmax = fmaxf(__uint_as_float(rr[0]), __uint_as_float(rr[1])); }
                pmax = rowok ? pmax : NEG;
                const float m_loc = m_reg - tb;
                const float mn = fmaxf(m_loc, pmax); const float alpha = __builtin_amdgcn_exp2f(m_loc - mn); m_reg = mn + tb;
                const float ref0 = rowok ? mn : __builtin_inff(), ref1 = ref0 - sl32;
                float ps = 0.f;
#pragma unroll
                for (int r = 0; r < 16; ++r) { p0[r] = __builtin_amdgcn_exp2f(p0[r] - ref0); p1[r] = __builtin_amdgcn_exp2f(p1[r] - ref1); ps += p0[r] + p1[r]; }
                { auto rr = __builtin_amdgcn_permlane32_swap(__float_as_uint(ps), __float_as_uint(ps), false, false); ps = __uint_as_float(rr[0]) + __uint_as_float(rr[1]); }
                l_reg = l_reg * alpha + ps;
                pack_p(p0, p1, pa0, pa1, pa2, pa3);
                if (__any(alpha < 1.f)) { if (hi == 0) al_l[r32] = alpha; asm volatile("s_waitcnt lgkmcnt(0)" ::: "memory");
#pragma unroll
                    for (int d_ = 0; d_ < 4; ++d_)
#pragma unroll
                        for (int r = 0; r < 16; ++r) o[d_][r] *= al_l[crow(r, hi)]; }
            }
            SBAR();
            pv_tile(o, vb0 + buf * SHM_T, pa0, pa1, pa2, pa3);
        }
        if (mode == 2) { if (lane == 0) FLG[buf * 8 + wid] = wdone ? 1 : 0; }
        __syncthreads();
        if (mode == 2) { const i32x4 fa = *(const i32x4*)(FLG + buf * 8), fb = *(const i32x4*)(FLG + buf * 8 + 4);
            if ((fa[0] & fa[1] & fa[2] & fa[3] & fb[0] & fb[1] & fb[2] & fb[3]) != 0) break; }
    }
#undef TDMA
    if (mode != 2) {
        const int slot = (mode == 0) ? br : 0;
        const size_t tok0 = rowbase + (size_t)dil * qw0;
        int* ts_l = (int*)al_l;
        if (hi == 0) { const float lse = (l_reg > 0.f) ? (m_reg + __builtin_amdgcn_logf(l_reg) - ((mode == 0) ? sl * (float)pos : 0.f)) : -__builtin_inff();
            if (mode == 3) { const int ts = gvalid ? (int)((1u + (gent >> 12)) * (unsigned)NTOK + (unsigned)rowbase + (gent & 4095u)) : -1; ts_l[r32] = ts; if (gvalid) A.dpl[(size_t)ts * DPLW + h] = lse; }
            else A.dpl[((size_t)slot * NTOK + tok0 + (size_t)dil * r32) * DPLW + h] = lse;
            if (mode == 1) { for (int s_ = 1 + (qb < 3 ? qb : 3); s_ < 4; ++s_) A.dpl[((size_t)s_ * NTOK + tok0 + r32) * DPLW + h] = -__builtin_inff(); }
            li_l[r32] = (l_reg > 0.f) ? __builtin_amdgcn_rcpf(l_reg) : 0.f; }
        asm volatile("s_waitcnt lgkmcnt(0)" ::: "memory");
        float rli[16];
#pragma unroll
        for (int r = 0; r < 16; ++r) rli[r] = li_l[crow(r, hi)];
        if (mode == 3) {
#pragma unroll
            for (int r = 0; r < 16; ++r) { const int ts = ts_l[crow(r, hi)]; bf16* Ow = A.dpo + (size_t)(ts < 0 ? 0 : ts) * DPW + h * 128;
#pragma unroll
                for (int d0 = 0; d0 < 4; ++d0) { const float v = o[d0][r] * rli[r]; const float vn = xor_get<1>(v);
                    if ((r32 & 1) == 0 && ts >= 0) *(unsigned*)(Ow + d0 * 32 + r32) = cvtpk(v, vn); } }
        } else {
        bf16* Ow = A.dpo + ((size_t)slot * NTOK + tok0) * DPW + h * 128;
#pragma unroll
        for (int r = 0; r < 16; ++r) { const int orow = crow(r, hi);
#pragma unroll
            for (int d0 = 0; d0 < 4; ++d0) { const float v = o[d0][r] * rli[r]; const float vn = xor_get<1>(v);
                if ((r32 & 1) == 0) *(unsigned*)(Ow + (size_t)orow * dil * DPW + d0 * 32 + r32) = cvtpk(v, vn); } }
        }
    } else {
        float ssq[16];
#pragma unroll
        for (int r = 0; r < 16; ++r) { float a = 0.f;
#pragma unroll
            for (int d0 = 0; d0 < 4; ++d0) { const float v = o[d0][r]; a = fmaf(v, v, a); }
            ssq[r] = a; }
#pragma unroll
        for (int r = 0; r < 16; ++r) { float a = ssq[r]; a += xor_get<1>(a); a += xor_get<2>(a); a += xor_get<4>(a); a += xor_get<8>(a); a += xor_get<16>(a); ssq[r] = a; }
        float gn[4];
#pragma unroll
        for (int d0 = 0; d0 < 4; ++d0) gn[d0] = A.out_gain[h * 128 + d0 * 32 + r32];
        bf16* Ow = A.obuf + (rowbase + qw0) * DM + h * 128;
#pragma unroll
        for (int r = 0; r < 16; ++r) { const int orow = crow(r, hi); const float rn = 1.0f / sqrtf(ssq[r] * (1.0f / 128.0f) + 1e-6f);
#pragma unroll
            for (int d0 = 0; d0 < 4; ++d0) { const float v = o[d0][r] * rn * gn[d0]; const float vn = xor_get<1>(v);
                if (A.ob8) { const float v2 = xor_get<2>(v), v3 = xor_get<2>(vn);
                    if ((r32 & 3) == 0) *(unsigned*)((unsigned char*)A.obuf + (rowbase + qw0 + orow) * DM + h * 128 + d0 * 32 + r32) = pg8::pk4_fp8(v, vn, v2, v3); }
                else if ((r32 & 1) == 0) *(unsigned*)(Ow + (size_t)orow * DM + d0 * 32 + r32) = cvtpk(v, vn); } }
    }
}

__device__ __forceinline__ void moba_select(const AttnArgs& A, const int b, const int h, const int qb, char* shm, const int wave_) {
    const int tid = tid_of(wave_), wid = wave_, lane = tid & 63, r32 = lane & 31, hi = lane >> 5;
    float* KM = (float*)(shm + L_KM); int* LC = (int*)(shm + L_TL); int* LB = LC + 16;
    const int pos = qb * 256 + wid * 32 + r32;
    const bf16* Qp = A.qkv + ((size_t)b * SEQ + pos) * QS + h * 128;
    bf16x8 qr[8];
#pragma unroll
    for (int d0 = 0; d0 < 8; ++d0) qr[d0] = *reinterpret_cast<const bf16x8*>(Qp + d0 * 16 + hi * 8);
    if (tid < 16) LC[tid] = 0;
    { const float* src = A.kmean + (size_t)((b * 5 + (h - 6)) * 16) * 128; *(f32x4*)(KM + tid * 4) = *(const f32x4*)(src + tid * 4); }
    __syncthreads();
    float gate[16];
#pragma unroll
    for (int j = 0; j < 16; ++j) gate[j] = 0.f;
#pragma unroll
    for (int d0 = 0; d0 < 8; ++d0) {
        float qv[8];
#pragma unroll
        for (int e = 0; e < 8; ++e) qv[e] = bf2f(qr[d0][e]);
#pragma unroll
        for (int j = 0; j < 16; ++j) { const f32x4 k0 = *(const f32x4*)(KM + j * 128 + d0 * 16 + hi * 8), k1 = *(const f32x4*)(KM + j * 128 + d0 * 16 + hi * 8 + 4);
            float a = gate[j];
            a = fmaf(qv[0], k0[0], a); a = fmaf(qv[1], k0[1], a); a = fmaf(qv[2], k0[2], a); a = fmaf(qv[3], k0[3], a);
            a = fmaf(qv[4], k1[0], a); a = fmaf(qv[5], k1[1], a); a = fmaf(qv[6], k1[2], a); a = fmaf(qv[7], k1[3], a);
            gate[j] = a; }
    }
#pragma unroll
    for (int j = 0; j < 16; ++j) gate[j] = xor32_sum(gate[j]);
    unsigned sel = 0u;
#pragma unroll
    for (int it = 0; it < 3; ++it) { float best = -__builtin_inff(); int bi = -1;
#pragma unroll
        for (int j = 0; j < 16; ++j) { const bool ok = (j < qb) && (((sel >> j) & 1u) == 0u) && (gate[j] > best); if (ok) { best = gate[j]; bi = j; } }
        if (bi >= 0) sel |= 1u << bi; }
    int jj0 = -1, jj1 = -1, jj2 = -1, ll0 = 0, ll1 = 0, ll2 = 0;
    if (hi == 0) { unsigned s_ = sel;
        if (s_) { jj0 = __builtin_ctz(s_); s_ &= s_ - 1u; ll0 = __hip_atomic_fetch_add(LC + jj0, 1, __ATOMIC_RELAXED, __HIP_MEMORY_SCOPE_WORKGROUP); }
        if (s_) { jj1 = __builtin_ctz(s_); s_ &= s_ - 1u; ll1 = __hip_atomic_fetch_add(LC + jj1, 1, __ATOMIC_RELAXED, __HIP_MEMORY_SCOPE_WORKGROUP); }
        if (s_) { jj2 = __builtin_ctz(s_); ll2 = __hip_atomic_fetch_add(LC + jj2, 1, __ATOMIC_RELAXED, __HIP_MEMORY_SCOPE_WORKGROUP); } }
    __syncthreads();
    const int lbase = (b * 5 + (h - 6)) * 15;
    if (tid < 15) { const int n = LC[tid]; LB[tid] = n ? (int)__hip_atomic_fetch_add(A.mcnt + lbase + tid, (unsigned)n, __ATOMIC_RELAXED, __HIP_MEMORY_SCOPE_AGENT) : 0; }
    __syncthreads();
    if (hi == 0) {
        if (jj0 >= 0) st_sc1(A.mlist + (size_t)(lbase + jj0) * MLCAP + LB[jj0] + ll0, (unsigned)pos);
        if (jj1 >= 0) st_sc1(A.mlist + (size_t)(lbase + jj1) * MLCAP + LB[jj1] + ll1, (unsigned)pos | (1u << 12));
        if (jj2 >= 0) st_sc1(A.mlist + (size_t)(lbase + jj2) * MLCAP + LB[jj2] + ll2, (unsigned)pos | (2u << 12)); }
    asm volatile("s_waitcnt vmcnt(0)" ::: "memory");
    __syncthreads();
    if (tid == 0) __hip_atomic_fetch_add(A.mdone, 1u, __ATOMIC_RELAXED, __HIP_MEMORY_SCOPE_AGENT);
}

constexpr bool unit_valid(int mode, int sub) { return mode == 0 ? sub < 48 : sub < 16; }
constexpr int unit_cost(int mode, int sub) {
    if (mode == 0) return 4;
    if (mode == 2) return 4 * (sub + 1) < 6 ? 4 * (sub + 1) : 6;
    return 4;
}
constexpr int gath_expected(int kb) { int len = 0; for (int qb = kb + 1; qb < 16; ++qb) len += (qb <= 3) ? 256 : 768 / qb; return (len + 255) / 256; }
constexpr int N_GATH = 2 * 5 * 120;
constexpr int N_UNITS = 2 * 6 * 48 + 2 * 5 * 16 + 2 * 5 * 16;
constexpr int CHUNK_TILES = 2, N_CHUNKS = 2112;
constexpr int N_TICKETS = N_SEL + N_UNITS + N_GATH + N_CHUNKS;
struct OrderTab { unsigned short v[N_TICKETS]; };
constexpr OrderTab make_order() {
    OrderTab T{}; int n = 0, nc = 0; long tot = 0, acc = 0;
    for (int b = 0; b < 2; ++b) for (int hr = 0; hr < 5; ++hr) for (int qb = 15; qb >= 1; --qb) T.v[n++] = (unsigned short)(0x2000 | (b << 9) | (hr << 6) | qb);
    for (int mode = 0; mode < 3; ++mode) { const int nh = (mode == 0) ? 6 : 5; for (int sub = 0; sub < 64; ++sub) if (unit_valid(mode, sub)) tot += 2L * nh * unit_cost(mode, sub); }
    for (int kb = 0; kb < 15; ++kb) tot += 2L * 5 * 4 * (gath_expected(kb) < 15 - kb ? gath_expected(kb) : 15 - kb);
    for (int cost = 64; cost >= 1; --cost)
        for (int mode = 2; mode >= 0; --mode) { const int nh = (mode == 0) ? 6 : 5;
            for (int sub = 63; sub >= 0; --sub) { if (!unit_valid(mode, sub) || unit_cost(mode, sub) != cost) continue;
                for (int b = 0; b < 2; ++b) for (int hr = 0; hr < nh; ++hr) { T.v[n++] = (unsigned short)((mode << 10) | (b << 9) | (hr << 6) | sub);
                    acc += (long)cost * N_CHUNKS; while (acc >= tot && nc < N_CHUNKS) { T.v[n++] = (unsigned short)(0x8000 | nc); ++nc; acc -= tot; } } } }
    for (int c = 0; c < 15; ++c) for (int kb = 0; kb + c < 15; ++kb) { if (c >= gath_expected(kb)) continue;
        for (int b = 0; b < 2; ++b) for (int hr = 0; hr < 5; ++hr) { T.v[n++] = (unsigned short)(0x4000 | (b << 11) | (hr << 8) | (kb << 4) | c);
            acc += 4L * N_CHUNKS; while (acc >= tot && nc < N_CHUNKS) { T.v[n++] = (unsigned short)(0x8000 | nc); ++nc; acc -= tot; } } }
    while (nc < N_CHUNKS) { T.v[n++] = (unsigned short)(0x8000 | nc); ++nc; }
    for (int c = 0; c < 15; ++c) for (int kb = 0; kb + c < 15; ++kb) { if (c < gath_expected(kb)) continue;
        for (int b = 0; b < 2; ++b) for (int hr = 0; hr < 5; ++hr) T.v[n++] = (unsigned short)(0x4000 | (b << 11) | (hr << 8) | (kb << 4) | c); }
    return T;
}
__device__ const OrderTab ATT_ORDER = make_order();
#undef KSWZ
#undef SBAR
}


constexpr int NWAVES = 8;
#ifndef MK_SPLIT
#define MK_SPLIT 0
#endif
constexpr int BATCH = 2, SEQ = 4096, D = 2048, FF = 5632, NE = 8;
constexpr int M = BATCH * SEQ;
constexpr int NQKV = 3 * D, NGU = 2 * FF;
constexpr int MPAD = 18432;
constexpr float EPS = 1e-6f;
constexpr size_t MiB = 1u << 20;
constexpr size_t WS_CTL = 0, CTL_ZERO_BYTES = 1 * MiB;
constexpr size_t WS_WQKV = 1 * MiB;
constexpr size_t WS_WO = 49 * MiB;
constexpr size_t WS_WGU_D = 65 * MiB;
constexpr size_t WS_WD_D = 109 * MiB;
constexpr size_t WS_WGU_M = 131 * MiB;
constexpr size_t WS_WD_M = 483 * MiB;
constexpr size_t WS_H = 659 * MiB;
constexpr size_t WS_QKV = 723 * MiB;
constexpr size_t WS_O = 819 * MiB;
constexpr size_t WS_A = 851 * MiB;
constexpr size_t WS_YS = WS_QKV;
constexpr size_t WS_ACT = 883 * MiB;
constexpr size_t WS_XS = 1081 * MiB;
constexpr size_t WS_MISC = 1153 * MiB;
constexpr size_t WS_DPO = 1154 * MiB;
constexpr size_t WS_DPL = 1242 * MiB;
constexpr size_t WS_MLIST = 1244 * MiB;
constexpr size_t WS_WV8 = 1249 * MiB;
constexpr size_t WS_END = 1261 * MiB;
constexpr size_t MISC_KMEAN = 0, MISC_SELE = 131072, MISC_SELREL = MISC_SELE + 32768, MISC_SELG = MISC_SELREL + 65536, MISC_SELPOS = MISC_SELG + 65536, MISC_RSQ = 393216  , MISC_RSQ2 = MISC_RSQ + 262144;
static_assert(MISC_SELPOS + 65536 <= MISC_RSQ && MISC_RSQ2 + 262144 <= MiB && (size_t)MPAD * D * 4 <= 160 * MiB && (size_t)MPAD * FF * 2 <= 198 * MiB, "ws map");
constexpr int CW_TMO = 0, CW_CODE = 1;
constexpr int CW_BAR = 4096;
constexpr int CW_ATTQ = 8192;
constexpr int CW_CNT = 8448;
constexpr int CW_MCNT = 9216;
constexpr int CW_MDONE = 10240;
constexpr int RING_OFF = 0, RING_BYTES = 131072;
constexpr int LDSCTL_OFF = 143360, MISC_OFF = LDSCTL_OFF + 320;
constexpr int LDS_BYTES = 147456;
constexpr int PPL = 11, N_PHASES = 2 * PPL;

#define GAS __attribute__((address_space(1)))
#define LAS __attribute__((address_space(3)))
typedef unsigned short bf16;
typedef unsigned v4u __attribute__((ext_vector_type(4)));
typedef float f32x4 __attribute__((ext_vector_type(4)));
typedef short bf16x8 __attribute__((ext_vector_type(8)));
typedef GAS unsigned gu32;
typedef GAS unsigned long long gu64;
#define RLX_AGENT __ATOMIC_RELAXED, __HIP_MEMORY_SCOPE_AGENT
#define LDS_WAIT() asm volatile("s_waitcnt lgkmcnt(0)" ::: "memory")
#define VM_WAIT() asm volatile("s_waitcnt vmcnt(0)" ::: "memory")
__device__ __forceinline__ unsigned long long rt() { return __builtin_amdgcn_s_memrealtime(); }
__device__ __forceinline__ unsigned f2bf(float f) { unsigned u = __builtin_bit_cast(unsigned, f); return (u + 0x7fffu + ((u >> 16) & 1u)) >> 16; }
__device__ __forceinline__ unsigned pk2(float lo, float hi) { return f2bf(lo) | (f2bf(hi) << 16); }

#define XB_TMO      128
#define XB_XCNT(j)  (256  + 64 * (j))
#define XB_XSUB(j)  (1280 + 64 * (j))
#define XB_XGEN(j)  (2304 + 64 * (j))
#define XB_TOP      3328
#define XB_TOPGEN   3392
#define XCD_BAR_WORDS 3456
#define XB_SPIN_CAP (1u << 18)

__device__ __forceinline__ unsigned xb_ld(unsigned* p)              { return __hip_atomic_load(p, __ATOMIC_RELAXED, __HIP_MEMORY_SCOPE_AGENT); }
__device__ __forceinline__ unsigned xb_add(unsigned* p, unsigned v) { return __hip_atomic_fetch_add(p, v, __ATOMIC_RELAXED, __HIP_MEMORY_SCOPE_AGENT); }
__device__ __forceinline__ unsigned xb_xcc_id() { return (unsigned)__builtin_amdgcn_s_getreg((3 << 11) | 20) & 0xFu; }
#define XB_SPIN(cond, bar) do { unsigned _sp = 0; while (cond) { __builtin_amdgcn_s_sleep(1); \
    if ((++_sp & 255u) == 0u) { if (xb_ld(&(bar)[XB_TMO])) break; if (_sp > XB_SPIN_CAP) { atomicAdd(&(bar)[XB_TMO], 1u); break; } } } } while (0)

#define XB_IS_T0 (b.wv == 0 && lane_id() == 0)
struct XcdBarrier {
    int wv;
    unsigned* bar; unsigned x;
    volatile LAS unsigned* st;
};

__device__ __forceinline__ XcdBarrier xcd_barrier_post(unsigned* bar, volatile LAS unsigned* st, int wv) {
    XcdBarrier b; b.bar = bar; b.x = xb_xcc_id(); b.st = st; b.wv = wv;
    if (XB_IS_T0) (void)xb_add(&bar[XB_XCNT(b.x)], 1u);
    return b;
}
__device__ __forceinline__ void xcd_barrier_complete(unsigned* bar, unsigned x, unsigned& nloc, unsigned& nx) {
    const unsigned G = gridDim.x * gridDim.y * gridDim.z;
    unsigned sum, cnt, mine, sp = 0u;
    for (;;) {
        sum = 0u; cnt = 0u; mine = 0u;
#pragma unroll
        for (unsigned j = 0; j < 16; ++j) { const unsigned c = xb_ld(&bar[XB_XCNT(j)]); sum += c; cnt += (c > 0u) ? 1u : 0u; mine = (j == x) ? c : mine; }
        if (sum == G) break;
        __builtin_amdgcn_s_sleep(1);
        if ((++sp & 255u) == 0u) { if (xb_ld(&bar[XB_TMO])) break; if (sp > XB_SPIN_CAP) { atomicAdd(&bar[XB_TMO], 1u); break; } }
    }
    nloc = mine > 0u ? mine : 1u; nx = cnt > 0u ? cnt : 1u;
}

__device__ __forceinline__ void xcd_barrier(const XcdBarrier& b) {
    asm volatile("s_waitcnt vmcnt(0)" ::: "memory");
    __syncthreads();
    if (XB_IS_T0) {
        unsigned* bar = b.bar;
        __builtin_amdgcn_s_waitcnt(0);
        unsigned nloc = b.st[0], nx = b.st[1];
        if (nloc == 0u) { xcd_barrier_complete(bar, b.x, nloc, nx); b.st[0] = nloc; b.st[1] = nx; }
        const unsigned old = xb_add(&bar[XB_XSUB(b.x)], 1u);
        const unsigned gen = old / nloc;
        if (old + 1u == (gen + 1u) * nloc) {
            __builtin_amdgcn_fence(__ATOMIC_RELEASE, "agent");
            asm volatile("s_waitcnt vmcnt(0)" ::: "memory");
            const unsigned og = xb_add(&bar[XB_TOP], 1u);
            const unsigned tg = og / nx;
            if (og + 1u == (tg + 1u) * nx) xb_add(&bar[XB_TOPGEN], 1u);
            else XB_SPIN(xb_ld(&bar[XB_TOPGEN]) == tg, bar);
            __builtin_amdgcn_fence(__ATOMIC_ACQUIRE, "agent");
            xb_add(&bar[XB_XGEN(b.x)], 1u);
            asm volatile("s_waitcnt vmcnt(0)" ::: "memory");
        } else {
            XB_SPIN(xb_ld(&bar[XB_XGEN(b.x)]) == gen, bar);
            __builtin_amdgcn_fence(__ATOMIC_ACQUIRE, "agent");
            asm volatile("s_waitcnt vmcnt(0)" ::: "memory");
        }
    }
    __syncthreads();
}


__device__ __forceinline__ float wave_sum(float v) {
    v += xor_get<1>(v); v += xor_get<2>(v); v += xor_get<4>(v); v += xor_get<8>(v); v += xor_get<16>(v);
    return xor32_sum(v);
}
__device__ __forceinline__ float bf2f_u(unsigned short s) { return __uint_as_float(((unsigned)s) << 16); }
typedef unsigned u32x2_g __attribute__((ext_vector_type(2)));
__device__ __forceinline__ f32x4 bf4_to_f32(u32x2_g a) { return (f32x4){__uint_as_float(a.x << 16), __uint_as_float(a.x & 0xffff0000u), __uint_as_float(a.y << 16), __uint_as_float(a.y & 0xffff0000u)}; }

__device__ __forceinline__ void p0_transpose_item(const float* W, int K, int N, bf16* WT, int mode, LAS float* scr, int item, int lane) {
    const int nblk = N / 32, kb = item / nblk, nb = item % nblk, k0 = 64 * kb, n0 = 32 * nb;
#pragma unroll 8
    for (int i = 0; i < 32; ++i) { const int kk = 2 * i + (lane >> 5); scr[kk * 33 + (lane & 31)] = W[(size_t)(k0 + kk) * N + n0 + (lane & 31)]; }
    LDS_WAIT(); asm volatile("" ::: "memory");
    const int drow0 = (mode == 0) ? n0 : (256 * (n0 >> 7) + (n0 & 127) + (mode == 2 ? 128 : 0));
    const int c = lane & 7;
#pragma unroll
    for (int j = 0; j < 4; ++j) { const int n = (lane >> 3) + 8 * j; const LAS float* s = scr + (8 * c) * 33 + n;
        v4u o; o.x = pk2(s[0 * 33], s[1 * 33]); o.y = pk2(s[2 * 33], s[3 * 33]); o.z = pk2(s[4 * 33], s[5 * 33]); o.w = pk2(s[6 * 33], s[7 * 33]);
        *(GAS v4u*)(WT + (size_t)(drow0 + n) * K + k0 + 8 * c) = o; }
    LDS_WAIT(); asm volatile("" ::: "memory");
}

__device__ __forceinline__ void p0_transpose_item_fp8(const float* W, int K, int N, unsigned char* WT, int mode, LAS float* scr, int item, int lane) {
    const int nblk = N / 32, kb = item / nblk, nb = item % nblk, k0 = 64 * kb, n0 = 32 * nb;
#pragma unroll 8
    for (int i = 0; i < 32; ++i) { const int kk = 2 * i + (lane >> 5); scr[kk * 33 + (lane & 31)] = W[(size_t)(k0 + kk) * N + n0 + (lane & 31)]; }
    LDS_WAIT(); asm volatile("" ::: "memory");
    const int drow0 = (mode == 0) ? n0 : (256 * (n0 >> 7) + (n0 & 127) + (mode == 2 ? 128 : 0));
    const int n = lane & 31, kq = lane >> 5; const LAS float* sp = scr + (32 * kq) * 33 + n;
    v4u o0, o1;
#define P4(j) pg8::pk4_fp8(sp[(4 * (j)) * 33] * 256.f, sp[(4 * (j) + 1) * 33] * 256.f, sp[(4 * (j) + 2) * 33] * 256.f, sp[(4 * (j) + 3) * 33] * 256.f)
    o0.x = P4(0); o0.y = P4(1); o0.z = P4(2); o0.w = P4(3); o1.x = P4(4); o1.y = P4(5); o1.z = P4(6); o1.w = P4(7);
#undef P4
    GAS v4u* dst = (GAS v4u*)(WT + (size_t)(drow0 + n) * K + k0 + 32 * kq);
    dst[0] = o0; dst[1] = o1;
    LDS_WAIT(); asm volatile("" ::: "memory");
}

struct Ptrs {
    const float *x, *attn_norm, *w_in, *q_gain, *k_gain, *out_gain, *w_out, *ffn_norm, *dwg, *dwu, *dwd, *router, *mwg, *mwu, *mwd;
    float* out;
    bf16 *Wqkv_t, *Wo_t, *QKV, *OB, *AB;
    unsigned char *Wgu_d, *Wd_d, *Wgu_m, *Wd_m, *AB8, *ACT, *XS;
    float *kmean, *DPL; bf16 *DPO, *YS, *H; unsigned* sel_e; int* sel_rel; float* sel_g; int* sel_pos;
    gu32* ctl; float* rsq; unsigned char* Wv8;
};

struct CvTile { const float* W; unsigned char* WT; int K, N, mode, f8, r; const float* gain; int pitch; };
__device__ __forceinline__ CvTile cv_decode(const Ptrs& P, int it) {
    constexpr int T_IN = (D / 128) * (NQKV / 256), T_O = (D / 128) * (D / 256), T_G = (D / 128) * (FF / 256), T_D = (FF / 128) * (D / 256), T_E = 2 * T_G + T_D;
    CvTile c; int r = it; c.gain = nullptr; c.pitch = 0;
    if (r < T_IN) { c.W = P.w_in; c.WT = (unsigned char*)P.Wqkv_t; c.K = D; c.N = NQKV; c.mode = 0; c.f8 = 0; c.r = r; return c; } r -= T_IN;
    if (r < T_O) { c.W = P.w_out; c.WT = (unsigned char*)P.Wo_t; c.K = D; c.N = D; c.mode = 0; c.f8 = (WO8_LAYER == 0) ? 1 : 0; c.r = r; return c; } r -= T_O;
    if (r < T_G) { c.W = P.dwg; c.WT = P.Wgu_d; c.K = D; c.N = FF; c.mode = 1; c.f8 = 1; c.r = r; return c; } r -= T_G;
    if (r < T_G) { c.W = P.dwu; c.WT = P.Wgu_d; c.K = D; c.N = FF; c.mode = 2; c.f8 = 1; c.r = r; return c; } r -= T_G;
    if (r < T_D) { c.W = P.dwd; c.WT = P.Wd_d; c.K = FF; c.N = D; c.mode = 0; c.f8 = 1; c.r = r; return c; } r -= T_D;
    if (r < T_IN) { const int kb = r / 24, nb = r - kb * 24; c.K = D; c.mode = 0; c.pitch = NQKV; c.gain = P.attn_norm + D;
        c.W = P.w_in + (size_t)D * NQKV; c.WT = P.Wv8; c.N = NQKV; c.f8 = 1; c.r = kb * 24 + nb;
        return c; } r -= T_IN;
    if (r < T_O) { c.W = P.w_out + (size_t)D * D; c.WT = (unsigned char*)(P.Wo_t + (size_t)D * D); c.K = D; c.N = D; c.mode = 0; c.f8 = (WO8_LAYER == 1) ? 1 : 0; c.r = r; return c; } r -= T_O;
    const int e = r / T_E; r -= e * T_E; c.f8 = 1;
    if (r < T_G) { c.W = P.mwg + (size_t)e * D * FF; c.WT = P.Wgu_m + (size_t)e * NGU * D; c.K = D; c.N = FF; c.mode = 1; c.r = r; return c; } r -= T_G;
    if (r < T_G) { c.W = P.mwu + (size_t)e * D * FF; c.WT = P.Wgu_m + (size_t)e * NGU * D; c.K = D; c.N = FF; c.mode = 2; c.r = r; return c; } r -= T_G;
    c.W = P.mwd + (size_t)e * FF * D; c.WT = P.Wd_m + (size_t)e * D * FF; c.K = FF; c.N = D; c.mode = 0; c.r = r; return c;
}
constexpr int CV_T_IN = (D / 128) * (NQKV / 256), CV_T_O = (D / 128) * (D / 256), CV_T_G = (D / 128) * (FF / 256), CV_T_D = (FF / 128) * (D / 256);
constexpr int CV_L0 = CV_T_IN + CV_T_O + 2 * CV_T_G + CV_T_D, CV_DEF = CV_T_IN + CV_T_O + NE * (2 * CV_T_G + CV_T_D);
constexpr int CV_FFN = 512;
static_assert(CV_DEF == 2 * att::N_CHUNKS * att::CHUNK_TILES + CV_FFN, "deferred conversion tiles = 2 phases x N_CHUNKS x CHUNK_TILES + the gate-up phase's share");
__device__ __forceinline__ void cv_tile_out(const CvTile& cur, LAS float* S, int tid_) {
    constexpr int LS = 260;
    const int nbl = cur.N / 256, kb = cur.r / nbl, nb = cur.r - kb * nbl;
    if (cur.f8) {
#pragma unroll
        for (int i = 0; i < 4; ++i) { const int p = tid_ + 512 * i, kq = p & 7, n = p >> 3, nn = 256 * nb + n;
            const int drow = (cur.mode == 0) ? nn : (256 * (nn >> 7) + (nn & 127) + (cur.mode == 2 ? 128 : 0));
            const LAS float* sp = S + (16 * kq) * LS + (n ^ (4 * kq)); v4u o;
#define P4(j) pg8::pk4_fp8(sp[(4 * (j)) * LS] * 256.f, sp[(4 * (j) + 1) * LS] * 256.f, sp[(4 * (j) + 2) * LS] * 256.f, sp[(4 * (j) + 3) * LS] * 256.f)
            o.x = P4(0); o.y = P4(1); o.z = P4(2); o.w = P4(3);
#undef P4
            __builtin_nontemporal_store(o, (GAS v4u*)(cur.WT + (size_t)drow * cur.K + 128 * kb + 16 * kq)); } }
    else {
#pragma unroll
        for (int i = 0; i < 8; ++i) { const int p = tid_ + 512 * i, kc = p & 15, n = p >> 4, nn = 256 * nb + n;
            const int drow = (cur.mode == 0) ? nn : (256 * (nn >> 7) + (nn & 127) + (cur.mode == 2 ? 128 : 0));
            const LAS float* sp = S + (8 * kc) * LS + (n ^ (4 * (kc >> 1))); v4u o;
            o.x = pk2(sp[0], sp[LS]); o.y = pk2(sp[2 * LS], sp[3 * LS]); o.z = pk2(sp[4 * LS], sp[5 * LS]); o.w = pk2(sp[6 * LS], sp[7 * LS]);
            *(GAS v4u*)((bf16*)cur.WT + (size_t)drow * cur.K + 128 * kb + 8 * kc) = o; } }
}
__device__ __forceinline__ void cv8_to_lds(const f32x4 (&v)[16], LAS unsigned char* T, int wave, int lane) {
    unsigned d[16];
#pragma unroll
    for (int i = 0; i < 16; ++i) d[i] = pg8::pk4_fp8(v[i].x * 256.f, v[i].y * 256.f, v[i].z * 256.f, v[i].w * 256.f);
    unsigned o[4][4];
#pragma unroll
    for (int q = 0; q < 4; ++q) { const unsigned a = d[4 * q], b = d[4 * q + 1], c = d[4 * q + 2], e = d[4 * q + 3];
        const unsigned t0 = __builtin_amdgcn_perm(b, a, 0x05010400u), t1 = __builtin_amdgcn_perm(b, a, 0x07030602u), t2 = __builtin_amdgcn_perm(e, c, 0x05010400u), t3 = __builtin_amdgcn_perm(e, c, 0x07030602u);
        o[0][q] = __builtin_amdgcn_perm(t2, t0, 0x05040100u); o[1][q] = __builtin_amdgcn_perm(t2, t0, 0x07060302u); o[2][q] = __builtin_amdgcn_perm(t3, t1, 0x05040100u); o[3][q] = __builtin_amdgcn_perm(t3, t1, 0x07060302u); }
#pragma unroll
    for (int j = 0; j < 4; ++j) { v4u w; w.x = o[j][0]; w.y = o[j][1]; w.z = o[j][2]; w.w = o[j][3];
        *(LAS v4u*)(T + (4 * lane + j) * 128 + 16 * (wave ^ (lane & 7))) = w; }
}
__device__ __forceinline__ void cv8_out(const CvTile& cur, const LAS unsigned char* T, int tid_) {
    const int nbl = cur.N / 256, kb = cur.r / nbl, nb = cur.r - kb * nbl;
#pragma unroll
    for (int i = 0; i < 4; ++i) { const int p = tid_ + 512 * i, c = p & 7, n = p >> 3, nn = 256 * nb + n;
        const int drow = (cur.mode == 0) ? nn : (256 * (nn >> 7) + (nn & 127) + (cur.mode == 2 ? 128 : 0));
        const v4u w = *(const LAS v4u*)(T + n * 128 + 16 * (c ^ ((n >> 2) & 7)));
        __builtin_nontemporal_store(w, (GAS v4u*)(cur.WT + (size_t)drow * cur.K + 128 * kb + 16 * c)); }
}
__device__ __forceinline__ void convert_weights(const Ptrs& P, LAS unsigned char* lds, int t0, int step, int t1, int wave, int lane) {
    asm volatile("" : "+v"(lane));
    constexpr int LS = 260;
    LAS float* S = (LAS float*)(lds + RING_OFF);
    LAS unsigned char* T8 = lds + RING_OFF;
    const int tid_ = wave * 64 + lane;
    if (t0 >= t1) return;
    f32x4 va[16], vb[16];
#define CV_LOAD(v, c) do { const int nbl_ = (c).N / 256, kb_ = (c).r / nbl_, nb_ = (c).r - kb_ * nbl_; const int pt_ = (c).pitch ? (c).pitch : (c).N; const float* p_ = (c).W + (size_t)(128 * kb_ + wave * 16) * pt_ + 256 * nb_ + 4 * lane; \
        _Pragma("unroll") for (int i_ = 0; i_ < 16; ++i_) (v)[i_] = __builtin_nontemporal_load((const f32x4*)(p_ + (size_t)i_ * pt_)); } while (0)
#define CV_TOLDS(v) do { _Pragma("unroll") for (int i_ = 0; i_ < 16; ++i_) *(LAS f32x4*)(S + (wave * 16 + i_) * LS + ((4 * lane) ^ (4 * wave))) = (v)[i_]; LDS_WAIT(); __syncthreads(); } while (0)
#define CV_STEP(v, c, tcur, tnext_is_f8) do { const CvTile done_ = (c); \
        if (done_.gain) { const int nbl_ = done_.N / 256; typedef __attribute__((address_space(4))) const float cfloat_; const cfloat_* gp_ = (const cfloat_*)(done_.gain + 128 * (done_.r / nbl_) + wave * 16);     \
            _Pragma("unroll") for (int i_ = 0; i_ < 16; ++i_) (v)[i_] = (v)[i_] * gp_[i_]; } \
        if (done_.f8) { cv8_to_lds(v, T8 + par * 32768, wave, lane); LDS_WAIT(); __syncthreads(); } else { CV_TOLDS(v); } \
        tcur += 2 * step; if (tcur < t1) { (c) = cv_decode(P, tcur); CV_LOAD(v, c); } \
        if (done_.f8) { cv8_out(done_, T8 + par * 32768, tid_); par ^= 1; if (!(tnext_is_f8)) { LDS_WAIT(); __syncthreads(); } } \
        else { cv_tile_out(done_, S, tid_); LDS_WAIT(); __syncthreads(); } } while (0)
    int ta = t0, tb = t0 + step, par = 0;
    CvTile ca = cv_decode(P, ta), cb = ca; CV_LOAD(va, ca);
    if (tb < t1) { cb = cv_decode(P, tb); CV_LOAD(vb, cb); }
    for (;;) {
        { const bool nf8 = (tb < t1) && cb.f8; CV_STEP(va, ca, ta, nf8); }
        if (tb >= t1) break;
        { const bool nf8 = (ta < t1) && ca.f8; CV_STEP(vb, cb, tb, nf8); }
        if (ta >= t1) break;
    }
#undef CV_LOAD
#undef CV_TOLDS
#undef CV_STEP
}
__device__ __forceinline__ void attn_conv_phase(const Ptrs& P, const att::AttnArgs& A, int layer, unsigned* qctr, unsigned char* lds, const int wave_) {
    char* shm = (char*)lds + RING_OFF;
    int* TK = (int*)(shm + att::L_MSK) + 4;
    const bool t0_ = (wave_ == 0 && lane_id() == 0);
    int nxt_ = 0; if (t0_) nxt_ = (int)__hip_atomic_fetch_add(qctr, 1u, __ATOMIC_RELAXED, __HIP_MEMORY_SCOPE_AGENT);
    bool selrdy = false;
    for (;;) {
        __syncthreads();
        if (t0_) TK[0] = nxt_;
        __syncthreads();
        const int tk = __builtin_amdgcn_readfirstlane(TK[0]);
        if (tk >= att::N_TICKETS) break;
        if (t0_) nxt_ = (int)__hip_atomic_fetch_add(qctr, 1u, __ATOMIC_RELAXED, __HIP_MEMORY_SCOPE_AGENT);
        const int code = att::ATT_ORDER.v[tk];
        if (code & 0x8000) {
            const int t0 = CV_L0 + (layer * att::N_CHUNKS + (code & 0x7fff)) * att::CHUNK_TILES;
            convert_weights(P, (LAS unsigned char*)lds, t0, 1, t0 + att::CHUNK_TILES, wave_, lane_id());
        } else if (code & 0x4000) {
            if (!selrdy) { if (t0_) { unsigned spins = 0; while (att::ld_sc1(A.mdone) < (unsigned)att::N_SEL && ++spins < (1u << 24)) __builtin_amdgcn_s_sleep(8); } selrdy = true; __syncthreads(); }
            att::attn_unit<3>(A, (code >> 11) & 1, 6 + ((code >> 8) & 7), code & 0xff, shm, wave_);
        } else if (code & 0x2000) {
            att::moba_select(A, (code >> 9) & 1, 6 + ((code >> 6) & 7), code & 63, shm, wave_);
        } else {
            const int mode = code >> 10, b = (code >> 9) & 1, hr = (code >> 6) & 7, sub = code & 63;
            const int h = (mode == 0) ? hr : ((mode == 1) ? 6 + hr : 11 + hr);
            if (mode == 0) att::attn_unit<0>(A, b, h, sub, shm, wave_); else if (mode == 1) att::attn_unit<1>(A, b, h, sub, shm, wave_); else att::attn_unit<2>(A, b, h, sub, shm, wave_);
        }
    }
}
template <bool F8, bool SRC16, int NR> __device__ __forceinline__ void norm_rows(const void* srcv, const float* gain, void* dstv, int vcu, int G, int wave, int lane) {
    asm volatile("" : "+v"(lane));
    const int gw = vcu * NWAVES + wave, NGW = G * NWAVES;
    f32x4 g[8];
#pragma unroll
    for (int j = 0; j < 8; ++j) g[j] = ((const GAS f32x4*)gain)[lane + 64 * j];
    for (int m0 = gw; m0 < M; m0 += NR * NGW) {
        f32x4 v[NR][8];
#pragma unroll
        for (int q = 0; q < NR; ++q) { const int mq = m0 + q * NGW; const int m = mq < M ? mq : m0;
            if constexpr (SRC16) { const GAS u32x2_g* xr = (const GAS u32x2_g*)((const bf16*)srcv + (size_t)m * D) + lane;
#pragma unroll
                for (int j = 0; j < 8; ++j) v[q][j] = bf4_to_f32(xr[64 * j]); }
            else { const GAS f32x4* xr = (const GAS f32x4*)((const float*)srcv + (size_t)m * D) + lane;
#pragma unroll
                for (int j = 0; j < 8; ++j) v[q][j] = xr[64 * j]; } }
#pragma unroll
        for (int q = 0; q < NR; ++q) { const int m = m0 + q * NGW; if (m >= M) break;
            float s = 0.f;
#pragma unroll
            for (int j = 0; j < 8; ++j) s += (v[q][j].x * v[q][j].x + v[q][j].y * v[q][j].y) + (v[q][j].z * v[q][j].z + v[q][j].w * v[q][j].w);
            const float r = 1.0f / sqrtf(wave_sum(s) * (1.0f / D) + EPS);
            if constexpr (F8) { GAS unsigned* o4 = (GAS unsigned*)((unsigned char*)dstv + (size_t)m * D) + lane;
#pragma unroll
                for (int j = 0; j < 8; ++j) o4[64 * j] = pg8::pk4_fp8(v[q][j].x * r * g[j].x, v[q][j].y * r * g[j].y, v[q][j].z * r * g[j].z, v[q][j].w * r * g[j].w); }
            else { GAS unsigned long long* o8 = (GAS unsigned long long*)((bf16*)dstv + (size_t)m * D) + lane;
#pragma unroll
                for (int j = 0; j < 8; ++j) o8[64 * j] = (unsigned long long)pk2(v[q][j].x * r * g[j].x, v[q][j].y * r * g[j].y) | ((unsigned long long)pk2(v[q][j].z * r * g[j].z, v[q][j].w * r * g[j].w) << 32); }
        }
    }
}
__device__ __forceinline__ void prep_phase(const Ptrs& P, int layer, LAS unsigned char* lds, int vcu, int G, int tid, int wave, int lane) {
    asm volatile("" : "+v"(lane), "+v"(tid));
    LAS float* red = (LAS float*)(lds + RING_OFF);
    const int tsub = lane >> 4, c = lane & 15;
#define PREP_ADDR(it_) (P.QKV + ((size_t)(((it_) / 22) >> 4) * SEQ + (((it_) / 22) & 15) * 256 + wave * 32 + tsub) * NQKV + ((((it_) % 22) >= 11) ? 2048 + (((it_) % 22) - 11) * 128 : ((it_) % 22) * 128) + 8 * c)
    v4u raws[8], rawn[8];
    if (vcu < 32 * 22) { bf16* const q0_ = PREP_ADDR(vcu);
#pragma unroll
        for (int i8 = 0; i8 < 8; ++i8) raws[i8] = *(const GAS v4u*)(q0_ + (size_t)(i8 * 4) * NQKV); }
    for (int it = vcu; it < 32 * 22; it += G) {
        const int v = it % 22, blk = it / 22, b = blk >> 4, n = blk & 15;
        if (it + G < 32 * 22) { bf16* const q1_ = PREP_ADDR(it + G);
#pragma unroll
            for (int i8 = 0; i8 < 8; ++i8) rawn[i8] = *(const GAS v4u*)(q1_ + (size_t)(i8 * 4) * NQKV); }
        const bool isk = v >= 11; const int hh = isk ? v - 11 : v;
        const int col0 = (isk ? 2048 : 0) + hh * 128;
        const float* gp = (isk ? P.k_gain : P.q_gain) + layer * 256 + (hh >= 6 ? 128 : 0) + 8 * c;
        const f32x4 g0 = *(const f32x4*)gp, g1 = *(const f32x4*)(gp + 4);
        const bool km = isk && hh >= 6;
        float cs[8];
#pragma unroll
        for (int e = 0; e < 8; ++e) cs[e] = 0.f;
        bf16* const p0_ = P.QKV + ((size_t)b * SEQ + n * 256 + wave * 32 + tsub) * NQKV + col0 + 8 * c;
#pragma unroll
        for (int i8 = 0; i8 < 8; ++i8) {
            bf16* p = p0_ + (size_t)(i8 * 4) * NQKV;
            const v4u raw = raws[i8];
            float x[8]; x[0] = bf2f_u((unsigned short)(raw.x & 0xffff)); x[1] = bf2f_u((unsigned short)(raw.x >> 16)); x[2] = bf2f_u((unsigned short)(raw.y & 0xffff)); x[3] = bf2f_u((unsigned short)(raw.y >> 16));
            x[4] = bf2f_u((unsigned short)(raw.z & 0xffff)); x[5] = bf2f_u((unsigned short)(raw.z >> 16)); x[6] = bf2f_u((unsigned short)(raw.w & 0xffff)); x[7] = bf2f_u((unsigned short)(raw.w >> 16));
            float ss = 0.f;
#pragma unroll
            for (int e = 0; e < 8; ++e) ss = fmaf(x[e], x[e], ss);
            ss += xor_get<1>(ss); ss += xor_get<2>(ss); ss += xor_get<4>(ss); ss += xor_get<8>(ss);
            const float r = (isk ? 1.0f : att::C2) / sqrtf(ss * (1.0f / 128.0f) + EPS);
            float y[8];
            y[0] = x[0] * r * g0.x; y[1] = x[1] * r * g0.y; y[2] = x[2] * r * g0.z; y[3] = x[3] * r * g0.w;
            y[4] = x[4] * r * g1.x; y[5] = x[5] * r * g1.y; y[6] = x[6] * r * g1.z; y[7] = x[7] * r * g1.w;
            v4u o; o.x = pk2(y[0], y[1]); o.y = pk2(y[2], y[3]); o.z = pk2(y[4], y[5]); o.w = pk2(y[6], y[7]);
            *(GAS v4u*)p = o;
#pragma unroll
            for (int e = 0; e < 8; ++e) cs[e] += y[e];
        }
        if (km) {
#pragma unroll
            for (int e = 0; e < 8; ++e) { cs[e] += xor_get<16>(cs[e]); cs[e] = xor32_sum(cs[e]); }
            if (lane < 16) {
#pragma unroll
                for (int e = 0; e < 8; ++e) red[wave * 128 + 8 * c + e] = cs[e]; }
            LDS_WAIT(); __syncthreads();
            if (tid < 128) { float s = 0.f;
#pragma unroll
                for (int w = 0; w < 8; ++w) s += red[w * 128 + tid];
                P.kmean[(size_t)((b * 5 + (hh - 6)) * 16 + n) * 128 + tid] = s * (1.0f / 256.0f); }
            LDS_WAIT(); __syncthreads();
        }
#pragma unroll
        for (int i8 = 0; i8 < 8; ++i8) raws[i8] = rawn[i8];
    }
#undef PREP_ADDR
}
__device__ __forceinline__ void dcombine_phase(const Ptrs& P, const float* gain, int vcu, int G, int wave, int lane, const bool ob8) {
    asm volatile("" : "+v"(lane));
    const int gw = vcu * NWAVES + wave, NGW = G * NWAVES; const int c = lane & 15; constexpr int NIT = M * 11 / 4;
    constexpr int NQ = 4;
    for (int it0 = gw; it0 < NIT; it0 += NQ * NGW) {
        int tok[NQ], hh[NQ]; float ls[NQ][4]; v4u raw[NQ][4];
#pragma unroll
        for (int q = 0; q < NQ; ++q) { const int itq = it0 + q * NGW; const int it = itq < NIT ? itq : it0; const int pair = it * 4 + (lane >> 4); tok[q] = pair / 11; hh[q] = pair - tok[q] * 11;
#pragma unroll
            for (int p = 0; p < 3; ++p) { ls[q][p] = P.DPL[((size_t)p * M + tok[q]) * 16 + hh[q]]; raw[q][p] = *(const GAS v4u*)(P.DPO + ((size_t)p * M + tok[q]) * 1408 + hh[q] * 128 + 8 * c); }
            ls[q][3] = -__builtin_inff(); raw[q][3] = (v4u){0u, 0u, 0u, 0u};
            if (hh[q] >= 6) { ls[q][3] = P.DPL[((size_t)3 * M + tok[q]) * 16 + hh[q]]; raw[q][3] = *(const GAS v4u*)(P.DPO + ((size_t)3 * M + tok[q]) * 1408 + hh[q] * 128 + 8 * c); } }
#pragma unroll
        for (int q = 0; q < NQ; ++q) { if (it0 + q * NGW >= NIT) break;
            const float mx = fmaxf(fmaxf(ls[q][0], ls[q][1]), fmaxf(ls[q][2], ls[q][3]));
            float w0 = __builtin_amdgcn_exp2f(ls[q][0] - mx), w1 = __builtin_amdgcn_exp2f(ls[q][1] - mx), w2 = __builtin_amdgcn_exp2f(ls[q][2] - mx), w3 = __builtin_amdgcn_exp2f(ls[q][3] - mx);
            const float inv = 1.0f / (w0 + w1 + w2 + w3); w0 *= inv; w1 *= inv; w2 *= inv; w3 *= inv;
            float acc[8];
#pragma unroll
            for (int e = 0; e < 8; ++e) acc[e] = 0.f;
#pragma unroll
            for (int p = 0; p < 4; ++p) { const v4u r_ = raw[q][p]; const float w = (p == 0) ? w0 : ((p == 1) ? w1 : ((p == 2) ? w2 : w3));
                acc[0] += w * bf2f_u((unsigned short)(r_.x & 0xffff)); acc[1] += w * bf2f_u((unsigned short)(r_.x >> 16)); acc[2] += w * bf2f_u((unsigned short)(r_.y & 0xffff)); acc[3] += w * bf2f_u((unsigned short)(r_.y >> 16));
                acc[4] += w * bf2f_u((unsigned short)(r_.z & 0xffff)); acc[5] += w * bf2f_u((unsigned short)(r_.z >> 16)); acc[6] += w * bf2f_u((unsigned short)(r_.w & 0xffff)); acc[7] += w * bf2f_u((unsigned short)(r_.w >> 16)); }
            float ss = 0.f;
#pragma unroll
            for (int e = 0; e < 8; ++e) ss = fmaf(acc[e], acc[e], ss);
            ss += xor_get<1>(ss); ss += xor_get<2>(ss); ss += xor_get<4>(ss); ss += xor_get<8>(ss);
            const float rn = 1.0f / sqrtf(ss * (1.0f / 128.0f) + EPS);
            const f32x4 g0 = *(const f32x4*)(gain + hh[q] * 128 + 8 * c), g1 = *(const f32x4*)(gain + hh[q] * 128 + 8 * c + 4);
            v4u o; o.x = pk2(acc[0] * rn * g0.x, acc[1] * rn * g0.y); o.y = pk2(acc[2] * rn * g0.z, acc[3] * rn * g0.w); o.z = pk2(acc[4] * rn * g1.x, acc[5] * rn * g1.y); o.w = pk2(acc[6] * rn * g1.z, acc[7] * rn * g1.w);
            if (ob8) { typedef unsigned u32x2_o __attribute__((ext_vector_type(2))); u32x2_o o8; o8.x = pg8::pk4_fp8(acc[0] * rn * g0.x, acc[1] * rn * g0.y, acc[2] * rn * g0.z, acc[3] * rn * g0.w); o8.y = pg8::pk4_fp8(acc[4] * rn * g1.x, acc[5] * rn * g1.y, acc[6] * rn * g1.z, acc[7] * rn * g1.w);
                *(GAS u32x2_o*)((unsigned char*)P.OB + (size_t)tok[q] * D + hh[q] * 128 + 8 * c) = o8; }
            else *(GAS v4u*)(P.OB + (size_t)tok[q] * D + hh[q] * 128 + 8 * c) = o; }
    }
}
__device__ __forceinline__ void router_phase(const Ptrs& P, const float* gain, LAS unsigned char* lds, int vcu, int G, int tid, int wave, int lane) {
    asm volatile("" : "+v"(lane), "+v"(tid));
    LAS unsigned* lcnt = (LAS unsigned*)(lds + RING_OFF);
    LAS unsigned* rinfo = (LAS unsigned*)(lds + RING_OFF + 256);
    if (tid < 16) lcnt[tid] = 0u;
    LAS f32x4* LT = (LAS f32x4*)(lds + RING_OFF + 4096);
    for (int i = tid; i < 2 * D; i += NWAVES * 64) { const int d = i >> 1, eq = i & 1; LT[eq * D + d] = ((const GAS f32x4*)P.router)[i]; }
    LDS_WAIT(); __syncthreads();
    int gw = vcu * NWAVES + wave; asm volatile("" : "+s"(gw));
    const int NGW = G * NWAVES;
    int li = wave;
    for (int m = gw; m < M; m += NGW, li += NWAVES) {
        const GAS u32x2_g* xr = (const GAS u32x2_g*)(P.H + (size_t)m * D) + lane;
        f32x4 v[8]; float s = 0.f;
#pragma unroll
        for (int j = 0; j < 8; ++j) { v[j] = bf4_to_f32(xr[64 * j]); s += (v[j].x * v[j].x + v[j].y * v[j].y) + (v[j].z * v[j].z + v[j].w * v[j].w); }
        const float r = 1.0f / sqrtf(wave_sum(s) * (1.0f / D) + EPS);
        float lg[8];
#pragma unroll
        for (int e = 0; e < 8; ++e) lg[e] = 0.f;
        GAS unsigned* o4 = (GAS unsigned*)(P.AB8 + (size_t)m * D) + lane;
#pragma unroll
        for (int j = 0; j < 8; ++j) { const f32x4 g = ((const GAS f32x4*)gain)[lane + 64 * j];
            const float f0 = v[j].x * r * g.x, f1 = v[j].y * r * g.y, f2 = v[j].z * r * g.z, f3 = v[j].w * r * g.w;
            o4[64 * j] = pg8::pk4_fp8(f0, f1, f2, f3);
            const LAS f32x4* rw = LT + 256 * j + 4 * lane;
            const f32x4 a0 = rw[0], a1 = rw[D], b0 = rw[1], b1 = rw[D + 1], c0 = rw[2], c1 = rw[D + 2], d0 = rw[3], d1 = rw[D + 3];
            lg[0] += f0 * a0.x + f1 * b0.x + f2 * c0.x + f3 * d0.x; lg[1] += f0 * a0.y + f1 * b0.y + f2 * c0.y + f3 * d0.y;
            lg[2] += f0 * a0.z + f1 * b0.z + f2 * c0.z + f3 * d0.z; lg[3] += f0 * a0.w + f1 * b0.w + f2 * c0.w + f3 * d0.w;
            lg[4] += f0 * a1.x + f1 * b1.x + f2 * c1.x + f3 * d1.x; lg[5] += f0 * a1.y + f1 * b1.y + f2 * c1.y + f3 * d1.y;
            lg[6] += f0 * a1.z + f1 * b1.z + f2 * c1.z + f3 * d1.z; lg[7] += f0 * a1.w + f1 * b1.w + f2 * c1.w + f3 * d1.w; }
#pragma unroll
        for (int e = 0; e < 8; ++e) lg[e] = wave_sum(lg[e]);
        int e0 = 0; float b0v = lg[0];
#pragma unroll
        for (int e = 1; e < 8; ++e) if (lg[e] > b0v) { b0v = lg[e]; e0 = e; }
        int e1 = -1; float b1v = -__builtin_inff();
#pragma unroll
        for (int e = 0; e < 8; ++e) if (e != e0 && lg[e] > b1v) { b1v = lg[e]; e1 = e; }
        const float g1 = 1.0f / (1.0f + __expf(b0v - b1v)), g0 = 1.0f - g1;
        if (lane == 0) {
            const unsigned k0 = __hip_atomic_fetch_add(lcnt + e0, 1u, __ATOMIC_RELAXED, __HIP_MEMORY_SCOPE_WORKGROUP);
            const unsigned k1 = __hip_atomic_fetch_add(lcnt + e1, 1u, __ATOMIC_RELAXED, __HIP_MEMORY_SCOPE_WORKGROUP);
            rinfo[li * 4 + 0] = (unsigned)e0 | ((unsigned)e1 << 8); rinfo[li * 4 + 1] = k0; rinfo[li * 4 + 2] = k1;
            P.sel_g[2 * m] = g0; P.sel_g[2 * m + 1] = g1;
        }
    }
    LDS_WAIT(); __syncthreads();
    if (tid < 8) lcnt[8 + tid] = __hip_atomic_fetch_add(P.ctl + CW_CNT + 64 * tid, lcnt[tid], RLX_AGENT);
    LDS_WAIT(); __syncthreads();
    li = wave;
    for (int m = gw; m < M; m += NGW, li += NWAVES) {
        if (lane == 0) { const unsigned ee = rinfo[li * 4 + 0]; const unsigned e0 = ee & 0xffu, e1 = ee >> 8;
            P.sel_e[m] = ee; P.sel_rel[2 * m] = (int)(lcnt[8 + e0] + rinfo[li * 4 + 1]); P.sel_rel[2 * m + 1] = (int)(lcnt[8 + e1] + rinfo[li * 4 + 2]); }
    }
}
__device__ __forceinline__ void build_tile_table(const Ptrs& P, bool moe, volatile LAS unsigned* MISC, int tid) {
    if (tid == 0) { unsigned t = 0u; MISC[16] = 0u;
        for (int e = 0; e < 8; ++e) { const unsigned cnt = moe ? __hip_atomic_load(P.ctl + CW_CNT + 64 * e, RLX_AGENT) : (e == 0 ? (unsigned)M : 0u); t += (cnt + 255u) >> 8; if (t > (unsigned)(MPAD / 256)) t = MPAD / 256; MISC[17 + e] = t; } }
    LDS_WAIT(); __syncthreads();
}
__device__ __forceinline__ void scatter_phase(const Ptrs& P, volatile LAS unsigned* MISC, int vcu, int G, int wave, int lane) {
    asm volatile("" : "+v"(lane));
    const int gw = vcu * NWAVES + wave, NGW = G * NWAVES;
    constexpr int NR = 4;
    for (int m0 = gw; m0 < M; m0 += NR * NGW) {
        unsigned ee[NR]; int r0[NR], r1[NR]; v4u a0[NR], a1[NR];
#pragma unroll
        for (int q = 0; q < NR; ++q) { const int mq = m0 + q * NGW; const int m = mq < M ? mq : m0;
            ee[q] = P.sel_e[m]; r0[q] = P.sel_rel[2 * m]; r1[q] = P.sel_rel[2 * m + 1];
            const GAS v4u* sp = (const GAS v4u*)(P.AB8 + (size_t)m * D) + lane; a0[q] = sp[0]; a1[q] = sp[64]; }
#pragma unroll
        for (int q = 0; q < NR; ++q) { const int m = m0 + q * NGW; if (m >= M) break;
            const int p0 = (int)(256u * MISC[16 + (ee[q] & 0xffu)]) + r0[q], p1 = (int)(256u * MISC[16 + ((ee[q] >> 8) & 0xffu)]) + r1[q];
            if (lane == 0) { P.sel_pos[2 * m] = p0; P.sel_pos[2 * m + 1] = p1; }
            GAS v4u* d0 = (GAS v4u*)(P.XS + (size_t)p0 * D) + lane; GAS v4u* d1 = (GAS v4u*)(P.XS + (size_t)p1 * D) + lane;
            d0[0] = a0[q]; d0[64] = a1[q]; d1[0] = a0[q]; d1[64] = a1[q]; }
    }
}
__device__ __forceinline__ void combine_phase(const Ptrs& P, int vcu, int G, int wave, int lane) {
    asm volatile("" : "+v"(lane));
    const int gw = vcu * NWAVES + wave, NGW = G * NWAVES;
    typedef unsigned u32x2_t __attribute__((ext_vector_type(2)));
    for (int m0 = gw; m0 < M; m0 += 2 * NGW) {
        const int m1 = m0 + NGW; const bool has1 = m1 < M; const int mm[2] = {m0, has1 ? m1 : m0};
        int pa[2], pb[2]; float ga[2], gb[2];
#pragma unroll
        for (int q = 0; q < 2; ++q) { pa[q] = P.sel_pos[2 * mm[q]]; pb[q] = P.sel_pos[2 * mm[q] + 1]; ga[q] = P.sel_g[2 * mm[q]]; gb[q] = P.sel_g[2 * mm[q] + 1]; }
        f32x4 ya[2][8], yb[2][8], hv[2][8];
#pragma unroll
        for (int q = 0; q < 2; ++q) { const GAS u32x2_t* y0 = (const GAS u32x2_t*)(P.YS + (size_t)pa[q] * D) + lane; const GAS u32x2_t* y1 = (const GAS u32x2_t*)(P.YS + (size_t)pb[q] * D) + lane;
            const GAS u32x2_g* hr = (const GAS u32x2_g*)(P.H + (size_t)mm[q] * D) + lane;
#pragma unroll
            for (int j = 0; j < 8; ++j) { ya[q][j] = bf4_to_f32(y0[64 * j]); yb[q][j] = bf4_to_f32(y1[64 * j]); hv[q][j] = bf4_to_f32(hr[64 * j]); } }
#pragma unroll
        for (int q = 0; q < 2; ++q) { if (q == 1 && !has1) break;
            if (pa[q] >= 16384) { const GAS u32x2_t* z0 = (const GAS u32x2_t*)(P.YS + (size_t)MPAD * D + (size_t)pa[q] * D) + lane;
#pragma unroll
                for (int j = 0; j < 8; ++j) ya[q][j] += bf4_to_f32(z0[64 * j]); }
            if (pb[q] >= 16384) { const GAS u32x2_t* z1 = (const GAS u32x2_t*)(P.YS + (size_t)MPAD * D + (size_t)pb[q] * D) + lane;
#pragma unroll
                for (int j = 0; j < 8; ++j) yb[q][j] += bf4_to_f32(z1[64 * j]); }
            GAS f32x4* orow = (GAS f32x4*)(P.out + (size_t)mm[q] * D) + lane;
#pragma unroll
            for (int j = 0; j < 8; ++j) orow[64 * j] = hv[q][j] + ya[q][j] * ga[q] + yb[q][j] * gb[q]; }
    }
}

struct Args { const float* in[15]; float* out; unsigned char* ws; int ph_lo, ph_hi, qoff, pad; };
__device__ __forceinline__ Ptrs make_ptrs(const Args& args, unsigned char* ws0) {
    int z = 0; asm volatile("" : "+s"(z));
    const float* const* in = args.in + z;
    unsigned char* ws = ws0 + z;
    Ptrs P;
    P.x = in[0]; P.attn_norm = in[1]; P.w_in = in[2]; P.q_gain = in[3]; P.k_gain = in[4]; P.out_gain = in[5]; P.w_out = in[6]; P.ffn_norm = in[7];
    P.dwg = in[8]; P.dwu = in[9]; P.dwd = in[10]; P.router = in[11]; P.mwg = in[12]; P.mwu = in[13]; P.mwd = in[14];
    P.out = args.out; P.ctl = (gu32*)(ws + WS_CTL);
    P.Wqkv_t = (bf16*)(ws + WS_WQKV); P.Wo_t = (bf16*)(ws + WS_WO); P.Wgu_d = ws + WS_WGU_D; P.Wd_d = ws + WS_WD_D; P.Wgu_m = ws + WS_WGU_M; P.Wd_m = ws + WS_WD_M;
    P.QKV = (bf16*)(ws + WS_QKV); P.OB = (bf16*)(ws + WS_O); P.AB = (bf16*)(ws + WS_A); P.AB8 = ws + WS_A; P.ACT = ws + WS_ACT; P.XS = ws + WS_XS;
    P.H = (bf16*)(ws + WS_H); P.YS = (bf16*)(ws + WS_YS); P.kmean = (float*)(ws + WS_MISC + MISC_KMEAN); P.DPO = (bf16*)(ws + WS_DPO); P.DPL = (float*)(ws + WS_DPL);
    P.rsq = (float*)(ws + WS_MISC + MISC_RSQ); P.Wv8 = ws + WS_WV8;
    P.sel_e = (unsigned*)(ws + WS_MISC + MISC_SELE); P.sel_rel = (int*)(ws + WS_MISC + MISC_SELREL); P.sel_g = (float*)(ws + WS_MISC + MISC_SELG); P.sel_pos = (int*)(ws + WS_MISC + MISC_SELPOS);
    return P;
}
__global__ void __launch_bounds__(NWAVES * 64, 2) hybrid_fwd(Args args) {
    extern __shared__ __attribute__((aligned(16))) unsigned char lds[];
    LAS unsigned char* ldsL = (LAS unsigned char*)lds;
    volatile LAS unsigned* MISC = (volatile LAS unsigned*)(ldsL + MISC_OFF);
    const int wave = __builtin_amdgcn_readfirstlane((int)threadIdx.x >> 6);
#define tid (tid_of(wave))
#define lane (lane_id())
    const int G = gridDim.x; int vcu; { const int bx = blockIdx.x; vcu = (G % 8 == 0) ? (bx % 8) * (G / 8) + bx / 8 : bx; }
    for (int u = tid; u < (LDS_BYTES - LDSCTL_OFF) / 4; u += NWAVES * 64) ((LAS unsigned*)(ldsL + LDSCTL_OFF))[u] = 0u;
    __syncthreads();
    int z0 = 0; asm volatile("" : "+s"(z0)); unsigned char* ws0 = args.ws + z0;
    unsigned* const barw = (unsigned*)(ws0 + WS_CTL) + CW_BAR;
    XcdBarrier bar; bar.bar = barw; bar.x = 0; bar.st = nullptr; bar.wv = wave;
    if (!MK_SPLIT) { bar = xcd_barrier_post(barw, MISC + 8, wave); }
    const int lo = args.ph_lo, hi = args.ph_hi;
#define PH(k) (lo <= (k) && (k) < hi)
#define SEAM(a, b) do { if (PH(a) && PH(b)) { int zb_ = 0; asm volatile("" : "+s"(zb_)); XcdBarrier b2_ = bar; b2_.bar = bar.bar + zb_; xcd_barrier(b2_); } } while (0)

    for (int layer = 0; layer < 2; ++layer) {
        const int PB = layer * PPL;
        if (layer == 0 && PH(PB + 0)) {
            const Ptrs P = make_ptrs(args, ws0);
            #ifndef NO_P0
            if (layer == 0) convert_weights(P, ldsL, vcu, G, CV_L0, wave, lane);
            if (layer == 0) norm_rows<false, false, 4>(P.x, P.attn_norm, P.AB, vcu, G, wave, lane);
#endif
        }
        if (layer == 0) SEAM(PB + 0, PB + 1);
        if (PH(PB + 1)) {
            const Ptrs P = make_ptrs(args, ws0);
            const int nqk = NQKV;
            pg8::Gemm g{layer == 0 ? P.AB : P.H, P.Wqkv_t + (size_t)layer * NQKV * D, M, nqk, D}; pg8::StaticOrder S; S.init(M, nqk, G, (int)blockIdx.x);
            pg8::EpiQKV E{P.QKV, NQKV, P.q_gain + layer * 256, P.k_gain + layer * 256, P.kmean, (LAS float*)(ldsL + RING_OFF + RING_BYTES), layer == 0 ? nullptr : P.rsq, 0};
#ifndef NO_P1
            if (layer == 0) pg8::gemm_phase<pg8::EpiQKV, pg8::StaticOrder, true, true>(ldsL + RING_OFF, g, S, E, wave);
            if (layer == 1) { const Ptrs P2 = make_ptrs(args, ws0);
                pg8::Gemm g8{(const bf16*)P2.XS, (const bf16*)P2.Wv8, M, NQKV, D / 2}; pg8::StaticOrder S8; S8.init(M, NQKV, G, (int)blockIdx.x);
                pg8::EpiQKV E8{P2.QKV, NQKV, P2.q_gain + layer * 256, P2.k_gain + layer * 256, P2.kmean, (LAS float*)(ldsL + RING_OFF + RING_BYTES), P2.rsq, 0};
                pg8::gemm_phase<pg8::EpiQKV, pg8::StaticOrder, true, KV8_SP2, true>(ldsL + RING_OFF, g8, S8, E8, wave); }
#endif
        }
        SEAM(PB + 1, PB + 3);
        if (PH(PB + 3)) {
            const Ptrs P = make_ptrs(args, ws0);
            const att::AttnArgs AA{P.QKV, P.OB, P.kmean, P.out_gain + layer * D, P.DPO, P.DPL, (unsigned*)((unsigned char*)P.DPL + (WS_MLIST - WS_DPL)) + (size_t)layer * att::N_SEL * att::MLCAP, (unsigned*)(P.ctl + CW_MCNT + 256 * (layer + args.qoff)), (unsigned*)(P.ctl + CW_MDONE + 64 * (layer + args.qoff)), (layer == WO8_LAYER) ? 1 : 0};
#ifndef NO_P3
            attn_conv_phase(P, AA, layer, (unsigned*)(P.ctl + CW_ATTQ + 64 * (layer + args.qoff)), lds, wave);
#endif
        }
        SEAM(PB + 3, PB + 4);
#ifndef NO_P4B
        if (PH(PB + 4)) { const Ptrs P = make_ptrs(args, ws0); dcombine_phase(P, P.out_gain + layer * D, vcu, G, wave, lane, layer == WO8_LAYER); }
#endif
        SEAM(PB + 4, PB + 5);
        if (PH(PB + 5)) {
            const Ptrs P = make_ptrs(args, ws0);
            pg8::Gemm g{P.OB, P.Wo_t + (size_t)layer * D * D, M, D, D}; pg8::StaticOrder S; S.init(M, D, G, (int)blockIdx.x);
            pg8::EpiResF32 E{layer == 0 ? P.x : nullptr, layer == 0 ? nullptr : P.H, P.H, D, nullptr, nullptr, (LAS float*)(ldsL + RING_OFF + RING_BYTES), nullptr};
#ifndef NO_P4
            if (layer == WO8_LAYER) { pg8::Gemm g8{P.OB, P.Wo_t + (size_t)layer * D * D, M, D, D / 2};
                pg8::gemm_phase<pg8::EpiResF32, pg8::StaticOrder, true, WO8_SP2, true>(ldsL + RING_OFF, g8, S, E, wave); }
            else pg8::gemm_phase<pg8::EpiResF32, pg8::StaticOrder, true, true>(ldsL + RING_OFF, g, S, E, wave);
#endif
        }
        SEAM(PB + 5, PB + 6);
        if (PH(PB + 6)) {
            const Ptrs P = make_ptrs(args, ws0);
#ifndef NO_P5
            if (layer == 0) norm_rows<true, true, 4>(P.H, P.ffn_norm, P.AB8, vcu, G, wave, lane);
            else router_phase(P, P.ffn_norm + D, ldsL, vcu, G, tid, wave, lane);
#endif
        }
        if (layer == 1) {
            SEAM(PB + 6, PB + 7);
#ifndef NO_P6
            if (PH(PB + 7)) { const Ptrs P = make_ptrs(args, ws0); build_tile_table(P, true, MISC, tid); scatter_phase(P, MISC, vcu, G, wave, lane); }
#endif
            SEAM(PB + 7, PB + 8);
        } else SEAM(PB + 6, PB + 8);
        if (PH(PB + 8)) {
            const Ptrs P = make_ptrs(args, ws0);
            build_tile_table(P, layer == 1, MISC, tid);
            pg8::GroupSched S; S.nMt = __builtin_amdgcn_readfirstlane((int)MISC[24]); S.nN = NGU / 256; S.nwg = S.nMt * S.nN;
            const int nconv = (layer == 0) ? (G >= 16 ? G / 16 : 1) : 0, ng = G - nconv; S.G = ng; S.c = (int)blockIdx.x;
            if ((int)blockIdx.x >= ng) { convert_weights(P, ldsL, CV_L0 + CV_DEF - CV_FFN + ((int)blockIdx.x - ng), nconv, CV_L0 + CV_DEF, wave, lane); } else {
            S.t1 = __builtin_amdgcn_readfirstlane((int)MISC[17]); S.t2 = __builtin_amdgcn_readfirstlane((int)MISC[18]); S.t3 = __builtin_amdgcn_readfirstlane((int)MISC[19]); S.t4 = __builtin_amdgcn_readfirstlane((int)MISC[20]);
            S.t5 = __builtin_amdgcn_readfirstlane((int)MISC[21]); S.t6 = __builtin_amdgcn_readfirstlane((int)MISC[22]); S.t7 = __builtin_amdgcn_readfirstlane((int)MISC[23]); S.estride = (size_t)NGU * D; S.nfullM = 1 << 20; S.ntail = 0; S.khalf = 0;
            pg8::Gemm g{(const bf16*)(layer == 0 ? P.AB8 : P.XS), (const bf16*)(layer == 0 ? P.Wgu_d : P.Wgu_m), MPAD, NGU, D / 2};
            pg8::EpiSwiGLU8 E{P.ACT, FF};
#ifndef NO_P7
            pg8::gemm_phase<pg8::EpiSwiGLU8, pg8::GroupSched, true, true, true>(ldsL + RING_OFF, g, S, E, wave);
#endif
            }
        }
        SEAM(PB + 8, PB + 9);
        if (PH(PB + 9)) {
            const Ptrs P = make_ptrs(args, ws0);
            build_tile_table(P, layer == 1, MISC, tid);
            pg8::GroupSched S; S.nMt = __builtin_amdgcn_readfirstlane((int)MISC[24]); S.nN = D / 256; S.nwg = S.nMt * S.nN; S.G = G; S.c = (int)blockIdx.x;
            S.t1 = __builtin_amdgcn_readfirstlane((int)MISC[17]); S.t2 = __builtin_amdgcn_readfirstlane((int)MISC[18]); S.t3 = __builtin_amdgcn_readfirstlane((int)MISC[19]); S.t4 = __builtin_amdgcn_readfirstlane((int)MISC[20]);
            S.t5 = __builtin_amdgcn_readfirstlane((int)MISC[21]); S.t6 = __builtin_amdgcn_readfirstlane((int)MISC[22]); S.t7 = __builtin_amdgcn_readfirstlane((int)MISC[23]); S.estride = (size_t)D * FF;
            if (layer == 1 && S.nMt > 64) { S.nfullM = 64; S.ntail = FF / 128 / 2; S.khalf = FF / 2; S.nwg = 64 * S.nN + 2 * S.nN * (S.nMt - 64); } else { S.nfullM = 1 << 20; S.ntail = 0; S.khalf = 0; }
            pg8::Gemm g{(const bf16*)P.ACT, (const bf16*)(layer == 0 ? P.Wd_d : P.Wd_m), MPAD, D, FF / 2};
            pg8::EpiResF32 E{nullptr, layer == 0 ? P.H : nullptr, layer == 0 ? P.H : P.YS, D, P.YS + (size_t)MPAD * D, layer == 0 ? P.rsq : nullptr, (LAS float*)(ldsL + RING_OFF + RING_BYTES), layer == 0 ? P.XS : nullptr};
#ifndef NO_P8
            pg8::gemm_phase<pg8::EpiResF32, pg8::GroupSched, true, true, true>(ldsL + RING_OFF, g, S, E, wave);
#endif
        }
        if (layer == 0) SEAM(PB + 9, PB + 12);
        else { SEAM(PB + 9, PB + 10);
#ifndef NO_P9
            if (PH(PB + 10)) { const Ptrs P = make_ptrs(args, ws0); combine_phase(P, vcu, G, wave, lane); }
#endif
        }
    }
#undef PH
#undef SEAM
#undef tid
#undef lane
}

extern "C" void kernel_launch(void* const* d_in, const int* in_sizes, int n_in, void* d_out, int out_size, void* d_ws, size_t ws_size, hipStream_t stream) {
    static int grid = 0;
    if (grid == 0) {
        if (n_in != 15 || in_sizes[0] != M * D || out_size != M * D || ws_size < WS_END) { fprintf(stderr, "kernel_launch: unexpected shapes / workspace (n_in %d, in0 %d, out %d, ws %zu < %zu); nothing launched\n", n_in, n_in > 0 ? in_sizes[0] : -1, out_size, ws_size, (size_t)WS_END); grid = -1; return; }
        int dev = 0, cus = 0, per_cu = 0;
        if (hipGetDevice(&dev) != hipSuccess || hipDeviceGetAttribute(&cus, hipDeviceAttributeMultiprocessorCount, dev) != hipSuccess) { fprintf(stderr, "kernel_launch: device query failed\n"); grid = -1; return; }
        if (hipFuncSetAttribute((const void*)hybrid_fwd, hipFuncAttributeMaxDynamicSharedMemorySize, LDS_BYTES) != hipSuccess) { fprintf(stderr, "kernel_launch: hipFuncSetAttribute failed\n"); grid = -1; return; }
        if (hipOccupancyMaxActiveBlocksPerMultiprocessor(&per_cu, (const void*)hybrid_fwd, NWAVES * 64, LDS_BYTES) != hipSuccess || per_cu < 1) fprintf(stderr, "kernel_launch: note: occupancy query reports %d workgroups per CU\n", per_cu);
        (void)hipGetLastError();
        grid = cus;
    }
    if (grid < 0) return;
    if (hipMemsetAsync((char*)d_ws + WS_CTL, 0, CTL_ZERO_BYTES, stream) != hipSuccess) { fprintf(stderr, "kernel_launch: memset failed\n"); return; }
    Args a{};
    for (int i = 0; i < 15; ++i) a.in[i] = (const float*)d_in[i];
    a.out = (float*)d_out; a.ws = (unsigned char*)d_ws;
#if MK_SPLIT
    for (int ph = 0; ph < N_PHASES; ++ph) {
        if (ph == 7 || ph == 10 || ph == 2 || ph == PPL + 2 || ph == PPL) continue;
        a.ph_lo = ph; a.ph_hi = ph + 1; a.qoff = 0;
        hipLaunchKernelGGL(hybrid_fwd, dim3(grid), dim3(NWAVES * 64), LDS_BYTES, stream, a);
#ifdef MK_PROBE_REPEAT
        if (((MK_PROBE_REPEAT) >> ph) & 1) { a.qoff = 2; hipLaunchKernelGGL(hybrid_fwd, dim3(grid), dim3(NWAVES * 64), LDS_BYTES, stream, a); }
#endif
    }
#else
    a.ph_lo = 0; a.ph_hi = N_PHASES;
    hipLaunchKernelGGL(hybrid_fwd, dim3(grid), dim3(NWAVES * 64), LDS_BYTES, stream, a);
#endif
    const hipError_t le = hipPeekAtLastError();
    if (le != hipSuccess) fprintf(stderr, "kernel_launch: launch failed: %s\n", hipGetErrorName(le));
}
```
